# Optimizing an MI355X kernel written in HIP

```python
import math
import jax, jax.numpy as jnp
from jax import lax
import numpy as np

D_MODEL = 1024
BATCH = 16
SEQ = 2048
DEPTH = 2

CHUNK = 64
EPS = 1e-6
N_EVEN = (DEPTH + 1) // 2
N_ODD = DEPTH // 2

A_WIDTH = 512
A_BLOCKS = 8
A_BLOCK = A_WIDTH // A_BLOCKS
CONV_WIDTH = 4
RG_C = 8.0
B_HEADS = 8
B_HEAD_DIM = 64
B_WIDTH = B_HEADS * B_HEAD_DIM
LEFT_CHUNKS = 8
BAND = LEFT_CHUNKS + 1
REL_CLIP = 256
AB_IN = 2 * A_WIDTH + 3 * B_WIDTH
AB_MIX = A_WIDTH + B_WIDTH
C_HEADS = 8
C_DK = 128
C_DV = 128
C_WIDTH = C_HEADS * C_DK
C_IN = 2 * C_HEADS * C_DK + 2 * C_HEADS * C_DV
N_GROUPS = 4
EXPERTS_PER_GROUP = 8
N_EXPERTS = N_GROUPS * EXPERTS_PER_GROUP
TOP_K = 2
D_EXPERT = 512
MOE_BLOCK = 128

kernel_name = "hybrid_rglru_chunkattn_hgrn2_hmoe"


def rms_norm(x, g):
    xf = x.astype(jnp.float32)
    y = xf * lax.rsqrt(jnp.mean(xf * xf, axis=-1, keepdims=True) + EPS)
    return (y * g.astype(jnp.float32)).astype(x.dtype)


def causal_depthwise_conv(x, w, b):
    S = x.shape[1]
    xp = jnp.pad(x, ((0, 0), (CONV_WIDTH - 1, 0), (0, 0)))
    y = b
    for j in range(CONV_WIDTH):
        y = y + w[j] * xp[:, j:j + S]
    return y


def rg_lru(x, w_a, b_a, w_x, b_x, lam):
    B_, S, _ = x.shape
    xb = x.reshape(B_, S, A_BLOCKS, A_BLOCK)
    r = jax.nn.sigmoid((jnp.einsum('bsnc,ncd->bsnd', xb, w_a).reshape(B_, S, A_WIDTH) + b_a).astype(jnp.float32))
    i = jax.nn.sigmoid((jnp.einsum('bsnc,ncd->bsnd', xb, w_x).reshape(B_, S, A_WIDTH) + b_x).astype(jnp.float32))
    log_a = RG_C * r * jax.nn.log_sigmoid(lam.astype(jnp.float32))
    a = jnp.exp(log_a)
    u = jnp.sqrt(-jnp.expm1(2.0 * log_a)) * (i * x.astype(jnp.float32))

    def combine(left, right):
        a1, b1 = left
        a2, b2 = right
        return a1 * a2, a2 * b1 + b2

    _, h = lax.associative_scan(combine, (a, u), axis=1)
    return h.astype(x.dtype)


def chunked_rel_attention(q, k, v, rel_bias):
    B_, S = q.shape[:2]
    NC = S // CHUNK
    qc = q.reshape(B_, NC, CHUNK, B_HEADS, B_HEAD_DIM)
    band_idx = jnp.arange(NC)[:, None] + jnp.arange(BAND)[None, :]

    def gather_band(t):
        tc = t.reshape(B_, NC, CHUNK, B_HEADS, B_HEAD_DIM)
        tp = jnp.pad(tc, ((0, 0), (LEFT_CHUNKS, 0), (0, 0), (0, 0), (0, 0)))
        return tp[:, band_idx].reshape(B_, NC, BAND * CHUNK, B_HEADS, B_HEAD_DIM)

    kb = gather_band(k)
    vb = gather_band(v)
    qpos = jnp.arange(CHUNK)
    kpos = ((jnp.arange(BAND)[:, None] - LEFT_CHUNKS) * CHUNK + jnp.arange(CHUNK)[None, :]).reshape(-1)
    rel = jnp.clip(qpos[:, None] - kpos[None, :], -REL_CLIP, REL_CLIP) + REL_CLIP
    bias = rel_bias[:, rel].astype(jnp.float32)
    valid = (jnp.arange(NC)[:, None] - LEFT_CHUNKS + jnp.arange(BAND)[None, :]) >= 0
    valid = jnp.repeat(valid, CHUNK, axis=1)
    s = jnp.einsum('bcihd,bckhd->bchik', qc, kb, preferred_element_type=jnp.float32) * (B_HEAD_DIM ** -0.5)
    s = s + bias[None, None]
    s = jnp.where(valid[None, :, None, None, :], s, -1e30)
    p = jax.nn.softmax(s, axis=-1)
    o = jnp.einsum('bchik,bckhd->bcihd', p.astype(v.dtype), vb)
    return o.reshape(B_, S, B_WIDTH)


def mixer_ab(h, w_in, conv_w, conv_b, w_a, b_a, w_x, b_x, lam, rel_bias, w_out):
    B_, S = h.shape[:2]
    z = h @ w_in
    xa, ga, q, k, v = jnp.split(z, [A_WIDTH, 2 * A_WIDTH, 2 * A_WIDTH + B_WIDTH, 2 * A_WIDTH + 2 * B_WIDTH], axis=-1)
    ya = rg_lru(causal_depthwise_conv(xa, conv_w, conv_b), w_a, b_a, w_x, b_x, lam) * jax.nn.gelu(ga)
    hs = (B_, S, B_HEADS, B_HEAD_DIM)
    yb = chunked_rel_attention(q.reshape(hs), k.reshape(hs), v.reshape(hs), rel_bias)
    return jnp.concatenate([ya, yb], axis=-1) @ w_out


def hgrn2_mixer(h, w_in, lb, norm_g, w_out):
    B_, S = h.shape[:2]
    NC = S // CHUNK
    f32 = jnp.float32
    z = h @ w_in
    q, fz, i, g = jnp.split(z, [C_HEADS * C_DK, 2 * C_HEADS * C_DK, 2 * C_HEADS * C_DK + C_HEADS * C_DV], axis=-1)
    lbf = lb.astype(f32)
    f = lbf + (1.0 - lbf) * jax.nn.sigmoid(fz.astype(f32))
    log_f = jnp.log(f)
    kk = 1.0 - f
    q = jax.nn.silu(q.astype(f32))

    def heads(t, d):
        return t.astype(f32).reshape(B_, NC, CHUNK, C_HEADS, d).transpose(1, 0, 3, 2, 4)

    qc, kc, lfc, vc = heads(q, C_DK), heads(kk, C_DK), heads(log_f, C_DK), heads(i, C_DV)
    causal = jnp.tril(jnp.ones((CHUNK, CHUNK), dtype=bool))

    def step(state, inp):
        qj, kj, lfj, vj = inp
        b = jnp.cumsum(lfj, axis=-2)
        diff = b[..., :, None, :] - b[..., None, :, :]
        decay = jnp.exp(jnp.where(causal[:, :, None], diff, -jnp.inf))
        attn = jnp.einsum('bhtk,bhsk,bhtsk->bhts', qj, kj, decay)
        o = jnp.einsum('bhts,bhsv->bhtv', attn, vj) + jnp.einsum('bhtk,bhkv->bhtv', qj * jnp.exp(b), state)
        b_last = b[..., -1:, :]
        new_state = jnp.exp(b_last[..., 0, :])[..., None] * state + jnp.einsum('bhsk,bhsv->bhkv', kj * jnp.exp(b_last - b), vj)
        return new_state, o

    s0 = jnp.zeros((B_, C_HEADS, C_DK, C_DV), f32)
    _, o = lax.scan(step, s0, (qc, kc, lfc, vc))
    o = o.transpose(1, 0, 3, 2, 4).reshape(B_, S, C_HEADS, C_DV)
    o = o * lax.rsqrt(jnp.mean(o * o, axis=-1, keepdims=True) + EPS)
    o = o.reshape(B_, S, C_HEADS * C_DV) * norm_g.astype(f32) * jax.nn.silu(g.astype(f32))
    return o.astype(h.dtype) @ w_out


def hier_moe(h, router_group, router_expert, w_gate, w_up, w_down):
    B_, S, D = h.shape
    T = B_ * S
    f32 = jnp.float32
    xt = h.reshape(T, D)
    g_prob = jax.nn.softmax(jnp.dot(xt, router_group, preferred_element_type=f32), axis=-1)
    g_gate, g_idx = lax.top_k(g_prob, 1)
    e_logits = jnp.dot(xt, router_expert, preferred_element_type=f32).reshape(T, N_GROUPS, EXPERTS_PER_GROUP)
    e_sel = e_logits[jnp.arange(T), g_idx[:, 0]]
    e_val, e_idx = lax.top_k(e_sel, TOP_K)
    gate = g_gate * jax.nn.softmax(e_val, axis=-1)
    expert = g_idx * EXPERTS_PER_GROUP + e_idx
    A = T * TOP_K
    e_flat = expert.reshape(A)
    w_flat = gate.reshape(A)
    tok_flat = jnp.repeat(jnp.arange(T, dtype=jnp.int32), TOP_K)
    order = jnp.argsort(e_flat)
    e_sorted = e_flat[order]
    counts = jnp.bincount(e_flat, length=N_EXPERTS)
    padded = (counts + MOE_BLOCK - 1) // MOE_BLOCK * MOE_BLOCK
    pad_end = jnp.cumsum(padded)
    pad_start = pad_end - padded
    start = jnp.cumsum(counts) - counts
    dest = pad_start[e_sorted] + (jnp.arange(A) - start[e_sorted])
    n_blocks = -(-(A + N_EXPERTS * (MOE_BLOCK - 1)) // MOE_BLOCK)
    P = n_blocks * MOE_BLOCK
    slot_tok = jnp.full((P,), T, dtype=jnp.int32).at[dest].set(tok_flat[order])
    slot_w = jnp.zeros((P,), f32).at[dest].set(w_flat[order])
    block_expert = jnp.minimum(jnp.searchsorted(pad_end, jnp.arange(n_blocks) * MOE_BLOCK, side='right'), N_EXPERTS - 1)
    x_pad = jnp.concatenate([xt, jnp.zeros((1, D), xt.dtype)], axis=0)

    def expert_block(args):
        toks, e = args
        xb = x_pad[toks]
        hb = jax.nn.silu(xb @ w_gate[e]) * (xb @ w_up[e])
        return hb @ w_down[e]

    y_blocks = lax.map(expert_block, (slot_tok.reshape(n_blocks, MOE_BLOCK), block_expert))
    y = jax.ops.segment_sum(y_blocks.reshape(P, D).astype(f32) * slot_w[:, None], slot_tok, num_segments=T + 1)[:T]
    return y.astype(h.dtype).reshape(B_, S, D)


def setup_inputs(seed: int = 0) -> dict:
    key = jax.random.key(seed)
    ks = jax.random.split(key, 24)

    def nrm(k, shape, scale):
        return jax.random.normal(k, shape, jnp.float32) * scale

    u = jax.random.uniform(ks[11], (N_EVEN, A_WIDTH), jnp.float32, minval=0.9, maxval=0.999)
    log_a = jnp.log(u) / RG_C
    rg_lambda = log_a - jnp.log(-jnp.expm1(log_a))
    return {
        "x": nrm(ks[0], (BATCH, SEQ, D_MODEL), 1.0),
        "norm_mix_g": 1.0 + nrm(ks[1], (DEPTH, D_MODEL), 0.02),
        "norm_ffn_g": 1.0 + nrm(ks[2], (DEPTH, D_MODEL), 0.02),
        "norm_final_g": 1.0 + nrm(ks[3], (D_MODEL,), 0.02),
        "ab_w_in": nrm(ks[4], (N_EVEN, D_MODEL, AB_IN), D_MODEL ** -0.5),
        "ab_conv_w": nrm(ks[5], (N_EVEN, CONV_WIDTH, A_WIDTH), CONV_WIDTH ** -0.5),
        "ab_conv_b": nrm(ks[6], (N_EVEN, A_WIDTH), 0.01),
        "rg_w_a": nrm(ks[7], (N_EVEN, A_BLOCKS, A_BLOCK, A_BLOCK), A_BLOCK ** -0.5),
        "rg_b_a": nrm(ks[8], (N_EVEN, A_WIDTH), 0.01),
        "rg_w_x": nrm(ks[9], (N_EVEN, A_BLOCKS, A_BLOCK, A_BLOCK), A_BLOCK ** -0.5),
        "rg_b_x": nrm(ks[10], (N_EVEN, A_WIDTH), 0.01),
        "rg_lambda": rg_lambda,
        "attn_rel_bias": nrm(ks[12], (N_EVEN, B_HEADS, 2 * REL_CLIP + 1), 0.1),
        "ab_w_out": nrm(ks[13], (N_EVEN, AB_MIX, D_MODEL), AB_MIX ** -0.5),
        "c_w_in": nrm(ks[14], (N_ODD, D_MODEL, C_IN), D_MODEL ** -0.5),
        "c_lb_logits": nrm(ks[15], (N_ODD + 1, C_WIDTH), 0.5),
        "c_norm_g": 1.0 + nrm(ks[16], (N_ODD, C_HEADS * C_DV), 0.02),
        "c_w_out": nrm(ks[17], (N_ODD, C_HEADS * C_DV, D_MODEL), (C_HEADS * C_DV) ** -0.5),
        "moe_router_group": nrm(ks[18], (DEPTH, D_MODEL, N_GROUPS), D_MODEL ** -0.5),
        "moe_router_expert": nrm(ks[19], (DEPTH, D_MODEL, N_EXPERTS), D_MODEL ** -0.5),
        "moe_w_gate": nrm(ks[20], (DEPTH, N_EXPERTS, D_MODEL, D_EXPERT), D_MODEL ** -0.5),
        "moe_w_up": nrm(ks[21], (DEPTH, N_EXPERTS, D_MODEL, D_EXPERT), D_MODEL ** -0.5),
        "moe_w_down": nrm(ks[22], (DEPTH, N_EXPERTS, D_EXPERT, D_MODEL), D_EXPERT ** -0.5),
    }


def reference(x, norm_mix_g, norm_ffn_g, norm_final_g, ab_w_in, ab_conv_w, ab_conv_b, rg_w_a, rg_b_a, rg_w_x, rg_b_x, rg_lambda, attn_rel_bias, ab_w_out, c_w_in, c_lb_logits, c_norm_g, c_w_out, moe_router_group, moe_router_expert, moe_w_gate, moe_w_up, moe_w_down):
    lb_all = jnp.cumsum(jax.nn.softmax(c_lb_logits.astype(jnp.float32), axis=0), axis=0)
    h = x
    for layer in range(DEPTH):
        j = layer // 2
        hn = rms_norm(h, norm_mix_g[layer])
        if layer % 2 == 0:
            mix = mixer_ab(hn, ab_w_in[j], ab_conv_w[j], ab_conv_b[j], rg_w_a[j], rg_b_a[j], rg_w_x[j], rg_b_x[j], rg_lambda[j], attn_rel_bias[j], ab_w_out[j])
        else:
            mix = hgrn2_mixer(hn, c_w_in[j], lb_all[j], c_norm_g[j], c_w_out[j])
        h = h + mix
        h = h + hier_moe(rms_norm(h, norm_ffn_g[layer]), moe_router_group[layer], moe_router_expert[layer], moe_w_gate[layer], moe_w_up[layer], moe_w_down[layer])
    return rms_norm(h, norm_final_g)
```

```cpp
#include <hip/hip_runtime.h>
#include <hip/hip_cooperative_groups.h>
#include <cstdio>
#include <cstdint>
namespace cg = cooperative_groups;

#ifndef MK_ONE_LAUNCH
#define MK_ONE_LAUNCH 0
#endif

constexpr int T = 32768, D = 1024, SEQ = 2048, NB = 16;
constexpr int AB_IN = 2560, C_IN = 4096;
constexpr int NEXP = 32, DEXP = 512, CAP = 32768;
constexpr int MAXTILES = 288;
constexpr float EPS = 1e-6f;

#define LAS __attribute__((address_space(3)))
typedef unsigned short bf16_t;
typedef short bf16x8 __attribute__((ext_vector_type(8)));
typedef float f32x4 __attribute__((ext_vector_type(4)));
typedef unsigned u32x4 __attribute__((ext_vector_type(4)));
typedef unsigned u32x2 __attribute__((ext_vector_type(2)));

constexpr size_t MiB = 1u << 20;
constexpr size_t WS_CTL = 0, CTL_BYTES = 1 * MiB;
constexpr size_t WS_RSTD = 1 * MiB;
constexpr size_t WS_LB = WS_RSTD + 128 * 1024;
constexpr size_t WS_RGT = WS_LB + 4096;
constexpr size_t WS_RET = WS_RGT + 2 * 4 * 1024 * 4;
constexpr size_t WS_TOKINFO = 2 * MiB;
constexpr size_t WS_LTOK = 3 * MiB, WS_LRSTD = 7 * MiB, WS_LW = 11 * MiB;
constexpr size_t WS_WIN0 = 16 * MiB, WS_WOUT0 = 21 * MiB, WS_WIN1 = 23 * MiB, WS_WOUT1 = 31 * MiB;
constexpr size_t WS_WGU = 34 * MiB, WS_WDN = 98 * MiB;
constexpr size_t WS_XB = 130 * MiB, WS_CAT = 194 * MiB;
constexpr size_t WS_Z = 258 * MiB;
constexpr size_t WS_HB = 258 * MiB, WS_Y = 330 * MiB;
constexpr size_t WS_END = 514 * MiB;
constexpr int CW_CNT = 64;
constexpr int CW_BAR = 4096;

constexpr int RING_BYTES = 131072;
constexpr int TAB_OFF = RING_BYTES;
constexpr int TS_OFF = TAB_OFF + 6 * 1024;
constexpr int LDS_BYTES = 147456;

__device__ __forceinline__ unsigned f2bf(float f) { unsigned u = __float_as_uint(f); return (u + 0x7fffu + ((u >> 16) & 1u)) >> 16; }
__device__ __forceinline__ float bf2f(unsigned b) { return __uint_as_float(b << 16); }
__device__ __forceinline__ unsigned pk2(float lo, float hi) { return f2bf(lo) | (f2bf(hi) << 16); }
__device__ __forceinline__ unsigned cvt_pk_bf16(float lo, float hi) { unsigned r; asm volatile("v_cvt_pk_bf16_f32 %0, %1, %2" : "=v"(r) : "v"(lo), "v"(hi)); return r; }
__device__ __forceinline__ float wave_sum(float v) {
#pragma unroll
    for (int o = 1; o < 64; o <<= 1) v += __shfl_xor(v, o);
    return v;
}
__device__ __forceinline__ float sigmoidf_(float x) { return 1.0f / (1.0f + __expf(-x)); }
__device__ __forceinline__ float siluf_(float x) { return x / (1.0f + __expf(-x)); }
__device__ __forceinline__ float gelu_tanh(float x) { const float u = 0.7978845608028654f * (x + 0.044715f * x * x * x); return 0.5f * x * (1.0f + tanhf(u)); }
#define LDS_WAIT() asm volatile("s_waitcnt lgkmcnt(0)" ::: "memory")

namespace pg8 {
constexpr int BM = 256, BK = 64, HALF = 128, HTB = HALF * BK * 2, NXCD = 8, WGM = 8;
__host__ __device__ __forceinline__ int lds_byte(int r, int c) { const int st = (r >> 4) * 2 + (c >> 5), rr = r & 15, cc = c & 31, ob = rr * 64 + cc * 2; return st * 1024 + (ob ^ (((ob >> 9) & 1) << 5)); }
__host__ __device__ __forceinline__ void stage_rc(int b, int& R, int& C) { const int st = b / 1024, sb = b % 1024, swz = sb ^ (((sb >> 9) & 1) << 5); R = (st >> 1) * 16 + swz / 64; C = (st & 1) * 32 + (swz % 64) / 2; }
__host__ __device__ __forceinline__ int perm32(int rho) { const int n = rho >> 4, i = rho & 15; return 8 * (i >> 2) + 4 * n + (i & 3); }

struct Unit { unsigned boff; int arow, orow, ocol, e, rl, slot; };

struct DenseOrder {
    int nM, nN, nwg, G, c, K;
    __device__ void init(int M, int N, int K_, int G_, int c_) { nM = M / BM; nN = N / BM; nwg = nM * nN; G = G_; c = c_; K = K_; }
    __device__ __forceinline__ bool next(int i, Unit& u) const {
        const long L = (long)i * G + c; if (L >= nwg) return false;
        int wgid = (int)L; { const int q = nwg / NXCD, r = nwg % NXCD, xcd = wgid % NXCD, off = wgid / NXCD; wgid = (xcd < r ? xcd * (q + 1) : r * (q + 1) + (xcd - r) * q) + off; }
        const int nig = WGM * nN, gid = wgid / nig, fm = gid * WGM, gsz = (nM - fm) < WGM ? (nM - fm) : WGM;
        const int pm = __builtin_amdgcn_readfirstlane(fm + ((wgid % nig) % gsz)), pn = __builtin_amdgcn_readfirstlane((wgid % nig) / gsz);
        u.arow = pm * BM; u.orow = pm * BM; u.ocol = pn * BM; u.boff = (unsigned)(pn * BM) * (unsigned)K * 2u; u.e = 0; u.rl = 0; u.slot = i; return true;
    }
    static constexpr bool GATHER = false;
    __device__ __forceinline__ size_t abase(const Unit& u) const { return (size_t)u.arow * (size_t)K * 2u; }
    __device__ __forceinline__ unsigned aoff(const Unit&, int) const { return 0u; }
};
template <bool GATHER_> struct MoeOrder {
    static constexpr bool GATHER = GATHER_;
    const LAS int* ts; const LAS unsigned* tab; int G, vcu, K;
    __device__ __forceinline__ bool next(int i, Unit& u) const {
        const int L = i * G + vcu; const int NT = __builtin_amdgcn_readfirstlane(ts[32]); if (L >= NT * 4) return false;
        const int rt = L >> 2, pn = L & 3; int e = 0;
#pragma unroll
        for (int j = 1; j < 32; ++j) e += (ts[j] <= rt) ? 1 : 0;
        e = __builtin_amdgcn_readfirstlane(e);
        u.e = e; u.rl = rt - __builtin_amdgcn_readfirstlane(ts[e]); u.orow = rt * BM; u.arow = rt * BM; u.ocol = pn * BM; u.boff = (unsigned)(e * 1024 + pn * BM) * (unsigned)K * 2u; u.slot = i; return true;
    }
    __device__ __forceinline__ size_t abase(const Unit& u) const { return GATHER ? (size_t)0 : (size_t)u.arow * (size_t)K * 2u; }
    __device__ __forceinline__ unsigned aoff(const Unit& u, int r) const { return tab[u.slot * 256 + r]; }
};

typedef f32x4 Acc[2][2][4][2];

struct EpiIn {
    static constexpr bool PERM = true;
    bf16_t* O; int ldc; const float* rstd; int silu_lo_end, silu_hi_start;
    __device__ __forceinline__ void operator()(const Acc& acc, const Unit& u, int wr, int wc, int fr, int fq) const {
        const bool act = (u.ocol < silu_lo_end) || (u.ocol >= silu_hi_start);
#pragma unroll
        for (int ai = 0; ai < 2; ++ai)
#pragma unroll
            for (int m = 0; m < 4; ++m) {
                const int row = u.orow + ai * HALF + wr * 64 + m * 16 + fr; const float rs = rstd[row];
                bf16_t* rowp = O + (size_t)row * ldc + u.ocol + wc * 32 + 8 * fq;
#pragma unroll
                for (int bj = 0; bj < 2; ++bj) { f32x4 v0 = acc[ai][bj][m][0] * rs, v1 = acc[ai][bj][m][1] * rs;
                    if (act) {
#pragma unroll
                        for (int j = 0; j < 4; ++j) { v0[j] = siluf_(v0[j]); v1[j] = siluf_(v1[j]); } }
                    u32x4 w; w.x = cvt_pk_bf16(v0[0], v0[1]); w.y = cvt_pk_bf16(v0[2], v0[3]); w.z = cvt_pk_bf16(v1[0], v1[1]); w.w = cvt_pk_bf16(v1[2], v1[3]);
                    *(u32x4*)(rowp + bj * HALF) = w; } }
    }
};
struct EpiOut {
    static constexpr bool PERM = true;
    const float* resid; float* H; bf16_t* XB;
    __device__ __forceinline__ void operator()(const Acc& acc, const Unit& u, int wr, int wc, int fr, int fq) const {
#pragma unroll
        for (int ai = 0; ai < 2; ++ai)
#pragma unroll
            for (int m = 0; m < 4; ++m) {
                const int row = u.orow + ai * HALF + wr * 64 + m * 16 + fr; const size_t off = (size_t)row * D + u.ocol + wc * 32 + 8 * fq;
#pragma unroll
                for (int bj = 0; bj < 2; ++bj) { const f32x4 r0 = *(const f32x4*)(resid + off + bj * HALF), r1 = *(const f32x4*)(resid + off + bj * HALF + 4);
                    const f32x4 v0 = acc[ai][bj][m][0] + r0, v1 = acc[ai][bj][m][1] + r1;
                    *(f32x4*)(H + off + bj * HALF) = v0; *(f32x4*)(H + off + bj * HALF + 4) = v1;
                    u32x4 w; w.x = cvt_pk_bf16(v0[0], v0[1]); w.y = cvt_pk_bf16(v0[2], v0[3]); w.z = cvt_pk_bf16(v1[0], v1[1]); w.w = cvt_pk_bf16(v1[2], v1[3]);
                    *(u32x4*)(XB + off + bj * HALF) = w; } }
    }
};
struct EpiGU {
    static constexpr bool PERM = true;
    bf16_t* HB; const float* lrstd; const LAS int* cnt;
    __device__ __forceinline__ void operator()(const Acc& acc, const Unit& u, int wr, int wc, int fr, int fq) const {
        const int n_e = cnt[u.e];
#pragma unroll
        for (int ai = 0; ai < 2; ++ai)
#pragma unroll
            for (int m = 0; m < 4; ++m) {
                const int r = ai * HALF + wr * 64 + m * 16 + fr, pos = u.rl * BM + r; const float rs = pos < n_e ? lrstd[(size_t)u.e * CAP + pos] : 0.f;
                float h[8];
#pragma unroll
                for (int n = 0; n < 2; ++n)
#pragma unroll
                    for (int j = 0; j < 4; ++j) { const float g = acc[ai][0][m][n][j] * rs, uu = acc[ai][1][m][n][j] * rs; h[n * 4 + j] = siluf_(g) * uu; }
                u32x4 w; w.x = cvt_pk_bf16(h[0], h[1]); w.y = cvt_pk_bf16(h[2], h[3]); w.z = cvt_pk_bf16(h[4], h[5]); w.w = cvt_pk_bf16(h[6], h[7]);
                *(u32x4*)(HB + (size_t)(u.orow + r) * DEXP + (u.ocol >> 1) + wc * 32 + 8 * fq) = w; }
    }
};
struct EpiDN {
    static constexpr bool PERM = true;
    bf16_t* Y; const float* lw; const LAS int* cnt;
    __device__ __forceinline__ void operator()(const Acc& acc, const Unit& u, int wr, int wc, int fr, int fq) const {
        const int n_e = cnt[u.e];
#pragma unroll
        for (int ai = 0; ai < 2; ++ai)
#pragma unroll
            for (int m = 0; m < 4; ++m) {
                const int r = ai * HALF + wr * 64 + m * 16 + fr, pos = u.rl * BM + r; const float ws = pos < n_e ? lw[(size_t)u.e * CAP + pos] : 0.f;
                bf16_t* rowp = Y + (size_t)(u.orow + r) * D + u.ocol + wc * 32 + 8 * fq;
#pragma unroll
                for (int bj = 0; bj < 2; ++bj) { const f32x4 v0 = acc[ai][bj][m][0] * ws, v1 = acc[ai][bj][m][1] * ws;
                    u32x4 w; w.x = cvt_pk_bf16(v0[0], v0[1]); w.y = cvt_pk_bf16(v0[2], v0[3]); w.z = cvt_pk_bf16(v1[0], v1[1]); w.w = cvt_pk_bf16(v1[2], v1[3]);
                    *(u32x4*)(rowp + bj * HALF) = w; } }
    }
};

template <class Epi, class Sched, bool ALIGN_EPI>
__device__ __forceinline__ void gemm_phase(LAS unsigned char* lds, const bf16_t* A, const bf16_t* Bt, const int K, const Sched& S, const Epi& E) {
    const int tid = threadIdx.x, wid = __builtin_amdgcn_readfirstlane(tid >> 6), lane = tid & 63, wr = wid >> 2, wc = wid & 3, fr = lane & 15, fq = lane >> 4;
    const int nt = K / BK;
    unsigned voffB[2], vA0[2], vA1[2];
#pragma unroll
    for (int i = 0; i < 2; ++i) { int R, C; stage_rc(tid * 16 + i * 8192, R, C); const int Rb = Epi::PERM ? ((R & ~31) + perm32(R & 31)) : R;
        vA0[i] = (unsigned)(R * K + C) * 2u; vA1[i] = vA0[i]; voffB[i] = (unsigned)(Rb * K + C) * 2u; }
#define PG8_FILL(u) do { if constexpr (Sched::GATHER) { int tv_ = tid; asm volatile("" : "+v"(tv_)); _Pragma("unroll") for (int i = 0; i < 2; ++i) { int R, C; stage_rc(tv_ * 16 + i * 8192, R, C); \
        vA0[i] = S.aoff(u, R) + (unsigned)C * 2u; vA1[i] = S.aoff(u, HALF + R) + (unsigned)C * 2u; } } } while (0)
    const size_t kstep = (size_t)(BK * 2);
    const size_t hstep = (size_t)HALF * K * 2;
    const unsigned ldsw = (unsigned)wid * 1024u;
    const int aoff = lds_byte(wr * 64 + fr, fq * 8), boff = lds_byte(wc * 32 + fr, fq * 8);
#define PG8_SA(b, h) (((b) * 2 + (h)) * HTB)
#define PG8_SB(b, h) ((4 + (b) * 2 + (h)) * HTB)
#define PG8_STAGE(bufoff, gbase, voff) do { _Pragma("unroll") for (int _i = 0; _i < 2; ++_i) \
        __builtin_amdgcn_global_load_lds((const unsigned*)((const char*)(gbase) + (voff)[_i]), (LAS unsigned*)(lds + (bufoff) + ldsw + _i * 8192), 16, 0, 0); } while (0)
#define PG8_LDA(dst, b, h) do { _Pragma("unroll") for (int m = 0; m < 4; ++m) _Pragma("unroll") for (int k = 0; k < 2; ++k) dst[m][k] = *(const LAS bf16x8*)(lds + PG8_SA(b, h) + aoff + m * 2048 + k * 1024); } while (0)
#define PG8_LDB(dst, b, h) do { _Pragma("unroll") for (int n = 0; n < 2; ++n) _Pragma("unroll") for (int k = 0; k < 2; ++k) dst[n][k] = *(const LAS bf16x8*)(lds + PG8_SB(b, h) + boff + n * 2048 + k * 1024); } while (0)
#define PG8_MMA(ai, bj, At, Bt_) do { __builtin_amdgcn_s_setprio(1); _Pragma("unroll") for (int m = 0; m < 4; ++m) _Pragma("unroll") for (int n = 0; n < 2; ++n) _Pragma("unroll") for (int k = 0; k < 2; ++k) \
        acc[ai][bj][m][n] = __builtin_amdgcn_mfma_f32_16x16x32_bf16(Bt_[n][k], At[m][k], acc[ai][bj][m][n], 0, 0, 0); __builtin_amdgcn_s_setprio(0); } while (0)
#define PG8_WAIT_V(n) asm volatile("s_waitcnt vmcnt(" #n ")" ::: "memory")
#define PG8_WAIT_L(n) asm volatile("s_waitcnt lgkmcnt(" #n ")" ::: "memory")
#define PG8_BAR __builtin_amdgcn_s_barrier()
#define PG8_SCHED __builtin_amdgcn_sched_barrier(0)
    Unit cur, nxt; int ui = 0;
    if (!S.next(0, cur)) return;
    f32x4 acc[2][2][4][2];
#pragma unroll
    for (int a = 0; a < 2; ++a)
#pragma unroll
        for (int b = 0; b < 2; ++b)
#pragma unroll
            for (int m = 0; m < 4; ++m)
#pragma unroll
                for (int n = 0; n < 2; ++n) acc[a][b][m][n] = (f32x4){0.f, 0.f, 0.f, 0.f};
    bf16x8 At[4][2], B0[2][2], B1[2][2];
    PG8_FILL(cur);
    const char* cA0 = (const char*)A + S.abase(cur); const char* cA1 = cA0 + (Sched::GATHER ? (size_t)0 : hstep); const char* cB = (const char*)Bt + cur.boff;
    PG8_STAGE(PG8_SB(0, 0), cB, voffB); PG8_STAGE(PG8_SB(0, 1), cB + hstep, voffB); PG8_STAGE(PG8_SA(0, 0), cA0, vA0); PG8_STAGE(PG8_SA(0, 1), cA1, vA1);
    if (wr == 1) PG8_BAR;
    PG8_WAIT_V(2); PG8_BAR;
    PG8_STAGE(PG8_SB(1, 0), cB + kstep, voffB); PG8_STAGE(PG8_SA(1, 0), cA0 + kstep, vA0); PG8_STAGE(PG8_SB(1, 1), cB + hstep + kstep, voffB);
    PG8_WAIT_V(6); PG8_BAR;
    for (;;) {
        const bool has_next = S.next(ui + 1, nxt);
        const char* nB = has_next ? (const char*)Bt + nxt.boff : cB;
        const char* nA0 = has_next ? (const char*)A + S.abase(nxt) : cA0; const char* nA1 = nA0 + (Sched::GATHER ? (size_t)0 : hstep);
        for (int t = 0; t < nt; t += 2) {
            const bool last = (t == nt - 2);
            const char* a1 = cA1 + (size_t)(t + 1) * kstep;
            const char* a2 = last ? nA0 : cA0 + (size_t)(t + 2) * kstep; const char* a2h = last ? nA1 : cA1 + (size_t)(t + 2) * kstep; const char* b2 = last ? nB : cB + (size_t)(t + 2) * kstep;
            const char* a3 = a2 + kstep; const char* b3 = b2 + kstep;
            PG8_LDB(B0, 0, 0); PG8_LDB(B1, 0, 1); PG8_SCHED; PG8_LDA(At, 0, 0); PG8_STAGE(PG8_SA(1, 1), a1, vA1);
            if (last && has_next) PG8_FILL(nxt);
            PG8_WAIT_V(8); PG8_WAIT_L(0); PG8_BAR; PG8_MMA(0, 0, At, B0); PG8_MMA(0, 1, At, B1); PG8_BAR; PG8_SCHED;
            PG8_LDA(At, 0, 1); PG8_STAGE(PG8_SB(0, 0), b2, voffB); PG8_STAGE(PG8_SB(0, 1), b2 + hstep, voffB); PG8_STAGE(PG8_SA(0, 0), a2, vA0);
            PG8_WAIT_V(8); PG8_WAIT_L(0); PG8_BAR; PG8_MMA(1, 0, At, B0); PG8_MMA(1, 1, At, B1); PG8_BAR; PG8_SCHED;
            PG8_LDB(B0, 1, 0); PG8_LDB(B1, 1, 1); PG8_SCHED; PG8_LDA(At, 1, 0); PG8_STAGE(PG8_SA(0, 1), a2h, vA1);
            PG8_WAIT_V(8); PG8_WAIT_L(0); PG8_BAR; PG8_MMA(0, 0, At, B0); PG8_MMA(0, 1, At, B1); PG8_BAR; PG8_SCHED;
            PG8_LDA(At, 1, 1); PG8_STAGE(PG8_SB(1, 0), b3, voffB); PG8_STAGE(PG8_SB(1, 1), b3 + hstep, voffB); PG8_STAGE(PG8_SA(1, 0), a3, vA0);
            PG8_WAIT_V(8); PG8_WAIT_L(0); PG8_BAR; PG8_MMA(1, 0, At, B0); PG8_MMA(1, 1, At, B1); PG8_BAR; PG8_SCHED;
        }
        if constexpr (ALIGN_EPI) { if (wr == 0) PG8_BAR; }
        E(acc, cur, wr, wc, fr, fq);
        if (!has_next) break;
#pragma unroll
        for (int a = 0; a < 2; ++a)
#pragma unroll
            for (int b = 0; b < 2; ++b)
#pragma unroll
                for (int m = 0; m < 4; ++m)
#pragma unroll
                    for (int n = 0; n < 2; ++n) acc[a][b][m][n] = (f32x4){0.f, 0.f, 0.f, 0.f};
        cur = nxt; cB = nB; cA0 = nA0; cA1 = nA1; ++ui;
        if constexpr (ALIGN_EPI) { if (wr == 1) PG8_BAR; }
    }
    PG8_WAIT_V(0);
    if constexpr (!ALIGN_EPI) { if (wr == 0) PG8_BAR; }
    PG8_BAR;
#undef PG8_FILL
#undef PG8_SA
#undef PG8_SB
#undef PG8_STAGE
#undef PG8_LDA
#undef PG8_LDB
#undef PG8_MMA
#undef PG8_WAIT_V
#undef PG8_WAIT_L
#undef PG8_BAR
#undef PG8_SCHED
}
}

struct Args { const float* in[23]; float* out; unsigned char* ws; int ph_lo, ph_hi; };
enum { PH_PRO = 0, PH_IN0, PH_MIX0, PH_OUT0, PH_R1, PH_GU0, PH_DN0, PH_R2, PH_IN1, PH_MIX1, PH_OUT1, PH_R3, PH_GU1, PH_DN1, PH_R4, NPH };

struct Frame {
    LAS unsigned char* lds; int tid, lane, wave, vcu, G;
    const float* const* in; float* out; unsigned char* ws;
};

__device__ __forceinline__ void transpose_item(const float* W, int K, int N, const float* kscale, bf16_t* WT, int dest_row0, LAS float* scr, int kb, int nb, int lane) {
    const int k0 = 64 * kb, n0 = 32 * nb;
#pragma unroll 8
    for (int i = 0; i < 32; ++i) { const int kk = 2 * i + (lane >> 5); float v = W[(size_t)(k0 + kk) * N + n0 + (lane & 31)]; if (kscale) v *= kscale[k0 + kk]; scr[kk * 33 + (lane & 31)] = v; }
    LDS_WAIT(); asm volatile("" ::: "memory");
    const int c = lane & 7;
#pragma unroll
    for (int j = 0; j < 4; ++j) { const int n = (lane >> 3) + 8 * j; const LAS float* s = scr + (8 * c) * 33 + n;
        u32x4 o; o.x = pk2(s[0 * 33], s[1 * 33]); o.y = pk2(s[2 * 33], s[3 * 33]); o.z = pk2(s[4 * 33], s[5 * 33]); o.w = pk2(s[6 * 33], s[7 * 33]);
        *(u32x4*)(WT + (size_t)(dest_row0 + n) * K + k0 + 8 * c) = o; }
    LDS_WAIT(); asm volatile("" ::: "memory");
}
__device__ __forceinline__ void moe_convert(Frame& F, int layer) {
    LAS float* scr = (LAS float*)(F.lds + F.wave * 16384);
    const int gw = F.vcu * 8 + F.wave, NGW = F.G * 8;
    const float* gffn = F.in[2] + layer * D;
    const float* Wg = F.in[20] + (size_t)layer * NEXP * D * DEXP; const float* Wu = F.in[21] + (size_t)layer * NEXP * D * DEXP; const float* Wd = F.in[22] + (size_t)layer * NEXP * DEXP * D;
    bf16_t* WGU = (bf16_t*)(F.ws + WS_WGU); bf16_t* WDN = (bf16_t*)(F.ws + WS_WDN);
    for (int it = gw; it < 3 * 8192; it += NGW) {
        const int which = it >> 13, r = it & 8191, e = r >> 8, q = r & 255;
        if (which < 2) { const int kb = q >> 4, nb = q & 15, n0 = nb * 32;
            const int dest = e * 1024 + (n0 >> 7) * 256 + (which ? 128 : 0) + (n0 & 127);
            transpose_item((which ? Wu : Wg) + (size_t)e * D * DEXP, D, DEXP, gffn, WGU, dest, scr, kb, nb, F.lane);
        } else { const int kb = q >> 5, nb = q & 31;
            transpose_item(Wd + (size_t)e * DEXP * D, DEXP, D, nullptr, WDN, e * 1024 + nb * 32, scr, kb, nb, F.lane); }
    }
}
__device__ __forceinline__ void p_prologue(Frame& F) {
    LAS float* scr = (LAS float*)(F.lds + F.wave * 16384);
    const int gw = F.vcu * 8 + F.wave, NGW = F.G * 8;
    constexpr int I0 = 16 * 80, I1 = 16 * 32, I2 = 16 * 128, I3 = 16 * 32;
    for (int it = gw; it < I0 + I1 + I2 + I3; it += NGW) {
        int r = it;
        if (r < I0) { transpose_item(F.in[4], D, AB_IN, F.in[1], (bf16_t*)(F.ws + WS_WIN0), (r % 80) * 32, scr, r / 80, r % 80, F.lane); continue; } r -= I0;
        if (r < I1) { transpose_item(F.in[13], D, D, nullptr, (bf16_t*)(F.ws + WS_WOUT0), (r % 32) * 32, scr, r / 32, r % 32, F.lane); continue; } r -= I1;
        if (r < I2) { transpose_item(F.in[14], D, C_IN, F.in[1] + D, (bf16_t*)(F.ws + WS_WIN1), (r % 128) * 32, scr, r / 128, r % 128, F.lane); continue; } r -= I2;
        transpose_item(F.in[17], D, D, nullptr, (bf16_t*)(F.ws + WS_WOUT1), (r % 32) * 32, scr, r / 32, r % 32, F.lane);
    }
    moe_convert(F, 0);
    { const float* x = F.in[0]; bf16_t* XB = (bf16_t*)(F.ws + WS_XB); float* rstd = (float*)(F.ws + WS_RSTD);
      for (int m = gw; m < T; m += NGW) { const f32x4* xr = (const f32x4*)(x + (size_t)m * D) + F.lane; f32x4 v[4]; float s = 0.f;
#pragma unroll
          for (int j = 0; j < 4; ++j) { v[j] = xr[64 * j]; s += (v[j].x * v[j].x + v[j].y * v[j].y) + (v[j].z * v[j].z + v[j].w * v[j].w); }
          s = wave_sum(s); if (F.lane == 0) rstd[m] = rsqrtf(s * (1.f / D) + EPS);
          u32x2* o8 = (u32x2*)(XB + (size_t)m * D) + F.lane;
#pragma unroll
          for (int j = 0; j < 4; ++j) o8[64 * j] = (u32x2){pk2(v[j].x, v[j].y), pk2(v[j].z, v[j].w)}; } }
    const int gt = F.vcu * 512 + F.tid, NGT = F.G * 512;
    { float* lb = (float*)(F.ws + WS_LB); const float* l = F.in[15];
      for (int c = gt; c < 1024; c += NGT) { const float a = l[c], b = l[1024 + c], mx = fmaxf(a, b), ea = __expf(a - mx), eb = __expf(b - mx); lb[c] = ea / (ea + eb); } }
    { float* RgT = (float*)(F.ws + WS_RGT); float* ReT = (float*)(F.ws + WS_RET);
      for (int i = gt; i < 2 * 36 * 1024; i += NGT) { const int l = i / (36 * 1024), r = i % (36 * 1024), j = r >> 10, c = r & 1023; const float g = F.in[2][l * D + c];
          if (j < 4) RgT[(l * 4 + j) * 1024 + c] = g * F.in[18][((size_t)l * D + c) * 4 + j];
          else ReT[(l * 32 + (j - 4)) * 1024 + c] = g * F.in[19][((size_t)l * D + c) * 32 + (j - 4)]; } }
}

__device__ __forceinline__ void moe_tables(Frame& F, int layer) {
    LAS int* ts = (LAS int*)(F.lds + TS_OFF); LAS int* cn = ts + 40;
    const unsigned* cnt = (const unsigned*)(F.ws + WS_CTL) + CW_CNT + layer * 32;
    __syncthreads();
    if (F.tid < 32) cn[F.tid] = (int)__hip_atomic_load(cnt + F.tid, __ATOMIC_RELAXED, __HIP_MEMORY_SCOPE_AGENT);
    __syncthreads();
    if (F.tid == 0) { int s = 0; for (int e = 0; e < 32; ++e) { ts[e] = s; s += (cn[e] + 255) >> 8; } ts[32] = s; }
    __syncthreads();
}

__device__ __forceinline__ void p_router(Frame& F, int layer) {
    const int gw = F.vcu * 8 + F.wave, NGW = F.G * 8;
    const float* H = F.out; const float* RgT = (const float*)(F.ws + WS_RGT) + layer * 4 * 1024; const float* ReT = (const float*)(F.ws + WS_RET) + layer * 32 * 1024;
    unsigned* cnt = (unsigned*)(F.ws + WS_CTL) + CW_CNT + layer * 32;
    int* ltok = (int*)(F.ws + WS_LTOK); float* lrstd = (float*)(F.ws + WS_LRSTD); float* lw = (float*)(F.ws + WS_LW); int* tokinfo = (int*)(F.ws + WS_TOKINFO);
    for (int m = gw; m < T; m += NGW) {
        const f32x4* hr = (const f32x4*)(H + (size_t)m * D) + F.lane; f32x4 v[4]; float s = 0.f;
#pragma unroll
        for (int j = 0; j < 4; ++j) { v[j] = hr[64 * j]; s += (v[j].x * v[j].x + v[j].y * v[j].y) + (v[j].z * v[j].z + v[j].w * v[j].w); }
        const float rstd = rsqrtf(wave_sum(s) * (1.f / D) + EPS);
        float lg[4];
#pragma unroll
        for (int gi = 0; gi < 4; ++gi) { const f32x4* w = (const f32x4*)(RgT + gi * 1024) + F.lane; float a = 0.f;
#pragma unroll
            for (int j = 0; j < 4; ++j) { const f32x4 ww = w[64 * j]; a += (v[j].x * ww.x + v[j].y * ww.y) + (v[j].z * ww.z + v[j].w * ww.w); }
            lg[gi] = wave_sum(a) * rstd; }
        int gidx = 0; float gmax = lg[0];
#pragma unroll
        for (int gi = 1; gi < 4; ++gi) if (lg[gi] > gmax) { gmax = lg[gi]; gidx = gi; }
        float gs = 0.f;
#pragma unroll
        for (int gi = 0; gi < 4; ++gi) gs += __expf(lg[gi] - gmax);
        const float ggate = 1.f / gs;
        gidx = __builtin_amdgcn_readfirstlane(gidx);
        float le[8];
#pragma unroll
        for (int e = 0; e < 8; ++e) { const f32x4* w = (const f32x4*)(ReT + (gidx * 8 + e) * 1024) + F.lane; float a = 0.f;
#pragma unroll
            for (int j = 0; j < 4; ++j) { const f32x4 ww = w[64 * j]; a += (v[j].x * ww.x + v[j].y * ww.y) + (v[j].z * ww.z + v[j].w * ww.w); }
            le[e] = wave_sum(a) * rstd; }
        int i0 = 0; float v0 = le[0];
#pragma unroll
        for (int e = 1; e < 8; ++e) if (le[e] > v0) { v0 = le[e]; i0 = e; }
        int i1 = -1; float v1 = -3.0e38f;
#pragma unroll
        for (int e = 0; e < 8; ++e) if (e != i0 && le[e] > v1) { v1 = le[e]; i1 = e; }
        const float ex = __expf(v1 - v0), w0 = ggate / (1.f + ex), w1 = ggate * ex / (1.f + ex);
        if (F.lane == 0) {
            ((float*)(F.ws + WS_RSTD))[m] = rstd;
            const int e0 = gidx * 8 + i0, e1 = gidx * 8 + i1;
            const unsigned p0 = atomicAdd(cnt + e0, 1u), p1 = atomicAdd(cnt + e1, 1u);
            ltok[(size_t)e0 * CAP + p0] = m; lrstd[(size_t)e0 * CAP + p0] = rstd; lw[(size_t)e0 * CAP + p0] = w0;
            ltok[(size_t)e1 * CAP + p1] = m; lrstd[(size_t)e1 * CAP + p1] = rstd; lw[(size_t)e1 * CAP + p1] = w1;
            tokinfo[2 * m] = e0 * CAP + (int)p0; tokinfo[2 * m + 1] = e1 * CAP + (int)p1;
        }
    }
}
__device__ __forceinline__ void p_combine(Frame& F, int layer, int mode) {
    moe_tables(F, layer);
    const LAS int* ts = (const LAS int*)(F.lds + TS_OFF);
    const int gw = F.vcu * 8 + F.wave, NGW = F.G * 8;
    float* H = F.out; const bf16_t* Y = (const bf16_t*)(F.ws + WS_Y); const int* tokinfo = (const int*)(F.ws + WS_TOKINFO);
    bf16_t* XB = (bf16_t*)(F.ws + WS_XB); float* rstd = (float*)(F.ws + WS_RSTD); const float* gfin = F.in[3];
    for (int m = gw; m < T; m += NGW) {
        const int t0 = tokinfo[2 * m], t1 = tokinfo[2 * m + 1];
        const size_t s0 = (size_t)ts[t0 >> 15] * 256 + (t0 & (CAP - 1)), s1 = (size_t)ts[t1 >> 15] * 256 + (t1 & (CAP - 1));
        f32x4* hr = (f32x4*)(H + (size_t)m * D) + F.lane; const u32x2* y0 = (const u32x2*)(Y + s0 * D) + F.lane; const u32x2* y1 = (const u32x2*)(Y + s1 * D) + F.lane;
        f32x4 v[4]; float s = 0.f;
#pragma unroll
        for (int j = 0; j < 4; ++j) { v[j] = hr[64 * j]; const u32x2 a = y0[64 * j], b = y1[64 * j];
            v[j].x += bf2f(a.x & 0xffffu) + bf2f(b.x & 0xffffu); v[j].y += bf2f(a.x >> 16) + bf2f(b.x >> 16); v[j].z += bf2f(a.y & 0xffffu) + bf2f(b.y & 0xffffu); v[j].w += bf2f(a.y >> 16) + bf2f(b.y >> 16);
            s += (v[j].x * v[j].x + v[j].y * v[j].y) + (v[j].z * v[j].z + v[j].w * v[j].w); }
        const float rs = rsqrtf(wave_sum(s) * (1.f / D) + EPS);
        if (mode == 0) {
            if (F.lane == 0) rstd[m] = rs;
            u32x2* o8 = (u32x2*)(XB + (size_t)m * D) + F.lane;
#pragma unroll
            for (int j = 0; j < 4; ++j) { hr[64 * j] = v[j]; o8[64 * j] = (u32x2){pk2(v[j].x, v[j].y), pk2(v[j].z, v[j].w)}; }
        } else {
            const f32x4* g4 = (const f32x4*)gfin + F.lane;
#pragma unroll
            for (int j = 0; j < 4; ++j) { const f32x4 g = g4[64 * j]; hr[64 * j] = (f32x4){v[j].x * rs * g.x, v[j].y * rs * g.y, v[j].z * rs * g.z, v[j].w * rs * g.w}; }
        }
    }
}

__device__ __forceinline__ void mix_rglru_item(Frame& F, int b, int nb) {
    LAS float* L = (LAS float*)F.lds;
    LAS float* wa = L; LAS float* wx = L + 4096; LAS float* xat = L + 8192;   LAS float* xc = xat + 67 * 64; LAS float* ga = xc + 4096; LAS float* av = ga + 4096; LAS float* uv = av + 4096; LAS float* prm = uv + 4096;
    const bf16_t* Z = (const bf16_t*)(F.ws + WS_Z); bf16_t* CAT = (bf16_t*)(F.ws + WS_CAT);
    const int tid = F.tid;
    __syncthreads();
    for (int i = tid; i < 4096; i += 512) { wa[i] = F.in[7][nb * 4096 + i]; wx[i] = F.in[9][nb * 4096 + i]; }
    if (tid < 64) { const int c = nb * 64 + tid; prm[tid] = F.in[6][c]; prm[64 + tid] = F.in[5][c]; prm[128 + tid] = F.in[5][512 + c]; prm[192 + tid] = F.in[5][1024 + c]; prm[256 + tid] = F.in[5][1536 + c];
        prm[320 + tid] = F.in[8][c]; prm[384 + tid] = F.in[10][c]; const float lam = F.in[11][c]; prm[448 + tid] = fminf(lam, 0.f) - log1pf(__expf(-fabsf(lam))); }
    float hcar = 0.f;
    for (int t0 = 0; t0 < SEQ; t0 += 64) {
        __syncthreads();
        for (int i = tid; i < 67 * 64; i += 512) { const int r = i >> 6, c = i & 63, tg = t0 - 3 + r; xat[i] = tg >= 0 ? bf2f(Z[((size_t)b * SEQ + tg) * AB_IN + nb * 64 + c]) : 0.f; }
        for (int i = tid; i < 4096; i += 512) { const int r = i >> 6, c = i & 63; ga[i] = bf2f(Z[((size_t)b * SEQ + t0 + r) * AB_IN + 512 + nb * 64 + c]); }
        __syncthreads();
        for (int i = tid; i < 4096; i += 512) { const int r = i >> 6, c = i & 63; xc[i] = prm[c] + prm[64 + c] * xat[r * 64 + c] + prm[128 + c] * xat[(r + 1) * 64 + c] + prm[192 + c] * xat[(r + 2) * 64 + c] + prm[256 + c] * xat[(r + 3) * 64 + c]; }
        __syncthreads();
        { const int tok = tid >> 3, dg = tid & 7; float aa[8], ax[8];
#pragma unroll
          for (int j = 0; j < 8; ++j) { aa[j] = 0.f; ax[j] = 0.f; }
          for (int c = 0; c < 64; ++c) { const float xv = xc[tok * 64 + c]; const LAS f32x4* pa = (const LAS f32x4*)(wa + c * 64 + dg * 8); const LAS f32x4* px = (const LAS f32x4*)(wx + c * 64 + dg * 8);
              const f32x4 a0 = pa[0], a1 = pa[1], x0 = px[0], x1 = px[1];
              aa[0] += xv * a0.x; aa[1] += xv * a0.y; aa[2] += xv * a0.z; aa[3] += xv * a0.w; aa[4] += xv * a1.x; aa[5] += xv * a1.y; aa[6] += xv * a1.z; aa[7] += xv * a1.w;
              ax[0] += xv * x0.x; ax[1] += xv * x0.y; ax[2] += xv * x0.z; ax[3] += xv * x0.w; ax[4] += xv * x1.x; ax[5] += xv * x1.y; ax[6] += xv * x1.z; ax[7] += xv * x1.w; }
#pragma unroll
          for (int j = 0; j < 8; ++j) { const int d = dg * 8 + j; const float r = sigmoidf_(aa[j] + prm[320 + d]), ig = sigmoidf_(ax[j] + prm[384 + d]);
              const float la = 8.0f * r * prm[448 + d]; av[tok * 64 + d] = __expf(la); uv[tok * 64 + d] = sqrtf(fmaxf(-expm1f(2.0f * la), 0.f)) * (ig * xc[tok * 64 + d]); } }
        __syncthreads();
        if (tid < 64) { for (int r = 0; r < 64; ++r) { hcar = av[r * 64 + tid] * hcar + uv[r * 64 + tid]; av[r * 64 + tid] = hcar; } }
        __syncthreads();
        for (int i = tid; i < 4096; i += 512) { const int r = i >> 6, c = i & 63; CAT[((size_t)b * SEQ + t0 + r) * D + nb * 64 + c] = (bf16_t)f2bf(av[i] * gelu_tanh(ga[i])); }
    }
    __syncthreads();
}
__device__ __forceinline__ void mix_attn_item(Frame& F, int b, int c, int h) {
    LAS float* Ks = (LAS float*)F.lds;   LAS float* Vs = Ks + 64 * 68;   LAS float* bs = Vs + 4096;   LAS float* Ss = bs + 520;
    const bf16_t* Z = (const bf16_t*)(F.ws + WS_Z); bf16_t* CAT = (bf16_t*)(F.ws + WS_CAT);
    const int tid = F.tid, t = tid >> 3, sub = tid & 7;
    __syncthreads();
    for (int i = tid; i < 513; i += 512) bs[i] = F.in[12][h * 513 + i];
    unsigned q2[32]; float o[64];
    { const unsigned* qp = (const unsigned*)(Z + ((size_t)b * SEQ + c * 64 + t) * AB_IN + 1024 + h * 64);
#pragma unroll
      for (int d = 0; d < 32; ++d) q2[d] = qp[d];
#pragma unroll
      for (int d = 0; d < 64; ++d) o[d] = 0.f; }
    float mrun = -3.0e38f, lrun = 0.f;
    for (int kc = (c >= 8 ? c - 8 : 0); kc <= c; ++kc) {
        __syncthreads();
        for (int i = tid; i < 4096; i += 512) { const int s = i >> 6, d = i & 63; const size_t base = ((size_t)b * SEQ + kc * 64 + s) * AB_IN + h * 64 + d;
            Ks[s * 68 + d] = bf2f(Z[base + 1536]); Vs[s * 64 + d] = bf2f(Z[base + 2048]); }
        __syncthreads();
        float tmax = -3.0e38f;
#pragma unroll 1
        for (int jj = 0; jj < 8; ++jj) { const int s = sub + 8 * jj; const LAS f32x4* kp = (const LAS f32x4*)(Ks + s * 68); float a = 0.f;
#pragma unroll
            for (int d4 = 0; d4 < 16; ++d4) { const f32x4 kv = kp[d4]; a += bf2f(q2[2 * d4] & 0xffffu) * kv.x + bf2f(q2[2 * d4] >> 16) * kv.y + bf2f(q2[2 * d4 + 1] & 0xffffu) * kv.z + bf2f(q2[2 * d4 + 1] >> 16) * kv.w; }
            a *= 0.125f;
            int rel = t - ((kc - c) * 64 + s); rel = rel < -256 ? -256 : (rel > 256 ? 256 : rel);
            a += bs[rel + 256]; Ss[t * 65 + s] = a; tmax = fmaxf(tmax, a); }
        const float mnew = fmaxf(mrun, tmax), f = __expf(mrun - mnew);
        lrun *= f;
#pragma unroll
        for (int d = 0; d < 64; ++d) o[d] *= f;
#pragma unroll 1
        for (int jj = 0; jj < 8; ++jj) { const int s = sub + 8 * jj; const float p = __expf(Ss[t * 65 + s] - mnew); lrun += p; const LAS f32x4* vp = (const LAS f32x4*)(Vs + s * 64);
#pragma unroll
            for (int d4 = 0; d4 < 16; ++d4) { const f32x4 vv = vp[d4]; o[4 * d4] += p * vv.x; o[4 * d4 + 1] += p * vv.y; o[4 * d4 + 2] += p * vv.z; o[4 * d4 + 3] += p * vv.w; } }
        mrun = mnew;
    }
    float mall = mrun;
    mall = fmaxf(mall, __shfl_xor(mall, 1)); mall = fmaxf(mall, __shfl_xor(mall, 2)); mall = fmaxf(mall, __shfl_xor(mall, 4));
    const float f = __expf(mrun - mall); lrun *= f;
    lrun += __shfl_xor(lrun, 1); lrun += __shfl_xor(lrun, 2); lrun += __shfl_xor(lrun, 4);
    const float inv = 1.0f / lrun;
    bf16_t* op = CAT + ((size_t)b * SEQ + c * 64 + t) * D + 512 + h * 64;
#pragma unroll
    for (int d = 0; d < 64; ++d) { float v = o[d] * f; v += __shfl_xor(v, 1); v += __shfl_xor(v, 2); v += __shfl_xor(v, 4); if ((d >> 3) == sub) op[d] = (bf16_t)f2bf(v * inv); }
}
__device__ __forceinline__ void p_mix0(Frame& F) {
    if (F.vcu < 128) mix_rglru_item(F, F.vcu >> 3, F.vcu & 7);
    for (int it = F.vcu; it < NB * 32 * 8; it += F.G) mix_attn_item(F, it >> 8, (it >> 3) & 31, it & 7);
}
__device__ __forceinline__ void mix_hgrn_item(Frame& F, int b, int h) {
    LAS float* L = (LAS float*)F.lds;
    LAS float* qs = L; LAS float* fs = L + 4096; LAS float* is = L + 8192; LAS float* gs = L + 12288; LAS float* op = L + 16384;
    const bf16_t* Z = (const bf16_t*)(F.ws + WS_Z); bf16_t* CAT = (bf16_t*)(F.ws + WS_CAT); const float* lb = (const float*)(F.ws + WS_LB); const float* ng = F.in[16];
    const int tid = F.tid, v = tid & 127, kq = tid >> 7;
    float S[32];
#pragma unroll
    for (int k = 0; k < 32; ++k) S[k] = 0.f;
    for (int t0 = 0; t0 < SEQ; t0 += 32) {
        __syncthreads();
        for (int i = tid; i < 4096; i += 512) { const int r = i >> 7, c = i & 127; const bf16_t* zr = Z + ((size_t)b * SEQ + t0 + r) * C_IN + h * 128 + c;
            qs[i] = bf2f(zr[0]); const float l = lb[h * 128 + c]; fs[i] = l + (1.f - l) * sigmoidf_(bf2f(zr[1024])); is[i] = bf2f(zr[2048]); gs[i] = bf2f(zr[3072]); }
        __syncthreads();
        for (int r = 0; r < 32; ++r) { const float iv = is[r * 128 + v]; float o = 0.f;
#pragma unroll
            for (int k4 = 0; k4 < 8; ++k4) { const f32x4 f4 = *(const LAS f32x4*)(fs + r * 128 + kq * 32 + 4 * k4), q4 = *(const LAS f32x4*)(qs + r * 128 + kq * 32 + 4 * k4);
                S[4 * k4] = f4.x * S[4 * k4] + (1.f - f4.x) * iv; o += q4.x * S[4 * k4];
                S[4 * k4 + 1] = f4.y * S[4 * k4 + 1] + (1.f - f4.y) * iv; o += q4.y * S[4 * k4 + 1];
                S[4 * k4 + 2] = f4.z * S[4 * k4 + 2] + (1.f - f4.z) * iv; o += q4.z * S[4 * k4 + 2];
                S[4 * k4 + 3] = f4.w * S[4 * k4 + 3] + (1.f - f4.w) * iv; o += q4.w * S[4 * k4 + 3]; }
            op[(r * 4 + kq) * 128 + v] = o; }
        __syncthreads();
#pragma unroll
        for (int rr = 0; rr < 4; ++rr) { const int r = F.wave * 4 + rr; const int l = F.lane;
            const float o1 = op[(r * 4 + 0) * 128 + l] + op[(r * 4 + 1) * 128 + l] + op[(r * 4 + 2) * 128 + l] + op[(r * 4 + 3) * 128 + l];
            const float o2 = op[(r * 4 + 0) * 128 + 64 + l] + op[(r * 4 + 1) * 128 + 64 + l] + op[(r * 4 + 2) * 128 + 64 + l] + op[(r * 4 + 3) * 128 + 64 + l];
            const float rinv = rsqrtf(wave_sum(o1 * o1 + o2 * o2) * (1.f / 128.f) + EPS);
            bf16_t* cp = CAT + ((size_t)b * SEQ + t0 + r) * D + h * 128;
            cp[l] = (bf16_t)f2bf(o1 * rinv * ng[h * 128 + l] * gs[r * 128 + l]); cp[64 + l] = (bf16_t)f2bf(o2 * rinv * ng[h * 128 + 64 + l] * gs[r * 128 + 64 + l]); }
    }
    __syncthreads();
}

__device__ __forceinline__ void p_gu(Frame& F, int layer) {
    unsigned char* ws = F.ws;
    moe_tables(F, layer);
    const LAS int* ts = (const LAS int*)(F.lds + TS_OFF); LAS unsigned* tab = (LAS unsigned*)(F.lds + TAB_OFF);
    pg8::MoeOrder<true> S{ts, tab, F.G, F.vcu, D};
    { const int* ltok = (const int*)(ws + WS_LTOK); pg8::Unit u;
      for (int i = 0; i < 6 && S.next(i, u); ++i) if (F.tid < 256) { const int pos = u.rl * 256 + F.tid; const int tok = pos < ts[40 + u.e] ? ltok[(size_t)u.e * CAP + pos] : 0; tab[i * 256 + F.tid] = (unsigned)tok * (unsigned)(D * 2); }
      __syncthreads(); }
    pg8::EpiGU E{(bf16_t*)(ws + WS_HB), (const float*)(ws + WS_LRSTD), ts + 40};
    pg8::gemm_phase<pg8::EpiGU, pg8::MoeOrder<true>, true>(F.lds, (const bf16_t*)(ws + WS_XB), (const bf16_t*)(ws + WS_WGU), D, S, E);
}
__device__ __forceinline__ void p_dn(Frame& F, int layer) {
    unsigned char* ws = F.ws;
    moe_tables(F, layer);
    const LAS int* ts = (const LAS int*)(F.lds + TS_OFF);
    pg8::MoeOrder<false> S{ts, nullptr, F.G, F.vcu, DEXP};
    pg8::EpiDN E{(bf16_t*)(ws + WS_Y), (const float*)(ws + WS_LW), ts + 40};
    pg8::gemm_phase<pg8::EpiDN, pg8::MoeOrder<false>, true>(F.lds, (const bf16_t*)(ws + WS_HB), (const bf16_t*)(ws + WS_WDN), DEXP, S, E);
}

__global__ void __launch_bounds__(512, 2) fwd(Args args) {
    extern __shared__ __attribute__((aligned(16))) unsigned char lds_raw[];
    Frame F;
    F.lds = (LAS unsigned char*)lds_raw; F.tid = threadIdx.x; F.lane = F.tid & 63; F.wave = __builtin_amdgcn_readfirstlane(F.tid >> 6);
    F.G = gridDim.x; { const int bx = blockIdx.x; F.vcu = (F.G % 8 == 0) ? (bx % 8) * (F.G / 8) + bx / 8 : bx; }
    F.in = args.in; F.out = args.out; F.ws = args.ws;
    unsigned char* ws = args.ws;
    bf16_t* XB = (bf16_t*)(ws + WS_XB); bf16_t* CAT = (bf16_t*)(ws + WS_CAT); bf16_t* Z = (bf16_t*)(ws + WS_Z);
    float* RSTD = (float*)(ws + WS_RSTD);
#if MK_ONE_LAUNCH
    cg::grid_group grid = cg::this_grid();
#define GRID_BAR() grid.sync()
#else
#define GRID_BAR() do {} while (0)
#endif
    #ifndef PH_MASK
#define PH_MASK 0x7fff
#endif
#define PHE(p) ((PH_MASK >> (p)) & 1)
    const int lo = args.ph_lo, hi = args.ph_hi;
#define IN(k) (PHE(k) && lo <= (k) && (k) < hi)
#define SEAM(k) do { if (lo <= (k) && (k) + 1 < hi) GRID_BAR(); } while (0)
    if (IN(PH_PRO)) { p_prologue(F); } SEAM(PH_PRO);
    if (IN(PH_IN0)) { pg8::DenseOrder S; S.init(T, AB_IN, D, F.G, (int)blockIdx.x); pg8::EpiIn E{Z, AB_IN, RSTD, 0, 1 << 30};
        pg8::gemm_phase<pg8::EpiIn, pg8::DenseOrder, true>(F.lds, XB, (const bf16_t*)(ws + WS_WIN0), D, S, E); } SEAM(PH_IN0);
    if (IN(PH_MIX0)) { p_mix0(F); } SEAM(PH_MIX0);
    if (IN(PH_OUT0)) { pg8::DenseOrder S; S.init(T, D, D, F.G, (int)blockIdx.x); pg8::EpiOut E{args.in[0], args.out, XB};
        pg8::gemm_phase<pg8::EpiOut, pg8::DenseOrder, true>(F.lds, CAT, (const bf16_t*)(ws + WS_WOUT0), D, S, E); } SEAM(PH_OUT0);
    if (IN(PH_R1)) { p_router(F, 0); } SEAM(PH_R1);
    if (IN(PH_GU0)) { p_gu(F, 0); } SEAM(PH_GU0);
    if (IN(PH_DN0)) { p_dn(F, 0); } SEAM(PH_DN0);
    if (IN(PH_R2)) { p_combine(F, 0, 0); moe_convert(F, 1); } SEAM(PH_R2);
    if (IN(PH_IN1)) { pg8::DenseOrder S; S.init(T, C_IN, D, F.G, (int)blockIdx.x); pg8::EpiIn E{Z, C_IN, RSTD, 1024, 3072};
        pg8::gemm_phase<pg8::EpiIn, pg8::DenseOrder, true>(F.lds, XB, (const bf16_t*)(ws + WS_WIN1), D, S, E); } SEAM(PH_IN1);
    if (IN(PH_MIX1)) { if (F.vcu < 128) mix_hgrn_item(F, F.vcu >> 3, F.vcu & 7); } SEAM(PH_MIX1);
    if (IN(PH_OUT1)) { pg8::DenseOrder S; S.init(T, D, D, F.G, (int)blockIdx.x); pg8::EpiOut E{args.out, args.out, XB};
        pg8::gemm_phase<pg8::EpiOut, pg8::DenseOrder, true>(F.lds, CAT, (const bf16_t*)(ws + WS_WOUT1), D, S, E); } SEAM(PH_OUT1);
    if (IN(PH_R3)) { p_router(F, 1); } SEAM(PH_R3);
    if (IN(PH_GU1)) { p_gu(F, 1); } SEAM(PH_GU1);
    if (IN(PH_DN1)) { p_dn(F, 1); } SEAM(PH_DN1);
    if (IN(PH_R4)) { p_combine(F, 1, 1); }
}

extern "C" void kernel_launch(void* const* d_in, const int* in_sizes, int n_in, void* d_out, int out_size, void* d_ws, size_t ws_size, hipStream_t stream) {
    static int grid = 0;
    if (grid == 0) {
        if (n_in != 23 || out_size != T * D || ws_size < WS_END) { fprintf(stderr, "kernel_launch: unexpected shapes: n_in %d out %d ws %zu (need %zu)\n", n_in, out_size, ws_size, (size_t)WS_END); grid = -1; return; }
        if (hipFuncSetAttribute((const void*)fwd, hipFuncAttributeMaxDynamicSharedMemorySize, LDS_BYTES) != hipSuccess) { fprintf(stderr, "kernel_launch: hipFuncSetAttribute failed\n"); grid = -1; return; }
        int dev = 0, cus = 0, per_cu = 0;
        hipGetDevice(&dev); hipDeviceGetAttribute(&cus, hipDeviceAttributeMultiprocessorCount, dev);
        hipOccupancyMaxActiveBlocksPerMultiprocessor(&per_cu, (const void*)fwd, 512, LDS_BYTES);
        (void)hipGetLastError();
        fprintf(stderr, "kernel_launch: cus %d per_cu %d ws %zu\n", cus, per_cu, ws_size);
        grid = cus > 0 ? cus : 256;
        if (per_cu < 1) fprintf(stderr, "kernel_launch: occupancy query says %d blocks per CU\n", per_cu);
    }
    if (grid < 0) return;
    hipMemsetAsync((char*)d_ws + WS_CTL, 0, CTL_BYTES, stream);
    Args a{};
    for (int i = 0; i < 23; ++i) a.in[i] = (const float*)d_in[i];
    a.out = (float*)d_out; a.ws = (unsigned char*)d_ws;
#if MK_ONE_LAUNCH
    a.ph_lo = 0; a.ph_hi = NPH;
    void* kargs[] = {&a};
    hipError_t e = hipLaunchCooperativeKernel((const void*)fwd, dim3(grid), dim3(512), kargs, LDS_BYTES, stream);
    if (e != hipSuccess) fprintf(stderr, "cooperative launch failed: %s (grid %d)\n", hipGetErrorString(e), grid);
#else
    for (int ph = 0; ph < NPH; ++ph) { a.ph_lo = ph; a.ph_hi = ph + 1; hipLaunchKernelGGL(fwd, dim3(grid), dim3(512), LDS_BYTES, stream, a); }
#endif
}
```

```cpp
#include <hip/hip_runtime.h>
#include <hip/hip_cooperative_groups.h>
#include <cstdio>
#include <cstdint>
namespace cg = cooperative_groups;

#ifndef MK_ONE_LAUNCH
#define MK_ONE_LAUNCH 1
#endif

constexpr int T = 32768, D = 1024, SEQ = 2048, NB = 16;
constexpr int AB_IN = 2560, C_IN = 4096;
constexpr int NEXP = 32, DEXP = 512, CAP = 32768;
constexpr int MAXTILES = 288;
constexpr float EPS = 1e-6f;

#define LAS __attribute__((address_space(3)))
typedef unsigned short bf16_t;
typedef short bf16x8 __attribute__((ext_vector_type(8)));
typedef float f32x4 __attribute__((ext_vector_type(4)));
typedef unsigned u32x4 __attribute__((ext_vector_type(4)));
typedef unsigned u32x2 __attribute__((ext_vector_type(2)));

constexpr size_t MiB = 1u << 20;
constexpr size_t WS_CTL = 0, CTL_BYTES = 1 * MiB;
constexpr size_t WS_RSTD = 1 * MiB;
constexpr size_t WS_LB = WS_RSTD + 128 * 1024;
constexpr size_t WS_RGT = WS_LB + 4096;
constexpr size_t WS_RET = WS_RGT + 2 * 4 * 1024 * 4;
constexpr size_t WS_TOKINFO = 2 * MiB;
constexpr size_t WS_LTOK = 3 * MiB, WS_LRSTD = 7 * MiB, WS_LW = 11 * MiB;
constexpr size_t WS_WIN0 = 16 * MiB, WS_WOUT0 = 21 * MiB, WS_WIN1 = 23 * MiB, WS_WOUT1 = 31 * MiB;
constexpr size_t WS_WGU = 34 * MiB, WS_WDN = 98 * MiB;
constexpr size_t WS_XB = 130 * MiB, WS_CAT = 194 * MiB;
constexpr size_t WS_Z = 258 * MiB;
constexpr size_t WS_HB = 258 * MiB, WS_Y = 330 * MiB;
constexpr size_t WS_END = 514 * MiB;
constexpr int CW_CNT = 64;
constexpr int CW_BAR = 4096;

constexpr int RING_BYTES = 131072;
constexpr int TAB_OFF = RING_BYTES;
constexpr int TS_OFF = TAB_OFF + 6 * 1024;
constexpr int LDS_BYTES = 147456;

__device__ __forceinline__ unsigned f2bf(float f) { unsigned u = __float_as_uint(f); return (u + 0x7fffu + ((u >> 16) & 1u)) >> 16; }
__device__ __forceinline__ float bf2f(unsigned b) { return __uint_as_float(b << 16); }
__device__ __forceinline__ unsigned pk2(float lo, float hi) { return f2bf(lo) | (f2bf(hi) << 16); }
__device__ __forceinline__ unsigned cvt_pk_bf16(float lo, float hi) { unsigned r; asm volatile("v_cvt_pk_bf16_f32 %0, %1, %2" : "=v"(r) : "v"(lo), "v"(hi)); return r; }
__device__ __forceinline__ float wave_sum(float v) {
#pragma unroll
    for (int o = 1; o < 64; o <<= 1) v += __shfl_xor(v, o);
    return v;
}
__device__ __forceinline__ float sigmoidf_(float x) { return 1.0f / (1.0f + __expf(-x)); }
__device__ __forceinline__ float siluf_(float x) { return x / (1.0f + __expf(-x)); }
__device__ __forceinline__ float gelu_tanh(float x) { const float u = 0.7978845608028654f * (x + 0.044715f * x * x * x); return 0.5f * x * (1.0f + tanhf(u)); }
#define LDS_WAIT() asm volatile("s_waitcnt lgkmcnt(0)" ::: "memory")

namespace pg8 {
constexpr int BM = 256, BK = 64, HALF = 128, HTB = HALF * BK * 2, NXCD = 8, WGM = 8;
__host__ __device__ __forceinline__ int lds_byte(int r, int c) { const int st = (r >> 4) * 2 + (c >> 5), rr = r & 15, cc = c & 31, ob = rr * 64 + cc * 2; return st * 1024 + (ob ^ (((ob >> 9) & 1) << 5)); }
__host__ __device__ __forceinline__ void stage_rc(int b, int& R, int& C) { const int st = b / 1024, sb = b % 1024, swz = sb ^ (((sb >> 9) & 1) << 5); R = (st >> 1) * 16 + swz / 64; C = (st & 1) * 32 + (swz % 64) / 2; }
__host__ __device__ __forceinline__ int perm32(int rho) { const int n = rho >> 4, i = rho & 15; return 8 * (i >> 2) + 4 * n + (i & 3); }

struct Unit { unsigned boff; int arow, orow, ocol, e, rl, slot; };

struct DenseOrder {
    int nM, nN, nwg, G, c, K;
    __device__ void init(int M, int N, int K_, int G_, int c_) { nM = M / BM; nN = N / BM; nwg = nM * nN; G = G_; c = c_; K = K_; }
    __device__ __forceinline__ bool next(int i, Unit& u) const {
        const long L = (long)i * G + c; if (L >= nwg) return false;
        int wgid = (int)L; { const int q = nwg / NXCD, r = nwg % NXCD, xcd = wgid % NXCD, off = wgid / NXCD; wgid = (xcd < r ? xcd * (q + 1) : r * (q + 1) + (xcd - r) * q) + off; }
        const int nig = WGM * nN, gid = wgid / nig, fm = gid * WGM, gsz = (nM - fm) < WGM ? (nM - fm) : WGM;
        const int pm = __builtin_amdgcn_readfirstlane(fm + ((wgid % nig) % gsz)), pn = __builtin_amdgcn_readfirstlane((wgid % nig) / gsz);
        u.arow = pm * BM; u.orow = pm * BM; u.ocol = pn * BM; u.boff = (unsigned)(pn * BM) * (unsigned)K * 2u; u.e = 0; u.rl = 0; u.slot = i; return true;
    }
    static constexpr bool GATHER = false;
    __device__ __forceinline__ size_t abase(const Unit& u) const { return (size_t)u.arow * (size_t)K * 2u; }
    __device__ __forceinline__ unsigned aoff(const Unit&, int) const { return 0u; }
};
template <bool GATHER_> struct MoeOrder {
    static constexpr bool GATHER = GATHER_;
    const LAS int* ts; const LAS unsigned* tab; int G, vcu, K;
    __device__ __forceinline__ bool next(int i, Unit& u) const {
        const int L = i * G + vcu; const int NT = __builtin_amdgcn_readfirstlane(ts[32]); if (L >= NT * 4) return false;
        const int rt = L >> 2, pn = L & 3; int e = 0;
#pragma unroll
        for (int j = 1; j < 32; ++j) e += (ts[j] <= rt) ? 1 : 0;
        e = __builtin_amdgcn_readfirstlane(e);
        u.e = e; u.rl = rt - __builtin_amdgcn_readfirstlane(ts[e]); u.orow = rt * BM; u.arow = rt * BM; u.ocol = pn * BM; u.boff = (unsigned)(e * 1024 + pn * BM) * (unsigned)K * 2u; u.slot = i; return true;
    }
    __device__ __forceinline__ size_t abase(const Unit& u) const { return GATHER ? (size_t)0 : (size_t)u.arow * (size_t)K * 2u; }
    __device__ __forceinline__ unsigned aoff(const Unit& u, int r) const { return tab[u.slot * 256 + r]; }
};

typedef f32x4 Acc[2][2][4][2];

struct EpiIn {
    static constexpr bool PERM = true;
    bf16_t* O; int ldc; const float* rstd; int silu_lo_end, silu_hi_start;
    __device__ __forceinline__ void operator()(const Acc& acc, const Unit& u, int wr, int wc, int fr, int fq) const {
        const bool act = (u.ocol < silu_lo_end) || (u.ocol >= silu_hi_start);
#pragma unroll
        for (int ai = 0; ai < 2; ++ai)
#pragma unroll
            for (int m = 0; m < 4; ++m) {
                const int row = u.orow + ai * HALF + wr * 64 + m * 16 + fr; const float rs = rstd[row];
                bf16_t* rowp = O + (size_t)row * ldc + u.ocol + wc * 32 + 8 * fq;
#pragma unroll
                for (int bj = 0; bj < 2; ++bj) { f32x4 v0 = acc[ai][bj][m][0] * rs, v1 = acc[ai][bj][m][1] * rs;
                    if (act) {
#pragma unroll
                        for (int j = 0; j < 4; ++j) { v0[j] = siluf_(v0[j]); v1[j] = siluf_(v1[j]); } }
                    u32x4 w; w.x = cvt_pk_bf16(v0[0], v0[1]); w.y = cvt_pk_bf16(v0[2], v0[3]); w.z = cvt_pk_bf16(v1[0], v1[1]); w.w = cvt_pk_bf16(v1[2], v1[3]);
                    *(u32x4*)(rowp + bj * HALF) = w; } }
    }
};
struct EpiOut {
    static constexpr bool PERM = true;
    const float* resid; float* H; bf16_t* XB;
    __device__ __forceinline__ void operator()(const Acc& acc, const Unit& u, int wr, int wc, int fr, int fq) const {
#pragma unroll
        for (int ai = 0; ai < 2; ++ai)
#pragma unroll
            for (int m = 0; m < 4; ++m) {
                const int row = u.orow + ai * HALF + wr * 64 + m * 16 + fr; const size_t off = (size_t)row * D + u.ocol + wc * 32 + 8 * fq;
#pragma unroll
                for (int bj = 0; bj < 2; ++bj) { const f32x4 r0 = *(const f32x4*)(resid + off + bj * HALF), r1 = *(const f32x4*)(resid + off + bj * HALF + 4);
                    const f32x4 v0 = acc[ai][bj][m][0] + r0, v1 = acc[ai][bj][m][1] + r1;
                    *(f32x4*)(H + off + bj * HALF) = v0; *(f32x4*)(H + off + bj * HALF + 4) = v1;
                    u32x4 w; w.x = cvt_pk_bf16(v0[0], v0[1]); w.y = cvt_pk_bf16(v0[2], v0[3]); w.z = cvt_pk_bf16(v1[0], v1[1]); w.w = cvt_pk_bf16(v1[2], v1[3]);
                    *(u32x4*)(XB + off + bj * HALF) = w; } }
    }
};
struct EpiGU {
    static constexpr bool PERM = true;
    bf16_t* HB; const float* lrstd; const LAS int* cnt;
    __device__ __forceinline__ void operator()(const Acc& acc, const Unit& u, int wr, int wc, int fr, int fq) const {
        const int n_e = cnt[u.e];
#pragma unroll
        for (int ai = 0; ai < 2; ++ai)
#pragma unroll
            for (int m = 0; m < 4; ++m) {
                const int r = ai * HALF + wr * 64 + m * 16 + fr, pos = u.rl * BM + r; const float rs = pos < n_e ? lrstd[(size_t)u.e * CAP + pos] : 0.f;
                float h[8];
#pragma unroll
                for (int n = 0; n < 2; ++n)
#pragma unroll
                    for (int j = 0; j < 4; ++j) { const float g = acc[ai][0][m][n][j] * rs, uu = acc[ai][1][m][n][j] * rs; h[n * 4 + j] = siluf_(g) * uu; }
                u32x4 w; w.x = cvt_pk_bf16(h[0], h[1]); w.y = cvt_pk_bf16(h[2], h[3]); w.z = cvt_pk_bf16(h[4], h[5]); w.w = cvt_pk_bf16(h[6], h[7]);
                *(u32x4*)(HB + (size_t)(u.orow + r) * DEXP + (u.ocol >> 1) + wc * 32 + 8 * fq) = w; }
    }
};
struct EpiDN {
    static constexpr bool PERM = true;
    bf16_t* Y; const float* lw; const LAS int* cnt;
    __device__ __forceinline__ void operator()(const Acc& acc, const Unit& u, int wr, int wc, int fr, int fq) const {
        const int n_e = cnt[u.e];
#pragma unroll
        for (int ai = 0; ai < 2; ++ai)
#pragma unroll
            for (int m = 0; m < 4; ++m) {
                const int r = ai * HALF + wr * 64 + m * 16 + fr, pos = u.rl * BM + r; const float ws = pos < n_e ? lw[(size_t)u.e * CAP + pos] : 0.f;
                bf16_t* rowp = Y + (size_t)(u.orow + r) * D + u.ocol + wc * 32 + 8 * fq;
#pragma unroll
                for (int bj = 0; bj < 2; ++bj) { const f32x4 v0 = acc[ai][bj][m][0] * ws, v1 = acc[ai][bj][m][1] * ws;
                    u32x4 w; w.x = cvt_pk_bf16(v0[0], v0[1]); w.y = cvt_pk_bf16(v0[2], v0[3]); w.z = cvt_pk_bf16(v1[0], v1[1]); w.w = cvt_pk_bf16(v1[2], v1[3]);
                    *(u32x4*)(rowp + bj * HALF) = w; } }
    }
};

template <class Epi, class Sched, bool ALIGN_EPI>
__device__ __forceinline__ void gemm_phase(LAS unsigned char* lds, const bf16_t* A, const bf16_t* Bt, const int K, const Sched& S, const Epi& E) {
    const int tid = threadIdx.x, wid = __builtin_amdgcn_readfirstlane(tid >> 6), lane = tid & 63, wr = wid >> 2, wc = wid & 3, fr = lane & 15, fq = lane >> 4;
    const int nt = K / BK;
    unsigned voffB[2], vA0[2], vA1[2];
#pragma unroll
    for (int i = 0; i < 2; ++i) { int R, C; stage_rc(tid * 16 + i * 8192, R, C); const int Rb = Epi::PERM ? ((R & ~31) + perm32(R & 31)) : R;
        vA0[i] = (unsigned)(R * K + C) * 2u; vA1[i] = vA0[i]; voffB[i] = (unsigned)(Rb * K + C) * 2u; }
#define PG8_FILL(u) do { if constexpr (Sched::GATHER) { int tv_ = tid; asm volatile("" : "+v"(tv_)); _Pragma("unroll") for (int i = 0; i < 2; ++i) { int R, C; stage_rc(tv_ * 16 + i * 8192, R, C); \
        vA0[i] = S.aoff(u, R) + (unsigned)C * 2u; vA1[i] = S.aoff(u, HALF + R) + (unsigned)C * 2u; } } } while (0)
    const size_t kstep = (size_t)(BK * 2);
    const size_t hstep = (size_t)HALF * K * 2;
    const unsigned ldsw = (unsigned)wid * 1024u;
    const int aoff = lds_byte(wr * 64 + fr, fq * 8), boff = lds_byte(wc * 32 + fr, fq * 8);
#define PG8_SA(b, h) (((b) * 2 + (h)) * HTB)
#define PG8_SB(b, h) ((4 + (b) * 2 + (h)) * HTB)
#define PG8_STAGE(bufoff, gbase, voff) do { _Pragma("unroll") for (int _i = 0; _i < 2; ++_i) \
        __builtin_amdgcn_global_load_lds((const unsigned*)((const char*)(gbase) + (voff)[_i]), (LAS unsigned*)(lds + (bufoff) + ldsw + _i * 8192), 16, 0, 0); } while (0)
#define PG8_LDA(dst, b, h) do { _Pragma("unroll") for (int m = 0; m < 4; ++m) _Pragma("unroll") for (int k = 0; k < 2; ++k) dst[m][k] = *(const LAS bf16x8*)(lds + PG8_SA(b, h) + aoff + m * 2048 + k * 1024); } while (0)
#define PG8_LDB(dst, b, h) do { _Pragma("unroll") for (int n = 0; n < 2; ++n) _Pragma("unroll") for (int k = 0; k < 2; ++k) dst[n][k] = *(const LAS bf16x8*)(lds + PG8_SB(b, h) + boff + n * 2048 + k * 1024); } while (0)
#define PG8_MMA(ai, bj, At, Bt_) do { __builtin_amdgcn_s_setprio(1); _Pragma("unroll") for (int m = 0; m < 4; ++m) _Pragma("unroll") for (int n = 0; n < 2; ++n) _Pragma("unroll") for (int k = 0; k < 2; ++k) \
        acc[ai][bj][m][n] = __builtin_amdgcn_mfma_f32_16x16x32_bf16(Bt_[n][k], At[m][k], acc[ai][bj][m][n], 0, 0, 0); __builtin_amdgcn_s_setprio(0); } while (0)
#define PG8_WAIT_V(n) asm volatile("s_waitcnt vmcnt(" #n ")" ::: "memory")
#define PG8_WAIT_L(n) asm volatile("s_waitcnt lgkmcnt(" #n ")" ::: "memory")
#define PG8_BAR __builtin_amdgcn_s_barrier()
#define PG8_SCHED __builtin_amdgcn_sched_barrier(0)
    Unit cur, nxt; int ui = 0;
    if (!S.next(0, cur)) return;
    f32x4 acc[2][2][4][2];
#pragma unroll
    for (int a = 0; a < 2; ++a)
#pragma unroll
        for (int b = 0; b < 2; ++b)
#pragma unroll
            for (int m = 0; m < 4; ++m)
#pragma unroll
                for (int n = 0; n < 2; ++n) acc[a][b][m][n] = (f32x4){0.f, 0.f, 0.f, 0.f};
    bf16x8 At[4][2], B0[2][2], B1[2][2];
    PG8_FILL(cur);
    const char* cA0 = (const char*)A + S.abase(cur); const char* cA1 = cA0 + (Sched::GATHER ? (size_t)0 : hstep); const char* cB = (const char*)Bt + cur.boff;
    PG8_STAGE(PG8_SB(0, 0), cB, voffB); PG8_STAGE(PG8_SB(0, 1), cB + hstep, voffB); PG8_STAGE(PG8_SA(0, 0), cA0, vA0); PG8_STAGE(PG8_SA(0, 1), cA1, vA1);
    if (wr == 1) PG8_BAR;
    PG8_WAIT_V(2); PG8_BAR;
    PG8_STAGE(PG8_SB(1, 0), cB + kstep, voffB); PG8_STAGE(PG8_SA(1, 0), cA0 + kstep, vA0); PG8_STAGE(PG8_SB(1, 1), cB + hstep + kstep, voffB);
    PG8_WAIT_V(6); PG8_BAR;
    for (;;) {
        const bool has_next = S.next(ui + 1, nxt);
        const char* nB = has_next ? (const char*)Bt + nxt.boff : cB;
        const char* nA0 = has_next ? (const char*)A + S.abase(nxt) : cA0; const char* nA1 = nA0 + (Sched::GATHER ? (size_t)0 : hstep);
        for (int t = 0; t < nt; t += 2) {
            const bool last = (t == nt - 2);
            const char* a1 = cA1 + (size_t)(t + 1) * kstep;
            const char* a2 = last ? nA0 : cA0 + (size_t)(t + 2) * kstep; const char* a2h = last ? nA1 : cA1 + (size_t)(t + 2) * kstep; const char* b2 = last ? nB : cB + (size_t)(t + 2) * kstep;
            const char* a3 = a2 + kstep; const char* b3 = b2 + kstep;
            PG8_LDB(B0, 0, 0); PG8_LDB(B1, 0, 1); PG8_SCHED; PG8_LDA(At, 0, 0); PG8_STAGE(PG8_SA(1, 1), a1, vA1);
            if (last && has_next) PG8_FILL(nxt);
            PG8_WAIT_V(8); PG8_WAIT_L(0); PG8_BAR; PG8_MMA(0, 0, At, B0); PG8_MMA(0, 1, At, B1); PG8_BAR; PG8_SCHED;
            PG8_LDA(At, 0, 1); PG8_STAGE(PG8_SB(0, 0), b2, voffB); PG8_STAGE(PG8_SB(0, 1), b2 + hstep, voffB); PG8_STAGE(PG8_SA(0, 0), a2, vA0);
            PG8_WAIT_V(8); PG8_WAIT_L(0); PG8_BAR; PG8_MMA(1, 0, At, B0); PG8_MMA(1, 1, At, B1); PG8_BAR; PG8_SCHED;
            PG8_LDB(B0, 1, 0); PG8_LDB(B1, 1, 1); PG8_SCHED; PG8_LDA(At, 1, 0); PG8_STAGE(PG8_SA(0, 1), a2h, vA1);
            PG8_WAIT_V(8); PG8_WAIT_L(0); PG8_BAR; PG8_MMA(0, 0, At, B0); PG8_MMA(0, 1, At, B1); PG8_BAR; PG8_SCHED;
            PG8_LDA(At, 1, 1); PG8_STAGE(PG8_SB(1, 0), b3, voffB); PG8_STAGE(PG8_SB(1, 1), b3 + hstep, voffB); PG8_STAGE(PG8_SA(1, 0), a3, vA0);
            PG8_WAIT_V(8); PG8_WAIT_L(0); PG8_BAR; PG8_MMA(1, 0, At, B0); PG8_MMA(1, 1, At, B1); PG8_BAR; PG8_SCHED;
        }
        if constexpr (ALIGN_EPI) { if (wr == 0) PG8_BAR; }
        E(acc, cur, wr, wc, fr, fq);
        if (!has_next) break;
#pragma unroll
        for (int a = 0; a < 2; ++a)
#pragma unroll
            for (int b = 0; b < 2; ++b)
#pragma unroll
                for (int m = 0; m < 4; ++m)
#pragma unroll
                    for (int n = 0; n < 2; ++n) acc[a][b][m][n] = (f32x4){0.f, 0.f, 0.f, 0.f};
        cur = nxt; cB = nB; cA0 = nA0; cA1 = nA1; ++ui;
        if constexpr (ALIGN_EPI) { if (wr == 1) PG8_BAR; }
    }
    PG8_WAIT_V(0);
    if constexpr (!ALIGN_EPI) { if (wr == 0) PG8_BAR; }
    PG8_BAR;
#undef PG8_FILL
#undef PG8_SA
#undef PG8_SB
#undef PG8_STAGE
#undef PG8_LDA
#undef PG8_LDB
#undef PG8_MMA
#undef PG8_WAIT_V
#undef PG8_WAIT_L
#undef PG8_BAR
#undef PG8_SCHED
}
}

struct Args { const float* in[23]; float* out; unsigned char* ws; int ph_lo, ph_hi; };
enum { PH_PRO = 0, PH_IN0, PH_MIX0, PH_OUT0, PH_R1, PH_GU0, PH_DN0, PH_R2, PH_IN1, PH_MIX1, PH_OUT1, PH_R3, PH_GU1, PH_DN1, PH_R4, NPH };

struct Frame {
    LAS unsigned char* lds; int tid, lane, wave, vcu, G;
    const float* const* in; float* out; unsigned char* ws;
};

__device__ __forceinline__ void transpose_item(const float* W, int K, int N, const float* kscale, bf16_t* WT, int dest_row0, LAS float* scr, int kb, int nb, int lane) {
    const int k0 = 64 * kb, n0 = 32 * nb;
#pragma unroll 8
    for (int i = 0; i < 32; ++i) { const int kk = 2 * i + (lane >> 5); float v = W[(size_t)(k0 + kk) * N + n0 + (lane & 31)]; if (kscale) v *= kscale[k0 + kk]; scr[kk * 33 + (lane & 31)] = v; }
    LDS_WAIT(); asm volatile("" ::: "memory");
    const int c = lane & 7;
#pragma unroll
    for (int j = 0; j < 4; ++j) { const int n = (lane >> 3) + 8 * j; const LAS float* s = scr + (8 * c) * 33 + n;
        u32x4 o; o.x = pk2(s[0 * 33], s[1 * 33]); o.y = pk2(s[2 * 33], s[3 * 33]); o.z = pk2(s[4 * 33], s[5 * 33]); o.w = pk2(s[6 * 33], s[7 * 33]);
        *(u32x4*)(WT + (size_t)(dest_row0 + n) * K + k0 + 8 * c) = o; }
    LDS_WAIT(); asm volatile("" ::: "memory");
}
__device__ __forceinline__ void moe_convert(Frame& F, int layer) {
    LAS float* scr = (LAS float*)(F.lds + F.wave * 16384);
    const int gw = F.vcu * 8 + F.wave, NGW = F.G * 8;
    const float* gffn = F.in[2] + layer * D;
    const float* Wg = F.in[20] + (size_t)layer * NEXP * D * DEXP; const float* Wu = F.in[21] + (size_t)layer * NEXP * D * DEXP; const float* Wd = F.in[22] + (size_t)layer * NEXP * DEXP * D;
    bf16_t* WGU = (bf16_t*)(F.ws + WS_WGU); bf16_t* WDN = (bf16_t*)(F.ws + WS_WDN);
    for (int it = gw; it < 3 * 8192; it += NGW) {
        const int which = it >> 13, r = it & 8191, e = r >> 8, q = r & 255;
        if (which < 2) { const int kb = q >> 4, nb = q & 15, n0 = nb * 32;
            const int dest = e * 1024 + (n0 >> 7) * 256 + (which ? 128 : 0) + (n0 & 127);
            transpose_item((which ? Wu : Wg) + (size_t)e * D * DEXP, D, DEXP, gffn, WGU, dest, scr, kb, nb, F.lane);
        } else { const int kb = q >> 5, nb = q & 31;
            transpose_item(Wd + (size_t)e * DEXP * D, DEXP, D, nullptr, WDN, e * 1024 + nb * 32, scr, kb, nb, F.lane); }
    }
}
__device__ __forceinline__ void p_prologue(Frame& F) {
    LAS float* scr = (LAS float*)(F.lds + F.wave * 16384);
    const int gw = F.vcu * 8 + F.wave, NGW = F.G * 8;
    constexpr int I0 = 16 * 80, I1 = 16 * 32, I2 = 16 * 128, I3 = 16 * 32;
    for (int it = gw; it < I0 + I1 + I2 + I3; it += NGW) {
        int r = it;
        if (r < I0) { transpose_item(F.in[4], D, AB_IN, F.in[1], (bf16_t*)(F.ws + WS_WIN0), (r % 80) * 32, scr, r / 80, r % 80, F.lane); continue; } r -= I0;
        if (r < I1) { transpose_item(F.in[13], D, D, nullptr, (bf16_t*)(F.ws + WS_WOUT0), (r % 32) * 32, scr, r / 32, r % 32, F.lane); continue; } r -= I1;
        if (r < I2) { transpose_item(F.in[14], D, C_IN, F.in[1] + D, (bf16_t*)(F.ws + WS_WIN1), (r % 128) * 32, scr, r / 128, r % 128, F.lane); continue; } r -= I2;
        transpose_item(F.in[17], D, D, nullptr, (bf16_t*)(F.ws + WS_WOUT1), (r % 32) * 32, scr, r / 32, r % 32, F.lane);
    }
    moe_convert(F, 0);
    { const float* x = F.in[0]; bf16_t* XB = (bf16_t*)(F.ws + WS_XB); float* rstd = (float*)(F.ws + WS_RSTD);
      for (int m = gw; m < T; m += NGW) { const f32x4* xr = (const f32x4*)(x + (size_t)m * D) + F.lane; f32x4 v[4]; float s = 0.f;
#pragma unroll
          for (int j = 0; j < 4; ++j) { v[j] = xr[64 * j]; s += (v[j].x * v[j].x + v[j].y * v[j].y) + (v[j].z * v[j].z + v[j].w * v[j].w); }
          s = wave_sum(s); if (F.lane == 0) rstd[m] = rsqrtf(s * (1.f / D) + EPS);
          u32x2* o8 = (u32x2*)(XB + (size_t)m * D) + F.lane;
#pragma unroll
          for (int j = 0; j < 4; ++j) o8[64 * j] = (u32x2){pk2(v[j].x, v[j].y), pk2(v[j].z, v[j].w)}; } }
    const int gt = F.vcu * 512 + F.tid, NGT = F.G * 512;
    { float* lb = (float*)(F.ws + WS_LB); const float* l = F.in[15];
      for (int c = gt; c < 1024; c += NGT) { const float a = l[c], b = l[1024 + c], mx = fmaxf(a, b), ea = __expf(a - mx), eb = __expf(b - mx); lb[c] = ea / (ea + eb); } }
    { float* RgT = (float*)(F.ws + WS_RGT); float* ReT = (float*)(F.ws + WS_RET);
      for (int i = gt; i < 2 * 36 * 1024; i += NGT) { const int l = i / (36 * 1024), r = i % (36 * 1024), j = r >> 10, c = r & 1023; const float g = F.in[2][l * D + c];
          if (j < 4) RgT[(l * 4 + j) * 1024 + c] = g * F.in[18][((size_t)l * D + c) * 4 + j];
          else ReT[(l * 32 + (j - 4)) * 1024 + c] = g * F.in[19][((size_t)l * D + c) * 32 + (j - 4)]; } }
}

__device__ __forceinline__ void moe_tables(Frame& F, int layer) {
    LAS int* ts = (LAS int*)(F.lds + TS_OFF); LAS int* cn = ts + 40;
    const unsigned* cnt = (const unsigned*)(F.ws + WS_CTL) + CW_CNT + layer * 32;
    __syncthreads();
    if (F.tid < 32) cn[F.tid] = (int)__hip_atomic_load(cnt + F.tid, __ATOMIC_RELAXED, __HIP_MEMORY_SCOPE_AGENT);
    __syncthreads();
    if (F.tid == 0) { int s = 0; for (int e = 0; e < 32; ++e) { ts[e] = s; s += (cn[e] + 255) >> 8; } ts[32] = s; }
    __syncthreads();
}

__device__ __forceinline__ void p_router(Frame& F, int layer) {
    const int gw = F.vcu * 8 + F.wave, NGW = F.G * 8;
    const float* H = F.out; const float* RgT = (const float*)(F.ws + WS_RGT) + layer * 4 * 1024; const float* ReT = (const float*)(F.ws + WS_RET) + layer * 32 * 1024;
    unsigned* cnt = (unsigned*)(F.ws + WS_CTL) + CW_CNT + layer * 32;
    int* ltok = (int*)(F.ws + WS_LTOK); float* lrstd = (float*)(F.ws + WS_LRSTD); float* lw = (float*)(F.ws + WS_LW); int* tokinfo = (int*)(F.ws + WS_TOKINFO);
    for (int m = gw; m < T; m += NGW) {
        const f32x4* hr = (const f32x4*)(H + (size_t)m * D) + F.lane; f32x4 v[4]; float s = 0.f;
#pragma unroll
        for (int j = 0; j < 4; ++j) { v[j] = hr[64 * j]; s += (v[j].x * v[j].x + v[j].y * v[j].y) + (v[j].z * v[j].z + v[j].w * v[j].w); }
        const float rstd = rsqrtf(wave_sum(s) * (1.f / D) + EPS);
        float lg[4];
#pragma unroll
        for (int gi = 0; gi < 4; ++gi) { const f32x4* w = (const f32x4*)(RgT + gi * 1024) + F.lane; float a = 0.f;
#pragma unroll
            for (int j = 0; j < 4; ++j) { const f32x4 ww = w[64 * j]; a += (v[j].x * ww.x + v[j].y * ww.y) + (v[j].z * ww.z + v[j].w * ww.w); }
            lg[gi] = wave_sum(a) * rstd; }
        int gidx = 0; float gmax = lg[0];
#pragma unroll
        for (int gi = 1; gi < 4; ++gi) if (lg[gi] > gmax) { gmax = lg[gi]; gidx = gi; }
        float gs = 0.f;
#pragma unroll
        for (int gi = 0; gi < 4; ++gi) gs += __expf(lg[gi] - gmax);
        const float ggate = 1.f / gs;
        gidx = __builtin_amdgcn_readfirstlane(gidx);
        float le[8];
#pragma unroll
        for (int e = 0; e < 8; ++e) { const f32x4* w = (const f32x4*)(ReT + (gidx * 8 + e) * 1024) + F.lane; float a = 0.f;
#pragma unroll
            for (int j = 0; j < 4; ++j) { const f32x4 ww = w[64 * j]; a += (v[j].x * ww.x + v[j].y * ww.y) + (v[j].z * ww.z + v[j].w * ww.w); }
            le[e] = wave_sum(a) * rstd; }
        int i0 = 0; float v0 = le[0];
#pragma unroll
        for (int e = 1; e < 8; ++e) if (le[e] > v0) { v0 = le[e]; i0 = e; }
        int i1 = -1; float v1 = -3.0e38f;
#pragma unroll
        for (int e = 0; e < 8; ++e) if (e != i0 && le[e] > v1) { v1 = le[e]; i1 = e; }
        const float ex = __expf(v1 - v0), w0 = ggate / (1.f + ex), w1 = ggate * ex / (1.f + ex);
        if (F.lane == 0) {
            ((float*)(F.ws + WS_RSTD))[m] = rstd;
            const int e0 = gidx * 8 + i0, e1 = gidx * 8 + i1;
            const unsigned p0 = atomicAdd(cnt + e0, 1u), p1 = atomicAdd(cnt + e1, 1u);
            ltok[(size_t)e0 * CAP + p0] = m; lrstd[(size_t)e0 * CAP + p0] = rstd; lw[(size_t)e0 * CAP + p0] = w0;
            ltok[(size_t)e1 * CAP + p1] = m; lrstd[(size_t)e1 * CAP + p1] = rstd; lw[(size_t)e1 * CAP + p1] = w1;
            tokinfo[2 * m] = e0 * CAP + (int)p0; tokinfo[2 * m + 1] = e1 * CAP + (int)p1;
        }
    }
}
__device__ __forceinline__ void p_combine(Frame& F, int layer, int mode) {
    moe_tables(F, layer);
    const LAS int* ts = (const LAS int*)(F.lds + TS_OFF);
    const int gw = F.vcu * 8 + F.wave, NGW = F.G * 8;
    float* H = F.out; const bf16_t* Y = (const bf16_t*)(F.ws + WS_Y); const int* tokinfo = (const int*)(F.ws + WS_TOKINFO);
    bf16_t* XB = (bf16_t*)(F.ws + WS_XB); float* rstd = (float*)(F.ws + WS_RSTD); const float* gfin = F.in[3];
    for (int m = gw; m < T; m += NGW) {
        const int t0 = tokinfo[2 * m], t1 = tokinfo[2 * m + 1];
        const size_t s0 = (size_t)ts[t0 >> 15] * 256 + (t0 & (CAP - 1)), s1 = (size_t)ts[t1 >> 15] * 256 + (t1 & (CAP - 1));
        f32x4* hr = (f32x4*)(H + (size_t)m * D) + F.lane; const u32x2* y0 = (const u32x2*)(Y + s0 * D) + F.lane; const u32x2* y1 = (const u32x2*)(Y + s1 * D) + F.lane;
        f32x4 v[4]; float s = 0.f;
#pragma unroll
        for (int j = 0; j < 4; ++j) { v[j] = hr[64 * j]; const u32x2 a = y0[64 * j], b = y1[64 * j];
            v[j].x += bf2f(a.x & 0xffffu) + bf2f(b.x & 0xffffu); v[j].y += bf2f(a.x >> 16) + bf2f(b.x >> 16); v[j].z += bf2f(a.y & 0xffffu) + bf2f(b.y & 0xffffu); v[j].w += bf2f(a.y >> 16) + bf2f(b.y >> 16);
            s += (v[j].x * v[j].x + v[j].y * v[j].y) + (v[j].z * v[j].z + v[j].w * v[j].w); }
        const float rs = rsqrtf(wave_sum(s) * (1.f / D) + EPS);
        if (mode == 0) {
            if (F.lane == 0) rstd[m] = rs;
            u32x2* o8 = (u32x2*)(XB + (size_t)m * D) + F.lane;
#pragma unroll
            for (int j = 0; j < 4; ++j) { hr[64 * j] = v[j]; o8[64 * j] = (u32x2){pk2(v[j].x, v[j].y), pk2(v[j].z, v[j].w)}; }
        } else {
            const f32x4* g4 = (const f32x4*)gfin + F.lane;
#pragma unroll
            for (int j = 0; j < 4; ++j) { const f32x4 g = g4[64 * j]; hr[64 * j] = (f32x4){v[j].x * rs * g.x, v[j].y * rs * g.y, v[j].z * rs * g.z, v[j].w * rs * g.w}; }
        }
    }
}

__device__ __forceinline__ void mix_rglru_item(Frame& F, int b, int nb) {
    LAS float* L = (LAS float*)F.lds;
    LAS float* wa = L; LAS float* wx = L + 4096; LAS float* xat = L + 8192;   LAS float* xc = xat + 67 * 64; LAS float* ga = xc + 4096; LAS float* av = ga + 4096; LAS float* uv = av + 4096; LAS float* prm = uv + 4096;
    const bf16_t* Z = (const bf16_t*)(F.ws + WS_Z); bf16_t* CAT = (bf16_t*)(F.ws + WS_CAT);
    const int tid = F.tid;
    __syncthreads();
    for (int i = tid; i < 4096; i += 512) { wa[i] = F.in[7][nb * 4096 + i]; wx[i] = F.in[9][nb * 4096 + i]; }
    if (tid < 64) { const int c = nb * 64 + tid; prm[tid] = F.in[6][c]; prm[64 + tid] = F.in[5][c]; prm[128 + tid] = F.in[5][512 + c]; prm[192 + tid] = F.in[5][1024 + c]; prm[256 + tid] = F.in[5][1536 + c];
        prm[320 + tid] = F.in[8][c]; prm[384 + tid] = F.in[10][c]; const float lam = F.in[11][c]; prm[448 + tid] = fminf(lam, 0.f) - log1pf(__expf(-fabsf(lam))); }
    float hcar = 0.f;
    for (int t0 = 0; t0 < SEQ; t0 += 64) {
        __syncthreads();
        for (int i = tid; i < 67 * 64; i += 512) { const int r = i >> 6, c = i & 63, tg = t0 - 3 + r; xat[i] = tg >= 0 ? bf2f(Z[((size_t)b * SEQ + tg) * AB_IN + nb * 64 + c]) : 0.f; }
        for (int i = tid; i < 4096; i += 512) { const int r = i >> 6, c = i & 63; ga[i] = bf2f(Z[((size_t)b * SEQ + t0 + r) * AB_IN + 512 + nb * 64 + c]); }
        __syncthreads();
        for (int i = tid; i < 4096; i += 512) { const int r = i >> 6, c = i & 63; xc[i] = prm[c] + prm[64 + c] * xat[r * 64 + c] + prm[128 + c] * xat[(r + 1) * 64 + c] + prm[192 + c] * xat[(r + 2) * 64 + c] + prm[256 + c] * xat[(r + 3) * 64 + c]; }
        __syncthreads();
        { const int tok = tid >> 3, dg = tid & 7; float aa[8], ax[8];
#pragma unroll
          for (int j = 0; j < 8; ++j) { aa[j] = 0.f; ax[j] = 0.f; }
          for (int c = 0; c < 64; ++c) { const float xv = xc[tok * 64 + c]; const LAS f32x4* pa = (const LAS f32x4*)(wa + c * 64 + dg * 8); const LAS f32x4* px = (const LAS f32x4*)(wx + c * 64 + dg * 8);
              const f32x4 a0 = pa[0], a1 = pa[1], x0 = px[0], x1 = px[1];
              aa[0] += xv * a0.x; aa[1] += xv * a0.y; aa[2] += xv * a0.z; aa[3] += xv * a0.w; aa[4] += xv * a1.x; aa[5] += xv * a1.y; aa[6] += xv * a1.z; aa[7] += xv * a1.w;
              ax[0] += xv * x0.x; ax[1] += xv * x0.y; ax[2] += xv * x0.z; ax[3] += xv * x0.w; ax[4] += xv * x1.x; ax[5] += xv * x1.y; ax[6] += xv * x1.z; ax[7] += xv * x1.w; }
#pragma unroll
          for (int j = 0; j < 8; ++j) { const int d = dg * 8 + j; const float r = sigmoidf_(aa[j] + prm[320 + d]), ig = sigmoidf_(ax[j] + prm[384 + d]);
              const float la = 8.0f * r * prm[448 + d]; av[tok * 64 + d] = __expf(la); uv[tok * 64 + d] = sqrtf(fmaxf(-expm1f(2.0f * la), 0.f)) * (ig * xc[tok * 64 + d]); } }
        __syncthreads();
        if (tid < 64) { for (int r = 0; r < 64; ++r) { hcar = av[r * 64 + tid] * hcar + uv[r * 64 + tid]; av[r * 64 + tid] = hcar; } }
        __syncthreads();
        for (int i = tid; i < 4096; i += 512) { const int r = i >> 6, c = i & 63; CAT[((size_t)b * SEQ + t0 + r) * D + nb * 64 + c] = (bf16_t)f2bf(av[i] * gelu_tanh(ga[i])); }
    }
    __syncthreads();
}
__device__ __forceinline__ void mix_attn_item(Frame& F, int b, int c, int h) {
    LAS float* Ks = (LAS float*)F.lds;   LAS float* Vs = Ks + 64 * 68;   LAS float* bs = Vs + 4096;   LAS float* Ss = bs + 520;
    const bf16_t* Z = (const bf16_t*)(F.ws + WS_Z); bf16_t* CAT = (bf16_t*)(F.ws + WS_CAT);
    const int tid = F.tid, t = tid >> 3, sub = tid & 7;
    __syncthreads();
    for (int i = tid; i < 513; i += 512) bs[i] = F.in[12][h * 513 + i];
    unsigned q2[32]; float o[64];
    { const unsigned* qp = (const unsigned*)(Z + ((size_t)b * SEQ + c * 64 + t) * AB_IN + 1024 + h * 64);
#pragma unroll
      for (int d = 0; d < 32; ++d) q2[d] = qp[d];
#pragma unroll
      for (int d = 0; d < 64; ++d) o[d] = 0.f; }
    float mrun = -3.0e38f, lrun = 0.f;
    for (int kc = (c >= 8 ? c - 8 : 0); kc <= c; ++kc) {
        __syncthreads();
        for (int i = tid; i < 4096; i += 512) { const int s = i >> 6, d = i & 63; const size_t base = ((size_t)b * SEQ + kc * 64 + s) * AB_IN + h * 64 + d;
            Ks[s * 68 + d] = bf2f(Z[base + 1536]); Vs[s * 64 + d] = bf2f(Z[base + 2048]); }
        __syncthreads();
        float tmax = -3.0e38f;
#pragma unroll 1
        for (int jj = 0; jj < 8; ++jj) { const int s = sub + 8 * jj; const LAS f32x4* kp = (const LAS f32x4*)(Ks + s * 68); float a = 0.f;
#pragma unroll
            for (int d4 = 0; d4 < 16; ++d4) { const f32x4 kv = kp[d4]; a += bf2f(q2[2 * d4] & 0xffffu) * kv.x + bf2f(q2[2 * d4] >> 16) * kv.y + bf2f(q2[2 * d4 + 1] & 0xffffu) * kv.z + bf2f(q2[2 * d4 + 1] >> 16) * kv.w; }
            a *= 0.125f;
            int rel = t - ((kc - c) * 64 + s); rel = rel < -256 ? -256 : (rel > 256 ? 256 : rel);
            a += bs[rel + 256]; Ss[t * 65 + s] = a; tmax = fmaxf(tmax, a); }
        const float mnew = fmaxf(mrun, tmax), f = __expf(mrun - mnew);
        lrun *= f;
#pragma unroll
        for (int d = 0; d < 64; ++d) o[d] *= f;
#pragma unroll 1
        for (int jj = 0; jj < 8; ++jj) { const int s = sub + 8 * jj; const float p = __expf(Ss[t * 65 + s] - mnew); lrun += p; const LAS f32x4* vp = (const LAS f32x4*)(Vs + s * 64);
#pragma unroll
            for (int d4 = 0; d4 < 16; ++d4) { const f32x4 vv = vp[d4]; o[4 * d4] += p * vv.x; o[4 * d4 + 1] += p * vv.y; o[4 * d4 + 2] += p * vv.z; o[4 * d4 + 3] += p * vv.w; } }
        mrun = mnew;
    }
    float mall = mrun;
    mall = fmaxf(mall, __shfl_xor(mall, 1)); mall = fmaxf(mall, __shfl_xor(mall, 2)); mall = fmaxf(mall, __shfl_xor(mall, 4));
    const float f = __expf(mrun - mall); lrun *= f;
    lrun += __shfl_xor(lrun, 1); lrun += __shfl_xor(lrun, 2); lrun += __shfl_xor(lrun, 4);
    const float inv = 1.0f / lrun;
    bf16_t* op = CAT + ((size_t)b * SEQ + c * 64 + t) * D + 512 + h * 64;
#pragma unroll
    for (int d = 0; d < 64; ++d) { float v = o[d] * f; v += __shfl_xor(v, 1); v += __shfl_xor(v, 2); v += __shfl_xor(v, 4); if ((d >> 3) == sub) op[d] = (bf16_t)f2bf(v * inv); }
}
__device__ __forceinline__ void p_mix0(Frame& F) {
    if (F.vcu < 128) mix_rglru_item(F, F.vcu >> 3, F.vcu & 7);
    for (int it = F.vcu; it < NB * 32 * 8; it += F.G) mix_attn_item(F, it >> 8, (it >> 3) & 31, it & 7);
}
__device__ __forceinline__ void mix_hgrn_item(Frame& F, int b, int h) {
    LAS float* L = (LAS float*)F.lds;
    LAS float* qs = L; LAS float* fs = L + 4096; LAS float* is = L + 8192; LAS float* gs = L + 12288; LAS float* op = L + 16384;
    const bf16_t* Z = (const bf16_t*)(F.ws + WS_Z); bf16_t* CAT = (bf16_t*)(F.ws + WS_CAT); const float* lb = (const float*)(F.ws + WS_LB); const float* ng = F.in[16];
    const int tid = F.tid, v = tid & 127, kq = tid >> 7;
    float S[32];
#pragma unroll
    for (int k = 0; k < 32; ++k) S[k] = 0.f;
    for (int t0 = 0; t0 < SEQ; t0 += 32) {
        __syncthreads();
        for (int i = tid; i < 4096; i += 512) { const int r = i >> 7, c = i & 127; const bf16_t* zr = Z + ((size_t)b * SEQ + t0 + r) * C_IN + h * 128 + c;
            qs[i] = bf2f(zr[0]); const float l = lb[h * 128 + c]; fs[i] = l + (1.f - l) * sigmoidf_(bf2f(zr[1024])); is[i] = bf2f(zr[2048]); gs[i] = bf2f(zr[3072]); }
        __syncthreads();
        for (int r = 0; r < 32; ++r) { const float iv = is[r * 128 + v]; float o = 0.f;
#pragma unroll
            for (int k4 = 0; k4 < 8; ++k4) { const f32x4 f4 = *(const LAS f32x4*)(fs + r * 128 + kq * 32 + 4 * k4), q4 = *(const LAS f32x4*)(qs + r * 128 + kq * 32 + 4 * k4);
                S[4 * k4] = f4.x * S[4 * k4] + (1.f - f4.x) * iv; o += q4.x * S[4 * k4];
                S[4 * k4 + 1] = f4.y * S[4 * k4 + 1] + (1.f - f4.y) * iv; o += q4.y * S[4 * k4 + 1];
                S[4 * k4 + 2] = f4.z * S[4 * k4 + 2] + (1.f - f4.z) * iv; o += q4.z * S[4 * k4 + 2];
                S[4 * k4 + 3] = f4.w * S[4 * k4 + 3] + (1.f - f4.w) * iv; o += q4.w * S[4 * k4 + 3]; }
            op[(r * 4 + kq) * 128 + v] = o; }
        __syncthreads();
#pragma unroll
        for (int rr = 0; rr < 4; ++rr) { const int r = F.wave * 4 + rr; const int l = F.lane;
            const float o1 = op[(r * 4 + 0) * 128 + l] + op[(r * 4 + 1) * 128 + l] + op[(r * 4 + 2) * 128 + l] + op[(r * 4 + 3) * 128 + l];
            const float o2 = op[(r * 4 + 0) * 128 + 64 + l] + op[(r * 4 + 1) * 128 + 64 + l] + op[(r * 4 + 2) * 128 + 64 + l] + op[(r * 4 + 3) * 128 + 64 + l];
            const float rinv = rsqrtf(wave_sum(o1 * o1 + o2 * o2) * (1.f / 128.f) + EPS);
            bf16_t* cp = CAT + ((size_t)b * SEQ + t0 + r) * D + h * 128;
            cp[l] = (bf16_t)f2bf(o1 * rinv * ng[h * 128 + l] * gs[r * 128 + l]); cp[64 + l] = (bf16_t)f2bf(o2 * rinv * ng[h * 128 + 64 + l] * gs[r * 128 + 64 + l]); }
    }
    __syncthreads();
}

__device__ __forceinline__ void p_gu(Frame& F, int layer) {
    unsigned char* ws = F.ws;
    moe_tables(F, layer);
    const LAS int* ts = (const LAS int*)(F.lds + TS_OFF); LAS unsigned* tab = (LAS unsigned*)(F.lds + TAB_OFF);
    pg8::MoeOrder<true> S{ts, tab, F.G, F.vcu, D};
    { const int* ltok = (const int*)(ws + WS_LTOK); pg8::Unit u;
      for (int i = 0; i < 6 && S.next(i, u); ++i) if (F.tid < 256) { const int pos = u.rl * 256 + F.tid; const int tok = pos < ts[40 + u.e] ? ltok[(size_t)u.e * CAP + pos] : 0; tab[i * 256 + F.tid] = (unsigned)tok * (unsigned)(D * 2); }
      __syncthreads(); }
    pg8::EpiGU E{(bf16_t*)(ws + WS_HB), (const float*)(ws + WS_LRSTD), ts + 40};
    pg8::gemm_phase<pg8::EpiGU, pg8::MoeOrder<true>, true>(F.lds, (const bf16_t*)(ws + WS_XB), (const bf16_t*)(ws + WS_WGU), D, S, E);
}
__device__ __forceinline__ void p_dn(Frame& F, int layer) {
    unsigned char* ws = F.ws;
    moe_tables(F, layer);
    const LAS int* ts = (const LAS int*)(F.lds + TS_OFF);
    pg8::MoeOrder<false> S{ts, nullptr, F.G, F.vcu, DEXP};
    pg8::EpiDN E{(bf16_t*)(ws + WS_Y), (const float*)(ws + WS_LW), ts + 40};
    pg8::gemm_phase<pg8::EpiDN, pg8::MoeOrder<false>, true>(F.lds, (const bf16_t*)(ws + WS_HB), (const bf16_t*)(ws + WS_WDN), DEXP, S, E);
}

__global__ void __launch_bounds__(512, 2) fwd(Args args) {
    extern __shared__ __attribute__((aligned(16))) unsigned char lds_raw[];
    Frame F;
    F.lds = (LAS unsigned char*)lds_raw; F.tid = threadIdx.x; F.lane = F.tid & 63; F.wave = __builtin_amdgcn_readfirstlane(F.tid >> 6);
    F.G = gridDim.x; { const int bx = blockIdx.x; F.vcu = (F.G % 8 == 0) ? (bx % 8) * (F.G / 8) + bx / 8 : bx; }
    F.in = args.in; F.out = args.out; F.ws = args.ws;
    unsigned char* ws = args.ws;
    bf16_t* XB = (bf16_t*)(ws + WS_XB); bf16_t* CAT = (bf16_t*)(ws + WS_CAT); bf16_t* Z = (bf16_t*)(ws + WS_Z);
    float* RSTD = (float*)(ws + WS_RSTD);
#if MK_ONE_LAUNCH
    cg::grid_group grid = cg::this_grid();
#define GRID_BAR() grid.sync()
#else
#define GRID_BAR() do {} while (0)
#endif
    #ifndef PH_MASK
#define PH_MASK 0x7fff
#endif
#define PHE(p) ((PH_MASK >> (p)) & 1)
    const int lo = args.ph_lo, hi = args.ph_hi;
#define IN(k) (PHE(k) && lo <= (k) && (k) < hi)
#define SEAM(k) do { if (lo <= (k) && (k) + 1 < hi) GRID_BAR(); } while (0)
    if (IN(PH_PRO)) { p_prologue(F); } SEAM(PH_PRO);
    if (IN(PH_IN0)) { pg8::DenseOrder S; S.init(T, AB_IN, D, F.G, (int)blockIdx.x); pg8::EpiIn E{Z, AB_IN, RSTD, 0, 1 << 30};
        pg8::gemm_phase<pg8::EpiIn, pg8::DenseOrder, true>(F.lds, XB, (const bf16_t*)(ws + WS_WIN0), D, S, E); } SEAM(PH_IN0);
    if (IN(PH_MIX0)) { p_mix0(F); } SEAM(PH_MIX0);
    if (IN(PH_OUT0)) { pg8::DenseOrder S; S.init(T, D, D, F.G, (int)blockIdx.x); pg8::EpiOut E{args.in[0], args.out, XB};
        pg8::gemm_phase<pg8::EpiOut, pg8::DenseOrder, true>(F.lds, CAT, (const bf16_t*)(ws + WS_WOUT0), D, S, E); } SEAM(PH_OUT0);
    if (IN(PH_R1)) { p_router(F, 0); } SEAM(PH_R1);
    if (IN(PH_GU0)) { p_gu(F, 0); } SEAM(PH_GU0);
    if (IN(PH_DN0)) { p_dn(F, 0); } SEAM(PH_DN0);
    if (IN(PH_R2)) { p_combine(F, 0, 0); moe_convert(F, 1); } SEAM(PH_R2);
    if (IN(PH_IN1)) { pg8::DenseOrder S; S.init(T, C_IN, D, F.G, (int)blockIdx.x); pg8::EpiIn E{Z, C_IN, RSTD, 1024, 3072};
        pg8::gemm_phase<pg8::EpiIn, pg8::DenseOrder, true>(F.lds, XB, (const bf16_t*)(ws + WS_WIN1), D, S, E); } SEAM(PH_IN1);
    if (IN(PH_MIX1)) { if (F.vcu < 128) mix_hgrn_item(F, F.vcu >> 3, F.vcu & 7); } SEAM(PH_MIX1);
    if (IN(PH_OUT1)) { pg8::DenseOrder S; S.init(T, D, D, F.G, (int)blockIdx.x); pg8::EpiOut E{args.out, args.out, XB};
        pg8::gemm_phase<pg8::EpiOut, pg8::DenseOrder, true>(F.lds, CAT, (const bf16_t*)(ws + WS_WOUT1), D, S, E); } SEAM(PH_OUT1);
    if (IN(PH_R3)) { p_router(F, 1); } SEAM(PH_R3);
    if (IN(PH_GU1)) { p_gu(F, 1); } SEAM(PH_GU1);
    if (IN(PH_DN1)) { p_dn(F, 1); } SEAM(PH_DN1);
    if (IN(PH_R4)) { p_combine(F, 1, 1); }
}

extern "C" void kernel_launch(void* const* d_in, const int* in_sizes, int n_in, void* d_out, int out_size, void* d_ws, size_t ws_size, hipStream_t stream) {
    static int grid = 0;
    if (grid == 0) {
        if (n_in != 23 || out_size != T * D || ws_size < WS_END) { fprintf(stderr, "kernel_launch: unexpected shapes: n_in %d out %d ws %zu (need %zu)\n", n_in, out_size, ws_size, (size_t)WS_END); grid = -1; return; }
        if (hipFuncSetAttribute((const void*)fwd, hipFuncAttributeMaxDynamicSharedMemorySize, LDS_BYTES) != hipSuccess) { fprintf(stderr, "kernel_launch: hipFuncSetAttribute failed\n"); grid = -1; return; }
        int dev = 0, cus = 0, per_cu = 0;
        hipGetDevice(&dev); hipDeviceGetAttribute(&cus, hipDeviceAttributeMultiprocessorCount, dev);
        hipOccupancyMaxActiveBlocksPerMultiprocessor(&per_cu, (const void*)fwd, 512, LDS_BYTES);
        (void)hipGetLastError();
        fprintf(stderr, "kernel_launch: cus %d per_cu %d ws %zu\n", cus, per_cu, ws_size);
        grid = cus > 0 ? cus : 256;
        if (per_cu < 1) fprintf(stderr, "kernel_launch: occupancy query says %d blocks per CU\n", per_cu);
    }
    if (grid < 0) return;
    hipMemsetAsync((char*)d_ws + WS_CTL, 0, CTL_BYTES, stream);
    Args a{};
    for (int i = 0; i < 23; ++i) a.in[i] = (const float*)d_in[i];
    a.out = (float*)d_out; a.ws = (unsigned char*)d_ws;
#if MK_ONE_LAUNCH
    a.ph_lo = 0; a.ph_hi = NPH;
    void* kargs[] = {&a};
    hipError_t e = hipLaunchCooperativeKernel((const void*)fwd, dim3(grid), dim3(512), kargs, LDS_BYTES, stream);
    if (e != hipSuccess) fprintf(stderr, "cooperative launch failed: %s (grid %d)\n", hipGetErrorString(e), grid);
#else
    for (int ph = 0; ph < NPH; ++ph) { a.ph_lo = ph; a.ph_hi = ph + 1; hipLaunchKernelGGL(fwd, dim3(grid), dim3(512), LDS_BYTES, stream, a); }
#endif
}
```

```cpp
#include <hip/hip_runtime.h>
#include <hip/hip_cooperative_groups.h>
#include <cstdio>
#include <cstdint>
namespace cg = cooperative_groups;

#ifndef MK_ONE_LAUNCH
#define MK_ONE_LAUNCH 1
#endif

constexpr int T = 32768, D = 1024, SEQ = 2048, NB = 16;
constexpr int AB_IN = 2560, C_IN = 4096;
constexpr int NEXP = 32, DEXP = 512, CAP = 32768;
constexpr int MAXTILES = 288;
constexpr float EPS = 1e-6f;

#define LAS __attribute__((address_space(3)))
typedef unsigned short bf16_t;
typedef short bf16x8 __attribute__((ext_vector_type(8)));
typedef float f32x4 __attribute__((ext_vector_type(4)));
typedef unsigned u32x4 __attribute__((ext_vector_type(4)));
typedef unsigned u32x2 __attribute__((ext_vector_type(2)));

constexpr size_t MiB = 1u << 20;
constexpr size_t WS_CTL = 0, CTL_BYTES = 1 * MiB;
constexpr size_t WS_RSTD = 1 * MiB;
constexpr size_t WS_LB = WS_RSTD + 128 * 1024;
constexpr size_t WS_RGT = WS_LB + 4096;
constexpr size_t WS_RET = WS_RGT + 2 * 4 * 1024 * 4;
constexpr size_t WS_TOKINFO = 2 * MiB;
constexpr size_t WS_LTOK = 3 * MiB, WS_LRSTD = 7 * MiB, WS_LW = 11 * MiB;
constexpr size_t WS_WIN0 = 16 * MiB, WS_WOUT0 = 21 * MiB, WS_WIN1 = 23 * MiB, WS_WOUT1 = 31 * MiB;
constexpr size_t WS_WGU = 34 * MiB, WS_WDN = 98 * MiB;
constexpr size_t WS_XB = 130 * MiB, WS_CAT = 194 * MiB;
constexpr size_t WS_Z = 258 * MiB;
constexpr size_t WS_HB = 258 * MiB, WS_Y = 330 * MiB;
constexpr size_t WS_END = 514 * MiB;
constexpr int CW_CNT = 64;
constexpr int CW_BAR = 4096;

constexpr int RING_BYTES = 131072;
constexpr int TAB_OFF = RING_BYTES;
constexpr int TS_OFF = TAB_OFF + 6 * 1024;
constexpr int LDS_BYTES = 147456;

__device__ __forceinline__ unsigned f2bf(float f) { unsigned u = __float_as_uint(f); return (u + 0x7fffu + ((u >> 16) & 1u)) >> 16; }
__device__ __forceinline__ float bf2f(unsigned b) { return __uint_as_float(b << 16); }
__device__ __forceinline__ unsigned pk2(float lo, float hi) { return f2bf(lo) | (f2bf(hi) << 16); }
__device__ __forceinline__ unsigned cvt_pk_bf16(float lo, float hi) { unsigned r; asm volatile("v_cvt_pk_bf16_f32 %0, %1, %2" : "=v"(r) : "v"(lo), "v"(hi)); return r; }
__device__ __forceinline__ float wave_sum(float v) {
#pragma unroll
    for (int o = 1; o < 64; o <<= 1) v += __shfl_xor(v, o);
    return v;
}
__device__ __forceinline__ float sigmoidf_(float x) { return 1.0f / (1.0f + __expf(-x)); }
__device__ __forceinline__ float siluf_(float x) { return x / (1.0f + __expf(-x)); }
__device__ __forceinline__ float gelu_tanh(float x) { const float u = 0.7978845608028654f * (x + 0.044715f * x * x * x); return 0.5f * x * (1.0f + tanhf(u)); }
#define LDS_WAIT() asm volatile("s_waitcnt lgkmcnt(0)" ::: "memory")

namespace pg8 {
constexpr int BM = 256, BK = 64, HALF = 128, HTB = HALF * BK * 2, NXCD = 8, WGM = 8;
__host__ __device__ __forceinline__ int lds_byte(int r, int c) { const int st = (r >> 4) * 2 + (c >> 5), rr = r & 15, cc = c & 31, ob = rr * 64 + cc * 2; return st * 1024 + (ob ^ (((ob >> 9) & 1) << 5)); }
__host__ __device__ __forceinline__ void stage_rc(int b, int& R, int& C) { const int st = b / 1024, sb = b % 1024, swz = sb ^ (((sb >> 9) & 1) << 5); R = (st >> 1) * 16 + swz / 64; C = (st & 1) * 32 + (swz % 64) / 2; }
__host__ __device__ __forceinline__ int perm32(int rho) { const int n = rho >> 4, i = rho & 15; return 8 * (i >> 2) + 4 * n + (i & 3); }

struct Unit { unsigned boff; int arow, orow, ocol, e, rl, slot; };

struct DenseOrder {
    int nM, nN, nwg, G, c, K;
    __device__ void init(int M, int N, int K_, int G_, int c_) { nM = M / BM; nN = N / BM; nwg = nM * nN; G = G_; c = c_; K = K_; }
    __device__ __forceinline__ bool next(int i, Unit& u) const {
        const long L = (long)i * G + c; if (L >= nwg) return false;
        int wgid = (int)L; { const int q = nwg / NXCD, r = nwg % NXCD, xcd = wgid % NXCD, off = wgid / NXCD; wgid = (xcd < r ? xcd * (q + 1) : r * (q + 1) + (xcd - r) * q) + off; }
        const int nig = WGM * nN, gid = wgid / nig, fm = gid * WGM, gsz = (nM - fm) < WGM ? (nM - fm) : WGM;
        const int pm = __builtin_amdgcn_readfirstlane(fm + ((wgid % nig) % gsz)), pn = __builtin_amdgcn_readfirstlane((wgid % nig) / gsz);
        u.arow = pm * BM; u.orow = pm * BM; u.ocol = pn * BM; u.boff = (unsigned)(pn * BM) * (unsigned)K * 2u; u.e = 0; u.rl = 0; u.slot = i; return true;
    }
    static constexpr bool GATHER = false;
    __device__ __forceinline__ size_t abase(const Unit& u) const { return (size_t)u.arow * (size_t)K * 2u; }
    __device__ __forceinline__ unsigned aoff(const Unit&, int) const { return 0u; }
};
template <bool GATHER_> struct MoeOrder {
    static constexpr bool GATHER = GATHER_;
    const LAS int* ts; const LAS unsigned* tab; int G, vcu, K;
    __device__ __forceinline__ bool next(int i, Unit& u) const {
        const int L = i * G + vcu; const int NT = __builtin_amdgcn_readfirstlane(ts[32]); if (L >= NT * 4) return false;
        const int rt = L >> 2, pn = L & 3; int e = 0;
#pragma unroll
        for (int j = 1; j < 32; ++j) e += (ts[j] <= rt) ? 1 : 0;
        e = __builtin_amdgcn_readfirstlane(e);
        u.e = e; u.rl = rt - __builtin_amdgcn_readfirstlane(ts[e]); u.orow = rt * BM; u.arow = rt * BM; u.ocol = pn * BM; u.boff = (unsigned)(e * 1024 + pn * BM) * (unsigned)K * 2u; u.slot = i; return true;
    }
    __device__ __forceinline__ size_t abase(const Unit& u) const { return GATHER ? (size_t)0 : (size_t)u.arow * (size_t)K * 2u; }
    __device__ __forceinline__ unsigned aoff(const Unit& u, int r) const { return tab[u.slot * 256 + r]; }
};

typedef f32x4 Acc[2][2][4][2];

struct EpiIn {
    static constexpr bool PERM = true;
    bf16_t* O; int ldc; const float* rstd; int silu_lo_end, silu_hi_start;
    __device__ __forceinline__ void operator()(const Acc& acc, const Unit& u, int wr, int wc, int fr, int fq) const {
        const bool act = (u.ocol < silu_lo_end) || (u.ocol >= silu_hi_start);
#pragma unroll
        for (int ai = 0; ai < 2; ++ai)
#pragma unroll
            for (int m = 0; m < 4; ++m) {
                const int row = u.orow + ai * HALF + wr * 64 + m * 16 + fr; const float rs = rstd[row];
                bf16_t* rowp = O + (size_t)row * ldc + u.ocol + wc * 32 + 8 * fq;
#pragma unroll
                for (int bj = 0; bj < 2; ++bj) { f32x4 v0 = acc[ai][bj][m][0] * rs, v1 = acc[ai][bj][m][1] * rs;
                    if (act) {
#pragma unroll
                        for (int j = 0; j < 4; ++j) { v0[j] = siluf_(v0[j]); v1[j] = siluf_(v1[j]); } }
                    u32x4 w; w.x = cvt_pk_bf16(v0[0], v0[1]); w.y = cvt_pk_bf16(v0[2], v0[3]); w.z = cvt_pk_bf16(v1[0], v1[1]); w.w = cvt_pk_bf16(v1[2], v1[3]);
                    *(u32x4*)(rowp + bj * HALF) = w; } }
    }
};
struct EpiOut {
    static constexpr bool PERM = true;
    const float* resid; float* H; bf16_t* XB;
    __device__ __forceinline__ void operator()(const Acc& acc, const Unit& u, int wr, int wc, int fr, int fq) const {
#pragma unroll
        for (int ai = 0; ai < 2; ++ai)
#pragma unroll
            for (int m = 0; m < 4; ++m) {
                const int row = u.orow + ai * HALF + wr * 64 + m * 16 + fr; const size_t off = (size_t)row * D + u.ocol + wc * 32 + 8 * fq;
#pragma unroll
                for (int bj = 0; bj < 2; ++bj) { const f32x4 r0 = *(const f32x4*)(resid + off + bj * HALF), r1 = *(const f32x4*)(resid + off + bj * HALF + 4);
                    const f32x4 v0 = acc[ai][bj][m][0] + r0, v1 = acc[ai][bj][m][1] + r1;
                    *(f32x4*)(H + off + bj * HALF) = v0; *(f32x4*)(H + off + bj * HALF + 4) = v1;
                    u32x4 w; w.x = cvt_pk_bf16(v0[0], v0[1]); w.y = cvt_pk_bf16(v0[2], v0[3]); w.z = cvt_pk_bf16(v1[0], v1[1]); w.w = cvt_pk_bf16(v1[2], v1[3]);
                    *(u32x4*)(XB + off + bj * HALF) = w; } }
    }
};
struct EpiGU {
    static constexpr bool PERM = true;
    bf16_t* HB; const float* lrstd; const LAS int* cnt;
    __device__ __forceinline__ void operator()(const Acc& acc, const Unit& u, int wr, int wc, int fr, int fq) const {
        const int n_e = cnt[u.e];
#pragma unroll
        for (int ai = 0; ai < 2; ++ai)
#pragma unroll
            for (int m = 0; m < 4; ++m) {
                const int r = ai * HALF + wr * 64 + m * 16 + fr, pos = u.rl * BM + r; const float rs = pos < n_e ? lrstd[(size_t)u.e * CAP + pos] : 0.f;
                float h[8];
#pragma unroll
                for (int n = 0; n < 2; ++n)
#pragma unroll
                    for (int j = 0; j < 4; ++j) { const float g = acc[ai][0][m][n][j] * rs, uu = acc[ai][1][m][n][j] * rs; h[n * 4 + j] = siluf_(g) * uu; }
                u32x4 w; w.x = cvt_pk_bf16(h[0], h[1]); w.y = cvt_pk_bf16(h[2], h[3]); w.z = cvt_pk_bf16(h[4], h[5]); w.w = cvt_pk_bf16(h[6], h[7]);
                *(u32x4*)(HB + (size_t)(u.orow + r) * DEXP + (u.ocol >> 1) + wc * 32 + 8 * fq) = w; }
    }
};
struct EpiDN {
    static constexpr bool PERM = true;
    bf16_t* Y; const float* lw; const LAS int* cnt;
    __device__ __forceinline__ void operator()(const Acc& acc, const Unit& u, int wr, int wc, int fr, int fq) const {
        const int n_e = cnt[u.e];
#pragma unroll
        for (int ai = 0; ai < 2; ++ai)
#pragma unroll
            for (int m = 0; m < 4; ++m) {
                const int r = ai * HALF + wr * 64 + m * 16 + fr, pos = u.rl * BM + r; const float ws = pos < n_e ? lw[(size_t)u.e * CAP + pos] : 0.f;
                bf16_t* rowp = Y + (size_t)(u.orow + r) * D + u.ocol + wc * 32 + 8 * fq;
#pragma unroll
                for (int bj = 0; bj < 2; ++bj) { const f32x4 v0 = acc[ai][bj][m][0] * ws, v1 = acc[ai][bj][m][1] * ws;
                    u32x4 w; w.x = cvt_pk_bf16(v0[0], v0[1]); w.y = cvt_pk_bf16(v0[2], v0[3]); w.z = cvt_pk_bf16(v1[0], v1[1]); w.w = cvt_pk_bf16(v1[2], v1[3]);
                    *(u32x4*)(rowp + bj * HALF) = w; } }
    }
};

template <class Epi, class Sched, bool ALIGN_EPI>
__device__ __forceinline__ void gemm_phase(LAS unsigned char* lds, const bf16_t* A, const bf16_t* Bt, const int K, const Sched& S, const Epi& E) {
    const int tid = threadIdx.x, wid = __builtin_amdgcn_readfirstlane(tid >> 6), lane = tid & 63, wr = wid >> 2, wc = wid & 3, fr = lane & 15, fq = lane >> 4;
    const int nt = K / BK;
    unsigned voffB[2], vA0[2], vA1[2];
#pragma unroll
    for (int i = 0; i < 2; ++i) { int R, C; stage_rc(tid * 16 + i * 8192, R, C); const int Rb = Epi::PERM ? ((R & ~31) + perm32(R & 31)) : R;
        vA0[i] = (unsigned)(R * K + C) * 2u; vA1[i] = vA0[i]; voffB[i] = (unsigned)(Rb * K + C) * 2u; }
#define PG8_FILL(u) do { if constexpr (Sched::GATHER) { int tv_ = tid; asm volatile("" : "+v"(tv_)); _Pragma("unroll") for (int i = 0; i < 2; ++i) { int R, C; stage_rc(tv_ * 16 + i * 8192, R, C); \
        vA0[i] = S.aoff(u, R) + (unsigned)C * 2u; vA1[i] = S.aoff(u, HALF + R) + (unsigned)C * 2u; } } } while (0)
    const size_t kstep = (size_t)(BK * 2);
    const size_t hstep = (size_t)HALF * K * 2;
    const unsigned ldsw = (unsigned)wid * 1024u;
    const int aoff = lds_byte(wr * 64 + fr, fq * 8), boff = lds_byte(wc * 32 + fr, fq * 8);
#define PG8_SA(b, h) (((b) * 2 + (h)) * HTB)
#define PG8_SB(b, h) ((4 + (b) * 2 + (h)) * HTB)
#define PG8_STAGE(bufoff, gbase, voff) do { _Pragma("unroll") for (int _i = 0; _i < 2; ++_i) \
        __builtin_amdgcn_global_load_lds((const unsigned*)((const char*)(gbase) + (voff)[_i]), (LAS unsigned*)(lds + (bufoff) + ldsw + _i * 8192), 16, 0, 0); } while (0)
#define PG8_LDA(dst, b, h) do { _Pragma("unroll") for (int m = 0; m < 4; ++m) _Pragma("unroll") for (int k = 0; k < 2; ++k) dst[m][k] = *(const LAS bf16x8*)(lds + PG8_SA(b, h) + aoff + m * 2048 + k * 1024); } while (0)
#define PG8_LDB(dst, b, h) do { _Pragma("unroll") for (int n = 0; n < 2; ++n) _Pragma("unroll") for (int k = 0; k < 2; ++k) dst[n][k] = *(const LAS bf16x8*)(lds + PG8_SB(b, h) + boff + n * 2048 + k * 1024); } while (0)
#define PG8_MMA(ai, bj, At, Bt_) do { __builtin_amdgcn_s_setprio(1); _Pragma("unroll") for (int m = 0; m < 4; ++m) _Pragma("unroll") for (int n = 0; n < 2; ++n) _Pragma("unroll") for (int k = 0; k < 2; ++k) \
        acc[ai][bj][m][n] = __builtin_amdgcn_mfma_f32_16x16x32_bf16(Bt_[n][k], At[m][k], acc[ai][bj][m][n], 0, 0, 0); __builtin_amdgcn_s_setprio(0); } while (0)
#define PG8_WAIT_V(n) asm volatile("s_waitcnt vmcnt(" #n ")" ::: "memory")
#define PG8_WAIT_L(n) asm volatile("s_waitcnt lgkmcnt(" #n ")" ::: "memory")
#define PG8_BAR __builtin_amdgcn_s_barrier()
#define PG8_SCHED __builtin_amdgcn_sched_barrier(0)
    Unit cur, nxt; int ui = 0;
    if (!S.next(0, cur)) return;
    f32x4 acc[2][2][4][2];
#pragma unroll
    for (int a = 0; a < 2; ++a)
#pragma unroll
        for (int b = 0; b < 2; ++b)
#pragma unroll
            for (int m = 0; m < 4; ++m)
#pragma unroll
                for (int n = 0; n < 2; ++n) acc[a][b][m][n] = (f32x4){0.f, 0.f, 0.f, 0.f};
    bf16x8 At[4][2], B0[2][2], B1[2][2];
    PG8_FILL(cur);
    const char* cA0 = (const char*)A + S.abase(cur); const char* cA1 = cA0 + (Sched::GATHER ? (size_t)0 : hstep); const char* cB = (const char*)Bt + cur.boff;
    PG8_STAGE(PG8_SB(0, 0), cB, voffB); PG8_STAGE(PG8_SB(0, 1), cB + hstep, voffB); PG8_STAGE(PG8_SA(0, 0), cA0, vA0); PG8_STAGE(PG8_SA(0, 1), cA1, vA1);
    if (wr == 1) PG8_BAR;
    PG8_WAIT_V(2); PG8_BAR;
    PG8_STAGE(PG8_SB(1, 0), cB + kstep, voffB); PG8_STAGE(PG8_SA(1, 0), cA0 + kstep, vA0); PG8_STAGE(PG8_SB(1, 1), cB + hstep + kstep, voffB);
    PG8_WAIT_V(6); PG8_BAR;
    for (;;) {
        const bool has_next = S.next(ui + 1, nxt);
        const char* nB = has_next ? (const char*)Bt + nxt.boff : cB;
        const char* nA0 = has_next ? (const char*)A + S.abase(nxt) : cA0; const char* nA1 = nA0 + (Sched::GATHER ? (size_t)0 : hstep);
        for (int t = 0; t < nt; t += 2) {
            const bool last = (t == nt - 2);
            const char* a1 = cA1 + (size_t)(t + 1) * kstep;
            const char* a2 = last ? nA0 : cA0 + (size_t)(t + 2) * kstep; const char* a2h = last ? nA1 : cA1 + (size_t)(t + 2) * kstep; const char* b2 = last ? nB : cB + (size_t)(t + 2) * kstep;
            const char* a3 = a2 + kstep; const char* b3 = b2 + kstep;
            PG8_LDB(B0, 0, 0); PG8_LDB(B1, 0, 1); PG8_SCHED; PG8_LDA(At, 0, 0); PG8_STAGE(PG8_SA(1, 1), a1, vA1);
            if (last && has_next) PG8_FILL(nxt);
            PG8_WAIT_V(8); PG8_WAIT_L(0); PG8_BAR; PG8_MMA(0, 0, At, B0); PG8_MMA(0, 1, At, B1); PG8_BAR; PG8_SCHED;
            PG8_LDA(At, 0, 1); PG8_STAGE(PG8_SB(0, 0), b2, voffB); PG8_STAGE(PG8_SB(0, 1), b2 + hstep, voffB); PG8_STAGE(PG8_SA(0, 0), a2, vA0);
            PG8_WAIT_V(8); PG8_WAIT_L(0); PG8_BAR; PG8_MMA(1, 0, At, B0); PG8_MMA(1, 1, At, B1); PG8_BAR; PG8_SCHED;
            PG8_LDB(B0, 1, 0); PG8_LDB(B1, 1, 1); PG8_SCHED; PG8_LDA(At, 1, 0); PG8_STAGE(PG8_SA(0, 1), a2h, vA1);
            PG8_WAIT_V(8); PG8_WAIT_L(0); PG8_BAR; PG8_MMA(0, 0, At, B0); PG8_MMA(0, 1, At, B1); PG8_BAR; PG8_SCHED;
            PG8_LDA(At, 1, 1); PG8_STAGE(PG8_SB(1, 0), b3, voffB); PG8_STAGE(PG8_SB(1, 1), b3 + hstep, voffB); PG8_STAGE(PG8_SA(1, 0), a3, vA0);
            PG8_WAIT_V(8); PG8_WAIT_L(0); PG8_BAR; PG8_MMA(1, 0, At, B0); PG8_MMA(1, 1, At, B1); PG8_BAR; PG8_SCHED;
        }
        if constexpr (ALIGN_EPI) { if (wr == 0) PG8_BAR; }
        E(acc, cur, wr, wc, fr, fq);
        if (!has_next) break;
#pragma unroll
        for (int a = 0; a < 2; ++a)
#pragma unroll
            for (int b = 0; b < 2; ++b)
#pragma unroll
                for (int m = 0; m < 4; ++m)
#pragma unroll
                    for (int n = 0; n < 2; ++n) acc[a][b][m][n] = (f32x4){0.f, 0.f, 0.f, 0.f};
        cur = nxt; cB = nB; cA0 = nA0; cA1 = nA1; ++ui;
        if constexpr (ALIGN_EPI) { if (wr == 1) PG8_BAR; }
    }
    PG8_WAIT_V(0);
    if constexpr (!ALIGN_EPI) { if (wr == 0) PG8_BAR; }
    PG8_BAR;
#undef PG8_FILL
#undef PG8_SA
#undef PG8_SB
#undef PG8_STAGE
#undef PG8_LDA
#undef PG8_LDB
#undef PG8_MMA
#undef PG8_WAIT_V
#undef PG8_WAIT_L
#undef PG8_BAR
#undef PG8_SCHED
}
}

struct Args { const float* in[23]; float* out; unsigned char* ws; int ph_lo, ph_hi; };
enum { PH_PRO = 0, PH_IN0, PH_MIX0, PH_OUT0, PH_R1, PH_GU0, PH_DN0, PH_R2, PH_IN1, PH_MIX1, PH_OUT1, PH_R3, PH_GU1, PH_DN1, PH_R4, NPH };

struct Frame {
    LAS unsigned char* lds; int tid, lane, wave, vcu, G;
    const float* const* in; float* out; unsigned char* ws;
};

__device__ __forceinline__ void transpose_item(const float* W, int K, int N, const float* kscale, bf16_t* WT, int dest_row0, LAS float* scr, int kb, int nb, int lane) {
    const int k0 = 64 * kb, n0 = 32 * nb;
#pragma unroll 8
    for (int i = 0; i < 32; ++i) { const int kk = 2 * i + (lane >> 5); float v = W[(size_t)(k0 + kk) * N + n0 + (lane & 31)]; if (kscale) v *= kscale[k0 + kk]; scr[kk * 33 + (lane & 31)] = v; }
    LDS_WAIT(); asm volatile("" ::: "memory");
    const int c = lane & 7;
#pragma unroll
    for (int j = 0; j < 4; ++j) { const int n = (lane >> 3) + 8 * j; const LAS float* s = scr + (8 * c) * 33 + n;
        u32x4 o; o.x = pk2(s[0 * 33], s[1 * 33]); o.y = pk2(s[2 * 33], s[3 * 33]); o.z = pk2(s[4 * 33], s[5 * 33]); o.w = pk2(s[6 * 33], s[7 * 33]);
        *(u32x4*)(WT + (size_t)(dest_row0 + n) * K + k0 + 8 * c) = o; }
    LDS_WAIT(); asm volatile("" ::: "memory");
}
__device__ __forceinline__ void moe_convert(Frame& F, int layer) {
    LAS float* scr = (LAS float*)(F.lds + F.wave * 16384);
    const int gw = F.vcu * 8 + F.wave, NGW = F.G * 8;
    const float* gffn = F.in[2] + layer * D;
    const float* Wg = F.in[20] + (size_t)layer * NEXP * D * DEXP; const float* Wu = F.in[21] + (size_t)layer * NEXP * D * DEXP; const float* Wd = F.in[22] + (size_t)layer * NEXP * DEXP * D;
    bf16_t* WGU = (bf16_t*)(F.ws + WS_WGU); bf16_t* WDN = (bf16_t*)(F.ws + WS_WDN);
    for (int it = gw; it < 3 * 8192; it += NGW) {
        const int which = it >> 13, r = it & 8191, e = r >> 8, q = r & 255;
        if (which < 2) { const int kb = q >> 4, nb = q & 15, n0 = nb * 32;
            const int dest = e * 1024 + (n0 >> 7) * 256 + (which ? 128 : 0) + (n0 & 127);
            transpose_item((which ? Wu : Wg) + (size_t)e * D * DEXP, D, DEXP, gffn, WGU, dest, scr, kb, nb, F.lane);
        } else { const int kb = q >> 5, nb = q & 31;
            transpose_item(Wd + (size_t)e * DEXP * D, DEXP, D, nullptr, WDN, e * 1024 + nb * 32, scr, kb, nb, F.lane); }
    }
}
__device__ __forceinline__ void p_prologue(Frame& F) {
    LAS float* scr = (LAS float*)(F.lds + F.wave * 16384);
    const int gw = F.vcu * 8 + F.wave, NGW = F.G * 8;
    constexpr int I0 = 16 * 80, I1 = 16 * 32, I2 = 16 * 128, I3 = 16 * 32;
    for (int it = gw; it < I0 + I1 + I2 + I3; it += NGW) {
        int r = it;
        if (r < I0) { transpose_item(F.in[4], D, AB_IN, F.in[1], (bf16_t*)(F.ws + WS_WIN0), (r % 80) * 32, scr, r / 80, r % 80, F.lane); continue; } r -= I0;
        if (r < I1) { transpose_item(F.in[13], D, D, nullptr, (bf16_t*)(F.ws + WS_WOUT0), (r % 32) * 32, scr, r / 32, r % 32, F.lane); continue; } r -= I1;
        if (r < I2) { transpose_item(F.in[14], D, C_IN, F.in[1] + D, (bf16_t*)(F.ws + WS_WIN1), (r % 128) * 32, scr, r / 128, r % 128, F.lane); continue; } r -= I2;
        transpose_item(F.in[17], D, D, nullptr, (bf16_t*)(F.ws + WS_WOUT1), (r % 32) * 32, scr, r / 32, r % 32, F.lane);
    }
    moe_convert(F, 0);
    { const float* x = F.in[0]; bf16_t* XB = (bf16_t*)(F.ws + WS_XB); float* rstd = (float*)(F.ws + WS_RSTD);
      for (int m = gw; m < T; m += NGW) { const f32x4* xr = (const f32x4*)(x + (size_t)m * D) + F.lane; f32x4 v[4]; float s = 0.f;
#pragma unroll
          for (int j = 0; j < 4; ++j) { v[j] = xr[64 * j]; s += (v[j].x * v[j].x + v[j].y * v[j].y) + (v[j].z * v[j].z + v[j].w * v[j].w); }
          s = wave_sum(s); if (F.lane == 0) rstd[m] = rsqrtf(s * (1.f / D) + EPS);
          u32x2* o8 = (u32x2*)(XB + (size_t)m * D) + F.lane;
#pragma unroll
          for (int j = 0; j < 4; ++j) o8[64 * j] = (u32x2){pk2(v[j].x, v[j].y), pk2(v[j].z, v[j].w)}; } }
    const int gt = F.vcu * 512 + F.tid, NGT = F.G * 512;
    { float* lb = (float*)(F.ws + WS_LB); const float* l = F.in[15];
      for (int c = gt; c < 1024; c += NGT) { const float a = l[c], b = l[1024 + c], mx = fmaxf(a, b), ea = __expf(a - mx), eb = __expf(b - mx); lb[c] = ea / (ea + eb); } }
    { float* RgT = (float*)(F.ws + WS_RGT); float* ReT = (float*)(F.ws + WS_RET);
      for (int i = gt; i < 2 * 36 * 1024; i += NGT) { const int l = i / (36 * 1024), r = i % (36 * 1024), j = r >> 10, c = r & 1023; const float g = F.in[2][l * D + c];
          if (j < 4) RgT[(l * 4 + j) * 1024 + c] = g * F.in[18][((size_t)l * D + c) * 4 + j];
          else ReT[(l * 32 + (j - 4)) * 1024 + c] = g * F.in[19][((size_t)l * D + c) * 32 + (j - 4)]; } }
}

__device__ __forceinline__ void moe_tables(Frame& F, int layer) {
    LAS int* ts = (LAS int*)(F.lds + TS_OFF); LAS int* cn = ts + 40;
    const unsigned* cnt = (const unsigned*)(F.ws + WS_CTL) + CW_CNT + layer * 32;
    __syncthreads();
    if (F.tid < 32) cn[F.tid] = (int)__hip_atomic_load(cnt + F.tid, __ATOMIC_RELAXED, __HIP_MEMORY_SCOPE_AGENT);
    __syncthreads();
    if (F.tid == 0) { int s = 0; for (int e = 0; e < 32; ++e) { ts[e] = s; s += (cn[e] + 255) >> 8; } ts[32] = s; }
    __syncthreads();
}

__device__ __forceinline__ void p_router(Frame& F, int layer) {
    const int gw = F.vcu * 8 + F.wave, NGW = F.G * 8;
    const float* H = F.out; const float* RgT = (const float*)(F.ws + WS_RGT) + layer * 4 * 1024; const float* ReT = (const float*)(F.ws + WS_RET) + layer * 32 * 1024;
    unsigned* cnt = (unsigned*)(F.ws + WS_CTL) + CW_CNT + layer * 32;
    int* ltok = (int*)(F.ws + WS_LTOK); float* lrstd = (float*)(F.ws + WS_LRSTD); float* lw = (float*)(F.ws + WS_LW); int* tokinfo = (int*)(F.ws + WS_TOKINFO);
    for (int m = gw; m < T; m += NGW) {
        const f32x4* hr = (const f32x4*)(H + (size_t)m * D) + F.lane; f32x4 v[4]; float s = 0.f;
#pragma unroll
        for (int j = 0; j < 4; ++j) { v[j] = hr[64 * j]; s += (v[j].x * v[j].x + v[j].y * v[j].y) + (v[j].z * v[j].z + v[j].w * v[j].w); }
        const float rstd = rsqrtf(wave_sum(s) * (1.f / D) + EPS);
        float lg[4];
#pragma unroll
        for (int gi = 0; gi < 4; ++gi) { const f32x4* w = (const f32x4*)(RgT + gi * 1024) + F.lane; float a = 0.f;
#pragma unroll
            for (int j = 0; j < 4; ++j) { const f32x4 ww = w[64 * j]; a += (v[j].x * ww.x + v[j].y * ww.y) + (v[j].z * ww.z + v[j].w * ww.w); }
            lg[gi] = wave_sum(a) * rstd; }
        int gidx = 0; float gmax = lg[0];
#pragma unroll
        for (int gi = 1; gi < 4; ++gi) if (lg[gi] > gmax) { gmax = lg[gi]; gidx = gi; }
        float gs = 0.f;
#pragma unroll
        for (int gi = 0; gi < 4; ++gi) gs += __expf(lg[gi] - gmax);
        const float ggate = 1.f / gs;
        gidx = __builtin_amdgcn_readfirstlane(gidx);
        float le[8];
#pragma unroll
        for (int e = 0; e < 8; ++e) { const f32x4* w = (const f32x4*)(ReT + (gidx * 8 + e) * 1024) + F.lane; float a = 0.f;
#pragma unroll
            for (int j = 0; j < 4; ++j) { const f32x4 ww = w[64 * j]; a += (v[j].x * ww.x + v[j].y * ww.y) + (v[j].z * ww.z + v[j].w * ww.w); }
            le[e] = wave_sum(a) * rstd; }
        int i0 = 0; float v0 = le[0];
#pragma unroll
        for (int e = 1; e < 8; ++e) if (le[e] > v0) { v0 = le[e]; i0 = e; }
        int i1 = -1; float v1 = -3.0e38f;
#pragma unroll
        for (int e = 0; e < 8; ++e) if (e != i0 && le[e] > v1) { v1 = le[e]; i1 = e; }
        const float ex = __expf(v1 - v0), w0 = ggate / (1.f + ex), w1 = ggate * ex / (1.f + ex);
        if (F.lane == 0) {
            ((float*)(F.ws + WS_RSTD))[m] = rstd;
            const int e0 = gidx * 8 + i0, e1 = gidx * 8 + i1;
            const unsigned p0 = atomicAdd(cnt + e0, 1u), p1 = atomicAdd(cnt + e1, 1u);
            ltok[(size_t)e0 * CAP + p0] = m; lrstd[(size_t)e0 * CAP + p0] = rstd; lw[(size_t)e0 * CAP + p0] = w0;
            ltok[(size_t)e1 * CAP + p1] = m; lrstd[(size_t)e1 * CAP + p1] = rstd; lw[(size_t)e1 * CAP + p1] = w1;
            tokinfo[2 * m] = e0 * CAP + (int)p0; tokinfo[2 * m + 1] = e1 * CAP + (int)p1;
        }
    }
}
__device__ __forceinline__ void p_combine(Frame& F, int layer, int mode) {
    moe_tables(F, layer);
    const LAS int* ts = (const LAS int*)(F.lds + TS_OFF);
    const int gw = F.vcu * 8 + F.wave, NGW = F.G * 8;
    float* H = F.out; const bf16_t* Y = (const bf16_t*)(F.ws + WS_Y); const int* tokinfo = (const int*)(F.ws + WS_TOKINFO);
    bf16_t* XB = (bf16_t*)(F.ws + WS_XB); float* rstd = (float*)(F.ws + WS_RSTD); const float* gfin = F.in[3];
    for (int m = gw; m < T; m += NGW) {
        const int t0 = tokinfo[2 * m], t1 = tokinfo[2 * m + 1];
        const size_t s0 = (size_t)ts[t0 >> 15] * 256 + (t0 & (CAP - 1)), s1 = (size_t)ts[t1 >> 15] * 256 + (t1 & (CAP - 1));
        f32x4* hr = (f32x4*)(H + (size_t)m * D) + F.lane; const u32x2* y0 = (const u32x2*)(Y + s0 * D) + F.lane; const u32x2* y1 = (const u32x2*)(Y + s1 * D) + F.lane;
        f32x4 v[4]; float s = 0.f;
#pragma unroll
        for (int j = 0; j < 4; ++j) { v[j] = hr[64 * j]; const u32x2 a = y0[64 * j], b = y1[64 * j];
            v[j].x += bf2f(a.x & 0xffffu) + bf2f(b.x & 0xffffu); v[j].y += bf2f(a.x >> 16) + bf2f(b.x >> 16); v[j].z += bf2f(a.y & 0xffffu) + bf2f(b.y & 0xffffu); v[j].w += bf2f(a.y >> 16) + bf2f(b.y >> 16);
            s += (v[j].x * v[j].x + v[j].y * v[j].y) + (v[j].z * v[j].z + v[j].w * v[j].w); }
        const float rs = rsqrtf(wave_sum(s) * (1.f / D) + EPS);
        if (mode == 0) {
            if (F.lane == 0) rstd[m] = rs;
            u32x2* o8 = (u32x2*)(XB + (size_t)m * D) + F.lane;
#pragma unroll
            for (int j = 0; j < 4; ++j) { hr[64 * j] = v[j]; o8[64 * j] = (u32x2){pk2(v[j].x, v[j].y), pk2(v[j].z, v[j].w)}; }
        } else {
            const f32x4* g4 = (const f32x4*)gfin + F.lane;
#pragma unroll
            for (int j = 0; j < 4; ++j) { const f32x4 g = g4[64 * j]; hr[64 * j] = (f32x4){v[j].x * rs * g.x, v[j].y * rs * g.y, v[j].z * rs * g.z, v[j].w * rs * g.w}; }
        }
    }
}

__device__ __forceinline__ void mix_rglru_item(Frame& F, int b, int nb) {
    LAS float* L = (LAS float*)F.lds;
    LAS float* wa = L; LAS float* wx = L + 4096; LAS float* xat = L + 8192;   LAS float* xc = xat + 67 * 64; LAS float* ga = xc + 4096; LAS float* av = ga + 4096; LAS float* uv = av + 4096; LAS float* prm = uv + 4096;
    const bf16_t* Z = (const bf16_t*)(F.ws + WS_Z); bf16_t* CAT = (bf16_t*)(F.ws + WS_CAT);
    const int tid = F.tid;
    __syncthreads();
    for (int i = tid; i < 4096; i += 512) { wa[i] = F.in[7][nb * 4096 + i]; wx[i] = F.in[9][nb * 4096 + i]; }
    if (tid < 64) { const int c = nb * 64 + tid; prm[tid] = F.in[6][c]; prm[64 + tid] = F.in[5][c]; prm[128 + tid] = F.in[5][512 + c]; prm[192 + tid] = F.in[5][1024 + c]; prm[256 + tid] = F.in[5][1536 + c];
        prm[320 + tid] = F.in[8][c]; prm[384 + tid] = F.in[10][c]; const float lam = F.in[11][c]; prm[448 + tid] = fminf(lam, 0.f) - log1pf(__expf(-fabsf(lam))); }
    float hcar = 0.f;
    for (int t0 = 0; t0 < SEQ; t0 += 64) {
        __syncthreads();
        for (int i = tid; i < 67 * 64; i += 512) { const int r = i >> 6, c = i & 63, tg = t0 - 3 + r; xat[i] = tg >= 0 ? bf2f(Z[((size_t)b * SEQ + tg) * AB_IN + nb * 64 + c]) : 0.f; }
        for (int i = tid; i < 4096; i += 512) { const int r = i >> 6, c = i & 63; ga[i] = bf2f(Z[((size_t)b * SEQ + t0 + r) * AB_IN + 512 + nb * 64 + c]); }
        __syncthreads();
        for (int i = tid; i < 4096; i += 512) { const int r = i >> 6, c = i & 63; xc[i] = prm[c] + prm[64 + c] * xat[r * 64 + c] + prm[128 + c] * xat[(r + 1) * 64 + c] + prm[192 + c] * xat[(r + 2) * 64 + c] + prm[256 + c] * xat[(r + 3) * 64 + c]; }
        __syncthreads();
        { const int tok = tid >> 3, dg = tid & 7; float aa[8], ax[8];
#pragma unroll
          for (int j = 0; j < 8; ++j) { aa[j] = 0.f; ax[j] = 0.f; }
          for (int c = 0; c < 64; ++c) { const float xv = xc[tok * 64 + c]; const LAS f32x4* pa = (const LAS f32x4*)(wa + c * 64 + dg * 8); const LAS f32x4* px = (const LAS f32x4*)(wx + c * 64 + dg * 8);
              const f32x4 a0 = pa[0], a1 = pa[1], x0 = px[0], x1 = px[1];
              aa[0] += xv * a0.x; aa[1] += xv * a0.y; aa[2] += xv * a0.z; aa[3] += xv * a0.w; aa[4] += xv * a1.x; aa[5] += xv * a1.y; aa[6] += xv * a1.z; aa[7] += xv * a1.w;
              ax[0] += xv * x0.x; ax[1] += xv * x0.y; ax[2] += xv * x0.z; ax[3] += xv * x0.w; ax[4] += xv * x1.x; ax[5] += xv * x1.y; ax[6] += xv * x1.z; ax[7] += xv * x1.w; }
#pragma unroll
          for (int j = 0; j < 8; ++j) { const int d = dg * 8 + j; const float r = sigmoidf_(aa[j] + prm[320 + d]), ig = sigmoidf_(ax[j] + prm[384 + d]);
              const float la = 8.0f * r * prm[448 + d]; av[tok * 64 + d] = __expf(la); uv[tok * 64 + d] = sqrtf(fmaxf(-expm1f(2.0f * la), 0.f)) * (ig * xc[tok * 64 + d]); } }
        __syncthreads();
        if (tid < 64) { for (int r = 0; r < 64; ++r) { hcar = av[r * 64 + tid] * hcar + uv[r * 64 + tid]; av[r * 64 + tid] = hcar; } }
        __syncthreads();
        for (int i = tid; i < 4096; i += 512) { const int r = i >> 6, c = i & 63; CAT[((size_t)b * SEQ + t0 + r) * D + nb * 64 + c] = (bf16_t)f2bf(av[i] * gelu_tanh(ga[i])); }
    }
    __syncthreads();
}
__device__ __forceinline__ void mix_attn_item(Frame& F, int b, int c, int h) {
    LAS float* Ks = (LAS float*)F.lds;   LAS float* Vs = Ks + 64 * 68;   LAS float* bs = Vs + 4096;   LAS float* Ss = bs + 520;
    const bf16_t* Z = (const bf16_t*)(F.ws + WS_Z); bf16_t* CAT = (bf16_t*)(F.ws + WS_CAT);
    const int tid = F.tid, t = tid >> 3, sub = tid & 7;
    __syncthreads();
    for (int i = tid; i < 513; i += 512) bs[i] = F.in[12][h * 513 + i];
    unsigned q2[32]; float o[64];
    { const unsigned* qp = (const unsigned*)(Z + ((size_t)b * SEQ + c * 64 + t) * AB_IN + 1024 + h * 64);
#pragma unroll
      for (int d = 0; d < 32; ++d) q2[d] = qp[d];
#pragma unroll
      for (int d = 0; d < 64; ++d) o[d] = 0.f; }
    float mrun = -3.0e38f, lrun = 0.f;
    for (int kc = (c >= 8 ? c - 8 : 0); kc <= c; ++kc) {
        __syncthreads();
        for (int i = tid; i < 4096; i += 512) { const int s = i >> 6, d = i & 63; const size_t base = ((size_t)b * SEQ + kc * 64 + s) * AB_IN + h * 64 + d;
            Ks[s * 68 + d] = bf2f(Z[base + 1536]); Vs[s * 64 + d] = bf2f(Z[base + 2048]); }
        __syncthreads();
        float tmax = -3.0e38f;
#pragma unroll 1
        for (int jj = 0; jj < 8; ++jj) { const int s = sub + 8 * jj; const LAS f32x4* kp = (const LAS f32x4*)(Ks + s * 68); float a = 0.f;
#pragma unroll
            for (int d4 = 0; d4 < 16; ++d4) { const f32x4 kv = kp[d4]; a += bf2f(q2[2 * d4] & 0xffffu) * kv.x + bf2f(q2[2 * d4] >> 16) * kv.y + bf2f(q2[2 * d4 + 1] & 0xffffu) * kv.z + bf2f(q2[2 * d4 + 1] >> 16) * kv.w; }
            a *= 0.125f;
            int rel = t - ((kc - c) * 64 + s); rel = rel < -256 ? -256 : (rel > 256 ? 256 : rel);
            a += bs[rel + 256]; Ss[t * 65 + s] = a; tmax = fmaxf(tmax, a); }
        const float mnew = fmaxf(mrun, tmax), f = __expf(mrun - mnew);
        lrun *= f;
#pragma unroll
        for (int d = 0; d < 64; ++d) o[d] *= f;
#pragma unroll 1
        for (int jj = 0; jj < 8; ++jj) { const int s = sub + 8 * jj; const float p = __expf(Ss[t * 65 + s] - mnew); lrun += p; const LAS f32x4* vp = (const LAS f32x4*)(Vs + s * 64);
#pragma unroll
            for (int d4 = 0; d4 < 16; ++d4) { const f32x4 vv = vp[d4]; o[4 * d4] += p * vv.x; o[4 * d4 + 1] += p * vv.y; o[4 * d4 + 2] += p * vv.z; o[4 * d4 + 3] += p * vv.w; } }
        mrun = mnew;
    }
    float mall = mrun;
    mall = fmaxf(mall, __shfl_xor(mall, 1)); mall = fmaxf(mall, __shfl_xor(mall, 2)); mall = fmaxf(mall, __shfl_xor(mall, 4));
    const float f = __expf(mrun - mall); lrun *= f;
    lrun += __shfl_xor(lrun, 1); lrun += __shfl_xor(lrun, 2); lrun += __shfl_xor(lrun, 4);
    const float inv = 1.0f / lrun;
    bf16_t* op = CAT + ((size_t)b * SEQ + c * 64 + t) * D + 512 + h * 64;
#pragma unroll
    for (int d = 0; d < 64; ++d) { float v = o[d] * f; v += __shfl_xor(v, 1); v += __shfl_xor(v, 2); v += __shfl_xor(v, 4); if ((d >> 3) == sub) op[d] = (bf16_t)f2bf(v * inv); }
}

typedef float f32x16 __attribute__((ext_vector_type(16)));
typedef short s16x4 __attribute__((ext_vector_type(4)));
__device__ __forceinline__ s16x4 ds_tr16(const LAS unsigned char* p) { return __builtin_bit_cast(s16x4, __builtin_amdgcn_ds_read_tr16_b64_v4i16((LAS s16x4*)p)); }
constexpr int ATT_BT_BYTES = 8 * 520 * 4;
__device__ __forceinline__ void attn_load_bias(Frame& F) {
    LAS float* bt = (LAS float*)F.lds;
    __syncthreads();
    for (int i = F.tid; i < 8 * 513; i += 512) { const int h = i / 513, j = i % 513; bt[h * 520 + j] = F.in[12][i] * 1.4426950408889634f; }
    __syncthreads();
}
__device__ __forceinline__ void attn_wave_mfma(Frame& F, int b, int c, int h) {
    const bf16_t* Z = (const bf16_t*)(F.ws + WS_Z); bf16_t* CAT = (bf16_t*)(F.ws + WS_CAT);
    const int l = F.lane, r = l & 31, hh = l >> 5;
    const LAS float* btab = (const LAS float*)F.lds + h * 520;
    LAS unsigned char* Vw = F.lds + ATT_BT_BYTES + F.wave * 8192;
    const float SC = 0.125f * 1.4426950408889634f;
    bf16x8 qf[2][4];
    { const bf16_t* Qb = Z + ((size_t)b * SEQ + c * 64) * AB_IN + 1024 + h * 64;
#pragma unroll
      for (int qb = 0; qb < 2; ++qb)
#pragma unroll
          for (int ks = 0; ks < 4; ++ks) qf[qb][ks] = *(const bf16x8*)(Qb + (size_t)(qb * 32 + r) * AB_IN + ks * 16 + hh * 8); }
    f32x16 o[2][2];
#pragma unroll
    for (int a = 0; a < 2; ++a)
#pragma unroll
        for (int d = 0; d < 2; ++d)
#pragma unroll
            for (int i = 0; i < 16; ++i) o[a][d][i] = 0.f;
    float mrun[2] = {-1.0e30f, -1.0e30f}, lsum[2] = {0.f, 0.f};
    const int q4 = (l & 15) >> 2, p4 = l & 3, cb = (l >> 4) & 1, xs = (q4 >> 1) & 1;
    const LAS unsigned char* vbase = Vw + (4 * hh + q4) * 128 + p4 * 8 + cb * 32;
    const LAS unsigned char* vb[2] = {vbase + xs * 64, vbase + (1 - xs) * 64};
    for (int kc = (c >= 8 ? c - 8 : 0); kc <= c; ++kc) {
        const bf16_t* Kb = Z + ((size_t)b * SEQ + kc * 64) * AB_IN + 1536 + h * 64; const bf16_t* Vb = Kb + 512;
        { u32x4 vr[8];
#pragma unroll
          for (int i = 0; i < 8; ++i) vr[i] = *(const u32x4*)(Vb + (size_t)(i * 8 + (l >> 3)) * AB_IN + (l & 7) * 8);
#pragma unroll
          for (int i = 0; i < 8; ++i) { const int s = i * 8 + (l >> 3), ci = l & 7, pb = (ci >> 1) ^ (((s >> 1) & 1) << 1); *(LAS u32x4*)(Vw + s * 128 + pb * 32 + (ci & 1) * 16) = vr[i]; } }
        asm volatile("" ::: "memory");
        bf16x8 kf[2][4];
#pragma unroll
        for (int sb = 0; sb < 2; ++sb)
#pragma unroll
            for (int ks = 0; ks < 4; ++ks) kf[sb][ks] = *(const bf16x8*)(Kb + (size_t)(sb * 32 + r) * AB_IN + ks * 16 + hh * 8);
        const int dt = (c - kc) * 64;
#pragma unroll
        for (int qb = 0; qb < 2; ++qb) {
            f32x16 st[2];
#pragma unroll
            for (int sb = 0; sb < 2; ++sb) {
#pragma unroll
                for (int i = 0; i < 16; ++i) st[sb][i] = 0.f;
#pragma unroll
                for (int ks = 0; ks < 4; ++ks) st[sb] = __builtin_amdgcn_mfma_f32_32x32x16_bf16(kf[sb][ks], qf[qb][ks], st[sb], 0, 0, 0); }
            if (dt >= 320) { const float bc = btab[512];
#pragma unroll
                for (int sb = 0; sb < 2; ++sb)
#pragma unroll
                    for (int i = 0; i < 16; ++i) st[sb][i] = st[sb][i] * SC + bc;
            } else { const int base = dt + qb * 32 + r - 4 * hh + 256;
#pragma unroll
                for (int sb = 0; sb < 2; ++sb)
#pragma unroll
                    for (int i = 0; i < 16; ++i) { int idx = base - sb * 32 - ((i & 3) + 8 * (i >> 2)); idx = idx > 512 ? 512 : idx; st[sb][i] = st[sb][i] * SC + btab[idx]; } }
            float mx = st[0][0];
#pragma unroll
            for (int sb = 0; sb < 2; ++sb)
#pragma unroll
                for (int i = 0; i < 16; ++i) mx = fmaxf(mx, st[sb][i]);
            mx = fmaxf(mx, __shfl_xor(mx, 32));
            const float mn = fmaxf(mrun[qb], mx), alpha = __builtin_amdgcn_exp2f(mrun[qb] - mn); mrun[qb] = mn;
            float rs = 0.f;
#pragma unroll
            for (int sb = 0; sb < 2; ++sb)
#pragma unroll
                for (int i = 0; i < 16; ++i) { const float pv = __builtin_amdgcn_exp2f(st[sb][i] - mn); st[sb][i] = pv; rs += pv; }
            rs += __shfl_xor(rs, 32); lsum[qb] = lsum[qb] * alpha + rs;
#pragma unroll
            for (int d = 0; d < 2; ++d)
#pragma unroll
                for (int i = 0; i < 16; ++i) o[qb][d][i] *= alpha;
            bf16x8 pf[4];
#pragma unroll
            for (int kk = 0; kk < 4; ++kk) { const int sb = kk >> 1, s2 = kk & 1; u32x4 w;
                w.x = cvt_pk_bf16(st[sb][8 * s2 + 0], st[sb][8 * s2 + 1]); w.y = cvt_pk_bf16(st[sb][8 * s2 + 2], st[sb][8 * s2 + 3]);
                w.z = cvt_pk_bf16(st[sb][8 * s2 + 4], st[sb][8 * s2 + 5]); w.w = cvt_pk_bf16(st[sb][8 * s2 + 6], st[sb][8 * s2 + 7]); pf[kk] = __builtin_bit_cast(bf16x8, w); }
#pragma unroll
            for (int d = 0; d < 2; ++d)
#pragma unroll
                for (int kk = 0; kk < 4; ++kk) { const int rowoff = ((kk >> 1) * 32 + 16 * (kk & 1)) * 128;
                    const s16x4 lo = ds_tr16(vb[d] + rowoff), hi = ds_tr16(vb[d] + rowoff + 8 * 128);
                    const bf16x8 vf = (bf16x8){lo[0], lo[1], lo[2], lo[3], hi[0], hi[1], hi[2], hi[3]};
                    o[qb][d] = __builtin_amdgcn_mfma_f32_32x32x16_bf16(vf, pf[kk], o[qb][d], 0, 0, 0); }
        }
    }
#pragma unroll
    for (int qb = 0; qb < 2; ++qb) { const float inv = 1.0f / lsum[qb]; bf16_t* op = CAT + ((size_t)b * SEQ + c * 64 + qb * 32 + r) * D + 512 + h * 64 + 4 * hh;
#pragma unroll
        for (int d = 0; d < 2; ++d)
#pragma unroll
            for (int g = 0; g < 4; ++g) { u32x2 w; w.x = cvt_pk_bf16(o[qb][d][4 * g] * inv, o[qb][d][4 * g + 1] * inv); w.y = cvt_pk_bf16(o[qb][d][4 * g + 2] * inv, o[qb][d][4 * g + 3] * inv);
                *(u32x2*)(op + d * 32 + 8 * g) = w; } }
}
__device__ __forceinline__ void p_mix0(Frame& F) {
    const int j = F.vcu;
    if (j >= 128 && j < 256) mix_rglru_item(F, (j - 128) >> 3, (j - 128) & 7);
    attn_load_bias(F);
    if (j < 256) {
#pragma unroll 1
        for (int rep = 0; rep < 2; ++rep) attn_wave_mfma(F, j & 15, rep == 0 ? 16 + (j >> 4) : 15 - (j >> 4), F.wave);
    }
    __syncthreads();
}
__device__ __forceinline__ void mix_hgrn_item(Frame& F, int b, int h) {
    LAS float* L = (LAS float*)F.lds;
    LAS float* qs = L; LAS float* fs = L + 4096; LAS float* is = L + 8192; LAS float* gs = L + 12288; LAS float* op = L + 16384;
    const bf16_t* Z = (const bf16_t*)(F.ws + WS_Z); bf16_t* CAT = (bf16_t*)(F.ws + WS_CAT); const float* lb = (const float*)(F.ws + WS_LB); const float* ng = F.in[16];
    const int tid = F.tid, v = tid & 127, kq = tid >> 7;
    float S[32];
#pragma unroll
    for (int k = 0; k < 32; ++k) S[k] = 0.f;
    for (int t0 = 0; t0 < SEQ; t0 += 32) {
        __syncthreads();
        for (int i = tid; i < 4096; i += 512) { const int r = i >> 7, c = i & 127; const bf16_t* zr = Z + ((size_t)b * SEQ + t0 + r) * C_IN + h * 128 + c;
            qs[i] = bf2f(zr[0]); const float l = lb[h * 128 + c]; fs[i] = l + (1.f - l) * sigmoidf_(bf2f(zr[1024])); is[i] = bf2f(zr[2048]); gs[i] = bf2f(zr[3072]); }
        __syncthreads();
        for (int r = 0; r < 32; ++r) { const float iv = is[r * 128 + v]; float o = 0.f;
#pragma unroll
            for (int k4 = 0; k4 < 8; ++k4) { const f32x4 f4 = *(const LAS f32x4*)(fs + r * 128 + kq * 32 + 4 * k4), q4 = *(const LAS f32x4*)(qs + r * 128 + kq * 32 + 4 * k4);
                S[4 * k4] = f4.x * S[4 * k4] + (1.f - f4.x) * iv; o += q4.x * S[4 * k4];
                S[4 * k4 + 1] = f4.y * S[4 * k4 + 1] + (1.f - f4.y) * iv; o += q4.y * S[4 * k4 + 1];
                S[4 * k4 + 2] = f4.z * S[4 * k4 + 2] + (1.f - f4.z) * iv; o += q4.z * S[4 * k4 + 2];
                S[4 * k4 + 3] = f4.w * S[4 * k4 + 3] + (1.f - f4.w) * iv; o += q4.w * S[4 * k4 + 3]; }
            op[(r * 4 + kq) * 128 + v] = o; }
        __syncthreads();
#pragma unroll
        for (int rr = 0; rr < 4; ++rr) { const int r = F.wave * 4 + rr; const int l = F.lane;
            const float o1 = op[(r * 4 + 0) * 128 + l] + op[(r * 4 + 1) * 128 + l] + op[(r * 4 + 2) * 128 + l] + op[(r * 4 + 3) * 128 + l];
            const float o2 = op[(r * 4 + 0) * 128 + 64 + l] + op[(r * 4 + 1) * 128 + 64 + l] + op[(r * 4 + 2) * 128 + 64 + l] + op[(r * 4 + 3) * 128 + 64 + l];
            const float rinv = rsqrtf(wave_sum(o1 * o1 + o2 * o2) * (1.f / 128.f) + EPS);
            bf16_t* cp = CAT + ((size_t)b * SEQ + t0 + r) * D + h * 128;
            cp[l] = (bf16_t)f2bf(o1 * rinv * ng[h * 128 + l] * gs[r * 128 + l]); cp[64 + l] = (bf16_t)f2bf(o2 * rinv * ng[h * 128 + 64 + l] * gs[r * 128 + 64 + l]); }
    }
    __syncthreads();
}

__device__ __forceinline__ void p_gu(Frame& F, int layer) {
    unsigned char* ws = F.ws;
    moe_tables(F, layer);
    const LAS int* ts = (const LAS int*)(F.lds + TS_OFF); LAS unsigned* tab = (LAS unsigned*)(F.lds + TAB_OFF);
    pg8::MoeOrder<true> S{ts, tab, F.G, F.vcu, D};
    { const int* ltok = (const int*)(ws + WS_LTOK); pg8::Unit u;
      for (int i = 0; i < 6 && S.next(i, u); ++i) if (F.tid < 256) { const int pos = u.rl * 256 + F.tid; const int tok = pos < ts[40 + u.e] ? ltok[(size_t)u.e * CAP + pos] : 0; tab[i * 256 + F.tid] = (unsigned)tok * (unsigned)(D * 2); }
      __syncthreads(); }
    pg8::EpiGU E{(bf16_t*)(ws + WS_HB), (const float*)(ws + WS_LRSTD), ts + 40};
    pg8::gemm_phase<pg8::EpiGU, pg8::MoeOrder<true>, true>(F.lds, (const bf16_t*)(ws + WS_XB), (const bf16_t*)(ws + WS_WGU), D, S, E);
}
__device__ __forceinline__ void p_dn(Frame& F, int layer) {
    unsigned char* ws = F.ws;
    moe_tables(F, layer);
    const LAS int* ts = (const LAS int*)(F.lds + TS_OFF);
    pg8::MoeOrder<false> S{ts, nullptr, F.G, F.vcu, DEXP};
    pg8::EpiDN E{(bf16_t*)(ws + WS_Y), (const float*)(ws + WS_LW), ts + 40};
    pg8::gemm_phase<pg8::EpiDN, pg8::MoeOrder<false>, true>(F.lds, (const bf16_t*)(ws + WS_HB), (const bf16_t*)(ws + WS_WDN), DEXP, S, E);
}

__global__ void __launch_bounds__(512, 2) fwd(Args args) {
    extern __shared__ __attribute__((aligned(16))) unsigned char lds_raw[];
    Frame F;
    F.lds = (LAS unsigned char*)lds_raw; F.tid = threadIdx.x; F.lane = F.tid & 63; F.wave = __builtin_amdgcn_readfirstlane(F.tid >> 6);
    F.G = gridDim.x; { const int bx = blockIdx.x; F.vcu = (F.G % 8 == 0) ? (bx % 8) * (F.G / 8) + bx / 8 : bx; }
    F.in = args.in; F.out = args.out; F.ws = args.ws;
    unsigned char* ws = args.ws;
    bf16_t* XB = (bf16_t*)(ws + WS_XB); bf16_t* CAT = (bf16_t*)(ws + WS_CAT); bf16_t* Z = (bf16_t*)(ws + WS_Z);
    float* RSTD = (float*)(ws + WS_RSTD);
#if MK_ONE_LAUNCH
    cg::grid_group grid = cg::this_grid();
#define GRID_BAR() grid.sync()
#else
#define GRID_BAR() do {} while (0)
#endif
    #ifndef PH_MASK
#define PH_MASK 0x7fff
#endif
#define PHE(p) ((PH_MASK >> (p)) & 1)
    const int lo = args.ph_lo, hi = args.ph_hi;
#define IN(k) (PHE(k) && lo <= (k) && (k) < hi)
#define SEAM(k) do { if (lo <= (k) && (k) + 1 < hi) GRID_BAR(); } while (0)
    if (IN(PH_PRO)) { p_prologue(F); } SEAM(PH_PRO);
    if (IN(PH_IN0)) { pg8::DenseOrder S; S.init(T, AB_IN, D, F.G, (int)blockIdx.x); pg8::EpiIn E{Z, AB_IN, RSTD, 0, 1 << 30};
        pg8::gemm_phase<pg8::EpiIn, pg8::DenseOrder, true>(F.lds, XB, (const bf16_t*)(ws + WS_WIN0), D, S, E); } SEAM(PH_IN0);
    if (IN(PH_MIX0)) { p_mix0(F); } SEAM(PH_MIX0);
    if (IN(PH_OUT0)) { pg8::DenseOrder S; S.init(T, D, D, F.G, (int)blockIdx.x); pg8::EpiOut E{args.in[0], args.out, XB};
        pg8::gemm_phase<pg8::EpiOut, pg8::DenseOrder, true>(F.lds, CAT, (const bf16_t*)(ws + WS_WOUT0), D, S, E); } SEAM(PH_OUT0);
    if (IN(PH_R1)) { p_router(F, 0); } SEAM(PH_R1);
    if (IN(PH_GU0)) { p_gu(F, 0); } SEAM(PH_GU0);
    if (IN(PH_DN0)) { p_dn(F, 0); } SEAM(PH_DN0);
    if (IN(PH_R2)) { p_combine(F, 0, 0); moe_convert(F, 1); } SEAM(PH_R2);
    if (IN(PH_IN1)) { pg8::DenseOrder S; S.init(T, C_IN, D, F.G, (int)blockIdx.x); pg8::EpiIn E{Z, C_IN, RSTD, 1024, 3072};
        pg8::gemm_phase<pg8::EpiIn, pg8::DenseOrder, true>(F.lds, XB, (const bf16_t*)(ws + WS_WIN1), D, S, E); } SEAM(PH_IN1);
    if (IN(PH_MIX1)) { if (F.vcu < 128) mix_hgrn_item(F, F.vcu >> 3, F.vcu & 7); } SEAM(PH_MIX1);
    if (IN(PH_OUT1)) { pg8::DenseOrder S; S.init(T, D, D, F.G, (int)blockIdx.x); pg8::EpiOut E{args.out, args.out, XB};
        pg8::gemm_phase<pg8::EpiOut, pg8::DenseOrder, true>(F.lds, CAT, (const bf16_t*)(ws + WS_WOUT1), D, S, E); } SEAM(PH_OUT1);
    if (IN(PH_R3)) { p_router(F, 1); } SEAM(PH_R3);
    if (IN(PH_GU1)) { p_gu(F, 1); } SEAM(PH_GU1);
    if (IN(PH_DN1)) { p_dn(F, 1); } SEAM(PH_DN1);
    if (IN(PH_R4)) { p_combine(F, 1, 1); }
}

extern "C" void kernel_launch(void* const* d_in, const int* in_sizes, int n_in, void* d_out, int out_size, void* d_ws, size_t ws_size, hipStream_t stream) {
    static int grid = 0;
    if (grid == 0) {
        if (n_in != 23 || out_size != T * D || ws_size < WS_END) { fprintf(stderr, "kernel_launch: unexpected shapes: n_in %d out %d ws %zu (need %zu)\n", n_in, out_size, ws_size, (size_t)WS_END); grid = -1; return; }
        if (hipFuncSetAttribute((const void*)fwd, hipFuncAttributeMaxDynamicSharedMemorySize, LDS_BYTES) != hipSuccess) { fprintf(stderr, "kernel_launch: hipFuncSetAttribute failed\n"); grid = -1; return; }
        int dev = 0, cus = 0, per_cu = 0;
        hipGetDevice(&dev); hipDeviceGetAttribute(&cus, hipDeviceAttributeMultiprocessorCount, dev);
        hipOccupancyMaxActiveBlocksPerMultiprocessor(&per_cu, (const void*)fwd, 512, LDS_BYTES);
        (void)hipGetLastError();
        fprintf(stderr, "kernel_launch: cus %d per_cu %d ws %zu\n", cus, per_cu, ws_size);
        grid = cus > 0 ? cus : 256;
        if (per_cu < 1) fprintf(stderr, "kernel_launch: occupancy query says %d blocks per CU\n", per_cu);
    }
    if (grid < 0) return;
    hipMemsetAsync((char*)d_ws + WS_CTL, 0, CTL_BYTES, stream);
    Args a{};
    for (int i = 0; i < 23; ++i) a.in[i] = (const float*)d_in[i];
    a.out = (float*)d_out; a.ws = (unsigned char*)d_ws;
#if MK_ONE_LAUNCH
    a.ph_lo = 0; a.ph_hi = NPH;
    void* kargs[] = {&a};
    hipError_t e = hipLaunchCooperativeKernel((const void*)fwd, dim3(grid), dim3(512), kargs, LDS_BYTES, stream);
    if (e != hipSuccess) fprintf(stderr, "cooperative launch failed: %s (grid %d)\n", hipGetErrorString(e), grid);
#else
    for (int ph = 0; ph < NPH; ++ph) { a.ph_lo = ph; a.ph_hi = ph + 1; hipLaunchKernelGGL(fwd, dim3(grid), dim3(512), LDS_BYTES, stream, a); }
#endif
}
```

```cpp
#include <hip/hip_runtime.h>
#include <hip/hip_cooperative_groups.h>
#include <cstdio>
#include <cstdint>
namespace cg = cooperative_groups;

#ifndef MK_ONE_LAUNCH
#define MK_ONE_LAUNCH 1
#endif

constexpr int T = 32768, D = 1024, SEQ = 2048, NB = 16;
constexpr int AB_IN = 2560, C_IN = 4096;
constexpr int NEXP = 32, DEXP = 512, CAP = 32768;
constexpr int MAXTILES = 288;
constexpr float EPS = 1e-6f;

#define LAS __attribute__((address_space(3)))
typedef unsigned short bf16_t;
typedef short bf16x8 __attribute__((ext_vector_type(8)));
typedef float f32x4 __attribute__((ext_vector_type(4)));
typedef unsigned u32x4 __attribute__((ext_vector_type(4)));
typedef unsigned u32x2 __attribute__((ext_vector_type(2)));

constexpr size_t MiB = 1u << 20;
constexpr size_t WS_CTL = 0, CTL_BYTES = 1 * MiB;
constexpr size_t WS_RSTD = 1 * MiB;
constexpr size_t WS_LB = WS_RSTD + 128 * 1024;
constexpr size_t WS_RGT = WS_LB + 4096;
constexpr size_t WS_RET = WS_RGT + 2 * 4 * 1024 * 4;
constexpr size_t WS_TOKINFO = 2 * MiB;
constexpr size_t WS_LTOK = 3 * MiB, WS_LRSTD = 7 * MiB, WS_LW = 11 * MiB;
constexpr size_t WS_WIN0 = 16 * MiB, WS_WOUT0 = 21 * MiB, WS_WIN1 = 23 * MiB, WS_WOUT1 = 31 * MiB;
constexpr size_t WS_WGU = 34 * MiB, WS_WDN = 98 * MiB;
constexpr size_t WS_XB = 130 * MiB, WS_CAT = 194 * MiB;
constexpr size_t WS_Z = 258 * MiB;
constexpr size_t WS_HB = 258 * MiB, WS_Y = 330 * MiB;
constexpr size_t WS_END = 514 * MiB;
constexpr int CW_CNT = 64;
constexpr int CW_BAR = 4096;

constexpr int RING_BYTES = 131072;
constexpr int TAB_OFF = RING_BYTES;
constexpr int TS_OFF = TAB_OFF + 6 * 1024;
constexpr int LDS_BYTES = 147456;

__device__ __forceinline__ unsigned f2bf(float f) { unsigned u = __float_as_uint(f); return (u + 0x7fffu + ((u >> 16) & 1u)) >> 16; }
__device__ __forceinline__ float bf2f(unsigned b) { return __uint_as_float(b << 16); }
__device__ __forceinline__ unsigned pk2(float lo, float hi) { return f2bf(lo) | (f2bf(hi) << 16); }
__device__ __forceinline__ unsigned cvt_pk_bf16(float lo, float hi) { unsigned r; asm volatile("v_cvt_pk_bf16_f32 %0, %1, %2" : "=v"(r) : "v"(lo), "v"(hi)); return r; }
__device__ __forceinline__ float wave_sum(float v) {
#pragma unroll
    for (int o = 1; o < 64; o <<= 1) v += __shfl_xor(v, o);
    return v;
}
__device__ __forceinline__ float sigmoidf_(float x) { return 1.0f / (1.0f + __expf(-x)); }
__device__ __forceinline__ float siluf_(float x) { return x / (1.0f + __expf(-x)); }
__device__ __forceinline__ float gelu_tanh(float x) { const float u = 0.7978845608028654f * (x + 0.044715f * x * x * x); return 0.5f * x * (1.0f + tanhf(u)); }
#define LDS_WAIT() asm volatile("s_waitcnt lgkmcnt(0)" ::: "memory")

namespace pg8 {
constexpr int BM = 256, BK = 64, HALF = 128, HTB = HALF * BK * 2, NXCD = 8, WGM = 8;
__host__ __device__ __forceinline__ int lds_byte(int r, int c) { const int st = (r >> 4) * 2 + (c >> 5), rr = r & 15, cc = c & 31, ob = rr * 64 + cc * 2; return st * 1024 + (ob ^ (((ob >> 9) & 1) << 5)); }
__host__ __device__ __forceinline__ void stage_rc(int b, int& R, int& C) { const int st = b / 1024, sb = b % 1024, swz = sb ^ (((sb >> 9) & 1) << 5); R = (st >> 1) * 16 + swz / 64; C = (st & 1) * 32 + (swz % 64) / 2; }
__host__ __device__ __forceinline__ int perm32(int rho) { const int n = rho >> 4, i = rho & 15; return 8 * (i >> 2) + 4 * n + (i & 3); }

struct Unit { unsigned boff; int arow, orow, ocol, e, rl, slot; };

struct DenseOrder {
    int nM, nN, nwg, G, c, K;
    __device__ void init(int M, int N, int K_, int G_, int c_) { nM = M / BM; nN = N / BM; nwg = nM * nN; G = G_; c = c_; K = K_; }
    __device__ __forceinline__ bool next(int i, Unit& u) const {
        const long L = (long)i * G + c; if (L >= nwg) return false;
        int wgid = (int)L; { const int q = nwg / NXCD, r = nwg % NXCD, xcd = wgid % NXCD, off = wgid / NXCD; wgid = (xcd < r ? xcd * (q + 1) : r * (q + 1) + (xcd - r) * q) + off; }
        const int nig = WGM * nN, gid = wgid / nig, fm = gid * WGM, gsz = (nM - fm) < WGM ? (nM - fm) : WGM;
        const int pm = __builtin_amdgcn_readfirstlane(fm + ((wgid % nig) % gsz)), pn = __builtin_amdgcn_readfirstlane((wgid % nig) / gsz);
        u.arow = pm * BM; u.orow = pm * BM; u.ocol = pn * BM; u.boff = (unsigned)(pn * BM) * (unsigned)K * 2u; u.e = 0; u.rl = 0; u.slot = i; return true;
    }
    static constexpr bool GATHER = false;
    __device__ __forceinline__ size_t abase(const Unit& u) const { return (size_t)u.arow * (size_t)K * 2u; }
    __device__ __forceinline__ unsigned aoff(const Unit&, int) const { return 0u; }
};
template <bool GATHER_> struct MoeOrder {
    static constexpr bool GATHER = GATHER_;
    const LAS int* ts; const LAS unsigned* tab; int G, vcu, K;
    __device__ __forceinline__ bool next(int i, Unit& u) const {
        const int L = i * G + vcu; const int NT = __builtin_amdgcn_readfirstlane(ts[32]); if (L >= NT * 4) return false;
        const int rt = L >> 2, pn = L & 3; int e = 0;
#pragma unroll
        for (int j = 1; j < 32; ++j) e += (ts[j] <= rt) ? 1 : 0;
        e = __builtin_amdgcn_readfirstlane(e);
        u.e = e; u.rl = rt - __builtin_amdgcn_readfirstlane(ts[e]); u.orow = rt * BM; u.arow = rt * BM; u.ocol = pn * BM; u.boff = (unsigned)(e * 1024 + pn * BM) * (unsigned)K * 2u; u.slot = i; return true;
    }
    __device__ __forceinline__ size_t abase(const Unit& u) const { return GATHER ? (size_t)0 : (size_t)u.arow * (size_t)K * 2u; }
    __device__ __forceinline__ unsigned aoff(const Unit& u, int r) const { return tab[u.slot * 256 + r]; }
};

typedef f32x4 Acc[2][2][4][2];

struct EpiIn {
    static constexpr bool PERM = true;
    bf16_t* O; int ldc; const float* rstd; int silu_lo_end, silu_hi_start;
    __device__ __forceinline__ void operator()(const Acc& acc, const Unit& u, int wr, int wc, int fr, int fq) const {
        const bool act = (u.ocol < silu_lo_end) || (u.ocol >= silu_hi_start);
#pragma unroll
        for (int ai = 0; ai < 2; ++ai)
#pragma unroll
            for (int m = 0; m < 4; ++m) {
                const int row = u.orow + ai * HALF + wr * 64 + m * 16 + fr; const float rs = rstd[row];
                bf16_t* rowp = O + (size_t)row * ldc + u.ocol + wc * 32 + 8 * fq;
#pragma unroll
                for (int bj = 0; bj < 2; ++bj) { f32x4 v0 = acc[ai][bj][m][0] * rs, v1 = acc[ai][bj][m][1] * rs;
                    if (act) {
#pragma unroll
                        for (int j = 0; j < 4; ++j) { v0[j] = siluf_(v0[j]); v1[j] = siluf_(v1[j]); } }
                    u32x4 w; w.x = cvt_pk_bf16(v0[0], v0[1]); w.y = cvt_pk_bf16(v0[2], v0[3]); w.z = cvt_pk_bf16(v1[0], v1[1]); w.w = cvt_pk_bf16(v1[2], v1[3]);
                    *(u32x4*)(rowp + bj * HALF) = w; } }
    }
};
struct EpiOut {
    static constexpr bool PERM = true;
    const float* resid; float* H; bf16_t* XB;
    __device__ __forceinline__ void operator()(const Acc& acc, const Unit& u, int wr, int wc, int fr, int fq) const {
#pragma unroll
        for (int ai = 0; ai < 2; ++ai)
#pragma unroll
            for (int m = 0; m < 4; ++m) {
                const int row = u.orow + ai * HALF + wr * 64 + m * 16 + fr; const size_t off = (size_t)row * D + u.ocol + wc * 32 + 8 * fq;
#pragma unroll
                for (int bj = 0; bj < 2; ++bj) { const f32x4 r0 = *(const f32x4*)(resid + off + bj * HALF), r1 = *(const f32x4*)(resid + off + bj * HALF + 4);
                    const f32x4 v0 = acc[ai][bj][m][0] + r0, v1 = acc[ai][bj][m][1] + r1;
                    *(f32x4*)(H + off + bj * HALF) = v0; *(f32x4*)(H + off + bj * HALF + 4) = v1;
                    u32x4 w; w.x = cvt_pk_bf16(v0[0], v0[1]); w.y = cvt_pk_bf16(v0[2], v0[3]); w.z = cvt_pk_bf16(v1[0], v1[1]); w.w = cvt_pk_bf16(v1[2], v1[3]);
                    *(u32x4*)(XB + off + bj * HALF) = w; } }
    }
};
struct EpiGU {
    static constexpr bool PERM = true;
    bf16_t* HB; const float* lrstd; const LAS int* cnt;
    __device__ __forceinline__ void operator()(const Acc& acc, const Unit& u, int wr, int wc, int fr, int fq) const {
        const int n_e = cnt[u.e];
#pragma unroll
        for (int ai = 0; ai < 2; ++ai)
#pragma unroll
            for (int m = 0; m < 4; ++m) {
                const int r = ai * HALF + wr * 64 + m * 16 + fr, pos = u.rl * BM + r; const float rs = pos < n_e ? lrstd[(size_t)u.e * CAP + pos] : 0.f;
                float h[8];
#pragma unroll
                for (int n = 0; n < 2; ++n)
#pragma unroll
                    for (int j = 0; j < 4; ++j) { const float g = acc[ai][0][m][n][j] * rs, uu = acc[ai][1][m][n][j] * rs; h[n * 4 + j] = siluf_(g) * uu; }
                u32x4 w; w.x = cvt_pk_bf16(h[0], h[1]); w.y = cvt_pk_bf16(h[2], h[3]); w.z = cvt_pk_bf16(h[4], h[5]); w.w = cvt_pk_bf16(h[6], h[7]);
                *(u32x4*)(HB + (size_t)(u.orow + r) * DEXP + (u.ocol >> 1) + wc * 32 + 8 * fq) = w; }
    }
};
struct EpiDN {
    static constexpr bool PERM = true;
    bf16_t* Y; const float* lw; const LAS int* cnt;
    __device__ __forceinline__ void operator()(const Acc& acc, const Unit& u, int wr, int wc, int fr, int fq) const {
        const int n_e = cnt[u.e];
#pragma unroll
        for (int ai = 0; ai < 2; ++ai)
#pragma unroll
            for (int m = 0; m < 4; ++m) {
                const int r = ai * HALF + wr * 64 + m * 16 + fr, pos = u.rl * BM + r; const float ws = pos < n_e ? lw[(size_t)u.e * CAP + pos] : 0.f;
                bf16_t* rowp = Y + (size_t)(u.orow + r) * D + u.ocol + wc * 32 + 8 * fq;
#pragma unroll
                for (int bj = 0; bj < 2; ++bj) { const f32x4 v0 = acc[ai][bj][m][0] * ws, v1 = acc[ai][bj][m][1] * ws;
                    u32x4 w; w.x = cvt_pk_bf16(v0[0], v0[1]); w.y = cvt_pk_bf16(v0[2], v0[3]); w.z = cvt_pk_bf16(v1[0], v1[1]); w.w = cvt_pk_bf16(v1[2], v1[3]);
                    *(u32x4*)(rowp + bj * HALF) = w; } }
    }
};

template <class Epi, class Sched, bool ALIGN_EPI>
__device__ __forceinline__ void gemm_phase(LAS unsigned char* lds, const bf16_t* A, const bf16_t* Bt, const int K, const Sched& S, const Epi& E) {
    const int tid = threadIdx.x, wid = __builtin_amdgcn_readfirstlane(tid >> 6), lane = tid & 63, wr = wid >> 2, wc = wid & 3, fr = lane & 15, fq = lane >> 4;
    const int nt = K / BK;
    unsigned voffB[2], vA0[2], vA1[2];
#pragma unroll
    for (int i = 0; i < 2; ++i) { int R, C; stage_rc(tid * 16 + i * 8192, R, C); const int Rb = Epi::PERM ? ((R & ~31) + perm32(R & 31)) : R;
        vA0[i] = (unsigned)(R * K + C) * 2u; vA1[i] = vA0[i]; voffB[i] = (unsigned)(Rb * K + C) * 2u; }
#define PG8_FILL(u) do { if constexpr (Sched::GATHER) { int tv_ = tid; asm volatile("" : "+v"(tv_)); _Pragma("unroll") for (int i = 0; i < 2; ++i) { int R, C; stage_rc(tv_ * 16 + i * 8192, R, C); \
        vA0[i] = S.aoff(u, R) + (unsigned)C * 2u; vA1[i] = S.aoff(u, HALF + R) + (unsigned)C * 2u; } } } while (0)
    const size_t kstep = (size_t)(BK * 2);
    const size_t hstep = (size_t)HALF * K * 2;
    const unsigned ldsw = (unsigned)wid * 1024u;
    const int aoff = lds_byte(wr * 64 + fr, fq * 8), boff = lds_byte(wc * 32 + fr, fq * 8);
#define PG8_SA(b, h) (((b) * 2 + (h)) * HTB)
#define PG8_SB(b, h) ((4 + (b) * 2 + (h)) * HTB)
#define PG8_STAGE(bufoff, gbase, voff) do { _Pragma("unroll") for (int _i = 0; _i < 2; ++_i) \
        __builtin_amdgcn_global_load_lds((const unsigned*)((const char*)(gbase) + (voff)[_i]), (LAS unsigned*)(lds + (bufoff) + ldsw + _i * 8192), 16, 0, 0); } while (0)
#define PG8_LDA(dst, b, h) do { _Pragma("unroll") for (int m = 0; m < 4; ++m) _Pragma("unroll") for (int k = 0; k < 2; ++k) dst[m][k] = *(const LAS bf16x8*)(lds + PG8_SA(b, h) + aoff + m * 2048 + k * 1024); } while (0)
#define PG8_LDB(dst, b, h) do { _Pragma("unroll") for (int n = 0; n < 2; ++n) _Pragma("unroll") for (int k = 0; k < 2; ++k) dst[n][k] = *(const LAS bf16x8*)(lds + PG8_SB(b, h) + boff + n * 2048 + k * 1024); } while (0)
#define PG8_MMA(ai, bj, At, Bt_) do { __builtin_amdgcn_s_setprio(1); _Pragma("unroll") for (int m = 0; m < 4; ++m) _Pragma("unroll") for (int n = 0; n < 2; ++n) _Pragma("unroll") for (int k = 0; k < 2; ++k) \
        acc[ai][bj][m][n] = __builtin_amdgcn_mfma_f32_16x16x32_bf16(Bt_[n][k], At[m][k], acc[ai][bj][m][n], 0, 0, 0); __builtin_amdgcn_s_setprio(0); } while (0)
#define PG8_WAIT_V(n) asm volatile("s_waitcnt vmcnt(" #n ")" ::: "memory")
#define PG8_WAIT_L(n) asm volatile("s_waitcnt lgkmcnt(" #n ")" ::: "memory")
#define PG8_BAR __builtin_amdgcn_s_barrier()
#define PG8_SCHED __builtin_amdgcn_sched_barrier(0)
    Unit cur, nxt; int ui = 0;
    if (!S.next(0, cur)) return;
    f32x4 acc[2][2][4][2];
#pragma unroll
    for (int a = 0; a < 2; ++a)
#pragma unroll
        for (int b = 0; b < 2; ++b)
#pragma unroll
            for (int m = 0; m < 4; ++m)
#pragma unroll
                for (int n = 0; n < 2; ++n) acc[a][b][m][n] = (f32x4){0.f, 0.f, 0.f, 0.f};
    bf16x8 At[4][2], B0[2][2], B1[2][2];
    PG8_FILL(cur);
    const char* cA0 = (const char*)A + S.abase(cur); const char* cA1 = cA0 + (Sched::GATHER ? (size_t)0 : hstep); const char* cB = (const char*)Bt + cur.boff;
    PG8_STAGE(PG8_SB(0, 0), cB, voffB); PG8_STAGE(PG8_SB(0, 1), cB + hstep, voffB); PG8_STAGE(PG8_SA(0, 0), cA0, vA0); PG8_STAGE(PG8_SA(0, 1), cA1, vA1);
    if (wr == 1) PG8_BAR;
    PG8_WAIT_V(2); PG8_BAR;
    PG8_STAGE(PG8_SB(1, 0), cB + kstep, voffB); PG8_STAGE(PG8_SA(1, 0), cA0 + kstep, vA0); PG8_STAGE(PG8_SB(1, 1), cB + hstep + kstep, voffB);
    PG8_WAIT_V(6); PG8_BAR;
    for (;;) {
        const bool has_next = S.next(ui + 1, nxt);
        const char* nB = has_next ? (const char*)Bt + nxt.boff : cB;
        const char* nA0 = has_next ? (const char*)A + S.abase(nxt) : cA0; const char* nA1 = nA0 + (Sched::GATHER ? (size_t)0 : hstep);
        for (int t = 0; t < nt; t += 2) {
            const bool last = (t == nt - 2);
            const char* a1 = cA1 + (size_t)(t + 1) * kstep;
            const char* a2 = last ? nA0 : cA0 + (size_t)(t + 2) * kstep; const char* a2h = last ? nA1 : cA1 + (size_t)(t + 2) * kstep; const char* b2 = last ? nB : cB + (size_t)(t + 2) * kstep;
            const char* a3 = a2 + kstep; const char* b3 = b2 + kstep;
            PG8_LDB(B0, 0, 0); PG8_LDB(B1, 0, 1); PG8_SCHED; PG8_LDA(At, 0, 0); PG8_STAGE(PG8_SA(1, 1), a1, vA1);
            if (last && has_next) PG8_FILL(nxt);
            PG8_WAIT_V(8); PG8_WAIT_L(0); PG8_BAR; PG8_MMA(0, 0, At, B0); PG8_MMA(0, 1, At, B1); PG8_BAR; PG8_SCHED;
            PG8_LDA(At, 0, 1); PG8_STAGE(PG8_SB(0, 0), b2, voffB); PG8_STAGE(PG8_SB(0, 1), b2 + hstep, voffB); PG8_STAGE(PG8_SA(0, 0), a2, vA0);
            PG8_WAIT_V(8); PG8_WAIT_L(0); PG8_BAR; PG8_MMA(1, 0, At, B0); PG8_MMA(1, 1, At, B1); PG8_BAR; PG8_SCHED;
            PG8_LDB(B0, 1, 0); PG8_LDB(B1, 1, 1); PG8_SCHED; PG8_LDA(At, 1, 0); PG8_STAGE(PG8_SA(0, 1), a2h, vA1);
            PG8_WAIT_V(8); PG8_WAIT_L(0); PG8_BAR; PG8_MMA(0, 0, At, B0); PG8_MMA(0, 1, At, B1); PG8_BAR; PG8_SCHED;
            PG8_LDA(At, 1, 1); PG8_STAGE(PG8_SB(1, 0), b3, voffB); PG8_STAGE(PG8_SB(1, 1), b3 + hstep, voffB); PG8_STAGE(PG8_SA(1, 0), a3, vA0);
            PG8_WAIT_V(8); PG8_WAIT_L(0); PG8_BAR; PG8_MMA(1, 0, At, B0); PG8_MMA(1, 1, At, B1); PG8_BAR; PG8_SCHED;
        }
        if constexpr (ALIGN_EPI) { if (wr == 0) PG8_BAR; }
        E(acc, cur, wr, wc, fr, fq);
        if (!has_next) break;
#pragma unroll
        for (int a = 0; a < 2; ++a)
#pragma unroll
            for (int b = 0; b < 2; ++b)
#pragma unroll
                for (int m = 0; m < 4; ++m)
#pragma unroll
                    for (int n = 0; n < 2; ++n) acc[a][b][m][n] = (f32x4){0.f, 0.f, 0.f, 0.f};
        cur = nxt; cB = nB; cA0 = nA0; cA1 = nA1; ++ui;
        if constexpr (ALIGN_EPI) { if (wr == 1) PG8_BAR; }
    }
    PG8_WAIT_V(0);
    if constexpr (!ALIGN_EPI) { if (wr == 0) PG8_BAR; }
    PG8_BAR;
#undef PG8_FILL
#undef PG8_SA
#undef PG8_SB
#undef PG8_STAGE
#undef PG8_LDA
#undef PG8_LDB
#undef PG8_MMA
#undef PG8_WAIT_V
#undef PG8_WAIT_L
#undef PG8_BAR
#undef PG8_SCHED
}
}

struct Args { const float* in[23]; float* out; unsigned char* ws; int ph_lo, ph_hi; };
enum { PH_PRO = 0, PH_IN0, PH_MIX0, PH_OUT0, PH_R1, PH_GU0, PH_DN0, PH_R2, PH_IN1, PH_MIX1, PH_OUT1, PH_R3, PH_GU1, PH_DN1, PH_R4, NPH };

struct Frame {
    LAS unsigned char* lds; int tid, lane, wave, vcu, G;
    const float* const* in; float* out; unsigned char* ws;
};

__device__ __forceinline__ void transpose_item(const float* W, int K, int N, const float* kscale, bf16_t* WT, int dest_row0, LAS float* scr, int kb, int nb, int lane) {
    const int k0 = 64 * kb, n0 = 32 * nb;
#pragma unroll 8
    for (int i = 0; i < 32; ++i) { const int kk = 2 * i + (lane >> 5); float v = W[(size_t)(k0 + kk) * N + n0 + (lane & 31)]; if (kscale) v *= kscale[k0 + kk]; scr[kk * 33 + (lane & 31)] = v; }
    LDS_WAIT(); asm volatile("" ::: "memory");
    const int c = lane & 7;
#pragma unroll
    for (int j = 0; j < 4; ++j) { const int n = (lane >> 3) + 8 * j; const LAS float* s = scr + (8 * c) * 33 + n;
        u32x4 o; o.x = pk2(s[0 * 33], s[1 * 33]); o.y = pk2(s[2 * 33], s[3 * 33]); o.z = pk2(s[4 * 33], s[5 * 33]); o.w = pk2(s[6 * 33], s[7 * 33]);
        *(u32x4*)(WT + (size_t)(dest_row0 + n) * K + k0 + 8 * c) = o; }
    LDS_WAIT(); asm volatile("" ::: "memory");
}
__device__ __forceinline__ void moe_convert(Frame& F, int layer) {
    LAS float* scr = (LAS float*)(F.lds + F.wave * 16384);
    const int gw = F.vcu * 8 + F.wave, NGW = F.G * 8;
    const float* gffn = F.in[2] + layer * D;
    const float* Wg = F.in[20] + (size_t)layer * NEXP * D * DEXP; const float* Wu = F.in[21] + (size_t)layer * NEXP * D * DEXP; const float* Wd = F.in[22] + (size_t)layer * NEXP * DEXP * D;
    bf16_t* WGU = (bf16_t*)(F.ws + WS_WGU); bf16_t* WDN = (bf16_t*)(F.ws + WS_WDN);
    for (int it = gw; it < 3 * 8192; it += NGW) {
        const int which = it >> 13, r = it & 8191, e = r >> 8, q = r & 255;
        if (which < 2) { const int kb = q >> 4, nb = q & 15, n0 = nb * 32;
            const int dest = e * 1024 + (n0 >> 7) * 256 + (which ? 128 : 0) + (n0 & 127);
            transpose_item((which ? Wu : Wg) + (size_t)e * D * DEXP, D, DEXP, gffn, WGU, dest, scr, kb, nb, F.lane);
        } else { const int kb = q >> 5, nb = q & 31;
            transpose_item(Wd + (size_t)e * DEXP * D, DEXP, D, nullptr, WDN, e * 1024 + nb * 32, scr, kb, nb, F.lane); }
    }
}
__device__ __forceinline__ void p_prologue(Frame& F) {
    LAS float* scr = (LAS float*)(F.lds + F.wave * 16384);
    const int gw = F.vcu * 8 + F.wave, NGW = F.G * 8;
    constexpr int I0 = 16 * 80, I1 = 16 * 32, I2 = 16 * 128, I3 = 16 * 32;
    for (int it = gw; it < I0 + I1 + I2 + I3; it += NGW) {
        int r = it;
        if (r < I0) { transpose_item(F.in[4], D, AB_IN, F.in[1], (bf16_t*)(F.ws + WS_WIN0), (r % 80) * 32, scr, r / 80, r % 80, F.lane); continue; } r -= I0;
        if (r < I1) { transpose_item(F.in[13], D, D, nullptr, (bf16_t*)(F.ws + WS_WOUT0), (r % 32) * 32, scr, r / 32, r % 32, F.lane); continue; } r -= I1;
        if (r < I2) { transpose_item(F.in[14], D, C_IN, F.in[1] + D, (bf16_t*)(F.ws + WS_WIN1), (r % 128) * 32, scr, r / 128, r % 128, F.lane); continue; } r -= I2;
        transpose_item(F.in[17], D, D, nullptr, (bf16_t*)(F.ws + WS_WOUT1), (r % 32) * 32, scr, r / 32, r % 32, F.lane);
    }
    moe_convert(F, 0);
    { const float* x = F.in[0]; bf16_t* XB = (bf16_t*)(F.ws + WS_XB); float* rstd = (float*)(F.ws + WS_RSTD);
      for (int m = gw; m < T; m += NGW) { const f32x4* xr = (const f32x4*)(x + (size_t)m * D) + F.lane; f32x4 v[4]; float s = 0.f;
#pragma unroll
          for (int j = 0; j < 4; ++j) { v[j] = xr[64 * j]; s += (v[j].x * v[j].x + v[j].y * v[j].y) + (v[j].z * v[j].z + v[j].w * v[j].w); }
          s = wave_sum(s); if (F.lane == 0) rstd[m] = rsqrtf(s * (1.f / D) + EPS);
          u32x2* o8 = (u32x2*)(XB + (size_t)m * D) + F.lane;
#pragma unroll
          for (int j = 0; j < 4; ++j) o8[64 * j] = (u32x2){pk2(v[j].x, v[j].y), pk2(v[j].z, v[j].w)}; } }
    const int gt = F.vcu * 512 + F.tid, NGT = F.G * 512;
    { float* lb = (float*)(F.ws + WS_LB); const float* l = F.in[15];
      for (int c = gt; c < 1024; c += NGT) { const float a = l[c], b = l[1024 + c], mx = fmaxf(a, b), ea = __expf(a - mx), eb = __expf(b - mx); lb[c] = ea / (ea + eb); } }
    { float* RgT = (float*)(F.ws + WS_RGT); float* ReT = (float*)(F.ws + WS_RET);
      for (int i = gt; i < 2 * 36 * 1024; i += NGT) { const int l = i / (36 * 1024), r = i % (36 * 1024), j = r >> 10, c = r & 1023; const float g = F.in[2][l * D + c];
          if (j < 4) RgT[(l * 4 + j) * 1024 + c] = g * F.in[18][((size_t)l * D + c) * 4 + j];
          else ReT[(l * 32 + (j - 4)) * 1024 + c] = g * F.in[19][((size_t)l * D + c) * 32 + (j - 4)]; } }
}

__device__ __forceinline__ void moe_tables(Frame& F, int layer) {
    LAS int* ts = (LAS int*)(F.lds + TS_OFF); LAS int* cn = ts + 40;
    const unsigned* cnt = (const unsigned*)(F.ws + WS_CTL) + CW_CNT + layer * 32;
    __syncthreads();
    if (F.tid < 32) cn[F.tid] = (int)__hip_atomic_load(cnt + F.tid, __ATOMIC_RELAXED, __HIP_MEMORY_SCOPE_AGENT);
    __syncthreads();
    if (F.tid == 0) { int s = 0; for (int e = 0; e < 32; ++e) { ts[e] = s; s += (cn[e] + 255) >> 8; } ts[32] = s; }
    __syncthreads();
}

__device__ __forceinline__ void p_router(Frame& F, int layer) {
    const int gw = F.vcu * 8 + F.wave, NGW = F.G * 8;
    const float* H = F.out; const float* RgT = (const float*)(F.ws + WS_RGT) + layer * 4 * 1024; const float* ReT = (const float*)(F.ws + WS_RET) + layer * 32 * 1024;
    unsigned* cnt = (unsigned*)(F.ws + WS_CTL) + CW_CNT + layer * 32;
    int* ltok = (int*)(F.ws + WS_LTOK); float* lrstd = (float*)(F.ws + WS_LRSTD); float* lw = (float*)(F.ws + WS_LW); int* tokinfo = (int*)(F.ws + WS_TOKINFO);
    for (int m = gw; m < T; m += NGW) {
        const f32x4* hr = (const f32x4*)(H + (size_t)m * D) + F.lane; f32x4 v[4]; float s = 0.f;
#pragma unroll
        for (int j = 0; j < 4; ++j) { v[j] = hr[64 * j]; s += (v[j].x * v[j].x + v[j].y * v[j].y) + (v[j].z * v[j].z + v[j].w * v[j].w); }
        const float rstd = rsqrtf(wave_sum(s) * (1.f / D) + EPS);
        float lg[4];
#pragma unroll
        for (int gi = 0; gi < 4; ++gi) { const f32x4* w = (const f32x4*)(RgT + gi * 1024) + F.lane; float a = 0.f;
#pragma unroll
            for (int j = 0; j < 4; ++j) { const f32x4 ww = w[64 * j]; a += (v[j].x * ww.x + v[j].y * ww.y) + (v[j].z * ww.z + v[j].w * ww.w); }
            lg[gi] = wave_sum(a) * rstd; }
        int gidx = 0; float gmax = lg[0];
#pragma unroll
        for (int gi = 1; gi < 4; ++gi) if (lg[gi] > gmax) { gmax = lg[gi]; gidx = gi; }
        float gs = 0.f;
#pragma unroll
        for (int gi = 0; gi < 4; ++gi) gs += __expf(lg[gi] - gmax);
        const float ggate = 1.f / gs;
        gidx = __builtin_amdgcn_readfirstlane(gidx);
        float le[8];
#pragma unroll
        for (int e = 0; e < 8; ++e) { const f32x4* w = (const f32x4*)(ReT + (gidx * 8 + e) * 1024) + F.lane; float a = 0.f;
#pragma unroll
            for (int j = 0; j < 4; ++j) { const f32x4 ww = w[64 * j]; a += (v[j].x * ww.x + v[j].y * ww.y) + (v[j].z * ww.z + v[j].w * ww.w); }
            le[e] = wave_sum(a) * rstd; }
        int i0 = 0; float v0 = le[0];
#pragma unroll
        for (int e = 1; e < 8; ++e) if (le[e] > v0) { v0 = le[e]; i0 = e; }
        int i1 = -1; float v1 = -3.0e38f;
#pragma unroll
        for (int e = 0; e < 8; ++e) if (e != i0 && le[e] > v1) { v1 = le[e]; i1 = e; }
        const float ex = __expf(v1 - v0), w0 = ggate / (1.f + ex), w1 = ggate * ex / (1.f + ex);
        if (F.lane == 0) {
            ((float*)(F.ws + WS_RSTD))[m] = rstd;
            const int e0 = gidx * 8 + i0, e1 = gidx * 8 + i1;
            const unsigned p0 = atomicAdd(cnt + e0, 1u), p1 = atomicAdd(cnt + e1, 1u);
            ltok[(size_t)e0 * CAP + p0] = m; lrstd[(size_t)e0 * CAP + p0] = rstd; lw[(size_t)e0 * CAP + p0] = w0;
            ltok[(size_t)e1 * CAP + p1] = m; lrstd[(size_t)e1 * CAP + p1] = rstd; lw[(size_t)e1 * CAP + p1] = w1;
            tokinfo[2 * m] = e0 * CAP + (int)p0; tokinfo[2 * m + 1] = e1 * CAP + (int)p1;
        }
    }
}
__device__ __forceinline__ void p_combine(Frame& F, int layer, int mode) {
    moe_tables(F, layer);
    const LAS int* ts = (const LAS int*)(F.lds + TS_OFF);
    const int gw = F.vcu * 8 + F.wave, NGW = F.G * 8;
    float* H = F.out; const bf16_t* Y = (const bf16_t*)(F.ws + WS_Y); const int* tokinfo = (const int*)(F.ws + WS_TOKINFO);
    bf16_t* XB = (bf16_t*)(F.ws + WS_XB); float* rstd = (float*)(F.ws + WS_RSTD); const float* gfin = F.in[3];
    for (int m = gw; m < T; m += NGW) {
        const int t0 = tokinfo[2 * m], t1 = tokinfo[2 * m + 1];
        const size_t s0 = (size_t)ts[t0 >> 15] * 256 + (t0 & (CAP - 1)), s1 = (size_t)ts[t1 >> 15] * 256 + (t1 & (CAP - 1));
        f32x4* hr = (f32x4*)(H + (size_t)m * D) + F.lane; const u32x2* y0 = (const u32x2*)(Y + s0 * D) + F.lane; const u32x2* y1 = (const u32x2*)(Y + s1 * D) + F.lane;
        f32x4 v[4]; float s = 0.f;
#pragma unroll
        for (int j = 0; j < 4; ++j) { v[j] = hr[64 * j]; const u32x2 a = y0[64 * j], b = y1[64 * j];
            v[j].x += bf2f(a.x & 0xffffu) + bf2f(b.x & 0xffffu); v[j].y += bf2f(a.x >> 16) + bf2f(b.x >> 16); v[j].z += bf2f(a.y & 0xffffu) + bf2f(b.y & 0xffffu); v[j].w += bf2f(a.y >> 16) + bf2f(b.y >> 16);
            s += (v[j].x * v[j].x + v[j].y * v[j].y) + (v[j].z * v[j].z + v[j].w * v[j].w); }
        const float rs = rsqrtf(wave_sum(s) * (1.f / D) + EPS);
        if (mode == 0) {
            if (F.lane == 0) rstd[m] = rs;
            u32x2* o8 = (u32x2*)(XB + (size_t)m * D) + F.lane;
#pragma unroll
            for (int j = 0; j < 4; ++j) { hr[64 * j] = v[j]; o8[64 * j] = (u32x2){pk2(v[j].x, v[j].y), pk2(v[j].z, v[j].w)}; }
        } else {
            const f32x4* g4 = (const f32x4*)gfin + F.lane;
#pragma unroll
            for (int j = 0; j < 4; ++j) { const f32x4 g = g4[64 * j]; hr[64 * j] = (f32x4){v[j].x * rs * g.x, v[j].y * rs * g.y, v[j].z * rs * g.z, v[j].w * rs * g.w}; }
        }
    }
}

__device__ __forceinline__ void mix_rglru_item(Frame& F, int b, int nb) {
    LAS float* L = (LAS float*)F.lds;
    LAS float* wa = L; LAS float* wx = L + 4096; LAS float* xat = L + 8192;   LAS float* xc = xat + 67 * 64; LAS float* ga = xc + 4096; LAS float* av = ga + 4096; LAS float* uv = av + 4096; LAS float* prm = uv + 4096;
    const bf16_t* Z = (const bf16_t*)(F.ws + WS_Z); bf16_t* CAT = (bf16_t*)(F.ws + WS_CAT);
    const int tid = F.tid;
    __syncthreads();
    for (int i = tid; i < 4096; i += 512) { wa[i] = F.in[7][nb * 4096 + i]; wx[i] = F.in[9][nb * 4096 + i]; }
    if (tid < 64) { const int c = nb * 64 + tid; prm[tid] = F.in[6][c]; prm[64 + tid] = F.in[5][c]; prm[128 + tid] = F.in[5][512 + c]; prm[192 + tid] = F.in[5][1024 + c]; prm[256 + tid] = F.in[5][1536 + c];
        prm[320 + tid] = F.in[8][c]; prm[384 + tid] = F.in[10][c]; const float lam = F.in[11][c]; prm[448 + tid] = fminf(lam, 0.f) - log1pf(__expf(-fabsf(lam))); }
    float hcar = 0.f;
    for (int t0 = 0; t0 < SEQ; t0 += 64) {
        __syncthreads();
        for (int i = tid; i < 67 * 64; i += 512) { const int r = i >> 6, c = i & 63, tg = t0 - 3 + r; xat[i] = tg >= 0 ? bf2f(Z[((size_t)b * SEQ + tg) * AB_IN + nb * 64 + c]) : 0.f; }
        for (int i = tid; i < 4096; i += 512) { const int r = i >> 6, c = i & 63; ga[i] = bf2f(Z[((size_t)b * SEQ + t0 + r) * AB_IN + 512 + nb * 64 + c]); }
        __syncthreads();
        for (int i = tid; i < 4096; i += 512) { const int r = i >> 6, c = i & 63; xc[i] = prm[c] + prm[64 + c] * xat[r * 64 + c] + prm[128 + c] * xat[(r + 1) * 64 + c] + prm[192 + c] * xat[(r + 2) * 64 + c] + prm[256 + c] * xat[(r + 3) * 64 + c]; }
        __syncthreads();
        { const int tok = tid >> 3, dg = tid & 7; float aa[8], ax[8];
#pragma unroll
          for (int j = 0; j < 8; ++j) { aa[j] = 0.f; ax[j] = 0.f; }
          for (int c = 0; c < 64; ++c) { const float xv = xc[tok * 64 + c]; const LAS f32x4* pa = (const LAS f32x4*)(wa + c * 64 + dg * 8); const LAS f32x4* px = (const LAS f32x4*)(wx + c * 64 + dg * 8);
              const f32x4 a0 = pa[0], a1 = pa[1], x0 = px[0], x1 = px[1];
              aa[0] += xv * a0.x; aa[1] += xv * a0.y; aa[2] += xv * a0.z; aa[3] += xv * a0.w; aa[4] += xv * a1.x; aa[5] += xv * a1.y; aa[6] += xv * a1.z; aa[7] += xv * a1.w;
              ax[0] += xv * x0.x; ax[1] += xv * x0.y; ax[2] += xv * x0.z; ax[3] += xv * x0.w; ax[4] += xv * x1.x; ax[5] += xv * x1.y; ax[6] += xv * x1.z; ax[7] += xv * x1.w; }
#pragma unroll
          for (int j = 0; j < 8; ++j) { const int d = dg * 8 + j; const float r = sigmoidf_(aa[j] + prm[320 + d]), ig = sigmoidf_(ax[j] + prm[384 + d]);
              const float la = 8.0f * r * prm[448 + d]; av[tok * 64 + d] = __expf(la); uv[tok * 64 + d] = sqrtf(fmaxf(-expm1f(2.0f * la), 0.f)) * (ig * xc[tok * 64 + d]); } }
        __syncthreads();
        if (tid < 64) { for (int r = 0; r < 64; ++r) { hcar = av[r * 64 + tid] * hcar + uv[r * 64 + tid]; av[r * 64 + tid] = hcar; } }
        __syncthreads();
        for (int i = tid; i < 4096; i += 512) { const int r = i >> 6, c = i & 63; CAT[((size_t)b * SEQ + t0 + r) * D + nb * 64 + c] = (bf16_t)f2bf(av[i] * gelu_tanh(ga[i])); }
    }
    __syncthreads();
}
__device__ __forceinline__ void mix_attn_item(Frame& F, int b, int c, int h) {
    LAS float* Ks = (LAS float*)F.lds;   LAS float* Vs = Ks + 64 * 68;   LAS float* bs = Vs + 4096;   LAS float* Ss = bs + 520;
    const bf16_t* Z = (const bf16_t*)(F.ws + WS_Z); bf16_t* CAT = (bf16_t*)(F.ws + WS_CAT);
    const int tid = F.tid, t = tid >> 3, sub = tid & 7;
    __syncthreads();
    for (int i = tid; i < 513; i += 512) bs[i] = F.in[12][h * 513 + i];
    unsigned q2[32]; float o[64];
    { const unsigned* qp = (const unsigned*)(Z + ((size_t)b * SEQ + c * 64 + t) * AB_IN + 1024 + h * 64);
#pragma unroll
      for (int d = 0; d < 32; ++d) q2[d] = qp[d];
#pragma unroll
      for (int d = 0; d < 64; ++d) o[d] = 0.f; }
    float mrun = -3.0e38f, lrun = 0.f;
    for (int kc = (c >= 8 ? c - 8 : 0); kc <= c; ++kc) {
        __syncthreads();
        for (int i = tid; i < 4096; i += 512) { const int s = i >> 6, d = i & 63; const size_t base = ((size_t)b * SEQ + kc * 64 + s) * AB_IN + h * 64 + d;
            Ks[s * 68 + d] = bf2f(Z[base + 1536]); Vs[s * 64 + d] = bf2f(Z[base + 2048]); }
        __syncthreads();
        float tmax = -3.0e38f;
#pragma unroll 1
        for (int jj = 0; jj < 8; ++jj) { const int s = sub + 8 * jj; const LAS f32x4* kp = (const LAS f32x4*)(Ks + s * 68); float a = 0.f;
#pragma unroll
            for (int d4 = 0; d4 < 16; ++d4) { const f32x4 kv = kp[d4]; a += bf2f(q2[2 * d4] & 0xffffu) * kv.x + bf2f(q2[2 * d4] >> 16) * kv.y + bf2f(q2[2 * d4 + 1] & 0xffffu) * kv.z + bf2f(q2[2 * d4 + 1] >> 16) * kv.w; }
            a *= 0.125f;
            int rel = t - ((kc - c) * 64 + s); rel = rel < -256 ? -256 : (rel > 256 ? 256 : rel);
            a += bs[rel + 256]; Ss[t * 65 + s] = a; tmax = fmaxf(tmax, a); }
        const float mnew = fmaxf(mrun, tmax), f = __expf(mrun - mnew);
        lrun *= f;
#pragma unroll
        for (int d = 0; d < 64; ++d) o[d] *= f;
#pragma unroll 1
        for (int jj = 0; jj < 8; ++jj) { const int s = sub + 8 * jj; const float p = __expf(Ss[t * 65 + s] - mnew); lrun += p; const LAS f32x4* vp = (const LAS f32x4*)(Vs + s * 64);
#pragma unroll
            for (int d4 = 0; d4 < 16; ++d4) { const f32x4 vv = vp[d4]; o[4 * d4] += p * vv.x; o[4 * d4 + 1] += p * vv.y; o[4 * d4 + 2] += p * vv.z; o[4 * d4 + 3] += p * vv.w; } }
        mrun = mnew;
    }
    float mall = mrun;
    mall = fmaxf(mall, __shfl_xor(mall, 1)); mall = fmaxf(mall, __shfl_xor(mall, 2)); mall = fmaxf(mall, __shfl_xor(mall, 4));
    const float f = __expf(mrun - mall); lrun *= f;
    lrun += __shfl_xor(lrun, 1); lrun += __shfl_xor(lrun, 2); lrun += __shfl_xor(lrun, 4);
    const float inv = 1.0f / lrun;
    bf16_t* op = CAT + ((size_t)b * SEQ + c * 64 + t) * D + 512 + h * 64;
#pragma unroll
    for (int d = 0; d < 64; ++d) { float v = o[d] * f; v += __shfl_xor(v, 1); v += __shfl_xor(v, 2); v += __shfl_xor(v, 4); if ((d >> 3) == sub) op[d] = (bf16_t)f2bf(v * inv); }
}

typedef float f32x16 __attribute__((ext_vector_type(16)));
typedef short s16x4 __attribute__((ext_vector_type(4)));
__device__ __forceinline__ s16x4 ds_tr16(const LAS unsigned char* p) { return __builtin_bit_cast(s16x4, __builtin_amdgcn_ds_read_tr16_b64_v4i16((LAS s16x4*)p)); }
constexpr int ATT_BT_BYTES = 8 * 520 * 4;
__device__ __forceinline__ void attn_load_bias(Frame& F) {
    LAS float* bt = (LAS float*)F.lds;
    __syncthreads();
    for (int i = F.tid; i < 8 * 513; i += 512) { const int h = i / 513, j = i % 513; bt[h * 520 + j] = F.in[12][i] * 1.4426950408889634f; }
    __syncthreads();
}
__device__ __forceinline__ void attn_wave_mfma(Frame& F, int b, int c, int h) {
    const bf16_t* Z = (const bf16_t*)(F.ws + WS_Z); bf16_t* CAT = (bf16_t*)(F.ws + WS_CAT);
    const int l = F.lane, r = l & 31, hh = l >> 5;
    const LAS float* btab = (const LAS float*)F.lds + h * 520;
    LAS unsigned char* Vw = F.lds + ATT_BT_BYTES + F.wave * 8192;
    const float SC = 0.125f * 1.4426950408889634f;
    bf16x8 qf[2][4];
    { const bf16_t* Qb = Z + ((size_t)b * SEQ + c * 64) * AB_IN + 1024 + h * 64;
#pragma unroll
      for (int qb = 0; qb < 2; ++qb)
#pragma unroll
          for (int ks = 0; ks < 4; ++ks) qf[qb][ks] = *(const bf16x8*)(Qb + (size_t)(qb * 32 + r) * AB_IN + ks * 16 + hh * 8); }
    f32x16 o[2][2];
#pragma unroll
    for (int a = 0; a < 2; ++a)
#pragma unroll
        for (int d = 0; d < 2; ++d)
#pragma unroll
            for (int i = 0; i < 16; ++i) o[a][d][i] = 0.f;
    float mrun[2] = {-1.0e30f, -1.0e30f}, lsum[2] = {0.f, 0.f};
    const int q4 = (l & 15) >> 2, p4 = l & 3, cb = (l >> 4) & 1, xs = (q4 >> 1) & 1;
    const LAS unsigned char* vbase = Vw + (4 * hh + q4) * 128 + p4 * 8 + cb * 32;
    const LAS unsigned char* vb[2] = {vbase + xs * 64, vbase + (1 - xs) * 64};
    for (int kc = (c >= 8 ? c - 8 : 0); kc <= c; ++kc) {
        const bf16_t* Kb = Z + ((size_t)b * SEQ + kc * 64) * AB_IN + 1536 + h * 64; const bf16_t* Vb = Kb + 512;
        { u32x4 vr[8];
#pragma unroll
          for (int i = 0; i < 8; ++i) vr[i] = *(const u32x4*)(Vb + (size_t)(i * 8 + (l >> 3)) * AB_IN + (l & 7) * 8);
#pragma unroll
          for (int i = 0; i < 8; ++i) { const int s = i * 8 + (l >> 3), ci = l & 7, pb = (ci >> 1) ^ (((s >> 1) & 1) << 1); *(LAS u32x4*)(Vw + s * 128 + pb * 32 + (ci & 1) * 16) = vr[i]; } }
        asm volatile("" ::: "memory");
        bf16x8 kf[2][4];
#pragma unroll
        for (int sb = 0; sb < 2; ++sb)
#pragma unroll
            for (int ks = 0; ks < 4; ++ks) kf[sb][ks] = *(const bf16x8*)(Kb + (size_t)(sb * 32 + r) * AB_IN + ks * 16 + hh * 8);
        const int dt = (c - kc) * 64;
#pragma unroll
        for (int qb = 0; qb < 2; ++qb) {
            f32x16 st[2];
#pragma unroll
            for (int sb = 0; sb < 2; ++sb) {
#pragma unroll
                for (int i = 0; i < 16; ++i) st[sb][i] = 0.f;
#pragma unroll
                for (int ks = 0; ks < 4; ++ks) st[sb] = __builtin_amdgcn_mfma_f32_32x32x16_bf16(kf[sb][ks], qf[qb][ks], st[sb], 0, 0, 0); }
            if (dt >= 320) { const float bc = btab[512];
#pragma unroll
                for (int sb = 0; sb < 2; ++sb)
#pragma unroll
                    for (int i = 0; i < 16; ++i) st[sb][i] = st[sb][i] * SC + bc;
            } else { const int base = dt + qb * 32 + r - 4 * hh + 256;
#pragma unroll
                for (int sb = 0; sb < 2; ++sb)
#pragma unroll
                    for (int i = 0; i < 16; ++i) { int idx = base - sb * 32 - ((i & 3) + 8 * (i >> 2)); idx = idx > 512 ? 512 : idx; st[sb][i] = st[sb][i] * SC + btab[idx]; } }
            float mx = st[0][0];
#pragma unroll
            for (int sb = 0; sb < 2; ++sb)
#pragma unroll
                for (int i = 0; i < 16; ++i) mx = fmaxf(mx, st[sb][i]);
            mx = fmaxf(mx, __shfl_xor(mx, 32));
            const float mn = fmaxf(mrun[qb], mx), alpha = __builtin_amdgcn_exp2f(mrun[qb] - mn); mrun[qb] = mn;
            float rs = 0.f;
#pragma unroll
            for (int sb = 0; sb < 2; ++sb)
#pragma unroll
                for (int i = 0; i < 16; ++i) { const float pv = __builtin_amdgcn_exp2f(st[sb][i] - mn); st[sb][i] = pv; rs += pv; }
            rs += __shfl_xor(rs, 32); lsum[qb] = lsum[qb] * alpha + rs;
#pragma unroll
            for (int d = 0; d < 2; ++d)
#pragma unroll
                for (int i = 0; i < 16; ++i) o[qb][d][i] *= alpha;
            bf16x8 pf[4];
#pragma unroll
            for (int kk = 0; kk < 4; ++kk) { const int sb = kk >> 1, s2 = kk & 1; u32x4 w;
                w.x = cvt_pk_bf16(st[sb][8 * s2 + 0], st[sb][8 * s2 + 1]); w.y = cvt_pk_bf16(st[sb][8 * s2 + 2], st[sb][8 * s2 + 3]);
                w.z = cvt_pk_bf16(st[sb][8 * s2 + 4], st[sb][8 * s2 + 5]); w.w = cvt_pk_bf16(st[sb][8 * s2 + 6], st[sb][8 * s2 + 7]); pf[kk] = __builtin_bit_cast(bf16x8, w); }
#pragma unroll
            for (int d = 0; d < 2; ++d)
#pragma unroll
                for (int kk = 0; kk < 4; ++kk) { const int rowoff = ((kk >> 1) * 32 + 16 * (kk & 1)) * 128;
                    const s16x4 lo = ds_tr16(vb[d] + rowoff), hi = ds_tr16(vb[d] + rowoff + 8 * 128);
                    const bf16x8 vf = (bf16x8){lo[0], lo[1], lo[2], lo[3], hi[0], hi[1], hi[2], hi[3]};
                    o[qb][d] = __builtin_amdgcn_mfma_f32_32x32x16_bf16(vf, pf[kk], o[qb][d], 0, 0, 0); }
        }
    }
#pragma unroll
    for (int qb = 0; qb < 2; ++qb) { const float inv = 1.0f / lsum[qb]; bf16_t* op = CAT + ((size_t)b * SEQ + c * 64 + qb * 32 + r) * D + 512 + h * 64 + 4 * hh;
#pragma unroll
        for (int d = 0; d < 2; ++d)
#pragma unroll
            for (int g = 0; g < 4; ++g) { u32x2 w; w.x = cvt_pk_bf16(o[qb][d][4 * g] * inv, o[qb][d][4 * g + 1] * inv); w.y = cvt_pk_bf16(o[qb][d][4 * g + 2] * inv, o[qb][d][4 * g + 3] * inv);
                *(u32x2*)(op + d * 32 + 8 * g) = w; } }
}
__device__ __forceinline__ void p_mix0(Frame& F) {
    const int j = F.vcu;
    if (j >= 128 && j < 256) mix_rglru_item(F, (j - 128) >> 3, (j - 128) & 7);
    attn_load_bias(F);
    if (j < 256) {
#pragma unroll 1
        for (int rep = 0; rep < 2; ++rep) attn_wave_mfma(F, j & 15, rep == 0 ? 16 + (j >> 4) : 15 - (j >> 4), F.wave);
    }
    __syncthreads();
}
__device__ __forceinline__ void mix_hgrn_item(Frame& F, int b, int h) {
    LAS float* L = (LAS float*)F.lds;
    LAS float* qs = L; LAS float* fs = L + 4096; LAS float* is = L + 8192; LAS float* gs = L + 12288; LAS float* op = L + 16384;
    const bf16_t* Z = (const bf16_t*)(F.ws + WS_Z); bf16_t* CAT = (bf16_t*)(F.ws + WS_CAT); const float* lb = (const float*)(F.ws + WS_LB); const float* ng = F.in[16];
    const int tid = F.tid, v = tid & 127, kq = tid >> 7;
    float S[32];
#pragma unroll
    for (int k = 0; k < 32; ++k) S[k] = 0.f;
    for (int t0 = 0; t0 < SEQ; t0 += 32) {
        __syncthreads();
        for (int i = tid; i < 4096; i += 512) { const int r = i >> 7, c = i & 127; const bf16_t* zr = Z + ((size_t)b * SEQ + t0 + r) * C_IN + h * 128 + c;
            qs[i] = bf2f(zr[0]); const float l = lb[h * 128 + c]; fs[i] = l + (1.f - l) * sigmoidf_(bf2f(zr[1024])); is[i] = bf2f(zr[2048]); gs[i] = bf2f(zr[3072]); }
        __syncthreads();
        for (int r = 0; r < 32; ++r) { const float iv = is[r * 128 + v]; float o = 0.f;
#pragma unroll
            for (int k4 = 0; k4 < 8; ++k4) { const f32x4 f4 = *(const LAS f32x4*)(fs + r * 128 + kq * 32 + 4 * k4), q4 = *(const LAS f32x4*)(qs + r * 128 + kq * 32 + 4 * k4);
                S[4 * k4] = f4.x * S[4 * k4] + (1.f - f4.x) * iv; o += q4.x * S[4 * k4];
                S[4 * k4 + 1] = f4.y * S[4 * k4 + 1] + (1.f - f4.y) * iv; o += q4.y * S[4 * k4 + 1];
                S[4 * k4 + 2] = f4.z * S[4 * k4 + 2] + (1.f - f4.z) * iv; o += q4.z * S[4 * k4 + 2];
                S[4 * k4 + 3] = f4.w * S[4 * k4 + 3] + (1.f - f4.w) * iv; o += q4.w * S[4 * k4 + 3]; }
            op[(r * 4 + kq) * 128 + v] = o; }
        __syncthreads();
#pragma unroll
        for (int rr = 0; rr < 4; ++rr) { const int r = F.wave * 4 + rr; const int l = F.lane;
            const float o1 = op[(r * 4 + 0) * 128 + l] + op[(r * 4 + 1) * 128 + l] + op[(r * 4 + 2) * 128 + l] + op[(r * 4 + 3) * 128 + l];
            const float o2 = op[(r * 4 + 0) * 128 + 64 + l] + op[(r * 4 + 1) * 128 + 64 + l] + op[(r * 4 + 2) * 128 + 64 + l] + op[(r * 4 + 3) * 128 + 64 + l];
            const float rinv = rsqrtf(wave_sum(o1 * o1 + o2 * o2) * (1.f / 128.f) + EPS);
            bf16_t* cp = CAT + ((size_t)b * SEQ + t0 + r) * D + h * 128;
            cp[l] = (bf16_t)f2bf(o1 * rinv * ng[h * 128 + l] * gs[r * 128 + l]); cp[64 + l] = (bf16_t)f2bf(o2 * rinv * ng[h * 128 + 64 + l] * gs[r * 128 + 64 + l]); }
    }
    __syncthreads();
}


constexpr int HG_STR = 272;
constexpr int HG_LF = 0, HG_QH = 16384, HG_KK = 32768;
constexpr int HG_QE = 49152, HG_KN = HG_QE + 32 * HG_STR, HG_KS = HG_KN + 32 * HG_STR, HG_V0 = HG_KS + 32 * HG_STR, HG_V1 = HG_V0 + 32 * HG_STR, HG_G0 = HG_V1 + 32 * HG_STR, HG_G1 = HG_G0 + 32 * HG_STR;
constexpr int HG_AT = HG_G1 + 32 * HG_STR, HG_EB = HG_AT + 2560, HG_SEG = HG_EB + 512, HG_SSQ = HG_SEG + 2048, HG_END = HG_SSQ + 1024;
static_assert(HG_END <= RING_BYTES, "hgrn lds");
#define MFMA16(a, b, c) __builtin_amdgcn_mfma_f32_16x16x32_bf16((a), (b), (c), 0, 0, 0)
__device__ __forceinline__ void hgrn_item(Frame& F, int b, int h) {
    const bf16_t* Z = (const bf16_t*)(F.ws + WS_Z); bf16_t* CAT = (bf16_t*)(F.ws + WS_CAT); const float* lbp = (const float*)(F.ws + WS_LB); const float* ngp = F.in[16];
    LAS unsigned char* L = F.lds;
    LAS float* LF = (LAS float*)(L + HG_LF); LAS float* QH = (LAS float*)(L + HG_QH); LAS float* KK = (LAS float*)(L + HG_KK);
    LAS float* EB = (LAS float*)(L + HG_EB); LAS float* SEG = (LAS float*)(L + HG_SEG); LAS float* SSQ = (LAS float*)(L + HG_SSQ);
    LAS bf16_t* AT = (LAS bf16_t*)(L + HG_AT);
    const int tid = F.tid, l = F.lane, w = F.wave;
    const int lt = tid >> 4, lkc = tid & 15, sk = tid & 127, sseg = tid >> 7, i16 = l & 15, q4 = l >> 4, qq = i16 >> 2, pp = i16 & 3;
    float lbv[8];
#pragma unroll
    for (int j = 0; j < 8; ++j) lbv[j] = lbp[h * 128 + 8 * lkc + j];
    float ngv[4];
#pragma unroll
    for (int j = 0; j < 4; ++j) ngv[j] = ngp[h * 128 + 16 * w + 4 * q4 + j];
    f32x4 S[8];
#pragma unroll
    for (int i = 0; i < 8; ++i) S[i] = (f32x4){0.f, 0.f, 0.f, 0.f};
    __syncthreads();
    for (int i = tid; i < 640; i += 512) ((LAS unsigned*)(L + HG_AT))[i] = 0u;
    const bf16_t* zrow0 = Z + ((size_t)b * SEQ + lt) * C_IN + h * 128 + 8 * lkc;
    u32x4 pq = *(const u32x4*)(zrow0), pf = *(const u32x4*)(zrow0 + 1024), pv = *(const u32x4*)(zrow0 + 2048), pg = *(const u32x4*)(zrow0 + 3072);
#pragma unroll 1
    for (int st = 0; st < 64; ++st) {
        const int par = st & 1;
        LAS unsigned char* Vb = L + (par ? HG_V1 : HG_V0); LAS unsigned char* Gb = L + (par ? HG_G1 : HG_G0);
        { const unsigned qa[4] = {pq.x, pq.y, pq.z, pq.w}, fa[4] = {pf.x, pf.y, pf.z, pf.w};
          float lf[8], kk[8], qh[8];
#pragma unroll
          for (int j = 0; j < 8; ++j) { const float fz = bf2f((j & 1) ? (fa[j >> 1] >> 16) : (fa[j >> 1] & 0xffffu)); qh[j] = bf2f((j & 1) ? (qa[j >> 1] >> 16) : (qa[j >> 1] & 0xffffu));
              const float f = lbv[j] + (1.f - lbv[j]) * sigmoidf_(fz); lf[j] = __logf(f); kk[j] = 1.f - f; }
          LAS f32x4* d0 = (LAS f32x4*)(LF + lt * 128 + 8 * lkc); d0[0] = (f32x4){lf[0], lf[1], lf[2], lf[3]}; d0[1] = (f32x4){lf[4], lf[5], lf[6], lf[7]};
          LAS f32x4* d1 = (LAS f32x4*)(QH + lt * 128 + 8 * lkc); d1[0] = (f32x4){qh[0], qh[1], qh[2], qh[3]}; d1[1] = (f32x4){qh[4], qh[5], qh[6], qh[7]};
          LAS f32x4* d2 = (LAS f32x4*)(KK + lt * 128 + 8 * lkc); d2[0] = (f32x4){kk[0], kk[1], kk[2], kk[3]}; d2[1] = (f32x4){kk[4], kk[5], kk[6], kk[7]};
          *(LAS u32x4*)(Vb + lt * HG_STR + lkc * 16) = pv; *(LAS u32x4*)(Gb + lt * HG_STR + lkc * 16) = pg; }
        if (st < 63) { const bf16_t* zr = zrow0 + (size_t)(st + 1) * 32 * C_IN; pq = *(const u32x4*)(zr); pf = *(const u32x4*)(zr + 1024); pv = *(const u32x4*)(zr + 2048); pg = *(const u32x4*)(zr + 3072); }
        __syncthreads();
        float bl[8];
        { float a = 0.f;
#pragma unroll
          for (int j = 0; j < 8; ++j) { a += LF[(8 * sseg + j) * 128 + sk]; bl[j] = a; } }
        SEG[sseg * 128 + sk] = bl[7];
        __syncthreads();
        { const float s0 = SEG[sk], s1 = SEG[128 + sk], s2 = SEG[256 + sk], s3 = SEG[384 + sk];
          const float pre = (sseg > 0 ? s0 : 0.f) + (sseg > 1 ? s1 : 0.f) + (sseg > 2 ? s2 : 0.f), Bt = (s0 + s1) + (s2 + s3);
#pragma unroll
          for (int j = 0; j < 8; ++j) { const int t = 8 * sseg + j; const float bb = pre + bl[j];
              const float e1 = __expf(bb), e2 = __expf(fminf(-bb, 80.f)), e3 = __expf(Bt - bb), qh = QH[t * 128 + sk], kk = KK[t * 128 + sk];
              *(LAS bf16_t*)(L + HG_QE + t * HG_STR + sk * 2) = (bf16_t)f2bf(qh * e1);
              *(LAS bf16_t*)(L + HG_KN + t * HG_STR + sk * 2) = (bf16_t)f2bf(kk * e2);
              *(LAS bf16_t*)(L + HG_KS + t * HG_STR + sk * 2) = (bf16_t)f2bf(kk * e3); }
          if (sseg == 0) EB[sk] = __expf(Bt); }
        __syncthreads();
        if (w < 3) { const int tb = w ? 1 : 0, sb = (w == 2) ? 1 : 0; f32x4 acc = (f32x4){0.f, 0.f, 0.f, 0.f};
#pragma unroll
            for (int ks = 0; ks < 4; ++ks) { const bf16x8 a = *(const LAS bf16x8*)(L + HG_QE + (16 * tb + i16) * HG_STR + (32 * ks + 8 * q4) * 2), bq = *(const LAS bf16x8*)(L + HG_KN + (16 * sb + i16) * HG_STR + (32 * ks + 8 * q4) * 2);
                acc = MFMA16(a, bq, acc); }
#pragma unroll
            for (int rg = 0; rg < 4; ++rg) { const int t = 16 * tb + 4 * q4 + rg, sx = 16 * sb + i16; AT[t * 40 + sx] = (bf16_t)f2bf(sx <= t ? acc[rg] : 0.f); } }
        __syncthreads();
        bf16x8 vfr;
        { const s16x4 lo = ds_tr16(Vb + (8 * q4 + qq) * HG_STR + (16 * w + 4 * pp) * 2), hi = ds_tr16(Vb + (8 * q4 + 4 + qq) * HG_STR + (16 * w + 4 * pp) * 2);
          vfr = (bf16x8){lo[0], lo[1], lo[2], lo[3], hi[0], hi[1], hi[2], hi[3]}; }
        f32x4 O[2];
#pragma unroll
        for (int tb = 0; tb < 2; ++tb) { const bf16x8 at = *(const LAS bf16x8*)(L + HG_AT + (16 * tb + i16) * 80 + 16 * q4); O[tb] = MFMA16(vfr, at, ((f32x4){0.f, 0.f, 0.f, 0.f})); }
#pragma unroll
        for (int m = 0; m < 4; ++m) { u32x4 sp; sp.x = cvt_pk_bf16(S[2 * m][0], S[2 * m][1]); sp.y = cvt_pk_bf16(S[2 * m][2], S[2 * m][3]); sp.z = cvt_pk_bf16(S[2 * m + 1][0], S[2 * m + 1][1]); sp.w = cvt_pk_bf16(S[2 * m + 1][2], S[2 * m + 1][3]);
            const bf16x8 spk = __builtin_bit_cast(bf16x8, sp);
#pragma unroll
            for (int tb = 0; tb < 2; ++tb) { const u32x2 q0 = *(const LAS u32x2*)(L + HG_QE + (16 * tb + i16) * HG_STR + (32 * m + 4 * q4) * 2), q1 = *(const LAS u32x2*)(L + HG_QE + (16 * tb + i16) * HG_STR + (32 * m + 16 + 4 * q4) * 2);
                const u32x4 qv = (u32x4){q0.x, q0.y, q1.x, q1.y}; O[tb] = MFMA16(spk, __builtin_bit_cast(bf16x8, qv), O[tb]); } }
#pragma unroll
        for (int kb = 0; kb < 8; ++kb) { const s16x4 lo = ds_tr16(L + HG_KS + (8 * q4 + qq) * HG_STR + (16 * kb + 4 * pp) * 2), hi = ds_tr16(L + HG_KS + (8 * q4 + 4 + qq) * HG_STR + (16 * kb + 4 * pp) * 2);
            const bf16x8 kfr = (bf16x8){lo[0], lo[1], lo[2], lo[3], hi[0], hi[1], hi[2], hi[3]}; const f32x4 dec = *(const LAS f32x4*)(EB + 16 * kb + 4 * q4);
            S[kb] = MFMA16(kfr, vfr, S[kb] * dec); }
#pragma unroll
        for (int tb = 0; tb < 2; ++tb) { float ss = (O[tb][0] * O[tb][0] + O[tb][1] * O[tb][1]) + (O[tb][2] * O[tb][2] + O[tb][3] * O[tb][3]); ss += __shfl_xor(ss, 16); ss += __shfl_xor(ss, 32);
            if (q4 == 0) SSQ[(16 * tb + i16) * 8 + w] = ss; }
        __syncthreads();
#pragma unroll
        for (int tb = 0; tb < 2; ++tb) { const int t = 16 * tb + i16; const f32x4 a = *(const LAS f32x4*)(SSQ + t * 8), c = *(const LAS f32x4*)(SSQ + t * 8 + 4);
            const float rinv = rsqrtf(((a.x + a.y) + (a.z + a.w) + (c.x + c.y) + (c.z + c.w)) * (1.f / 128.f) + EPS);
            const u32x2 g2 = *(const LAS u32x2*)(Gb + t * HG_STR + (16 * w + 4 * q4) * 2);
            const float o0 = O[tb][0] * rinv * ngv[0] * bf2f(g2.x & 0xffffu), o1 = O[tb][1] * rinv * ngv[1] * bf2f(g2.x >> 16), o2 = O[tb][2] * rinv * ngv[2] * bf2f(g2.y & 0xffffu), o3 = O[tb][3] * rinv * ngv[3] * bf2f(g2.y >> 16);
            *(u32x2*)(CAT + ((size_t)b * SEQ + st * 32 + t) * D + h * 128 + 16 * w + 4 * q4) = (u32x2){cvt_pk_bf16(o0, o1), cvt_pk_bf16(o2, o3)}; }
    }
    __syncthreads();
}
__device__ __forceinline__ void p_gu(Frame& F, int layer) {
    unsigned char* ws = F.ws;
    moe_tables(F, layer);
    const LAS int* ts = (const LAS int*)(F.lds + TS_OFF); LAS unsigned* tab = (LAS unsigned*)(F.lds + TAB_OFF);
    pg8::MoeOrder<true> S{ts, tab, F.G, F.vcu, D};
    { const int* ltok = (const int*)(ws + WS_LTOK); pg8::Unit u;
      for (int i = 0; i < 6 && S.next(i, u); ++i) if (F.tid < 256) { const int pos = u.rl * 256 + F.tid; const int tok = pos < ts[40 + u.e] ? ltok[(size_t)u.e * CAP + pos] : 0; tab[i * 256 + F.tid] = (unsigned)tok * (unsigned)(D * 2); }
      __syncthreads(); }
    pg8::EpiGU E{(bf16_t*)(ws + WS_HB), (const float*)(ws + WS_LRSTD), ts + 40};
    pg8::gemm_phase<pg8::EpiGU, pg8::MoeOrder<true>, true>(F.lds, (const bf16_t*)(ws + WS_XB), (const bf16_t*)(ws + WS_WGU), D, S, E);
}
__device__ __forceinline__ void p_dn(Frame& F, int layer) {
    unsigned char* ws = F.ws;
    moe_tables(F, layer);
    const LAS int* ts = (const LAS int*)(F.lds + TS_OFF);
    pg8::MoeOrder<false> S{ts, nullptr, F.G, F.vcu, DEXP};
    pg8::EpiDN E{(bf16_t*)(ws + WS_Y), (const float*)(ws + WS_LW), ts + 40};
    pg8::gemm_phase<pg8::EpiDN, pg8::MoeOrder<false>, true>(F.lds, (const bf16_t*)(ws + WS_HB), (const bf16_t*)(ws + WS_WDN), DEXP, S, E);
}

__global__ void __launch_bounds__(512, 2) fwd(Args args) {
    extern __shared__ __attribute__((aligned(16))) unsigned char lds_raw[];
    Frame F;
    F.lds = (LAS unsigned char*)lds_raw; F.tid = threadIdx.x; F.lane = F.tid & 63; F.wave = __builtin_amdgcn_readfirstlane(F.tid >> 6);
    F.G = gridDim.x; { const int bx = blockIdx.x; F.vcu = (F.G % 8 == 0) ? (bx % 8) * (F.G / 8) + bx / 8 : bx; }
    F.in = args.in; F.out = args.out; F.ws = args.ws;
    unsigned char* ws = args.ws;
    bf16_t* XB = (bf16_t*)(ws + WS_XB); bf16_t* CAT = (bf16_t*)(ws + WS_CAT); bf16_t* Z = (bf16_t*)(ws + WS_Z);
    float* RSTD = (float*)(ws + WS_RSTD);
#if MK_ONE_LAUNCH
    cg::grid_group grid = cg::this_grid();
#define GRID_BAR() grid.sync()
#else
#define GRID_BAR() do {} while (0)
#endif
    #ifndef PH_MASK
#define PH_MASK 0x7fff
#endif
#define PHE(p) ((PH_MASK >> (p)) & 1)
    const int lo = args.ph_lo, hi = args.ph_hi;
#define IN(k) (PHE(k) && lo <= (k) && (k) < hi)
#define SEAM(k) do { if (lo <= (k) && (k) + 1 < hi) GRID_BAR(); } while (0)
    if (IN(PH_PRO)) { p_prologue(F); } SEAM(PH_PRO);
    if (IN(PH_IN0)) { pg8::DenseOrder S; S.init(T, AB_IN, D, F.G, (int)blockIdx.x); pg8::EpiIn E{Z, AB_IN, RSTD, 0, 1 << 30};
        pg8::gemm_phase<pg8::EpiIn, pg8::DenseOrder, true>(F.lds, XB, (const bf16_t*)(ws + WS_WIN0), D, S, E); } SEAM(PH_IN0);
    if (IN(PH_MIX0)) { p_mix0(F); } SEAM(PH_MIX0);
    if (IN(PH_OUT0)) { pg8::DenseOrder S; S.init(T, D, D, F.G, (int)blockIdx.x); pg8::EpiOut E{args.in[0], args.out, XB};
        pg8::gemm_phase<pg8::EpiOut, pg8::DenseOrder, true>(F.lds, CAT, (const bf16_t*)(ws + WS_WOUT0), D, S, E); } SEAM(PH_OUT0);
    if (IN(PH_R1)) { p_router(F, 0); } SEAM(PH_R1);
    if (IN(PH_GU0)) { p_gu(F, 0); } SEAM(PH_GU0);
    if (IN(PH_DN0)) { p_dn(F, 0); } SEAM(PH_DN0);
    if (IN(PH_R2)) { p_combine(F, 0, 0); moe_convert(F, 1); } SEAM(PH_R2);
    if (IN(PH_IN1)) { pg8::DenseOrder S; S.init(T, C_IN, D, F.G, (int)blockIdx.x); pg8::EpiIn E{Z, C_IN, RSTD, 1024, 3072};
        pg8::gemm_phase<pg8::EpiIn, pg8::DenseOrder, true>(F.lds, XB, (const bf16_t*)(ws + WS_WIN1), D, S, E); } SEAM(PH_IN1);
    if (IN(PH_MIX1)) { if (F.vcu < 128) hgrn_item(F, F.vcu >> 3, F.vcu & 7); } SEAM(PH_MIX1);
    if (IN(PH_OUT1)) { pg8::DenseOrder S; S.init(T, D, D, F.G, (int)blockIdx.x); pg8::EpiOut E{args.out, args.out, XB};
        pg8::gemm_phase<pg8::EpiOut, pg8::DenseOrder, true>(F.lds, CAT, (const bf16_t*)(ws + WS_WOUT1), D, S, E); } SEAM(PH_OUT1);
    if (IN(PH_R3)) { p_router(F, 1); } SEAM(PH_R3);
    if (IN(PH_GU1)) { p_gu(F, 1); } SEAM(PH_GU1);
    if (IN(PH_DN1)) { p_dn(F, 1); } SEAM(PH_DN1);
    if (IN(PH_R4)) { p_combine(F, 1, 1); }
}

extern "C" void kernel_launch(void* const* d_in, const int* in_sizes, int n_in, void* d_out, int out_size, void* d_ws, size_t ws_size, hipStream_t stream) {
    static int grid = 0;
    if (grid == 0) {
        if (n_in != 23 || out_size != T * D || ws_size < WS_END) { fprintf(stderr, "kernel_launch: unexpected shapes: n_in %d out %d ws %zu (need %zu)\n", n_in, out_size, ws_size, (size_t)WS_END); grid = -1; return; }
        if (hipFuncSetAttribute((const void*)fwd, hipFuncAttributeMaxDynamicSharedMemorySize, LDS_BYTES) != hipSuccess) { fprintf(stderr, "kernel_launch: hipFuncSetAttribute failed\n"); grid = -1; return; }
        int dev = 0, cus = 0, per_cu = 0;
        hipGetDevice(&dev); hipDeviceGetAttribute(&cus, hipDeviceAttributeMultiprocessorCount, dev);
        hipOccupancyMaxActiveBlocksPerMultiprocessor(&per_cu, (const void*)fwd, 512, LDS_BYTES);
        (void)hipGetLastError();
        fprintf(stderr, "kernel_launch: cus %d per_cu %d ws %zu\n", cus, per_cu, ws_size);
        grid = cus > 0 ? cus : 256;
        if (per_cu < 1) fprintf(stderr, "kernel_launch: occupancy query says %d blocks per CU\n", per_cu);
    }
    if (grid < 0) return;
    hipMemsetAsync((char*)d_ws + WS_CTL, 0, CTL_BYTES, stream);
    Args a{};
    for (int i = 0; i < 23; ++i) a.in[i] = (const float*)d_in[i];
    a.out = (float*)d_out; a.ws = (unsigned char*)d_ws;
#if MK_ONE_LAUNCH
    a.ph_lo = 0; a.ph_hi = NPH;
    void* kargs[] = {&a};
    hipError_t e = hipLaunchCooperativeKernel((const void*)fwd, dim3(grid), dim3(512), kargs, LDS_BYTES, stream);
    if (e != hipSuccess) fprintf(stderr, "cooperative launch failed: %s (grid %d)\n", hipGetErrorString(e), grid);
#else
    for (int ph = 0; ph < NPH; ++ph) { a.ph_lo = ph; a.ph_hi = ph + 1; hipLaunchKernelGGL(fwd, dim3(grid), dim3(512), LDS_BYTES, stream, a); }
#endif
}
```

```cpp
#include <hip/hip_runtime.h>
#include <hip/hip_cooperative_groups.h>
#include <cstdio>
#include <cstdint>
namespace cg = cooperative_groups;

#ifndef MK_ONE_LAUNCH
#define MK_ONE_LAUNCH 1
#endif

constexpr int T = 32768, D = 1024, SEQ = 2048, NB = 16;
constexpr int AB_IN = 2560, C_IN = 4096;
constexpr int NEXP = 32, DEXP = 512, CAP = 32768;
constexpr int MAXTILES = 288;
constexpr float EPS = 1e-6f;

#define LAS __attribute__((address_space(3)))
typedef unsigned short bf16_t;
typedef short bf16x8 __attribute__((ext_vector_type(8)));
typedef float f32x4 __attribute__((ext_vector_type(4)));
typedef unsigned u32x4 __attribute__((ext_vector_type(4)));
typedef unsigned u32x2 __attribute__((ext_vector_type(2)));

constexpr size_t MiB = 1u << 20;
constexpr size_t WS_CTL = 0, CTL_BYTES = 1 * MiB;
constexpr size_t WS_RSTD = 1 * MiB;
constexpr size_t WS_LB = WS_RSTD + 128 * 1024;
constexpr size_t WS_RGT = WS_LB + 4096;
constexpr size_t WS_RET = WS_RGT + 2 * 4 * 1024 * 4;
constexpr size_t WS_TOKINFO = 2 * MiB;
constexpr size_t WS_LTOK = 3 * MiB, WS_LRSTD = 7 * MiB, WS_LW = 11 * MiB;
constexpr size_t WS_WIN0 = 16 * MiB, WS_WOUT0 = 21 * MiB, WS_WIN1 = 23 * MiB, WS_WOUT1 = 31 * MiB;
constexpr size_t WS_WGU = 34 * MiB, WS_WDN = 98 * MiB;
constexpr size_t WS_XB = 130 * MiB, WS_CAT = 194 * MiB;
constexpr size_t WS_Z = 258 * MiB;
constexpr size_t WS_HB = 258 * MiB, WS_Y = 330 * MiB;
constexpr size_t WS_END = 514 * MiB;
constexpr int CW_CNT = 64;
constexpr int CW_BAR = 4096;

constexpr int RING_BYTES = 131072;
constexpr int TAB_OFF = RING_BYTES;
constexpr int TS_OFF = TAB_OFF + 6 * 1024;
constexpr int LDS_BYTES = 147456;

__device__ __forceinline__ unsigned f2bf(float f) { unsigned u = __float_as_uint(f); return (u + 0x7fffu + ((u >> 16) & 1u)) >> 16; }
__device__ __forceinline__ float bf2f(unsigned b) { return __uint_as_float(b << 16); }
__device__ __forceinline__ unsigned pk2(float lo, float hi) { return f2bf(lo) | (f2bf(hi) << 16); }
__device__ __forceinline__ unsigned cvt_pk_bf16(float lo, float hi) { unsigned r; asm volatile("v_cvt_pk_bf16_f32 %0, %1, %2" : "=v"(r) : "v"(lo), "v"(hi)); return r; }
__device__ __forceinline__ float wave_sum(float v) {
#pragma unroll
    for (int o = 1; o < 64; o <<= 1) v += __shfl_xor(v, o);
    return v;
}
__device__ __forceinline__ float sigmoidf_(float x) { return 1.0f / (1.0f + __expf(-x)); }
__device__ __forceinline__ float siluf_(float x) { return x / (1.0f + __expf(-x)); }
__device__ __forceinline__ float gelu_tanh(float x) { const float u = 0.7978845608028654f * (x + 0.044715f * x * x * x); return 0.5f * x * (1.0f + tanhf(u)); }
#define LDS_WAIT() asm volatile("s_waitcnt lgkmcnt(0)" ::: "memory")
#define MFMA16(a, b, c) __builtin_amdgcn_mfma_f32_16x16x32_bf16((a), (b), (c), 0, 0, 0)

namespace pg8 {
constexpr int BM = 256, BK = 64, HALF = 128, HTB = HALF * BK * 2, NXCD = 8, WGM = 8;
__host__ __device__ __forceinline__ int lds_byte(int r, int c) { const int st = (r >> 4) * 2 + (c >> 5), rr = r & 15, cc = c & 31, ob = rr * 64 + cc * 2; return st * 1024 + (ob ^ (((ob >> 9) & 1) << 5)); }
__host__ __device__ __forceinline__ void stage_rc(int b, int& R, int& C) { const int st = b / 1024, sb = b % 1024, swz = sb ^ (((sb >> 9) & 1) << 5); R = (st >> 1) * 16 + swz / 64; C = (st & 1) * 32 + (swz % 64) / 2; }
__host__ __device__ __forceinline__ int perm32(int rho) { const int n = rho >> 4, i = rho & 15; return 8 * (i >> 2) + 4 * n + (i & 3); }

struct Unit { unsigned boff; int arow, orow, ocol, e, rl, slot; };

struct DenseOrder {
    int nM, nN, nwg, G, c, K;
    __device__ void init(int M, int N, int K_, int G_, int c_) { nM = M / BM; nN = N / BM; nwg = nM * nN; G = G_; c = c_; K = K_; }
    __device__ __forceinline__ bool next(int i, Unit& u) const {
        const long L = (long)i * G + c; if (L >= nwg) return false;
        int wgid = (int)L; { const int q = nwg / NXCD, r = nwg % NXCD, xcd = wgid % NXCD, off = wgid / NXCD; wgid = (xcd < r ? xcd * (q + 1) : r * (q + 1) + (xcd - r) * q) + off; }
        const int nig = WGM * nN, gid = wgid / nig, fm = gid * WGM, gsz = (nM - fm) < WGM ? (nM - fm) : WGM;
        const int pm = __builtin_amdgcn_readfirstlane(fm + ((wgid % nig) % gsz)), pn = __builtin_amdgcn_readfirstlane((wgid % nig) / gsz);
        u.arow = pm * BM; u.orow = pm * BM; u.ocol = pn * BM; u.boff = (unsigned)(pn * BM) * (unsigned)K * 2u; u.e = 0; u.rl = 0; u.slot = i; return true;
    }
    static constexpr bool GATHER = false;
    __device__ __forceinline__ size_t abase(const Unit& u) const { return (size_t)u.arow * (size_t)K * 2u; }
    __device__ __forceinline__ unsigned aoff(const Unit&, int) const { return 0u; }
};
template <bool GATHER_> struct MoeOrder {
    static constexpr bool GATHER = GATHER_;
    const LAS int* ts; const LAS unsigned* tab; int G, vcu, K;
    __device__ __forceinline__ bool next(int i, Unit& u) const {
        const int L = i * G + vcu; const int NT = __builtin_amdgcn_readfirstlane(ts[32]); if (L >= NT * 4) return false;
        const int rt = L >> 2, pn = L & 3; int e = 0;
#pragma unroll
        for (int j = 1; j < 32; ++j) e += (ts[j] <= rt) ? 1 : 0;
        e = __builtin_amdgcn_readfirstlane(e);
        u.e = e; u.rl = rt - __builtin_amdgcn_readfirstlane(ts[e]); u.orow = rt * BM; u.arow = rt * BM; u.ocol = pn * BM; u.boff = (unsigned)(e * 1024 + pn * BM) * (unsigned)K * 2u; u.slot = i; return true;
    }
    __device__ __forceinline__ size_t abase(const Unit& u) const { return GATHER ? (size_t)0 : (size_t)u.arow * (size_t)K * 2u; }
    __device__ __forceinline__ unsigned aoff(const Unit& u, int r) const { return tab[u.slot * 256 + r]; }
};

typedef f32x4 Acc[2][2][4][2];

struct EpiIn {
    static constexpr bool PERM = true;
    bf16_t* O; int ldc; const float* rstd; int silu_lo_end, silu_hi_start;
    __device__ __forceinline__ void operator()(const Acc& acc, const Unit& u, int wr, int wc, int fr, int fq) const {
        const bool act = (u.ocol < silu_lo_end) || (u.ocol >= silu_hi_start);
#pragma unroll
        for (int ai = 0; ai < 2; ++ai)
#pragma unroll
            for (int m = 0; m < 4; ++m) {
                const int row = u.orow + ai * HALF + wr * 64 + m * 16 + fr; const float rs = rstd[row];
                bf16_t* rowp = O + (size_t)row * ldc + u.ocol + wc * 32 + 8 * fq;
#pragma unroll
                for (int bj = 0; bj < 2; ++bj) { f32x4 v0 = acc[ai][bj][m][0] * rs, v1 = acc[ai][bj][m][1] * rs;
                    if (act) {
#pragma unroll
                        for (int j = 0; j < 4; ++j) { v0[j] = siluf_(v0[j]); v1[j] = siluf_(v1[j]); } }
                    u32x4 w; w.x = cvt_pk_bf16(v0[0], v0[1]); w.y = cvt_pk_bf16(v0[2], v0[3]); w.z = cvt_pk_bf16(v1[0], v1[1]); w.w = cvt_pk_bf16(v1[2], v1[3]);
                    *(u32x4*)(rowp + bj * HALF) = w; } }
    }
};
struct EpiOut {
    static constexpr bool PERM = true;
    const float* resid; float* H; bf16_t* XB;
    __device__ __forceinline__ void operator()(const Acc& acc, const Unit& u, int wr, int wc, int fr, int fq) const {
#pragma unroll
        for (int ai = 0; ai < 2; ++ai)
#pragma unroll
            for (int m = 0; m < 4; ++m) {
                const int row = u.orow + ai * HALF + wr * 64 + m * 16 + fr; const size_t off = (size_t)row * D + u.ocol + wc * 32 + 8 * fq;
#pragma unroll
                for (int bj = 0; bj < 2; ++bj) { const f32x4 r0 = *(const f32x4*)(resid + off + bj * HALF), r1 = *(const f32x4*)(resid + off + bj * HALF + 4);
                    const f32x4 v0 = acc[ai][bj][m][0] + r0, v1 = acc[ai][bj][m][1] + r1;
                    *(f32x4*)(H + off + bj * HALF) = v0; *(f32x4*)(H + off + bj * HALF + 4) = v1;
                    u32x4 w; w.x = cvt_pk_bf16(v0[0], v0[1]); w.y = cvt_pk_bf16(v0[2], v0[3]); w.z = cvt_pk_bf16(v1[0], v1[1]); w.w = cvt_pk_bf16(v1[2], v1[3]);
                    *(u32x4*)(XB + off + bj * HALF) = w; } }
    }
};
struct EpiGU {
    static constexpr bool PERM = true;
    bf16_t* HB; const float* lrstd; const LAS int* cnt;
    __device__ __forceinline__ void operator()(const Acc& acc, const Unit& u, int wr, int wc, int fr, int fq) const {
        const int n_e = cnt[u.e];
#pragma unroll
        for (int ai = 0; ai < 2; ++ai)
#pragma unroll
            for (int m = 0; m < 4; ++m) {
                const int r = ai * HALF + wr * 64 + m * 16 + fr, pos = u.rl * BM + r; const float rs = pos < n_e ? lrstd[(size_t)u.e * CAP + pos] : 0.f;
                float h[8];
#pragma unroll
                for (int n = 0; n < 2; ++n)
#pragma unroll
                    for (int j = 0; j < 4; ++j) { const float g = acc[ai][0][m][n][j] * rs, uu = acc[ai][1][m][n][j] * rs; h[n * 4 + j] = siluf_(g) * uu; }
                u32x4 w; w.x = cvt_pk_bf16(h[0], h[1]); w.y = cvt_pk_bf16(h[2], h[3]); w.z = cvt_pk_bf16(h[4], h[5]); w.w = cvt_pk_bf16(h[6], h[7]);
                *(u32x4*)(HB + (size_t)(u.orow + r) * DEXP + (u.ocol >> 1) + wc * 32 + 8 * fq) = w; }
    }
};
struct EpiDN {
    static constexpr bool PERM = true;
    bf16_t* Y; const float* lw; const LAS int* cnt;
    __device__ __forceinline__ void operator()(const Acc& acc, const Unit& u, int wr, int wc, int fr, int fq) const {
        const int n_e = cnt[u.e];
#pragma unroll
        for (int ai = 0; ai < 2; ++ai)
#pragma unroll
            for (int m = 0; m < 4; ++m) {
                const int r = ai * HALF + wr * 64 + m * 16 + fr, pos = u.rl * BM + r; const float ws = pos < n_e ? lw[(size_t)u.e * CAP + pos] : 0.f;
                bf16_t* rowp = Y + (size_t)(u.orow + r) * D + u.ocol + wc * 32 + 8 * fq;
#pragma unroll
                for (int bj = 0; bj < 2; ++bj) { const f32x4 v0 = acc[ai][bj][m][0] * ws, v1 = acc[ai][bj][m][1] * ws;
                    u32x4 w; w.x = cvt_pk_bf16(v0[0], v0[1]); w.y = cvt_pk_bf16(v0[2], v0[3]); w.z = cvt_pk_bf16(v1[0], v1[1]); w.w = cvt_pk_bf16(v1[2], v1[3]);
                    *(u32x4*)(rowp + bj * HALF) = w; } }
    }
};

template <class Epi, class Sched, bool ALIGN_EPI>
__device__ __forceinline__ void gemm_phase(LAS unsigned char* lds, const bf16_t* A, const bf16_t* Bt, const int K, const Sched& S, const Epi& E) {
    const int tid = threadIdx.x, wid = __builtin_amdgcn_readfirstlane(tid >> 6), lane = tid & 63, wr = wid >> 2, wc = wid & 3, fr = lane & 15, fq = lane >> 4;
    const int nt = K / BK;
    unsigned voffB[2], vA0[2], vA1[2];
#pragma unroll
    for (int i = 0; i < 2; ++i) { int R, C; stage_rc(tid * 16 + i * 8192, R, C); const int Rb = Epi::PERM ? ((R & ~31) + perm32(R & 31)) : R;
        vA0[i] = (unsigned)(R * K + C) * 2u; vA1[i] = vA0[i]; voffB[i] = (unsigned)(Rb * K + C) * 2u; }
#define PG8_FILL(u) do { if constexpr (Sched::GATHER) { int tv_ = tid; asm volatile("" : "+v"(tv_)); _Pragma("unroll") for (int i = 0; i < 2; ++i) { int R, C; stage_rc(tv_ * 16 + i * 8192, R, C); \
        vA0[i] = S.aoff(u, R) + (unsigned)C * 2u; vA1[i] = S.aoff(u, HALF + R) + (unsigned)C * 2u; } } } while (0)
    const size_t kstep = (size_t)(BK * 2);
    const size_t hstep = (size_t)HALF * K * 2;
    const unsigned ldsw = (unsigned)wid * 1024u;
    const int aoff = lds_byte(wr * 64 + fr, fq * 8), boff = lds_byte(wc * 32 + fr, fq * 8);
#define PG8_SA(b, h) (((b) * 2 + (h)) * HTB)
#define PG8_SB(b, h) ((4 + (b) * 2 + (h)) * HTB)
#define PG8_STAGE(bufoff, gbase, voff) do { _Pragma("unroll") for (int _i = 0; _i < 2; ++_i) \
        __builtin_amdgcn_global_load_lds((const unsigned*)((const char*)(gbase) + (voff)[_i]), (LAS unsigned*)(lds + (bufoff) + ldsw + _i * 8192), 16, 0, 0); } while (0)
#define PG8_LDA(dst, b, h) do { _Pragma("unroll") for (int m = 0; m < 4; ++m) _Pragma("unroll") for (int k = 0; k < 2; ++k) dst[m][k] = *(const LAS bf16x8*)(lds + PG8_SA(b, h) + aoff + m * 2048 + k * 1024); } while (0)
#define PG8_LDB(dst, b, h) do { _Pragma("unroll") for (int n = 0; n < 2; ++n) _Pragma("unroll") for (int k = 0; k < 2; ++k) dst[n][k] = *(const LAS bf16x8*)(lds + PG8_SB(b, h) + boff + n * 2048 + k * 1024); } while (0)
#define PG8_MMA(ai, bj, At, Bt_) do { __builtin_amdgcn_s_setprio(1); _Pragma("unroll") for (int m = 0; m < 4; ++m) _Pragma("unroll") for (int n = 0; n < 2; ++n) _Pragma("unroll") for (int k = 0; k < 2; ++k) \
        acc[ai][bj][m][n] = __builtin_amdgcn_mfma_f32_16x16x32_bf16(Bt_[n][k], At[m][k], acc[ai][bj][m][n], 0, 0, 0); __builtin_amdgcn_s_setprio(0); } while (0)
#define PG8_WAIT_V(n) asm volatile("s_waitcnt vmcnt(" #n ")" ::: "memory")
#define PG8_WAIT_L(n) asm volatile("s_waitcnt lgkmcnt(" #n ")" ::: "memory")
#define PG8_BAR __builtin_amdgcn_s_barrier()
#define PG8_SCHED __builtin_amdgcn_sched_barrier(0)
    Unit cur, nxt; int ui = 0;
    if (!S.next(0, cur)) return;
    f32x4 acc[2][2][4][2];
#pragma unroll
    for (int a = 0; a < 2; ++a)
#pragma unroll
        for (int b = 0; b < 2; ++b)
#pragma unroll
            for (int m = 0; m < 4; ++m)
#pragma unroll
                for (int n = 0; n < 2; ++n) acc[a][b][m][n] = (f32x4){0.f, 0.f, 0.f, 0.f};
    bf16x8 At[4][2], B0[2][2], B1[2][2];
    PG8_FILL(cur);
    const char* cA0 = (const char*)A + S.abase(cur); const char* cA1 = cA0 + (Sched::GATHER ? (size_t)0 : hstep); const char* cB = (const char*)Bt + cur.boff;
    PG8_STAGE(PG8_SB(0, 0), cB, voffB); PG8_STAGE(PG8_SB(0, 1), cB + hstep, voffB); PG8_STAGE(PG8_SA(0, 0), cA0, vA0); PG8_STAGE(PG8_SA(0, 1), cA1, vA1);
    if (wr == 1) PG8_BAR;
    PG8_WAIT_V(2); PG8_BAR;
    PG8_STAGE(PG8_SB(1, 0), cB + kstep, voffB); PG8_STAGE(PG8_SA(1, 0), cA0 + kstep, vA0); PG8_STAGE(PG8_SB(1, 1), cB + hstep + kstep, voffB);
    PG8_WAIT_V(6); PG8_BAR;
    for (;;) {
        const bool has_next = S.next(ui + 1, nxt);
        const char* nB = has_next ? (const char*)Bt + nxt.boff : cB;
        const char* nA0 = has_next ? (const char*)A + S.abase(nxt) : cA0; const char* nA1 = nA0 + (Sched::GATHER ? (size_t)0 : hstep);
        for (int t = 0; t < nt; t += 2) {
            const bool last = (t == nt - 2);
            const char* a1 = cA1 + (size_t)(t + 1) * kstep;
            const char* a2 = last ? nA0 : cA0 + (size_t)(t + 2) * kstep; const char* a2h = last ? nA1 : cA1 + (size_t)(t + 2) * kstep; const char* b2 = last ? nB : cB + (size_t)(t + 2) * kstep;
            const char* a3 = a2 + kstep; const char* b3 = b2 + kstep;
            PG8_LDB(B0, 0, 0); PG8_LDB(B1, 0, 1); PG8_SCHED; PG8_LDA(At, 0, 0); PG8_STAGE(PG8_SA(1, 1), a1, vA1);
            if (last && has_next) PG8_FILL(nxt);
            PG8_WAIT_V(8); PG8_WAIT_L(0); PG8_BAR; PG8_MMA(0, 0, At, B0); PG8_MMA(0, 1, At, B1); PG8_BAR; PG8_SCHED;
            PG8_LDA(At, 0, 1); PG8_STAGE(PG8_SB(0, 0), b2, voffB); PG8_STAGE(PG8_SB(0, 1), b2 + hstep, voffB); PG8_STAGE(PG8_SA(0, 0), a2, vA0);
            PG8_WAIT_V(8); PG8_WAIT_L(0); PG8_BAR; PG8_MMA(1, 0, At, B0); PG8_MMA(1, 1, At, B1); PG8_BAR; PG8_SCHED;
            PG8_LDB(B0, 1, 0); PG8_LDB(B1, 1, 1); PG8_SCHED; PG8_LDA(At, 1, 0); PG8_STAGE(PG8_SA(0, 1), a2h, vA1);
            PG8_WAIT_V(8); PG8_WAIT_L(0); PG8_BAR; PG8_MMA(0, 0, At, B0); PG8_MMA(0, 1, At, B1); PG8_BAR; PG8_SCHED;
            PG8_LDA(At, 1, 1); PG8_STAGE(PG8_SB(1, 0), b3, voffB); PG8_STAGE(PG8_SB(1, 1), b3 + hstep, voffB); PG8_STAGE(PG8_SA(1, 0), a3, vA0);
            PG8_WAIT_V(8); PG8_WAIT_L(0); PG8_BAR; PG8_MMA(1, 0, At, B0); PG8_MMA(1, 1, At, B1); PG8_BAR; PG8_SCHED;
        }
        if constexpr (ALIGN_EPI) { if (wr == 0) PG8_BAR; }
        E(acc, cur, wr, wc, fr, fq);
        if (!has_next) break;
#pragma unroll
        for (int a = 0; a < 2; ++a)
#pragma unroll
            for (int b = 0; b < 2; ++b)
#pragma unroll
                for (int m = 0; m < 4; ++m)
#pragma unroll
                    for (int n = 0; n < 2; ++n) acc[a][b][m][n] = (f32x4){0.f, 0.f, 0.f, 0.f};
        cur = nxt; cB = nB; cA0 = nA0; cA1 = nA1; ++ui;
        if constexpr (ALIGN_EPI) { if (wr == 1) PG8_BAR; }
    }
    PG8_WAIT_V(0);
    if constexpr (!ALIGN_EPI) { if (wr == 0) PG8_BAR; }
    PG8_BAR;
#undef PG8_FILL
#undef PG8_SA
#undef PG8_SB
#undef PG8_STAGE
#undef PG8_LDA
#undef PG8_LDB
#undef PG8_MMA
#undef PG8_WAIT_V
#undef PG8_WAIT_L
#undef PG8_BAR
#undef PG8_SCHED
}
}

struct Args { const float* in[23]; float* out; unsigned char* ws; int ph_lo, ph_hi; };
enum { PH_PRO = 0, PH_IN0, PH_MIX0, PH_OUT0, PH_R1, PH_GU0, PH_DN0, PH_R2, PH_IN1, PH_MIX1, PH_OUT1, PH_R3, PH_GU1, PH_DN1, PH_R4, NPH };

struct Frame {
    LAS unsigned char* lds; int tid, lane, wave, vcu, G;
    const float* const* in; float* out; unsigned char* ws;
};

__device__ __forceinline__ void transpose_item(const float* W, int K, int N, const float* kscale, bf16_t* WT, int dest_row0, LAS float* scr, int kb, int nb, int lane) {
    const int k0 = 64 * kb, n0 = 32 * nb;
#pragma unroll 8
    for (int i = 0; i < 32; ++i) { const int kk = 2 * i + (lane >> 5); float v = W[(size_t)(k0 + kk) * N + n0 + (lane & 31)]; if (kscale) v *= kscale[k0 + kk]; scr[kk * 33 + (lane & 31)] = v; }
    LDS_WAIT(); asm volatile("" ::: "memory");
    const int c = lane & 7;
#pragma unroll
    for (int j = 0; j < 4; ++j) { const int n = (lane >> 3) + 8 * j; const LAS float* s = scr + (8 * c) * 33 + n;
        u32x4 o; o.x = pk2(s[0 * 33], s[1 * 33]); o.y = pk2(s[2 * 33], s[3 * 33]); o.z = pk2(s[4 * 33], s[5 * 33]); o.w = pk2(s[6 * 33], s[7 * 33]);
        *(u32x4*)(WT + (size_t)(dest_row0 + n) * K + k0 + 8 * c) = o; }
    LDS_WAIT(); asm volatile("" ::: "memory");
}
__device__ __forceinline__ void moe_convert(Frame& F, int layer) {
    LAS float* scr = (LAS float*)(F.lds + F.wave * 16384);
    const int gw = F.vcu * 8 + F.wave, NGW = F.G * 8;
    const float* gffn = F.in[2] + layer * D;
    const float* Wg = F.in[20] + (size_t)layer * NEXP * D * DEXP; const float* Wu = F.in[21] + (size_t)layer * NEXP * D * DEXP; const float* Wd = F.in[22] + (size_t)layer * NEXP * DEXP * D;
    bf16_t* WGU = (bf16_t*)(F.ws + WS_WGU); bf16_t* WDN = (bf16_t*)(F.ws + WS_WDN);
    for (int it = gw; it < 3 * 8192; it += NGW) {
        const int which = it >> 13, r = it & 8191, e = r >> 8, q = r & 255;
        if (which < 2) { const int kb = q >> 4, nb = q & 15, n0 = nb * 32;
            const int dest = e * 1024 + (n0 >> 7) * 256 + (which ? 128 : 0) + (n0 & 127);
            transpose_item((which ? Wu : Wg) + (size_t)e * D * DEXP, D, DEXP, gffn, WGU, dest, scr, kb, nb, F.lane);
        } else { const int kb = q >> 5, nb = q & 31;
            transpose_item(Wd + (size_t)e * DEXP * D, DEXP, D, nullptr, WDN, e * 1024 + nb * 32, scr, kb, nb, F.lane); }
    }
}
__device__ __forceinline__ void p_prologue(Frame& F) {
    LAS float* scr = (LAS float*)(F.lds + F.wave * 16384);
    const int gw = F.vcu * 8 + F.wave, NGW = F.G * 8;
    constexpr int I0 = 16 * 80, I1 = 16 * 32, I2 = 16 * 128, I3 = 16 * 32;
    for (int it = gw; it < I0 + I1 + I2 + I3; it += NGW) {
        int r = it;
        if (r < I0) { transpose_item(F.in[4], D, AB_IN, F.in[1], (bf16_t*)(F.ws + WS_WIN0), (r % 80) * 32, scr, r / 80, r % 80, F.lane); continue; } r -= I0;
        if (r < I1) { transpose_item(F.in[13], D, D, nullptr, (bf16_t*)(F.ws + WS_WOUT0), (r % 32) * 32, scr, r / 32, r % 32, F.lane); continue; } r -= I1;
        if (r < I2) { transpose_item(F.in[14], D, C_IN, F.in[1] + D, (bf16_t*)(F.ws + WS_WIN1), (r % 128) * 32, scr, r / 128, r % 128, F.lane); continue; } r -= I2;
        transpose_item(F.in[17], D, D, nullptr, (bf16_t*)(F.ws + WS_WOUT1), (r % 32) * 32, scr, r / 32, r % 32, F.lane);
    }
    moe_convert(F, 0);
    { const float* x = F.in[0]; bf16_t* XB = (bf16_t*)(F.ws + WS_XB); float* rstd = (float*)(F.ws + WS_RSTD);
      for (int m = gw; m < T; m += NGW) { const f32x4* xr = (const f32x4*)(x + (size_t)m * D) + F.lane; f32x4 v[4]; float s = 0.f;
#pragma unroll
          for (int j = 0; j < 4; ++j) { v[j] = xr[64 * j]; s += (v[j].x * v[j].x + v[j].y * v[j].y) + (v[j].z * v[j].z + v[j].w * v[j].w); }
          s = wave_sum(s); if (F.lane == 0) rstd[m] = rsqrtf(s * (1.f / D) + EPS);
          u32x2* o8 = (u32x2*)(XB + (size_t)m * D) + F.lane;
#pragma unroll
          for (int j = 0; j < 4; ++j) o8[64 * j] = (u32x2){pk2(v[j].x, v[j].y), pk2(v[j].z, v[j].w)}; } }
    const int gt = F.vcu * 512 + F.tid, NGT = F.G * 512;
    { float* lb = (float*)(F.ws + WS_LB); const float* l = F.in[15];
      for (int c = gt; c < 1024; c += NGT) { const float a = l[c], b = l[1024 + c], mx = fmaxf(a, b), ea = __expf(a - mx), eb = __expf(b - mx); lb[c] = ea / (ea + eb); } }
    { float* RgT = (float*)(F.ws + WS_RGT); float* ReT = (float*)(F.ws + WS_RET);
      for (int i = gt; i < 2 * 36 * 1024; i += NGT) { const int l = i / (36 * 1024), r = i % (36 * 1024), j = r >> 10, c = r & 1023; const float g = F.in[2][l * D + c];
          if (j < 4) RgT[(l * 4 + j) * 1024 + c] = g * F.in[18][((size_t)l * D + c) * 4 + j];
          else ReT[(l * 32 + (j - 4)) * 1024 + c] = g * F.in[19][((size_t)l * D + c) * 32 + (j - 4)]; } }
}

__device__ __forceinline__ void moe_tables(Frame& F, int layer) {
    LAS int* ts = (LAS int*)(F.lds + TS_OFF); LAS int* cn = ts + 40;
    const unsigned* cnt = (const unsigned*)(F.ws + WS_CTL) + CW_CNT + layer * 32;
    __syncthreads();
    if (F.tid < 32) cn[F.tid] = (int)__hip_atomic_load(cnt + F.tid, __ATOMIC_RELAXED, __HIP_MEMORY_SCOPE_AGENT);
    __syncthreads();
    if (F.tid == 0) { int s = 0; for (int e = 0; e < 32; ++e) { ts[e] = s; s += (cn[e] + 255) >> 8; } ts[32] = s; }
    __syncthreads();
}

__device__ __forceinline__ void p_router(Frame& F, int layer) {
    const int gw = F.vcu * 8 + F.wave, NGW = F.G * 8;
    const float* H = F.out; const float* RgT = (const float*)(F.ws + WS_RGT) + layer * 4 * 1024; const float* ReT = (const float*)(F.ws + WS_RET) + layer * 32 * 1024;
    unsigned* cnt = (unsigned*)(F.ws + WS_CTL) + CW_CNT + layer * 32;
    int* ltok = (int*)(F.ws + WS_LTOK); float* lrstd = (float*)(F.ws + WS_LRSTD); float* lw = (float*)(F.ws + WS_LW); int* tokinfo = (int*)(F.ws + WS_TOKINFO);
    for (int m = gw; m < T; m += NGW) {
        const f32x4* hr = (const f32x4*)(H + (size_t)m * D) + F.lane; f32x4 v[4]; float s = 0.f;
#pragma unroll
        for (int j = 0; j < 4; ++j) { v[j] = hr[64 * j]; s += (v[j].x * v[j].x + v[j].y * v[j].y) + (v[j].z * v[j].z + v[j].w * v[j].w); }
        const float rstd = rsqrtf(wave_sum(s) * (1.f / D) + EPS);
        float lg[4];
#pragma unroll
        for (int gi = 0; gi < 4; ++gi) { const f32x4* w = (const f32x4*)(RgT + gi * 1024) + F.lane; float a = 0.f;
#pragma unroll
            for (int j = 0; j < 4; ++j) { const f32x4 ww = w[64 * j]; a += (v[j].x * ww.x + v[j].y * ww.y) + (v[j].z * ww.z + v[j].w * ww.w); }
            lg[gi] = wave_sum(a) * rstd; }
        int gidx = 0; float gmax = lg[0];
#pragma unroll
        for (int gi = 1; gi < 4; ++gi) if (lg[gi] > gmax) { gmax = lg[gi]; gidx = gi; }
        float gs = 0.f;
#pragma unroll
        for (int gi = 0; gi < 4; ++gi) gs += __expf(lg[gi] - gmax);
        const float ggate = 1.f / gs;
        gidx = __builtin_amdgcn_readfirstlane(gidx);
        float le[8];
#pragma unroll
        for (int e = 0; e < 8; ++e) { const f32x4* w = (const f32x4*)(ReT + (gidx * 8 + e) * 1024) + F.lane; float a = 0.f;
#pragma unroll
            for (int j = 0; j < 4; ++j) { const f32x4 ww = w[64 * j]; a += (v[j].x * ww.x + v[j].y * ww.y) + (v[j].z * ww.z + v[j].w * ww.w); }
            le[e] = wave_sum(a) * rstd; }
        int i0 = 0; float v0 = le[0];
#pragma unroll
        for (int e = 1; e < 8; ++e) if (le[e] > v0) { v0 = le[e]; i0 = e; }
        int i1 = -1; float v1 = -3.0e38f;
#pragma unroll
        for (int e = 0; e < 8; ++e) if (e != i0 && le[e] > v1) { v1 = le[e]; i1 = e; }
        const float ex = __expf(v1 - v0), w0 = ggate / (1.f + ex), w1 = ggate * ex / (1.f + ex);
        if (F.lane == 0) {
            ((float*)(F.ws + WS_RSTD))[m] = rstd;
            const int e0 = gidx * 8 + i0, e1 = gidx * 8 + i1;
            const unsigned p0 = atomicAdd(cnt + e0, 1u), p1 = atomicAdd(cnt + e1, 1u);
            ltok[(size_t)e0 * CAP + p0] = m; lrstd[(size_t)e0 * CAP + p0] = rstd; lw[(size_t)e0 * CAP + p0] = w0;
            ltok[(size_t)e1 * CAP + p1] = m; lrstd[(size_t)e1 * CAP + p1] = rstd; lw[(size_t)e1 * CAP + p1] = w1;
            tokinfo[2 * m] = e0 * CAP + (int)p0; tokinfo[2 * m + 1] = e1 * CAP + (int)p1;
        }
    }
}
__device__ __forceinline__ void p_combine(Frame& F, int layer, int mode) {
    moe_tables(F, layer);
    const LAS int* ts = (const LAS int*)(F.lds + TS_OFF);
    const int gw = F.vcu * 8 + F.wave, NGW = F.G * 8;
    float* H = F.out; const bf16_t* Y = (const bf16_t*)(F.ws + WS_Y); const int* tokinfo = (const int*)(F.ws + WS_TOKINFO);
    bf16_t* XB = (bf16_t*)(F.ws + WS_XB); float* rstd = (float*)(F.ws + WS_RSTD); const float* gfin = F.in[3];
    for (int m = gw; m < T; m += NGW) {
        const int t0 = tokinfo[2 * m], t1 = tokinfo[2 * m + 1];
        const size_t s0 = (size_t)ts[t0 >> 15] * 256 + (t0 & (CAP - 1)), s1 = (size_t)ts[t1 >> 15] * 256 + (t1 & (CAP - 1));
        f32x4* hr = (f32x4*)(H + (size_t)m * D) + F.lane; const u32x2* y0 = (const u32x2*)(Y + s0 * D) + F.lane; const u32x2* y1 = (const u32x2*)(Y + s1 * D) + F.lane;
        f32x4 v[4]; float s = 0.f;
#pragma unroll
        for (int j = 0; j < 4; ++j) { v[j] = hr[64 * j]; const u32x2 a = y0[64 * j], b = y1[64 * j];
            v[j].x += bf2f(a.x & 0xffffu) + bf2f(b.x & 0xffffu); v[j].y += bf2f(a.x >> 16) + bf2f(b.x >> 16); v[j].z += bf2f(a.y & 0xffffu) + bf2f(b.y & 0xffffu); v[j].w += bf2f(a.y >> 16) + bf2f(b.y >> 16);
            s += (v[j].x * v[j].x + v[j].y * v[j].y) + (v[j].z * v[j].z + v[j].w * v[j].w); }
        const float rs = rsqrtf(wave_sum(s) * (1.f / D) + EPS);
        if (mode == 0) {
            if (F.lane == 0) rstd[m] = rs;
            u32x2* o8 = (u32x2*)(XB + (size_t)m * D) + F.lane;
#pragma unroll
            for (int j = 0; j < 4; ++j) { hr[64 * j] = v[j]; o8[64 * j] = (u32x2){pk2(v[j].x, v[j].y), pk2(v[j].z, v[j].w)}; }
        } else {
            const f32x4* g4 = (const f32x4*)gfin + F.lane;
#pragma unroll
            for (int j = 0; j < 4; ++j) { const f32x4 g = g4[64 * j]; hr[64 * j] = (f32x4){v[j].x * rs * g.x, v[j].y * rs * g.y, v[j].z * rs * g.z, v[j].w * rs * g.w}; }
        }
    }
}

__device__ __forceinline__ void mix_rglru_item(Frame& F, int b, int nb) {
    LAS float* L = (LAS float*)F.lds;
    LAS float* wa = L; LAS float* wx = L + 4096; LAS float* xat = L + 8192;   LAS float* xc = xat + 67 * 64; LAS float* ga = xc + 4096; LAS float* av = ga + 4096; LAS float* uv = av + 4096; LAS float* prm = uv + 4096;
    const bf16_t* Z = (const bf16_t*)(F.ws + WS_Z); bf16_t* CAT = (bf16_t*)(F.ws + WS_CAT);
    const int tid = F.tid;
    __syncthreads();
    for (int i = tid; i < 4096; i += 512) { wa[i] = F.in[7][nb * 4096 + i]; wx[i] = F.in[9][nb * 4096 + i]; }
    if (tid < 64) { const int c = nb * 64 + tid; prm[tid] = F.in[6][c]; prm[64 + tid] = F.in[5][c]; prm[128 + tid] = F.in[5][512 + c]; prm[192 + tid] = F.in[5][1024 + c]; prm[256 + tid] = F.in[5][1536 + c];
        prm[320 + tid] = F.in[8][c]; prm[384 + tid] = F.in[10][c]; const float lam = F.in[11][c]; prm[448 + tid] = fminf(lam, 0.f) - log1pf(__expf(-fabsf(lam))); }
    float hcar = 0.f;
    for (int t0 = 0; t0 < SEQ; t0 += 64) {
        __syncthreads();
        for (int i = tid; i < 67 * 64; i += 512) { const int r = i >> 6, c = i & 63, tg = t0 - 3 + r; xat[i] = tg >= 0 ? bf2f(Z[((size_t)b * SEQ + tg) * AB_IN + nb * 64 + c]) : 0.f; }
        for (int i = tid; i < 4096; i += 512) { const int r = i >> 6, c = i & 63; ga[i] = bf2f(Z[((size_t)b * SEQ + t0 + r) * AB_IN + 512 + nb * 64 + c]); }
        __syncthreads();
        for (int i = tid; i < 4096; i += 512) { const int r = i >> 6, c = i & 63; xc[i] = prm[c] + prm[64 + c] * xat[r * 64 + c] + prm[128 + c] * xat[(r + 1) * 64 + c] + prm[192 + c] * xat[(r + 2) * 64 + c] + prm[256 + c] * xat[(r + 3) * 64 + c]; }
        __syncthreads();
        { const int tok = tid >> 3, dg = tid & 7; float aa[8], ax[8];
#pragma unroll
          for (int j = 0; j < 8; ++j) { aa[j] = 0.f; ax[j] = 0.f; }
          for (int c = 0; c < 64; ++c) { const float xv = xc[tok * 64 + c]; const LAS f32x4* pa = (const LAS f32x4*)(wa + c * 64 + dg * 8); const LAS f32x4* px = (const LAS f32x4*)(wx + c * 64 + dg * 8);
              const f32x4 a0 = pa[0], a1 = pa[1], x0 = px[0], x1 = px[1];
              aa[0] += xv * a0.x; aa[1] += xv * a0.y; aa[2] += xv * a0.z; aa[3] += xv * a0.w; aa[4] += xv * a1.x; aa[5] += xv * a1.y; aa[6] += xv * a1.z; aa[7] += xv * a1.w;
              ax[0] += xv * x0.x; ax[1] += xv * x0.y; ax[2] += xv * x0.z; ax[3] += xv * x0.w; ax[4] += xv * x1.x; ax[5] += xv * x1.y; ax[6] += xv * x1.z; ax[7] += xv * x1.w; }
#pragma unroll
          for (int j = 0; j < 8; ++j) { const int d = dg * 8 + j; const float r = sigmoidf_(aa[j] + prm[320 + d]), ig = sigmoidf_(ax[j] + prm[384 + d]);
              const float la = 8.0f * r * prm[448 + d]; av[tok * 64 + d] = __expf(la); uv[tok * 64 + d] = sqrtf(fmaxf(-expm1f(2.0f * la), 0.f)) * (ig * xc[tok * 64 + d]); } }
        __syncthreads();
        if (tid < 64) { for (int r = 0; r < 64; ++r) { hcar = av[r * 64 + tid] * hcar + uv[r * 64 + tid]; av[r * 64 + tid] = hcar; } }
        __syncthreads();
        for (int i = tid; i < 4096; i += 512) { const int r = i >> 6, c = i & 63; CAT[((size_t)b * SEQ + t0 + r) * D + nb * 64 + c] = (bf16_t)f2bf(av[i] * gelu_tanh(ga[i])); }
    }
    __syncthreads();
}
__device__ __forceinline__ void mix_attn_item(Frame& F, int b, int c, int h) {
    LAS float* Ks = (LAS float*)F.lds;   LAS float* Vs = Ks + 64 * 68;   LAS float* bs = Vs + 4096;   LAS float* Ss = bs + 520;
    const bf16_t* Z = (const bf16_t*)(F.ws + WS_Z); bf16_t* CAT = (bf16_t*)(F.ws + WS_CAT);
    const int tid = F.tid, t = tid >> 3, sub = tid & 7;
    __syncthreads();
    for (int i = tid; i < 513; i += 512) bs[i] = F.in[12][h * 513 + i];
    unsigned q2[32]; float o[64];
    { const unsigned* qp = (const unsigned*)(Z + ((size_t)b * SEQ + c * 64 + t) * AB_IN + 1024 + h * 64);
#pragma unroll
      for (int d = 0; d < 32; ++d) q2[d] = qp[d];
#pragma unroll
      for (int d = 0; d < 64; ++d) o[d] = 0.f; }
    float mrun = -3.0e38f, lrun = 0.f;
    for (int kc = (c >= 8 ? c - 8 : 0); kc <= c; ++kc) {
        __syncthreads();
        for (int i = tid; i < 4096; i += 512) { const int s = i >> 6, d = i & 63; const size_t base = ((size_t)b * SEQ + kc * 64 + s) * AB_IN + h * 64 + d;
            Ks[s * 68 + d] = bf2f(Z[base + 1536]); Vs[s * 64 + d] = bf2f(Z[base + 2048]); }
        __syncthreads();
        float tmax = -3.0e38f;
#pragma unroll 1
        for (int jj = 0; jj < 8; ++jj) { const int s = sub + 8 * jj; const LAS f32x4* kp = (const LAS f32x4*)(Ks + s * 68); float a = 0.f;
#pragma unroll
            for (int d4 = 0; d4 < 16; ++d4) { const f32x4 kv = kp[d4]; a += bf2f(q2[2 * d4] & 0xffffu) * kv.x + bf2f(q2[2 * d4] >> 16) * kv.y + bf2f(q2[2 * d4 + 1] & 0xffffu) * kv.z + bf2f(q2[2 * d4 + 1] >> 16) * kv.w; }
            a *= 0.125f;
            int rel = t - ((kc - c) * 64 + s); rel = rel < -256 ? -256 : (rel > 256 ? 256 : rel);
            a += bs[rel + 256]; Ss[t * 65 + s] = a; tmax = fmaxf(tmax, a); }
        const float mnew = fmaxf(mrun, tmax), f = __expf(mrun - mnew);
        lrun *= f;
#pragma unroll
        for (int d = 0; d < 64; ++d) o[d] *= f;
#pragma unroll 1
        for (int jj = 0; jj < 8; ++jj) { const int s = sub + 8 * jj; const float p = __expf(Ss[t * 65 + s] - mnew); lrun += p; const LAS f32x4* vp = (const LAS f32x4*)(Vs + s * 64);
#pragma unroll
            for (int d4 = 0; d4 < 16; ++d4) { const f32x4 vv = vp[d4]; o[4 * d4] += p * vv.x; o[4 * d4 + 1] += p * vv.y; o[4 * d4 + 2] += p * vv.z; o[4 * d4 + 3] += p * vv.w; } }
        mrun = mnew;
    }
    float mall = mrun;
    mall = fmaxf(mall, __shfl_xor(mall, 1)); mall = fmaxf(mall, __shfl_xor(mall, 2)); mall = fmaxf(mall, __shfl_xor(mall, 4));
    const float f = __expf(mrun - mall); lrun *= f;
    lrun += __shfl_xor(lrun, 1); lrun += __shfl_xor(lrun, 2); lrun += __shfl_xor(lrun, 4);
    const float inv = 1.0f / lrun;
    bf16_t* op = CAT + ((size_t)b * SEQ + c * 64 + t) * D + 512 + h * 64;
#pragma unroll
    for (int d = 0; d < 64; ++d) { float v = o[d] * f; v += __shfl_xor(v, 1); v += __shfl_xor(v, 2); v += __shfl_xor(v, 4); if ((d >> 3) == sub) op[d] = (bf16_t)f2bf(v * inv); }
}

typedef float f32x16 __attribute__((ext_vector_type(16)));
typedef short s16x4 __attribute__((ext_vector_type(4)));
__device__ __forceinline__ s16x4 ds_tr16(const LAS unsigned char* p) { return __builtin_bit_cast(s16x4, __builtin_amdgcn_ds_read_tr16_b64_v4i16((LAS s16x4*)p)); }
constexpr int ATT_BT_BYTES = 8 * 520 * 4;
__device__ __forceinline__ void attn_load_bias(Frame& F) {
    LAS float* bt = (LAS float*)F.lds;
    __syncthreads();
    for (int i = F.tid; i < 8 * 513; i += 512) { const int h = i / 513, j = i % 513; bt[h * 520 + j] = F.in[12][i] * 1.4426950408889634f; }
    __syncthreads();
}
__device__ __forceinline__ void attn_wave_mfma(Frame& F, int b, int c, int h) {
    const bf16_t* Z = (const bf16_t*)(F.ws + WS_Z); bf16_t* CAT = (bf16_t*)(F.ws + WS_CAT);
    const int l = F.lane, r = l & 31, hh = l >> 5;
    const LAS float* btab = (const LAS float*)F.lds + h * 520;
    LAS unsigned char* Vw = F.lds + ATT_BT_BYTES + F.wave * 8192;
    const float SC = 0.125f * 1.4426950408889634f;
    bf16x8 qf[2][4];
    { const bf16_t* Qb = Z + ((size_t)b * SEQ + c * 64) * AB_IN + 1024 + h * 64;
#pragma unroll
      for (int qb = 0; qb < 2; ++qb)
#pragma unroll
          for (int ks = 0; ks < 4; ++ks) qf[qb][ks] = *(const bf16x8*)(Qb + (size_t)(qb * 32 + r) * AB_IN + ks * 16 + hh * 8); }
    f32x16 o[2][2];
#pragma unroll
    for (int a = 0; a < 2; ++a)
#pragma unroll
        for (int d = 0; d < 2; ++d)
#pragma unroll
            for (int i = 0; i < 16; ++i) o[a][d][i] = 0.f;
    float mrun[2] = {-1.0e30f, -1.0e30f}, lsum[2] = {0.f, 0.f};
    const int q4 = (l & 15) >> 2, p4 = l & 3, cb = (l >> 4) & 1, xs = (q4 >> 1) & 1;
    const LAS unsigned char* vbase = Vw + (4 * hh + q4) * 128 + p4 * 8 + cb * 32;
    const LAS unsigned char* vb[2] = {vbase + xs * 64, vbase + (1 - xs) * 64};
    for (int kc = (c >= 8 ? c - 8 : 0); kc <= c; ++kc) {
        const bf16_t* Kb = Z + ((size_t)b * SEQ + kc * 64) * AB_IN + 1536 + h * 64; const bf16_t* Vb = Kb + 512;
        { u32x4 vr[8];
#pragma unroll
          for (int i = 0; i < 8; ++i) vr[i] = *(const u32x4*)(Vb + (size_t)(i * 8 + (l >> 3)) * AB_IN + (l & 7) * 8);
#pragma unroll
          for (int i = 0; i < 8; ++i) { const int s = i * 8 + (l >> 3), ci = l & 7, pb = (ci >> 1) ^ (((s >> 1) & 1) << 1); *(LAS u32x4*)(Vw + s * 128 + pb * 32 + (ci & 1) * 16) = vr[i]; } }
        asm volatile("" ::: "memory");
        bf16x8 kf[2][4];
#pragma unroll
        for (int sb = 0; sb < 2; ++sb)
#pragma unroll
            for (int ks = 0; ks < 4; ++ks) kf[sb][ks] = *(const bf16x8*)(Kb + (size_t)(sb * 32 + r) * AB_IN + ks * 16 + hh * 8);
        const int dt = (c - kc) * 64;
#pragma unroll
        for (int qb = 0; qb < 2; ++qb) {
            f32x16 st[2];
#pragma unroll
            for (int sb = 0; sb < 2; ++sb) {
#pragma unroll
                for (int i = 0; i < 16; ++i) st[sb][i] = 0.f;
#pragma unroll
                for (int ks = 0; ks < 4; ++ks) st[sb] = __builtin_amdgcn_mfma_f32_32x32x16_bf16(kf[sb][ks], qf[qb][ks], st[sb], 0, 0, 0); }
            if (dt >= 320) { const float bc = btab[512];
#pragma unroll
                for (int sb = 0; sb < 2; ++sb)
#pragma unroll
                    for (int i = 0; i < 16; ++i) st[sb][i] = st[sb][i] * SC + bc;
            } else { const int base = dt + qb * 32 + r - 4 * hh + 256;
#pragma unroll
                for (int sb = 0; sb < 2; ++sb)
#pragma unroll
                    for (int i = 0; i < 16; ++i) { int idx = base - sb * 32 - ((i & 3) + 8 * (i >> 2)); idx = idx > 512 ? 512 : idx; st[sb][i] = st[sb][i] * SC + btab[idx]; } }
            float mx = st[0][0];
#pragma unroll
            for (int sb = 0; sb < 2; ++sb)
#pragma unroll
                for (int i = 0; i < 16; ++i) mx = fmaxf(mx, st[sb][i]);
            mx = fmaxf(mx, __shfl_xor(mx, 32));
            const float mn = fmaxf(mrun[qb], mx), alpha = __builtin_amdgcn_exp2f(mrun[qb] - mn); mrun[qb] = mn;
            float rs = 0.f;
#pragma unroll
            for (int sb = 0; sb < 2; ++sb)
#pragma unroll
                for (int i = 0; i < 16; ++i) { const float pv = __builtin_amdgcn_exp2f(st[sb][i] - mn); st[sb][i] = pv; rs += pv; }
            rs += __shfl_xor(rs, 32); lsum[qb] = lsum[qb] * alpha + rs;
#pragma unroll
            for (int d = 0; d < 2; ++d)
#pragma unroll
                for (int i = 0; i < 16; ++i) o[qb][d][i] *= alpha;
            bf16x8 pf[4];
#pragma unroll
            for (int kk = 0; kk < 4; ++kk) { const int sb = kk >> 1, s2 = kk & 1; u32x4 w;
                w.x = cvt_pk_bf16(st[sb][8 * s2 + 0], st[sb][8 * s2 + 1]); w.y = cvt_pk_bf16(st[sb][8 * s2 + 2], st[sb][8 * s2 + 3]);
                w.z = cvt_pk_bf16(st[sb][8 * s2 + 4], st[sb][8 * s2 + 5]); w.w = cvt_pk_bf16(st[sb][8 * s2 + 6], st[sb][8 * s2 + 7]); pf[kk] = __builtin_bit_cast(bf16x8, w); }
#pragma unroll
            for (int d = 0; d < 2; ++d)
#pragma unroll
                for (int kk = 0; kk < 4; ++kk) { const int rowoff = ((kk >> 1) * 32 + 16 * (kk & 1)) * 128;
                    const s16x4 lo = ds_tr16(vb[d] + rowoff), hi = ds_tr16(vb[d] + rowoff + 8 * 128);
                    const bf16x8 vf = (bf16x8){lo[0], lo[1], lo[2], lo[3], hi[0], hi[1], hi[2], hi[3]};
                    o[qb][d] = __builtin_amdgcn_mfma_f32_32x32x16_bf16(vf, pf[kk], o[qb][d], 0, 0, 0); }
        }
    }
#pragma unroll
    for (int qb = 0; qb < 2; ++qb) { const float inv = 1.0f / lsum[qb]; bf16_t* op = CAT + ((size_t)b * SEQ + c * 64 + qb * 32 + r) * D + 512 + h * 64 + 4 * hh;
#pragma unroll
        for (int d = 0; d < 2; ++d)
#pragma unroll
            for (int g = 0; g < 4; ++g) { u32x2 w; w.x = cvt_pk_bf16(o[qb][d][4 * g] * inv, o[qb][d][4 * g + 1] * inv); w.y = cvt_pk_bf16(o[qb][d][4 * g + 2] * inv, o[qb][d][4 * g + 3] * inv);
                *(u32x2*)(op + d * 32 + 8 * g) = w; } }
}

constexpr int RG_XA = 0, RG_GA0 = 8704, RG_GA1 = RG_GA0 + 8192, RG_XCB = RG_GA1 + 8192, RG_WA = RG_XCB + 9216, RG_WX = RG_WA + 9216, RG_AV = RG_WX + 9216, RG_UV = RG_AV + 16384, RG_SA = RG_UV + 16384, RG_SH = RG_SA + 2048, RG_END = RG_SH + 2048;
static_assert(RG_END <= RING_BYTES, "rglru lds");
__device__ __forceinline__ float gelu_fast(float x) { const float u = 1.5957691216057308f * (x + 0.044715f * x * x * x); return x / (1.0f + __expf(-u)); }
__device__ __forceinline__ void rglru_item(Frame& F, int b, int nb) {
    const bf16_t* Z = (const bf16_t*)(F.ws + WS_Z); bf16_t* CAT = (bf16_t*)(F.ws + WS_CAT);
    LAS unsigned char* L = F.lds;
    LAS float* AV = (LAS float*)(L + RG_AV); LAS float* UV = (LAS float*)(L + RG_UV); LAS float* SA = (LAS float*)(L + RG_SA); LAS float* SH = (LAS float*)(L + RG_SH);
    const int tid = F.tid, l = F.lane, w = F.wave, i16 = l & 15, q4 = l >> 4;
    __syncthreads();
    for (int i = tid; i < 4096; i += 512) { const int c = i >> 6, d = i & 63;
        *(LAS bf16_t*)(L + RG_WA + d * 144 + c * 2) = (bf16_t)f2bf(F.in[7][nb * 4096 + i]); *(LAS bf16_t*)(L + RG_WX + d * 144 + c * 2) = (bf16_t)f2bf(F.in[9][nb * 4096 + i]); }
    const int ct = tid >> 3, ch8 = tid & 7;
    float cw[4][8], cbv[8];
#pragma unroll
    for (int j = 0; j < 8; ++j) { const int ch = nb * 64 + 8 * ch8 + j; cbv[j] = F.in[6][ch];
#pragma unroll
        for (int k = 0; k < 4; ++k) cw[k][j] = F.in[5][k * 512 + ch]; }
    const int tb = w >> 1;
    float bav[2], bxv[2], lsv[2];
#pragma unroll
    for (int cc = 0; cc < 2; ++cc) { const int d = nb * 64 + 16 * ((w & 1) * 2 + cc) + i16; bav[cc] = F.in[8][d]; bxv[cc] = F.in[10][d]; const float lam = F.in[11][d]; lsv[cc] = 8.0f * (fminf(lam, 0.f) - log1pf(__expf(-fabsf(lam)))); }
    const int sc = tid & 63, sseg = tid >> 6;
    float carry = 0.f;
    const size_t rowb = (size_t)b * SEQ;
    u32x4 px0, px1, pg;
    const u32x4 zero4 = (u32x4){0u, 0u, 0u, 0u};
#define RG_LOAD(t0_) do { { const int r = tid >> 3, tg = (t0_) - 3 + r; px0 = tg >= 0 ? *(const u32x4*)(Z + (rowb + tg) * AB_IN + nb * 64 + (tid & 7) * 8) : zero4; } \
        if (tid < 24) { const int r = 64 + (tid >> 3), tg = (t0_) - 3 + r; px1 = *(const u32x4*)(Z + (rowb + tg) * AB_IN + nb * 64 + (tid & 7) * 8); } \
        pg = *(const u32x4*)(Z + (rowb + (t0_) + (tid >> 3)) * AB_IN + 512 + nb * 64 + (tid & 7) * 8); } while (0)
    RG_LOAD(0);
#pragma unroll 1
    for (int tile = 0; tile < 32; ++tile) {
        const int t0 = tile * 64; LAS unsigned char* GA = L + ((tile & 1) ? RG_GA1 : RG_GA0);
        *(LAS u32x4*)(L + RG_XA + tid * 16) = px0; if (tid < 24) *(LAS u32x4*)(L + RG_XA + (512 + tid) * 16) = px1;
        *(LAS u32x4*)(GA + tid * 16) = pg;
        __syncthreads();
        if (tile < 31) RG_LOAD(t0 + 64);
        { float xc[8];
#pragma unroll
          for (int j = 0; j < 8; ++j) xc[j] = cbv[j];
#pragma unroll
          for (int k = 0; k < 4; ++k) { const u32x4 xv = *(const LAS u32x4*)(L + RG_XA + (ct + k) * 128 + ch8 * 16); const unsigned xa[4] = {xv.x, xv.y, xv.z, xv.w};
#pragma unroll
              for (int j = 0; j < 8; ++j) xc[j] += cw[k][j] * bf2f((j & 1) ? (xa[j >> 1] >> 16) : (xa[j >> 1] & 0xffffu)); }
          *(LAS u32x4*)(L + RG_XCB + ct * 144 + ch8 * 16) = (u32x4){cvt_pk_bf16(xc[0], xc[1]), cvt_pk_bf16(xc[2], xc[3]), cvt_pk_bf16(xc[4], xc[5]), cvt_pk_bf16(xc[6], xc[7])}; }
        __syncthreads();
#pragma unroll
        for (int cc = 0; cc < 2; ++cc) { const int db = (w & 1) * 2 + cc; f32x4 aA = (f32x4){0.f, 0.f, 0.f, 0.f}, aX = aA;
#pragma unroll
            for (int ks = 0; ks < 2; ++ks) { const bf16x8 a = *(const LAS bf16x8*)(L + RG_XCB + (16 * tb + i16) * 144 + (32 * ks + 8 * q4) * 2);
                const bf16x8 ba = *(const LAS bf16x8*)(L + RG_WA + (16 * db + i16) * 144 + (32 * ks + 8 * q4) * 2), bx = *(const LAS bf16x8*)(L + RG_WX + (16 * db + i16) * 144 + (32 * ks + 8 * q4) * 2);
                aA = MFMA16(a, ba, aA); aX = MFMA16(a, bx, aX); }
#pragma unroll
            for (int rg = 0; rg < 4; ++rg) { const int t = 16 * tb + 4 * q4 + rg, d = 16 * db + i16; const float xcv = bf2f(*(const LAS bf16_t*)(L + RG_XCB + t * 144 + d * 2));
                const float r = sigmoidf_(aA[rg] + bav[cc]), ig = sigmoidf_(aX[rg] + bxv[cc]), la = r * lsv[cc];
                AV[t * 64 + d] = __expf(la); UV[t * 64 + d] = sqrtf(fmaxf(1.0f - __expf(2.0f * la), 0.f)) * (ig * xcv); } }
        __syncthreads();
        float aj[8], uj[8];
        { float A = 1.f, H = 0.f;
#pragma unroll
          for (int j = 0; j < 8; ++j) { aj[j] = AV[(8 * sseg + j) * 64 + sc]; uj[j] = UV[(8 * sseg + j) * 64 + sc]; H = aj[j] * H + uj[j]; A *= aj[j]; }
          SA[sseg * 64 + sc] = A; SH[sseg * 64 + sc] = H; }
        __syncthreads();
        { float run = carry, hin = carry;
#pragma unroll
          for (int sg = 0; sg < 8; ++sg) { if (sg == sseg) hin = run; run = SA[sg * 64 + sc] * run + SH[sg * 64 + sc]; }
          carry = run; float hv = hin;
#pragma unroll
          for (int j = 0; j < 8; ++j) { hv = aj[j] * hv + uj[j]; const int t = 8 * sseg + j; const float g = bf2f(*(const LAS bf16_t*)(GA + t * 128 + sc * 2));
              CAT[(rowb + t0 + t) * D + nb * 64 + sc] = (bf16_t)f2bf(hv * gelu_fast(g)); } }
    }
#undef RG_LOAD
    __syncthreads();
}
__device__ __forceinline__ void p_mix0(Frame& F) {
    const int j = F.vcu;
    if (j >= 128 && j < 256) rglru_item(F, (j - 128) >> 3, (j - 128) & 7);
    attn_load_bias(F);
    if (j < 256) {
#pragma unroll 1
        for (int rep = 0; rep < 2; ++rep) attn_wave_mfma(F, j & 15, rep == 0 ? 16 + (j >> 4) : 15 - (j >> 4), F.wave);
    }
    __syncthreads();
}
__device__ __forceinline__ void mix_hgrn_item(Frame& F, int b, int h) {
    LAS float* L = (LAS float*)F.lds;
    LAS float* qs = L; LAS float* fs = L + 4096; LAS float* is = L + 8192; LAS float* gs = L + 12288; LAS float* op = L + 16384;
    const bf16_t* Z = (const bf16_t*)(F.ws + WS_Z); bf16_t* CAT = (bf16_t*)(F.ws + WS_CAT); const float* lb = (const float*)(F.ws + WS_LB); const float* ng = F.in[16];
    const int tid = F.tid, v = tid & 127, kq = tid >> 7;
    float S[32];
#pragma unroll
    for (int k = 0; k < 32; ++k) S[k] = 0.f;
    for (int t0 = 0; t0 < SEQ; t0 += 32) {
        __syncthreads();
        for (int i = tid; i < 4096; i += 512) { const int r = i >> 7, c = i & 127; const bf16_t* zr = Z + ((size_t)b * SEQ + t0 + r) * C_IN + h * 128 + c;
            qs[i] = bf2f(zr[0]); const float l = lb[h * 128 + c]; fs[i] = l + (1.f - l) * sigmoidf_(bf2f(zr[1024])); is[i] = bf2f(zr[2048]); gs[i] = bf2f(zr[3072]); }
        __syncthreads();
        for (int r = 0; r < 32; ++r) { const float iv = is[r * 128 + v]; float o = 0.f;
#pragma unroll
            for (int k4 = 0; k4 < 8; ++k4) { const f32x4 f4 = *(const LAS f32x4*)(fs + r * 128 + kq * 32 + 4 * k4), q4 = *(const LAS f32x4*)(qs + r * 128 + kq * 32 + 4 * k4);
                S[4 * k4] = f4.x * S[4 * k4] + (1.f - f4.x) * iv; o += q4.x * S[4 * k4];
                S[4 * k4 + 1] = f4.y * S[4 * k4 + 1] + (1.f - f4.y) * iv; o += q4.y * S[4 * k4 + 1];
                S[4 * k4 + 2] = f4.z * S[4 * k4 + 2] + (1.f - f4.z) * iv; o += q4.z * S[4 * k4 + 2];
                S[4 * k4 + 3] = f4.w * S[4 * k4 + 3] + (1.f - f4.w) * iv; o += q4.w * S[4 * k4 + 3]; }
            op[(r * 4 + kq) * 128 + v] = o; }
        __syncthreads();
#pragma unroll
        for (int rr = 0; rr < 4; ++rr) { const int r = F.wave * 4 + rr; const int l = F.lane;
            const float o1 = op[(r * 4 + 0) * 128 + l] + op[(r * 4 + 1) * 128 + l] + op[(r * 4 + 2) * 128 + l] + op[(r * 4 + 3) * 128 + l];
            const float o2 = op[(r * 4 + 0) * 128 + 64 + l] + op[(r * 4 + 1) * 128 + 64 + l] + op[(r * 4 + 2) * 128 + 64 + l] + op[(r * 4 + 3) * 128 + 64 + l];
            const float rinv = rsqrtf(wave_sum(o1 * o1 + o2 * o2) * (1.f / 128.f) + EPS);
            bf16_t* cp = CAT + ((size_t)b * SEQ + t0 + r) * D + h * 128;
            cp[l] = (bf16_t)f2bf(o1 * rinv * ng[h * 128 + l] * gs[r * 128 + l]); cp[64 + l] = (bf16_t)f2bf(o2 * rinv * ng[h * 128 + 64 + l] * gs[r * 128 + 64 + l]); }
    }
    __syncthreads();
}


constexpr int HG_STR = 272;
constexpr int HG_LF = 0, HG_QH = 16384, HG_KK = 32768;
constexpr int HG_QE = 49152, HG_KN = HG_QE + 32 * HG_STR, HG_KS = HG_KN + 32 * HG_STR, HG_V0 = HG_KS + 32 * HG_STR, HG_V1 = HG_V0 + 32 * HG_STR, HG_G0 = HG_V1 + 32 * HG_STR, HG_G1 = HG_G0 + 32 * HG_STR;
constexpr int HG_AT = HG_G1 + 32 * HG_STR, HG_EB = HG_AT + 2560, HG_SEG = HG_EB + 512, HG_SSQ = HG_SEG + 2048, HG_END = HG_SSQ + 1024;
static_assert(HG_END <= RING_BYTES, "hgrn lds");
__device__ __forceinline__ void hgrn_item(Frame& F, int b, int h) {
    const bf16_t* Z = (const bf16_t*)(F.ws + WS_Z); bf16_t* CAT = (bf16_t*)(F.ws + WS_CAT); const float* lbp = (const float*)(F.ws + WS_LB); const float* ngp = F.in[16];
    LAS unsigned char* L = F.lds;
    LAS float* LF = (LAS float*)(L + HG_LF); LAS float* QH = (LAS float*)(L + HG_QH); LAS float* KK = (LAS float*)(L + HG_KK);
    LAS float* EB = (LAS float*)(L + HG_EB); LAS float* SEG = (LAS float*)(L + HG_SEG); LAS float* SSQ = (LAS float*)(L + HG_SSQ);
    LAS bf16_t* AT = (LAS bf16_t*)(L + HG_AT);
    const int tid = F.tid, l = F.lane, w = F.wave;
    const int lt = tid >> 4, lkc = tid & 15, sk = tid & 127, sseg = tid >> 7, i16 = l & 15, q4 = l >> 4, qq = i16 >> 2, pp = i16 & 3;
    float lbv[8];
#pragma unroll
    for (int j = 0; j < 8; ++j) lbv[j] = lbp[h * 128 + 8 * lkc + j];
    float ngv[4];
#pragma unroll
    for (int j = 0; j < 4; ++j) ngv[j] = ngp[h * 128 + 16 * w + 4 * q4 + j];
    f32x4 S[8];
#pragma unroll
    for (int i = 0; i < 8; ++i) S[i] = (f32x4){0.f, 0.f, 0.f, 0.f};
    __syncthreads();
    for (int i = tid; i < 640; i += 512) ((LAS unsigned*)(L + HG_AT))[i] = 0u;
    const bf16_t* zrow0 = Z + ((size_t)b * SEQ + lt) * C_IN + h * 128 + 8 * lkc;
    u32x4 pq = *(const u32x4*)(zrow0), pf = *(const u32x4*)(zrow0 + 1024), pv = *(const u32x4*)(zrow0 + 2048), pg = *(const u32x4*)(zrow0 + 3072);
#pragma unroll 1
    for (int st = 0; st < 64; ++st) {
        const int par = st & 1;
        LAS unsigned char* Vb = L + (par ? HG_V1 : HG_V0); LAS unsigned char* Gb = L + (par ? HG_G1 : HG_G0);
        { const unsigned qa[4] = {pq.x, pq.y, pq.z, pq.w}, fa[4] = {pf.x, pf.y, pf.z, pf.w};
          float lf[8], kk[8], qh[8];
#pragma unroll
          for (int j = 0; j < 8; ++j) { const float fz = bf2f((j & 1) ? (fa[j >> 1] >> 16) : (fa[j >> 1] & 0xffffu)); qh[j] = bf2f((j & 1) ? (qa[j >> 1] >> 16) : (qa[j >> 1] & 0xffffu));
              const float f = lbv[j] + (1.f - lbv[j]) * sigmoidf_(fz); lf[j] = __logf(f); kk[j] = 1.f - f; }
          LAS f32x4* d0 = (LAS f32x4*)(LF + lt * 128 + 8 * lkc); d0[0] = (f32x4){lf[0], lf[1], lf[2], lf[3]}; d0[1] = (f32x4){lf[4], lf[5], lf[6], lf[7]};
          LAS f32x4* d1 = (LAS f32x4*)(QH + lt * 128 + 8 * lkc); d1[0] = (f32x4){qh[0], qh[1], qh[2], qh[3]}; d1[1] = (f32x4){qh[4], qh[5], qh[6], qh[7]};
          LAS f32x4* d2 = (LAS f32x4*)(KK + lt * 128 + 8 * lkc); d2[0] = (f32x4){kk[0], kk[1], kk[2], kk[3]}; d2[1] = (f32x4){kk[4], kk[5], kk[6], kk[7]};
          *(LAS u32x4*)(Vb + lt * HG_STR + lkc * 16) = pv; *(LAS u32x4*)(Gb + lt * HG_STR + lkc * 16) = pg; }
        if (st < 63) { const bf16_t* zr = zrow0 + (size_t)(st + 1) * 32 * C_IN; pq = *(const u32x4*)(zr); pf = *(const u32x4*)(zr + 1024); pv = *(const u32x4*)(zr + 2048); pg = *(const u32x4*)(zr + 3072); }
        __syncthreads();
        float bl[8];
        { float a = 0.f;
#pragma unroll
          for (int j = 0; j < 8; ++j) { a += LF[(8 * sseg + j) * 128 + sk]; bl[j] = a; } }
        SEG[sseg * 128 + sk] = bl[7];
        __syncthreads();
        { const float s0 = SEG[sk], s1 = SEG[128 + sk], s2 = SEG[256 + sk], s3 = SEG[384 + sk];
          const float pre = (sseg > 0 ? s0 : 0.f) + (sseg > 1 ? s1 : 0.f) + (sseg > 2 ? s2 : 0.f), Bt = (s0 + s1) + (s2 + s3);
#pragma unroll
          for (int j = 0; j < 8; ++j) { const int t = 8 * sseg + j; const float bb = pre + bl[j];
              const float e1 = __expf(bb), e2 = __expf(fminf(-bb, 80.f)), e3 = __expf(Bt - bb), qh = QH[t * 128 + sk], kk = KK[t * 128 + sk];
              *(LAS bf16_t*)(L + HG_QE + t * HG_STR + sk * 2) = (bf16_t)f2bf(qh * e1);
              *(LAS bf16_t*)(L + HG_KN + t * HG_STR + sk * 2) = (bf16_t)f2bf(kk * e2);
              *(LAS bf16_t*)(L + HG_KS + t * HG_STR + sk * 2) = (bf16_t)f2bf(kk * e3); }
          if (sseg == 0) EB[sk] = __expf(Bt); }
        __syncthreads();
        if (w < 3) { const int tb = w ? 1 : 0, sb = (w == 2) ? 1 : 0; f32x4 acc = (f32x4){0.f, 0.f, 0.f, 0.f};
#pragma unroll
            for (int ks = 0; ks < 4; ++ks) { const bf16x8 a = *(const LAS bf16x8*)(L + HG_QE + (16 * tb + i16) * HG_STR + (32 * ks + 8 * q4) * 2), bq = *(const LAS bf16x8*)(L + HG_KN + (16 * sb + i16) * HG_STR + (32 * ks + 8 * q4) * 2);
                acc = MFMA16(a, bq, acc); }
#pragma unroll
            for (int rg = 0; rg < 4; ++rg) { const int t = 16 * tb + 4 * q4 + rg, sx = 16 * sb + i16; AT[t * 40 + sx] = (bf16_t)f2bf(sx <= t ? acc[rg] : 0.f); } }
        __syncthreads();
        bf16x8 vfr;
        { const s16x4 lo = ds_tr16(Vb + (8 * q4 + qq) * HG_STR + (16 * w + 4 * pp) * 2), hi = ds_tr16(Vb + (8 * q4 + 4 + qq) * HG_STR + (16 * w + 4 * pp) * 2);
          vfr = (bf16x8){lo[0], lo[1], lo[2], lo[3], hi[0], hi[1], hi[2], hi[3]}; }
        f32x4 O[2];
#pragma unroll
        for (int tb = 0; tb < 2; ++tb) { const bf16x8 at = *(const LAS bf16x8*)(L + HG_AT + (16 * tb + i16) * 80 + 16 * q4); O[tb] = MFMA16(vfr, at, ((f32x4){0.f, 0.f, 0.f, 0.f})); }
#pragma unroll
        for (int m = 0; m < 4; ++m) { u32x4 sp; sp.x = cvt_pk_bf16(S[2 * m][0], S[2 * m][1]); sp.y = cvt_pk_bf16(S[2 * m][2], S[2 * m][3]); sp.z = cvt_pk_bf16(S[2 * m + 1][0], S[2 * m + 1][1]); sp.w = cvt_pk_bf16(S[2 * m + 1][2], S[2 * m + 1][3]);
            const bf16x8 spk = __builtin_bit_cast(bf16x8, sp);
#pragma unroll
            for (int tb = 0; tb < 2; ++tb) { const u32x2 q0 = *(const LAS u32x2*)(L + HG_QE + (16 * tb + i16) * HG_STR + (32 * m + 4 * q4) * 2), q1 = *(const LAS u32x2*)(L + HG_QE + (16 * tb + i16) * HG_STR + (32 * m + 16 + 4 * q4) * 2);
                const u32x4 qv = (u32x4){q0.x, q0.y, q1.x, q1.y}; O[tb] = MFMA16(spk, __builtin_bit_cast(bf16x8, qv), O[tb]); } }
#pragma unroll
        for (int kb = 0; kb < 8; ++kb) { const s16x4 lo = ds_tr16(L + HG_KS + (8 * q4 + qq) * HG_STR + (16 * kb + 4 * pp) * 2), hi = ds_tr16(L + HG_KS + (8 * q4 + 4 + qq) * HG_STR + (16 * kb + 4 * pp) * 2);
            const bf16x8 kfr = (bf16x8){lo[0], lo[1], lo[2], lo[3], hi[0], hi[1], hi[2], hi[3]}; const f32x4 dec = *(const LAS f32x4*)(EB + 16 * kb + 4 * q4);
            S[kb] = MFMA16(kfr, vfr, S[kb] * dec); }
#pragma unroll
        for (int tb = 0; tb < 2; ++tb) { float ss = (O[tb][0] * O[tb][0] + O[tb][1] * O[tb][1]) + (O[tb][2] * O[tb][2] + O[tb][3] * O[tb][3]); ss += __shfl_xor(ss, 16); ss += __shfl_xor(ss, 32);
            if (q4 == 0) SSQ[(16 * tb + i16) * 8 + w] = ss; }
        __syncthreads();
#pragma unroll
        for (int tb = 0; tb < 2; ++tb) { const int t = 16 * tb + i16; const f32x4 a = *(const LAS f32x4*)(SSQ + t * 8), c = *(const LAS f32x4*)(SSQ + t * 8 + 4);
            const float rinv = rsqrtf(((a.x + a.y) + (a.z + a.w) + (c.x + c.y) + (c.z + c.w)) * (1.f / 128.f) + EPS);
            const u32x2 g2 = *(const LAS u32x2*)(Gb + t * HG_STR + (16 * w + 4 * q4) * 2);
            const float o0 = O[tb][0] * rinv * ngv[0] * bf2f(g2.x & 0xffffu), o1 = O[tb][1] * rinv * ngv[1] * bf2f(g2.x >> 16), o2 = O[tb][2] * rinv * ngv[2] * bf2f(g2.y & 0xffffu), o3 = O[tb][3] * rinv * ngv[3] * bf2f(g2.y >> 16);
            *(u32x2*)(CAT + ((size_t)b * SEQ + st * 32 + t) * D + h * 128 + 16 * w + 4 * q4) = (u32x2){cvt_pk_bf16(o0, o1), cvt_pk_bf16(o2, o3)}; }
    }
    __syncthreads();
}
__device__ __forceinline__ void p_gu(Frame& F, int layer) {
    unsigned char* ws = F.ws;
    moe_tables(F, layer);
    const LAS int* ts = (const LAS int*)(F.lds + TS_OFF); LAS unsigned* tab = (LAS unsigned*)(F.lds + TAB_OFF);
    pg8::MoeOrder<true> S{ts, tab, F.G, F.vcu, D};
    { const int* ltok = (const int*)(ws + WS_LTOK); pg8::Unit u;
      for (int i = 0; i < 6 && S.next(i, u); ++i) if (F.tid < 256) { const int pos = u.rl * 256 + F.tid; const int tok = pos < ts[40 + u.e] ? ltok[(size_t)u.e * CAP + pos] : 0; tab[i * 256 + F.tid] = (unsigned)tok * (unsigned)(D * 2); }
      __syncthreads(); }
    pg8::EpiGU E{(bf16_t*)(ws + WS_HB), (const float*)(ws + WS_LRSTD), ts + 40};
    pg8::gemm_phase<pg8::EpiGU, pg8::MoeOrder<true>, true>(F.lds, (const bf16_t*)(ws + WS_XB), (const bf16_t*)(ws + WS_WGU), D, S, E);
}
__device__ __forceinline__ void p_dn(Frame& F, int layer) {
    unsigned char* ws = F.ws;
    moe_tables(F, layer);
    const LAS int* ts = (const LAS int*)(F.lds + TS_OFF);
    pg8::MoeOrder<false> S{ts, nullptr, F.G, F.vcu, DEXP};
    pg8::EpiDN E{(bf16_t*)(ws + WS_Y), (const float*)(ws + WS_LW), ts + 40};
    pg8::gemm_phase<pg8::EpiDN, pg8::MoeOrder<false>, true>(F.lds, (const bf16_t*)(ws + WS_HB), (const bf16_t*)(ws + WS_WDN), DEXP, S, E);
}

__global__ void __launch_bounds__(512, 2) fwd(Args args) {
    extern __shared__ __attribute__((aligned(16))) unsigned char lds_raw[];
    Frame F;
    F.lds = (LAS unsigned char*)lds_raw; F.tid = threadIdx.x; F.lane = F.tid & 63; F.wave = __builtin_amdgcn_readfirstlane(F.tid >> 6);
    F.G = gridDim.x; { const int bx = blockIdx.x; F.vcu = (F.G % 8 == 0) ? (bx % 8) * (F.G / 8) + bx / 8 : bx; }
    F.in = args.in; F.out = args.out; F.ws = args.ws;
    unsigned char* ws = args.ws;
    bf16_t* XB = (bf16_t*)(ws + WS_XB); bf16_t* CAT = (bf16_t*)(ws + WS_CAT); bf16_t* Z = (bf16_t*)(ws + WS_Z);
    float* RSTD = (float*)(ws + WS_RSTD);
#if MK_ONE_LAUNCH
    cg::grid_group grid = cg::this_grid();
#define GRID_BAR() grid.sync()
#else
#define GRID_BAR() do {} while (0)
#endif
    #ifndef PH_MASK
#define PH_MASK 0x7fff
#endif
#define PHE(p) ((PH_MASK >> (p)) & 1)
    const int lo = args.ph_lo, hi = args.ph_hi;
#define IN(k) (PHE(k) && lo <= (k) && (k) < hi)
#define SEAM(k) do { if (lo <= (k) && (k) + 1 < hi) GRID_BAR(); } while (0)
    if (IN(PH_PRO)) { p_prologue(F); } SEAM(PH_PRO);
    if (IN(PH_IN0)) { pg8::DenseOrder S; S.init(T, AB_IN, D, F.G, (int)blockIdx.x); pg8::EpiIn E{Z, AB_IN, RSTD, 0, 1 << 30};
        pg8::gemm_phase<pg8::EpiIn, pg8::DenseOrder, true>(F.lds, XB, (const bf16_t*)(ws + WS_WIN0), D, S, E); } SEAM(PH_IN0);
    if (IN(PH_MIX0)) { p_mix0(F); } SEAM(PH_MIX0);
    if (IN(PH_OUT0)) { pg8::DenseOrder S; S.init(T, D, D, F.G, (int)blockIdx.x); pg8::EpiOut E{args.in[0], args.out, XB};
        pg8::gemm_phase<pg8::EpiOut, pg8::DenseOrder, true>(F.lds, CAT, (const bf16_t*)(ws + WS_WOUT0), D, S, E); } SEAM(PH_OUT0);
    if (IN(PH_R1)) { p_router(F, 0); } SEAM(PH_R1);
    if (IN(PH_GU0)) { p_gu(F, 0); } SEAM(PH_GU0);
    if (IN(PH_DN0)) { p_dn(F, 0); } SEAM(PH_DN0);
    if (IN(PH_R2)) { p_combine(F, 0, 0); moe_convert(F, 1); } SEAM(PH_R2);
    if (IN(PH_IN1)) { pg8::DenseOrder S; S.init(T, C_IN, D, F.G, (int)blockIdx.x); pg8::EpiIn E{Z, C_IN, RSTD, 1024, 3072};
        pg8::gemm_phase<pg8::EpiIn, pg8::DenseOrder, true>(F.lds, XB, (const bf16_t*)(ws + WS_WIN1), D, S, E); } SEAM(PH_IN1);
    if (IN(PH_MIX1)) { if (F.vcu < 128) hgrn_item(F, F.vcu >> 3, F.vcu & 7); } SEAM(PH_MIX1);
    if (IN(PH_OUT1)) { pg8::DenseOrder S; S.init(T, D, D, F.G, (int)blockIdx.x); pg8::EpiOut E{args.out, args.out, XB};
        pg8::gemm_phase<pg8::EpiOut, pg8::DenseOrder, true>(F.lds, CAT, (const bf16_t*)(ws + WS_WOUT1), D, S, E); } SEAM(PH_OUT1);
    if (IN(PH_R3)) { p_router(F, 1); } SEAM(PH_R3);
    if (IN(PH_GU1)) { p_gu(F, 1); } SEAM(PH_GU1);
    if (IN(PH_DN1)) { p_dn(F, 1); } SEAM(PH_DN1);
    if (IN(PH_R4)) { p_combine(F, 1, 1); }
}

extern "C" void kernel_launch(void* const* d_in, const int* in_sizes, int n_in, void* d_out, int out_size, void* d_ws, size_t ws_size, hipStream_t stream) {
    static int grid = 0;
    if (grid == 0) {
        if (n_in != 23 || out_size != T * D || ws_size < WS_END) { fprintf(stderr, "kernel_launch: unexpected shapes: n_in %d out %d ws %zu (need %zu)\n", n_in, out_size, ws_size, (size_t)WS_END); grid = -1; return; }
        if (hipFuncSetAttribute((const void*)fwd, hipFuncAttributeMaxDynamicSharedMemorySize, LDS_BYTES) != hipSuccess) { fprintf(stderr, "kernel_launch: hipFuncSetAttribute failed\n"); grid = -1; return; }
        int dev = 0, cus = 0, per_cu = 0;
        hipGetDevice(&dev); hipDeviceGetAttribute(&cus, hipDeviceAttributeMultiprocessorCount, dev);
        hipOccupancyMaxActiveBlocksPerMultiprocessor(&per_cu, (const void*)fwd, 512, LDS_BYTES);
        (void)hipGetLastError();
        fprintf(stderr, "kernel_launch: cus %d per_cu %d ws %zu\n", cus, per_cu, ws_size);
        grid = cus > 0 ? cus : 256;
        if (per_cu < 1) fprintf(stderr, "kernel_launch: occupancy query says %d blocks per CU\n", per_cu);
    }
    if (grid < 0) return;
    hipMemsetAsync((char*)d_ws + WS_CTL, 0, CTL_BYTES, stream);
    Args a{};
    for (int i = 0; i < 23; ++i) a.in[i] = (const float*)d_in[i];
    a.out = (float*)d_out; a.ws = (unsigned char*)d_ws;
#if MK_ONE_LAUNCH
    a.ph_lo = 0; a.ph_hi = NPH;
    void* kargs[] = {&a};
    hipError_t e = hipLaunchCooperativeKernel((const void*)fwd, dim3(grid), dim3(512), kargs, LDS_BYTES, stream);
    if (e != hipSuccess) fprintf(stderr, "cooperative launch failed: %s (grid %d)\n", hipGetErrorString(e), grid);
#else
    for (int ph = 0; ph < NPH; ++ph) { a.ph_lo = ph; a.ph_hi = ph + 1; hipLaunchKernelGGL(fwd, dim3(grid), dim3(512), LDS_BYTES, stream, a); }
#endif
}
```

```cpp
#include <hip/hip_runtime.h>
#include <hip/hip_cooperative_groups.h>
#include <cstdio>
#include <cstdint>
namespace cg = cooperative_groups;

#ifndef MK_ONE_LAUNCH
#define MK_ONE_LAUNCH 1
#endif

constexpr int T = 32768, D = 1024, SEQ = 2048, NB = 16;
constexpr int AB_IN = 2560, C_IN = 4096;
constexpr int NEXP = 32, DEXP = 512, CAP = 32768;
constexpr int MAXTILES = 288;
constexpr float EPS = 1e-6f;

#define LAS __attribute__((address_space(3)))
typedef unsigned short bf16_t;
typedef short bf16x8 __attribute__((ext_vector_type(8)));
typedef float f32x4 __attribute__((ext_vector_type(4)));
typedef unsigned u32x4 __attribute__((ext_vector_type(4)));
typedef unsigned u32x2 __attribute__((ext_vector_type(2)));

constexpr size_t MiB = 1u << 20;
constexpr size_t WS_CTL = 0, CTL_BYTES = 1 * MiB;
constexpr size_t WS_RSTD = 1 * MiB;
constexpr size_t WS_LB = WS_RSTD + 128 * 1024;
constexpr size_t WS_RGT = WS_LB + 4096;
constexpr size_t WS_RET = WS_RGT + 2 * 4 * 1024 * 4;
constexpr size_t WS_TOKINFO = 2 * MiB;
constexpr size_t WS_LTOK = 3 * MiB, WS_LRSTD = 7 * MiB, WS_LW = 11 * MiB;
constexpr size_t WS_WIN0 = 16 * MiB, WS_WOUT0 = 21 * MiB, WS_WIN1 = 23 * MiB, WS_WOUT1 = 31 * MiB;
constexpr size_t WS_WGU = 34 * MiB, WS_WDN = 98 * MiB;
constexpr size_t WS_XB = 130 * MiB, WS_CAT = 194 * MiB;
constexpr size_t WS_Z = 258 * MiB;
constexpr size_t WS_HB = 258 * MiB, WS_Y = 330 * MiB;
constexpr size_t WS_END = 514 * MiB;
constexpr int CW_CNT = 64;
constexpr int CW_BAR = 4096;

constexpr int RING_BYTES = 131072;
constexpr int TAB_OFF = RING_BYTES;
constexpr int TS_OFF = TAB_OFF + 6 * 1024;
constexpr int MISC_OFF = TS_OFF + 512;
constexpr int LDS_BYTES = 147456;

__device__ __forceinline__ unsigned f2bf(float f) { unsigned u = __float_as_uint(f); return (u + 0x7fffu + ((u >> 16) & 1u)) >> 16; }
__device__ __forceinline__ float bf2f(unsigned b) { return __uint_as_float(b << 16); }
__device__ __forceinline__ unsigned pk2(float lo, float hi) { return f2bf(lo) | (f2bf(hi) << 16); }
__device__ __forceinline__ unsigned cvt_pk_bf16(float lo, float hi) { unsigned r; asm volatile("v_cvt_pk_bf16_f32 %0, %1, %2" : "=v"(r) : "v"(lo), "v"(hi)); return r; }
__device__ __forceinline__ float wave_sum(float v) {
#pragma unroll
    for (int o = 1; o < 64; o <<= 1) v += __shfl_xor(v, o);
    return v;
}
__device__ __forceinline__ float sigmoidf_(float x) { return 1.0f / (1.0f + __expf(-x)); }
__device__ __forceinline__ float siluf_(float x) { return x / (1.0f + __expf(-x)); }
__device__ __forceinline__ float gelu_tanh(float x) { const float u = 0.7978845608028654f * (x + 0.044715f * x * x * x); return 0.5f * x * (1.0f + tanhf(u)); }
#define LDS_WAIT() asm volatile("s_waitcnt lgkmcnt(0)" ::: "memory")
#define MFMA16(a, b, c) __builtin_amdgcn_mfma_f32_16x16x32_bf16((a), (b), (c), 0, 0, 0)

namespace pg8 {
constexpr int BM = 256, BK = 64, HALF = 128, HTB = HALF * BK * 2, NXCD = 8, WGM = 8;
__host__ __device__ __forceinline__ int lds_byte(int r, int c) { const int st = (r >> 4) * 2 + (c >> 5), rr = r & 15, cc = c & 31, ob = rr * 64 + cc * 2; return st * 1024 + (ob ^ (((ob >> 9) & 1) << 5)); }
__host__ __device__ __forceinline__ void stage_rc(int b, int& R, int& C) { const int st = b / 1024, sb = b % 1024, swz = sb ^ (((sb >> 9) & 1) << 5); R = (st >> 1) * 16 + swz / 64; C = (st & 1) * 32 + (swz % 64) / 2; }
__host__ __device__ __forceinline__ int perm32(int rho) { const int n = rho >> 4, i = rho & 15; return 8 * (i >> 2) + 4 * n + (i & 3); }

struct Unit { unsigned boff; int arow, orow, ocol, e, rl, slot; };

struct DenseOrder {
    int nM, nN, nwg, G, c, K;
    __device__ void init(int M, int N, int K_, int G_, int c_) { nM = M / BM; nN = N / BM; nwg = nM * nN; G = G_; c = c_; K = K_; }
    __device__ __forceinline__ bool next(int i, Unit& u) const {
        const long L = (long)i * G + c; if (L >= nwg) return false;
        int wgid = (int)L; { const int q = nwg / NXCD, r = nwg % NXCD, xcd = wgid % NXCD, off = wgid / NXCD; wgid = (xcd < r ? xcd * (q + 1) : r * (q + 1) + (xcd - r) * q) + off; }
        const int nig = WGM * nN, gid = wgid / nig, fm = gid * WGM, gsz = (nM - fm) < WGM ? (nM - fm) : WGM;
        const int pm = __builtin_amdgcn_readfirstlane(fm + ((wgid % nig) % gsz)), pn = __builtin_amdgcn_readfirstlane((wgid % nig) / gsz);
        u.arow = pm * BM; u.orow = pm * BM; u.ocol = pn * BM; u.boff = (unsigned)(pn * BM) * (unsigned)K * 2u; u.e = 0; u.rl = 0; u.slot = i; return true;
    }
    static constexpr bool GATHER = false;
    __device__ __forceinline__ size_t abase(const Unit& u) const { return (size_t)u.arow * (size_t)K * 2u; }
    __device__ __forceinline__ unsigned aoff(const Unit&, int) const { return 0u; }
};
template <bool GATHER_> struct MoeOrder {
    static constexpr bool GATHER = GATHER_;
    const LAS int* ts; const LAS unsigned* tab; int G, vcu, K;
    __device__ __forceinline__ bool next(int i, Unit& u) const {
        const int L = i * G + vcu; const int NT = __builtin_amdgcn_readfirstlane(ts[32]); if (L >= NT * 4) return false;
        const int rt = L >> 2, pn = L & 3; int e = 0;
#pragma unroll
        for (int j = 1; j < 32; ++j) e += (ts[j] <= rt) ? 1 : 0;
        e = __builtin_amdgcn_readfirstlane(e);
        u.e = e; u.rl = rt - __builtin_amdgcn_readfirstlane(ts[e]); u.orow = rt * BM; u.arow = rt * BM; u.ocol = pn * BM; u.boff = (unsigned)(e * 1024 + pn * BM) * (unsigned)K * 2u; u.slot = i; return true;
    }
    __device__ __forceinline__ size_t abase(const Unit& u) const { return GATHER ? (size_t)0 : (size_t)u.arow * (size_t)K * 2u; }
    __device__ __forceinline__ unsigned aoff(const Unit& u, int r) const { return tab[u.slot * 256 + r]; }
};

typedef f32x4 Acc[2][2][4][2];

struct EpiIn {
    static constexpr bool PERM = true;
    bf16_t* O; int ldc; const float* rstd; int silu_lo_end, silu_hi_start;
    __device__ __forceinline__ void operator()(const Acc& acc, const Unit& u, int wr, int wc, int fr, int fq) const {
        const bool act = (u.ocol < silu_lo_end) || (u.ocol >= silu_hi_start);
#pragma unroll
        for (int ai = 0; ai < 2; ++ai)
#pragma unroll
            for (int m = 0; m < 4; ++m) {
                const int row = u.orow + ai * HALF + wr * 64 + m * 16 + fr; const float rs = rstd[row];
                bf16_t* rowp = O + (size_t)row * ldc + u.ocol + wc * 32 + 8 * fq;
#pragma unroll
                for (int bj = 0; bj < 2; ++bj) { f32x4 v0 = acc[ai][bj][m][0] * rs, v1 = acc[ai][bj][m][1] * rs;
                    if (act) {
#pragma unroll
                        for (int j = 0; j < 4; ++j) { v0[j] = siluf_(v0[j]); v1[j] = siluf_(v1[j]); } }
                    u32x4 w; w.x = cvt_pk_bf16(v0[0], v0[1]); w.y = cvt_pk_bf16(v0[2], v0[3]); w.z = cvt_pk_bf16(v1[0], v1[1]); w.w = cvt_pk_bf16(v1[2], v1[3]);
                    *(u32x4*)(rowp + bj * HALF) = w; } }
    }
};
struct EpiOut {
    static constexpr bool PERM = true;
    const float* resid; float* H; bf16_t* XB;
    __device__ __forceinline__ void operator()(const Acc& acc, const Unit& u, int wr, int wc, int fr, int fq) const {
#pragma unroll
        for (int ai = 0; ai < 2; ++ai)
#pragma unroll
            for (int m = 0; m < 4; ++m) {
                const int row = u.orow + ai * HALF + wr * 64 + m * 16 + fr; const size_t off = (size_t)row * D + u.ocol + wc * 32 + 8 * fq;
#pragma unroll
                for (int bj = 0; bj < 2; ++bj) { const f32x4 r0 = *(const f32x4*)(resid + off + bj * HALF), r1 = *(const f32x4*)(resid + off + bj * HALF + 4);
                    const f32x4 v0 = acc[ai][bj][m][0] + r0, v1 = acc[ai][bj][m][1] + r1;
                    *(f32x4*)(H + off + bj * HALF) = v0; *(f32x4*)(H + off + bj * HALF + 4) = v1;
                    u32x4 w; w.x = cvt_pk_bf16(v0[0], v0[1]); w.y = cvt_pk_bf16(v0[2], v0[3]); w.z = cvt_pk_bf16(v1[0], v1[1]); w.w = cvt_pk_bf16(v1[2], v1[3]);
                    *(u32x4*)(XB + off + bj * HALF) = w; } }
    }
};
struct EpiGU {
    static constexpr bool PERM = true;
    bf16_t* HB; const float* lrstd; const LAS int* cnt;
    __device__ __forceinline__ void operator()(const Acc& acc, const Unit& u, int wr, int wc, int fr, int fq) const {
        const int n_e = cnt[u.e];
#pragma unroll
        for (int ai = 0; ai < 2; ++ai)
#pragma unroll
            for (int m = 0; m < 4; ++m) {
                const int r = ai * HALF + wr * 64 + m * 16 + fr, pos = u.rl * BM + r; const float rs = pos < n_e ? lrstd[(size_t)u.e * CAP + pos] : 0.f;
                float h[8];
#pragma unroll
                for (int n = 0; n < 2; ++n)
#pragma unroll
                    for (int j = 0; j < 4; ++j) { const float g = acc[ai][0][m][n][j] * rs, uu = acc[ai][1][m][n][j] * rs; h[n * 4 + j] = siluf_(g) * uu; }
                u32x4 w; w.x = cvt_pk_bf16(h[0], h[1]); w.y = cvt_pk_bf16(h[2], h[3]); w.z = cvt_pk_bf16(h[4], h[5]); w.w = cvt_pk_bf16(h[6], h[7]);
                *(u32x4*)(HB + (size_t)(u.orow + r) * DEXP + (u.ocol >> 1) + wc * 32 + 8 * fq) = w; }
    }
};
struct EpiDN {
    static constexpr bool PERM = true;
    bf16_t* Y; const float* lw; const LAS int* cnt;
    __device__ __forceinline__ void operator()(const Acc& acc, const Unit& u, int wr, int wc, int fr, int fq) const {
        const int n_e = cnt[u.e];
#pragma unroll
        for (int ai = 0; ai < 2; ++ai)
#pragma unroll
            for (int m = 0; m < 4; ++m) {
                const int r = ai * HALF + wr * 64 + m * 16 + fr, pos = u.rl * BM + r; const float ws = pos < n_e ? lw[(size_t)u.e * CAP + pos] : 0.f;
                bf16_t* rowp = Y + (size_t)(u.orow + r) * D + u.ocol + wc * 32 + 8 * fq;
#pragma unroll
                for (int bj = 0; bj < 2; ++bj) { const f32x4 v0 = acc[ai][bj][m][0] * ws, v1 = acc[ai][bj][m][1] * ws;
                    u32x4 w; w.x = cvt_pk_bf16(v0[0], v0[1]); w.y = cvt_pk_bf16(v0[2], v0[3]); w.z = cvt_pk_bf16(v1[0], v1[1]); w.w = cvt_pk_bf16(v1[2], v1[3]);
                    *(u32x4*)(rowp + bj * HALF) = w; } }
    }
};

template <class Epi, class Sched, bool ALIGN_EPI>
__device__ __forceinline__ void gemm_phase(LAS unsigned char* lds, const bf16_t* A, const bf16_t* Bt, const int K, const Sched& S, const Epi& E) {
    const int tid = threadIdx.x, wid = __builtin_amdgcn_readfirstlane(tid >> 6), lane = tid & 63, wr = wid >> 2, wc = wid & 3, fr = lane & 15, fq = lane >> 4;
    const int nt = K / BK;
    unsigned voffB[2], vA0[2], vA1[2];
#pragma unroll
    for (int i = 0; i < 2; ++i) { int R, C; stage_rc(tid * 16 + i * 8192, R, C); const int Rb = Epi::PERM ? ((R & ~31) + perm32(R & 31)) : R;
        vA0[i] = (unsigned)(R * K + C) * 2u; vA1[i] = vA0[i]; voffB[i] = (unsigned)(Rb * K + C) * 2u; }
#define PG8_FILL(u) do { if constexpr (Sched::GATHER) { int tv_ = tid; asm volatile("" : "+v"(tv_)); _Pragma("unroll") for (int i = 0; i < 2; ++i) { int R, C; stage_rc(tv_ * 16 + i * 8192, R, C); \
        vA0[i] = S.aoff(u, R) + (unsigned)C * 2u; vA1[i] = S.aoff(u, HALF + R) + (unsigned)C * 2u; } } } while (0)
    const size_t kstep = (size_t)(BK * 2);
    const size_t hstep = (size_t)HALF * K * 2;
    const unsigned ldsw = (unsigned)wid * 1024u;
    const int aoff = lds_byte(wr * 64 + fr, fq * 8), boff = lds_byte(wc * 32 + fr, fq * 8);
#define PG8_SA(b, h) (((b) * 2 + (h)) * HTB)
#define PG8_SB(b, h) ((4 + (b) * 2 + (h)) * HTB)
#define PG8_STAGE(bufoff, gbase, voff) do { _Pragma("unroll") for (int _i = 0; _i < 2; ++_i) \
        __builtin_amdgcn_global_load_lds((const unsigned*)((const char*)(gbase) + (voff)[_i]), (LAS unsigned*)(lds + (bufoff) + ldsw + _i * 8192), 16, 0, 0); } while (0)
#define PG8_LDA(dst, b, h) do { _Pragma("unroll") for (int m = 0; m < 4; ++m) _Pragma("unroll") for (int k = 0; k < 2; ++k) dst[m][k] = *(const LAS bf16x8*)(lds + PG8_SA(b, h) + aoff + m * 2048 + k * 1024); } while (0)
#define PG8_LDB(dst, b, h) do { _Pragma("unroll") for (int n = 0; n < 2; ++n) _Pragma("unroll") for (int k = 0; k < 2; ++k) dst[n][k] = *(const LAS bf16x8*)(lds + PG8_SB(b, h) + boff + n * 2048 + k * 1024); } while (0)
#define PG8_MMA(ai, bj, At, Bt_) do { __builtin_amdgcn_s_setprio(1); _Pragma("unroll") for (int m = 0; m < 4; ++m) _Pragma("unroll") for (int n = 0; n < 2; ++n) _Pragma("unroll") for (int k = 0; k < 2; ++k) \
        acc[ai][bj][m][n] = __builtin_amdgcn_mfma_f32_16x16x32_bf16(Bt_[n][k], At[m][k], acc[ai][bj][m][n], 0, 0, 0); __builtin_amdgcn_s_setprio(0); } while (0)
#define PG8_WAIT_V(n) asm volatile("s_waitcnt vmcnt(" #n ")" ::: "memory")
#define PG8_WAIT_L(n) asm volatile("s_waitcnt lgkmcnt(" #n ")" ::: "memory")
#define PG8_BAR __builtin_amdgcn_s_barrier()
#define PG8_SCHED __builtin_amdgcn_sched_barrier(0)
    Unit cur, nxt; int ui = 0;
    if (!S.next(0, cur)) return;
    f32x4 acc[2][2][4][2];
#pragma unroll
    for (int a = 0; a < 2; ++a)
#pragma unroll
        for (int b = 0; b < 2; ++b)
#pragma unroll
            for (int m = 0; m < 4; ++m)
#pragma unroll
                for (int n = 0; n < 2; ++n) acc[a][b][m][n] = (f32x4){0.f, 0.f, 0.f, 0.f};
    bf16x8 At[4][2], B0[2][2], B1[2][2];
    PG8_FILL(cur);
    const char* cA0 = (const char*)A + S.abase(cur); const char* cA1 = cA0 + (Sched::GATHER ? (size_t)0 : hstep); const char* cB = (const char*)Bt + cur.boff;
    PG8_STAGE(PG8_SB(0, 0), cB, voffB); PG8_STAGE(PG8_SB(0, 1), cB + hstep, voffB); PG8_STAGE(PG8_SA(0, 0), cA0, vA0); PG8_STAGE(PG8_SA(0, 1), cA1, vA1);
    if (wr == 1) PG8_BAR;
    PG8_WAIT_V(2); PG8_BAR;
    PG8_STAGE(PG8_SB(1, 0), cB + kstep, voffB); PG8_STAGE(PG8_SA(1, 0), cA0 + kstep, vA0); PG8_STAGE(PG8_SB(1, 1), cB + hstep + kstep, voffB);
    PG8_WAIT_V(6); PG8_BAR;
    for (;;) {
        const bool has_next = S.next(ui + 1, nxt);
        const char* nB = has_next ? (const char*)Bt + nxt.boff : cB;
        const char* nA0 = has_next ? (const char*)A + S.abase(nxt) : cA0; const char* nA1 = nA0 + (Sched::GATHER ? (size_t)0 : hstep);
        for (int t = 0; t < nt; t += 2) {
            const bool last = (t == nt - 2);
            const char* a1 = cA1 + (size_t)(t + 1) * kstep;
            const char* a2 = last ? nA0 : cA0 + (size_t)(t + 2) * kstep; const char* a2h = last ? nA1 : cA1 + (size_t)(t + 2) * kstep; const char* b2 = last ? nB : cB + (size_t)(t + 2) * kstep;
            const char* a3 = a2 + kstep; const char* b3 = b2 + kstep;
            PG8_LDB(B0, 0, 0); PG8_LDB(B1, 0, 1); PG8_SCHED; PG8_LDA(At, 0, 0); PG8_STAGE(PG8_SA(1, 1), a1, vA1);
            if (last && has_next) PG8_FILL(nxt);
            PG8_WAIT_V(8); PG8_WAIT_L(0); PG8_BAR; PG8_MMA(0, 0, At, B0); PG8_MMA(0, 1, At, B1); PG8_BAR; PG8_SCHED;
            PG8_LDA(At, 0, 1); PG8_STAGE(PG8_SB(0, 0), b2, voffB); PG8_STAGE(PG8_SB(0, 1), b2 + hstep, voffB); PG8_STAGE(PG8_SA(0, 0), a2, vA0);
            PG8_WAIT_V(8); PG8_WAIT_L(0); PG8_BAR; PG8_MMA(1, 0, At, B0); PG8_MMA(1, 1, At, B1); PG8_BAR; PG8_SCHED;
            PG8_LDB(B0, 1, 0); PG8_LDB(B1, 1, 1); PG8_SCHED; PG8_LDA(At, 1, 0); PG8_STAGE(PG8_SA(0, 1), a2h, vA1);
            PG8_WAIT_V(8); PG8_WAIT_L(0); PG8_BAR; PG8_MMA(0, 0, At, B0); PG8_MMA(0, 1, At, B1); PG8_BAR; PG8_SCHED;
            PG8_LDA(At, 1, 1); PG8_STAGE(PG8_SB(1, 0), b3, voffB); PG8_STAGE(PG8_SB(1, 1), b3 + hstep, voffB); PG8_STAGE(PG8_SA(1, 0), a3, vA0);
            PG8_WAIT_V(8); PG8_WAIT_L(0); PG8_BAR; PG8_MMA(1, 0, At, B0); PG8_MMA(1, 1, At, B1); PG8_BAR; PG8_SCHED;
        }
        if constexpr (ALIGN_EPI) { if (wr == 0) PG8_BAR; }
        E(acc, cur, wr, wc, fr, fq);
        if (!has_next) break;
#pragma unroll
        for (int a = 0; a < 2; ++a)
#pragma unroll
            for (int b = 0; b < 2; ++b)
#pragma unroll
                for (int m = 0; m < 4; ++m)
#pragma unroll
                    for (int n = 0; n < 2; ++n) acc[a][b][m][n] = (f32x4){0.f, 0.f, 0.f, 0.f};
        cur = nxt; cB = nB; cA0 = nA0; cA1 = nA1; ++ui;
        if constexpr (ALIGN_EPI) { if (wr == 1) PG8_BAR; }
    }
    PG8_WAIT_V(0);
    if constexpr (!ALIGN_EPI) { if (wr == 0) PG8_BAR; }
    PG8_BAR;
#undef PG8_FILL
#undef PG8_SA
#undef PG8_SB
#undef PG8_STAGE
#undef PG8_LDA
#undef PG8_LDB
#undef PG8_MMA
#undef PG8_WAIT_V
#undef PG8_WAIT_L
#undef PG8_BAR
#undef PG8_SCHED
}
}


#define XB_TMO      128
#define XB_XCNT(j)  (256  + 64 * (j))
#define XB_XSUB(j)  (1280 + 64 * (j))
#define XB_XGEN(j)  (2304 + 64 * (j))
#define XB_TOP      3328
#define XB_TOPGEN   3392
#define XB_SPIN_CAP (1u << 18)
__device__ __forceinline__ unsigned xb_ld(unsigned* p)              { return __hip_atomic_load(p, __ATOMIC_RELAXED, __HIP_MEMORY_SCOPE_AGENT); }
__device__ __forceinline__ unsigned xb_add(unsigned* p, unsigned v) { return __hip_atomic_fetch_add(p, v, __ATOMIC_RELAXED, __HIP_MEMORY_SCOPE_AGENT); }
__device__ __forceinline__ unsigned xb_xcc_id() { return (unsigned)__builtin_amdgcn_s_getreg((3 << 11) | 20) & 0xFu; }
#define XB_SPIN(cond, bar) do { unsigned _sp = 0; while (cond) { __builtin_amdgcn_s_sleep(1); \
    if ((++_sp & 255u) == 0u) { if (xb_ld(&(bar)[XB_TMO])) break; if (_sp > XB_SPIN_CAP) { atomicAdd(&(bar)[XB_TMO], 1u); break; } } } } while (0)
struct XcdBarrier { unsigned* bar; unsigned x; volatile LAS unsigned* st; };
__device__ __forceinline__ XcdBarrier xcd_barrier_post(unsigned* bar, volatile LAS unsigned* st) {
    XcdBarrier b; b.bar = bar; b.x = xb_xcc_id(); b.st = st;
    if (threadIdx.x == 0) (void)xb_add(&bar[XB_XCNT(b.x)], 1u);
    return b;
}
__device__ __forceinline__ void xcd_barrier_complete(unsigned* bar, unsigned x, unsigned& nloc, unsigned& nx) {
    const unsigned G = gridDim.x * gridDim.y * gridDim.z;
    unsigned sum, cnt, mine, sp = 0u;
    for (;;) {
        sum = 0u; cnt = 0u; mine = 0u;
#pragma unroll
        for (unsigned j = 0; j < 16; ++j) { const unsigned c = xb_ld(&bar[XB_XCNT(j)]); sum += c; cnt += (c > 0u) ? 1u : 0u; mine = (j == x) ? c : mine; }
        if (sum == G) break;
        __builtin_amdgcn_s_sleep(1);
        if ((++sp & 255u) == 0u) { if (xb_ld(&bar[XB_TMO])) break; if (sp > XB_SPIN_CAP) { atomicAdd(&bar[XB_TMO], 1u); break; } }
    }
    nloc = mine > 0u ? mine : 1u; nx = cnt > 0u ? cnt : 1u;
}
__device__ __forceinline__ void xcd_barrier(const XcdBarrier& b) {
    asm volatile("s_waitcnt vmcnt(0)" ::: "memory");
    __syncthreads();
    if (threadIdx.x == 0) {
        unsigned* bar = b.bar;
        __builtin_amdgcn_s_waitcnt(0);
        unsigned nloc = b.st[0], nx = b.st[1];
        if (nloc == 0u) { xcd_barrier_complete(bar, b.x, nloc, nx); b.st[0] = nloc; b.st[1] = nx; }
        const unsigned old = xb_add(&bar[XB_XSUB(b.x)], 1u);
        const unsigned gen = old / nloc;
        if (old + 1u == (gen + 1u) * nloc) {
            __builtin_amdgcn_fence(__ATOMIC_RELEASE, "agent");
            asm volatile("s_waitcnt vmcnt(0)" ::: "memory");
            const unsigned og = xb_add(&bar[XB_TOP], 1u);
            const unsigned tg = og / nx;
            if (og + 1u == (tg + 1u) * nx) xb_add(&bar[XB_TOPGEN], 1u);
            else XB_SPIN(xb_ld(&bar[XB_TOPGEN]) == tg, bar);
            __builtin_amdgcn_fence(__ATOMIC_ACQUIRE, "agent");
            xb_add(&bar[XB_XGEN(b.x)], 1u);
            asm volatile("s_waitcnt vmcnt(0)" ::: "memory");
        } else {
            XB_SPIN(xb_ld(&bar[XB_XGEN(b.x)]) == gen, bar);
            __builtin_amdgcn_fence(__ATOMIC_ACQUIRE, "agent");
            asm volatile("s_waitcnt vmcnt(0)" ::: "memory");
        }
    }
    __syncthreads();
}

struct Args { const float* in[23]; float* out; unsigned char* ws; int ph_lo, ph_hi; };
enum { PH_PRO = 0, PH_IN0, PH_MIX0, PH_OUT0, PH_R1, PH_GU0, PH_DN0, PH_R2, PH_IN1, PH_MIX1, PH_OUT1, PH_R3, PH_GU1, PH_DN1, PH_R4, NPH };

struct Frame {
    LAS unsigned char* lds; int tid, lane, wave, vcu, G;
    const float* const* in; float* out; unsigned char* ws;
};

__device__ __forceinline__ void transpose_item(const float* W, int K, int N, const float* kscale, bf16_t* WT, int dest_row0, LAS float* scr, int kb, int nb, int lane) {
    const int k0 = 64 * kb, n0 = 32 * nb;
#pragma unroll 8
    for (int i = 0; i < 32; ++i) { const int kk = 2 * i + (lane >> 5); float v = W[(size_t)(k0 + kk) * N + n0 + (lane & 31)]; if (kscale) v *= kscale[k0 + kk]; scr[kk * 33 + (lane & 31)] = v; }
    LDS_WAIT(); asm volatile("" ::: "memory");
    const int c = lane & 7;
#pragma unroll
    for (int j = 0; j < 4; ++j) { const int n = (lane >> 3) + 8 * j; const LAS float* s = scr + (8 * c) * 33 + n;
        u32x4 o; o.x = pk2(s[0 * 33], s[1 * 33]); o.y = pk2(s[2 * 33], s[3 * 33]); o.z = pk2(s[4 * 33], s[5 * 33]); o.w = pk2(s[6 * 33], s[7 * 33]);
        *(u32x4*)(WT + (size_t)(dest_row0 + n) * K + k0 + 8 * c) = o; }
    LDS_WAIT(); asm volatile("" ::: "memory");
}
__device__ __forceinline__ void moe_convert(Frame& F, int layer) {
    LAS float* scr = (LAS float*)(F.lds + F.wave * 16384);
    const int gw = F.vcu * 8 + F.wave, NGW = F.G * 8;
    const float* gffn = F.in[2] + layer * D;
    const float* Wg = F.in[20] + (size_t)layer * NEXP * D * DEXP; const float* Wu = F.in[21] + (size_t)layer * NEXP * D * DEXP; const float* Wd = F.in[22] + (size_t)layer * NEXP * DEXP * D;
    bf16_t* WGU = (bf16_t*)(F.ws + WS_WGU); bf16_t* WDN = (bf16_t*)(F.ws + WS_WDN);
    for (int it = gw; it < 3 * 8192; it += NGW) {
        const int which = it >> 13, r = it & 8191, e = r >> 8, q = r & 255;
        if (which < 2) { const int kb = q >> 4, nb = q & 15, n0 = nb * 32;
            const int dest = e * 1024 + (n0 >> 7) * 256 + (which ? 128 : 0) + (n0 & 127);
            transpose_item((which ? Wu : Wg) + (size_t)e * D * DEXP, D, DEXP, gffn, WGU, dest, scr, kb, nb, F.lane);
        } else { const int kb = q >> 5, nb = q & 31;
            transpose_item(Wd + (size_t)e * DEXP * D, DEXP, D, nullptr, WDN, e * 1024 + nb * 32, scr, kb, nb, F.lane); }
    }
}
__device__ __forceinline__ void p_prologue(Frame& F) {
    LAS float* scr = (LAS float*)(F.lds + F.wave * 16384);
    const int gw = F.vcu * 8 + F.wave, NGW = F.G * 8;
    constexpr int I0 = 16 * 80, I1 = 16 * 32, I2 = 16 * 128, I3 = 16 * 32;
    for (int it = gw; it < I0 + I1 + I2 + I3; it += NGW) {
        int r = it;
        if (r < I0) { transpose_item(F.in[4], D, AB_IN, F.in[1], (bf16_t*)(F.ws + WS_WIN0), (r % 80) * 32, scr, r / 80, r % 80, F.lane); continue; } r -= I0;
        if (r < I1) { transpose_item(F.in[13], D, D, nullptr, (bf16_t*)(F.ws + WS_WOUT0), (r % 32) * 32, scr, r / 32, r % 32, F.lane); continue; } r -= I1;
        if (r < I2) { transpose_item(F.in[14], D, C_IN, F.in[1] + D, (bf16_t*)(F.ws + WS_WIN1), (r % 128) * 32, scr, r / 128, r % 128, F.lane); continue; } r -= I2;
        transpose_item(F.in[17], D, D, nullptr, (bf16_t*)(F.ws + WS_WOUT1), (r % 32) * 32, scr, r / 32, r % 32, F.lane);
    }
    moe_convert(F, 0);
    { const float* x = F.in[0]; bf16_t* XB = (bf16_t*)(F.ws + WS_XB); float* rstd = (float*)(F.ws + WS_RSTD);
      for (int m = gw; m < T; m += NGW) { const f32x4* xr = (const f32x4*)(x + (size_t)m * D) + F.lane; f32x4 v[4]; float s = 0.f;
#pragma unroll
          for (int j = 0; j < 4; ++j) { v[j] = xr[64 * j]; s += (v[j].x * v[j].x + v[j].y * v[j].y) + (v[j].z * v[j].z + v[j].w * v[j].w); }
          s = wave_sum(s); if (F.lane == 0) rstd[m] = rsqrtf(s * (1.f / D) + EPS);
          u32x2* o8 = (u32x2*)(XB + (size_t)m * D) + F.lane;
#pragma unroll
          for (int j = 0; j < 4; ++j) o8[64 * j] = (u32x2){pk2(v[j].x, v[j].y), pk2(v[j].z, v[j].w)}; } }
    const int gt = F.vcu * 512 + F.tid, NGT = F.G * 512;
    { float* lb = (float*)(F.ws + WS_LB); const float* l = F.in[15];
      for (int c = gt; c < 1024; c += NGT) { const float a = l[c], b = l[1024 + c], mx = fmaxf(a, b), ea = __expf(a - mx), eb = __expf(b - mx); lb[c] = ea / (ea + eb); } }
    { float* RgT = (float*)(F.ws + WS_RGT); float* ReT = (float*)(F.ws + WS_RET);
      for (int i = gt; i < 2 * 36 * 1024; i += NGT) { const int l = i / (36 * 1024), r = i % (36 * 1024), j = r >> 10, c = r & 1023; const float g = F.in[2][l * D + c];
          if (j < 4) RgT[(l * 4 + j) * 1024 + c] = g * F.in[18][((size_t)l * D + c) * 4 + j];
          else ReT[(l * 32 + (j - 4)) * 1024 + c] = g * F.in[19][((size_t)l * D + c) * 32 + (j - 4)]; } }
}

__device__ __forceinline__ void moe_tables(Frame& F, int layer) {
    LAS int* ts = (LAS int*)(F.lds + TS_OFF); LAS int* cn = ts + 40;
    const unsigned* cnt = (const unsigned*)(F.ws + WS_CTL) + CW_CNT + layer * 32;
    __syncthreads();
    if (F.tid < 32) cn[F.tid] = (int)__hip_atomic_load(cnt + F.tid, __ATOMIC_RELAXED, __HIP_MEMORY_SCOPE_AGENT);
    __syncthreads();
    if (F.tid == 0) { int s = 0; for (int e = 0; e < 32; ++e) { ts[e] = s; s += (cn[e] + 255) >> 8; } ts[32] = s; }
    __syncthreads();
}

__device__ __forceinline__ void p_router(Frame& F, int layer) {
    const int gw = F.vcu * 8 + F.wave, NGW = F.G * 8;
    const float* H = F.out; const float* RgT = (const float*)(F.ws + WS_RGT) + layer * 4 * 1024; const float* ReT = (const float*)(F.ws + WS_RET) + layer * 32 * 1024;
    unsigned* cnt = (unsigned*)(F.ws + WS_CTL) + CW_CNT + layer * 32;
    int* ltok = (int*)(F.ws + WS_LTOK); float* lrstd = (float*)(F.ws + WS_LRSTD); float* lw = (float*)(F.ws + WS_LW); int* tokinfo = (int*)(F.ws + WS_TOKINFO);
    for (int m = gw; m < T; m += NGW) {
        const f32x4* hr = (const f32x4*)(H + (size_t)m * D) + F.lane; f32x4 v[4]; float s = 0.f;
#pragma unroll
        for (int j = 0; j < 4; ++j) { v[j] = hr[64 * j]; s += (v[j].x * v[j].x + v[j].y * v[j].y) + (v[j].z * v[j].z + v[j].w * v[j].w); }
        const float rstd = rsqrtf(wave_sum(s) * (1.f / D) + EPS);
        float lg[4];
#pragma unroll
        for (int gi = 0; gi < 4; ++gi) { const f32x4* w = (const f32x4*)(RgT + gi * 1024) + F.lane; float a = 0.f;
#pragma unroll
            for (int j = 0; j < 4; ++j) { const f32x4 ww = w[64 * j]; a += (v[j].x * ww.x + v[j].y * ww.y) + (v[j].z * ww.z + v[j].w * ww.w); }
            lg[gi] = wave_sum(a) * rstd; }
        int gidx = 0; float gmax = lg[0];
#pragma unroll
        for (int gi = 1; gi < 4; ++gi) if (lg[gi] > gmax) { gmax = lg[gi]; gidx = gi; }
        float gs = 0.f;
#pragma unroll
        for (int gi = 0; gi < 4; ++gi) gs += __expf(lg[gi] - gmax);
        const float ggate = 1.f / gs;
        gidx = __builtin_amdgcn_readfirstlane(gidx);
        float le[8];
#pragma unroll
        for (int e = 0; e < 8; ++e) { const f32x4* w = (const f32x4*)(ReT + (gidx * 8 + e) * 1024) + F.lane; float a = 0.f;
#pragma unroll
            for (int j = 0; j < 4; ++j) { const f32x4 ww = w[64 * j]; a += (v[j].x * ww.x + v[j].y * ww.y) + (v[j].z * ww.z + v[j].w * ww.w); }
            le[e] = wave_sum(a) * rstd; }
        int i0 = 0; float v0 = le[0];
#pragma unroll
        for (int e = 1; e < 8; ++e) if (le[e] > v0) { v0 = le[e]; i0 = e; }
        int i1 = -1; float v1 = -3.0e38f;
#pragma unroll
        for (int e = 0; e < 8; ++e) if (e != i0 && le[e] > v1) { v1 = le[e]; i1 = e; }
        const float ex = __expf(v1 - v0), w0 = ggate / (1.f + ex), w1 = ggate * ex / (1.f + ex);
        if (F.lane == 0) {
            ((float*)(F.ws + WS_RSTD))[m] = rstd;
            const int e0 = gidx * 8 + i0, e1 = gidx * 8 + i1;
            const unsigned p0 = atomicAdd(cnt + e0, 1u), p1 = atomicAdd(cnt + e1, 1u);
            ltok[(size_t)e0 * CAP + p0] = m; lrstd[(size_t)e0 * CAP + p0] = rstd; lw[(size_t)e0 * CAP + p0] = w0;
            ltok[(size_t)e1 * CAP + p1] = m; lrstd[(size_t)e1 * CAP + p1] = rstd; lw[(size_t)e1 * CAP + p1] = w1;
            tokinfo[2 * m] = e0 * CAP + (int)p0; tokinfo[2 * m + 1] = e1 * CAP + (int)p1;
        }
    }
}
__device__ __forceinline__ void p_combine(Frame& F, int layer, int mode) {
    moe_tables(F, layer);
    const LAS int* ts = (const LAS int*)(F.lds + TS_OFF);
    const int gw = F.vcu * 8 + F.wave, NGW = F.G * 8;
    float* H = F.out; const bf16_t* Y = (const bf16_t*)(F.ws + WS_Y); const int* tokinfo = (const int*)(F.ws + WS_TOKINFO);
    bf16_t* XB = (bf16_t*)(F.ws + WS_XB); float* rstd = (float*)(F.ws + WS_RSTD); const float* gfin = F.in[3];
    for (int m = gw; m < T; m += NGW) {
        const int t0 = tokinfo[2 * m], t1 = tokinfo[2 * m + 1];
        const size_t s0 = (size_t)ts[t0 >> 15] * 256 + (t0 & (CAP - 1)), s1 = (size_t)ts[t1 >> 15] * 256 + (t1 & (CAP - 1));
        f32x4* hr = (f32x4*)(H + (size_t)m * D) + F.lane; const u32x2* y0 = (const u32x2*)(Y + s0 * D) + F.lane; const u32x2* y1 = (const u32x2*)(Y + s1 * D) + F.lane;
        f32x4 v[4]; float s = 0.f;
#pragma unroll
        for (int j = 0; j < 4; ++j) { v[j] = hr[64 * j]; const u32x2 a = y0[64 * j], b = y1[64 * j];
            v[j].x += bf2f(a.x & 0xffffu) + bf2f(b.x & 0xffffu); v[j].y += bf2f(a.x >> 16) + bf2f(b.x >> 16); v[j].z += bf2f(a.y & 0xffffu) + bf2f(b.y & 0xffffu); v[j].w += bf2f(a.y >> 16) + bf2f(b.y >> 16);
            s += (v[j].x * v[j].x + v[j].y * v[j].y) + (v[j].z * v[j].z + v[j].w * v[j].w); }
        const float rs = rsqrtf(wave_sum(s) * (1.f / D) + EPS);
        if (mode == 0) {
            if (F.lane == 0) rstd[m] = rs;
            u32x2* o8 = (u32x2*)(XB + (size_t)m * D) + F.lane;
#pragma unroll
            for (int j = 0; j < 4; ++j) { hr[64 * j] = v[j]; o8[64 * j] = (u32x2){pk2(v[j].x, v[j].y), pk2(v[j].z, v[j].w)}; }
        } else {
            const f32x4* g4 = (const f32x4*)gfin + F.lane;
#pragma unroll
            for (int j = 0; j < 4; ++j) { const f32x4 g = g4[64 * j]; hr[64 * j] = (f32x4){v[j].x * rs * g.x, v[j].y * rs * g.y, v[j].z * rs * g.z, v[j].w * rs * g.w}; }
        }
    }
}

__device__ __forceinline__ void mix_rglru_item(Frame& F, int b, int nb) {
    LAS float* L = (LAS float*)F.lds;
    LAS float* wa = L; LAS float* wx = L + 4096; LAS float* xat = L + 8192;   LAS float* xc = xat + 67 * 64; LAS float* ga = xc + 4096; LAS float* av = ga + 4096; LAS float* uv = av + 4096; LAS float* prm = uv + 4096;
    const bf16_t* Z = (const bf16_t*)(F.ws + WS_Z); bf16_t* CAT = (bf16_t*)(F.ws + WS_CAT);
    const int tid = F.tid;
    __syncthreads();
    for (int i = tid; i < 4096; i += 512) { wa[i] = F.in[7][nb * 4096 + i]; wx[i] = F.in[9][nb * 4096 + i]; }
    if (tid < 64) { const int c = nb * 64 + tid; prm[tid] = F.in[6][c]; prm[64 + tid] = F.in[5][c]; prm[128 + tid] = F.in[5][512 + c]; prm[192 + tid] = F.in[5][1024 + c]; prm[256 + tid] = F.in[5][1536 + c];
        prm[320 + tid] = F.in[8][c]; prm[384 + tid] = F.in[10][c]; const float lam = F.in[11][c]; prm[448 + tid] = fminf(lam, 0.f) - log1pf(__expf(-fabsf(lam))); }
    float hcar = 0.f;
    for (int t0 = 0; t0 < SEQ; t0 += 64) {
        __syncthreads();
        for (int i = tid; i < 67 * 64; i += 512) { const int r = i >> 6, c = i & 63, tg = t0 - 3 + r; xat[i] = tg >= 0 ? bf2f(Z[((size_t)b * SEQ + tg) * AB_IN + nb * 64 + c]) : 0.f; }
        for (int i = tid; i < 4096; i += 512) { const int r = i >> 6, c = i & 63; ga[i] = bf2f(Z[((size_t)b * SEQ + t0 + r) * AB_IN + 512 + nb * 64 + c]); }
        __syncthreads();
        for (int i = tid; i < 4096; i += 512) { const int r = i >> 6, c = i & 63; xc[i] = prm[c] + prm[64 + c] * xat[r * 64 + c] + prm[128 + c] * xat[(r + 1) * 64 + c] + prm[192 + c] * xat[(r + 2) * 64 + c] + prm[256 + c] * xat[(r + 3) * 64 + c]; }
        __syncthreads();
        { const int tok = tid >> 3, dg = tid & 7; float aa[8], ax[8];
#pragma unroll
          for (int j = 0; j < 8; ++j) { aa[j] = 0.f; ax[j] = 0.f; }
          for (int c = 0; c < 64; ++c) { const float xv = xc[tok * 64 + c]; const LAS f32x4* pa = (const LAS f32x4*)(wa + c * 64 + dg * 8); const LAS f32x4* px = (const LAS f32x4*)(wx + c * 64 + dg * 8);
              const f32x4 a0 = pa[0], a1 = pa[1], x0 = px[0], x1 = px[1];
              aa[0] += xv * a0.x; aa[1] += xv * a0.y; aa[2] += xv * a0.z; aa[3] += xv * a0.w; aa[4] += xv * a1.x; aa[5] += xv * a1.y; aa[6] += xv * a1.z; aa[7] += xv * a1.w;
              ax[0] += xv * x0.x; ax[1] += xv * x0.y; ax[2] += xv * x0.z; ax[3] += xv * x0.w; ax[4] += xv * x1.x; ax[5] += xv * x1.y; ax[6] += xv * x1.z; ax[7] += xv * x1.w; }
#pragma unroll
          for (int j = 0; j < 8; ++j) { const int d = dg * 8 + j; const float r = sigmoidf_(aa[j] + prm[320 + d]), ig = sigmoidf_(ax[j] + prm[384 + d]);
              const float la = 8.0f * r * prm[448 + d]; av[tok * 64 + d] = __expf(la); uv[tok * 64 + d] = sqrtf(fmaxf(-expm1f(2.0f * la), 0.f)) * (ig * xc[tok * 64 + d]); } }
        __syncthreads();
        if (tid < 64) { for (int r = 0; r < 64; ++r) { hcar = av[r * 64 + tid] * hcar + uv[r * 64 + tid]; av[r * 64 + tid] = hcar; } }
        __syncthreads();
        for (int i = tid; i < 4096; i += 512) { const int r = i >> 6, c = i & 63; CAT[((size_t)b * SEQ + t0 + r) * D + nb * 64 + c] = (bf16_t)f2bf(av[i] * gelu_tanh(ga[i])); }
    }
    __syncthreads();
}
__device__ __forceinline__ void mix_attn_item(Frame& F, int b, int c, int h) {
    LAS float* Ks = (LAS float*)F.lds;   LAS float* Vs = Ks + 64 * 68;   LAS float* bs = Vs + 4096;   LAS float* Ss = bs + 520;
    const bf16_t* Z = (const bf16_t*)(F.ws + WS_Z); bf16_t* CAT = (bf16_t*)(F.ws + WS_CAT);
    const int tid = F.tid, t = tid >> 3, sub = tid & 7;
    __syncthreads();
    for (int i = tid; i < 513; i += 512) bs[i] = F.in[12][h * 513 + i];
    unsigned q2[32]; float o[64];
    { const unsigned* qp = (const unsigned*)(Z + ((size_t)b * SEQ + c * 64 + t) * AB_IN + 1024 + h * 64);
#pragma unroll
      for (int d = 0; d < 32; ++d) q2[d] = qp[d];
#pragma unroll
      for (int d = 0; d < 64; ++d) o[d] = 0.f; }
    float mrun = -3.0e38f, lrun = 0.f;
    for (int kc = (c >= 8 ? c - 8 : 0); kc <= c; ++kc) {
        __syncthreads();
        for (int i = tid; i < 4096; i += 512) { const int s = i >> 6, d = i & 63; const size_t base = ((size_t)b * SEQ + kc * 64 + s) * AB_IN + h * 64 + d;
            Ks[s * 68 + d] = bf2f(Z[base + 1536]); Vs[s * 64 + d] = bf2f(Z[base + 2048]); }
        __syncthreads();
        float tmax = -3.0e38f;
#pragma unroll 1
        for (int jj = 0; jj < 8; ++jj) { const int s = sub + 8 * jj; const LAS f32x4* kp = (const LAS f32x4*)(Ks + s * 68); float a = 0.f;
#pragma unroll
            for (int d4 = 0; d4 < 16; ++d4) { const f32x4 kv = kp[d4]; a += bf2f(q2[2 * d4] & 0xffffu) * kv.x + bf2f(q2[2 * d4] >> 16) * kv.y + bf2f(q2[2 * d4 + 1] & 0xffffu) * kv.z + bf2f(q2[2 * d4 + 1] >> 16) * kv.w; }
            a *= 0.125f;
            int rel = t - ((kc - c) * 64 + s); rel = rel < -256 ? -256 : (rel > 256 ? 256 : rel);
            a += bs[rel + 256]; Ss[t * 65 + s] = a; tmax = fmaxf(tmax, a); }
        const float mnew = fmaxf(mrun, tmax), f = __expf(mrun - mnew);
        lrun *= f;
#pragma unroll
        for (int d = 0; d < 64; ++d) o[d] *= f;
#pragma unroll 1
        for (int jj = 0; jj < 8; ++jj) { const int s = sub + 8 * jj; const float p = __expf(Ss[t * 65 + s] - mnew); lrun += p; const LAS f32x4* vp = (const LAS f32x4*)(Vs + s * 64);
#pragma unroll
            for (int d4 = 0; d4 < 16; ++d4) { const f32x4 vv = vp[d4]; o[4 * d4] += p * vv.x; o[4 * d4 + 1] += p * vv.y; o[4 * d4 + 2] += p * vv.z; o[4 * d4 + 3] += p * vv.w; } }
        mrun = mnew;
    }
    float mall = mrun;
    mall = fmaxf(mall, __shfl_xor(mall, 1)); mall = fmaxf(mall, __shfl_xor(mall, 2)); mall = fmaxf(mall, __shfl_xor(mall, 4));
    const float f = __expf(mrun - mall); lrun *= f;
    lrun += __shfl_xor(lrun, 1); lrun += __shfl_xor(lrun, 2); lrun += __shfl_xor(lrun, 4);
    const float inv = 1.0f / lrun;
    bf16_t* op = CAT + ((size_t)b * SEQ + c * 64 + t) * D + 512 + h * 64;
#pragma unroll
    for (int d = 0; d < 64; ++d) { float v = o[d] * f; v += __shfl_xor(v, 1); v += __shfl_xor(v, 2); v += __shfl_xor(v, 4); if ((d >> 3) == sub) op[d] = (bf16_t)f2bf(v * inv); }
}

typedef float f32x16 __attribute__((ext_vector_type(16)));
typedef short s16x4 __attribute__((ext_vector_type(4)));
__device__ __forceinline__ s16x4 ds_tr16(const LAS unsigned char* p) { return __builtin_bit_cast(s16x4, __builtin_amdgcn_ds_read_tr16_b64_v4i16((LAS s16x4*)p)); }
constexpr int ATT_BT_BYTES = 8 * 520 * 4;
__device__ __forceinline__ void attn_load_bias(Frame& F) {
    LAS float* bt = (LAS float*)F.lds;
    __syncthreads();
    for (int i = F.tid; i < 8 * 513; i += 512) { const int h = i / 513, j = i % 513; bt[h * 520 + j] = F.in[12][i] * 1.4426950408889634f; }
    __syncthreads();
}
__device__ __forceinline__ void attn_wave_mfma(Frame& F, int b, int c, int h) {
    const bf16_t* Z = (const bf16_t*)(F.ws + WS_Z); bf16_t* CAT = (bf16_t*)(F.ws + WS_CAT);
    const int l = F.lane, r = l & 31, hh = l >> 5;
    const LAS float* btab = (const LAS float*)F.lds + h * 520;
    LAS unsigned char* Vw = F.lds + ATT_BT_BYTES + F.wave * 8192;
    const float SC = 0.125f * 1.4426950408889634f;
    bf16x8 qf[2][4];
    { const bf16_t* Qb = Z + ((size_t)b * SEQ + c * 64) * AB_IN + 1024 + h * 64;
#pragma unroll
      for (int qb = 0; qb < 2; ++qb)
#pragma unroll
          for (int ks = 0; ks < 4; ++ks) qf[qb][ks] = *(const bf16x8*)(Qb + (size_t)(qb * 32 + r) * AB_IN + ks * 16 + hh * 8); }
    f32x16 o[2][2];
#pragma unroll
    for (int a = 0; a < 2; ++a)
#pragma unroll
        for (int d = 0; d < 2; ++d)
#pragma unroll
            for (int i = 0; i < 16; ++i) o[a][d][i] = 0.f;
    float mrun[2] = {-1.0e30f, -1.0e30f}, lsum[2] = {0.f, 0.f};
    const int q4 = (l & 15) >> 2, p4 = l & 3, cb = (l >> 4) & 1, xs = (q4 >> 1) & 1;
    const LAS unsigned char* vbase = Vw + (4 * hh + q4) * 128 + p4 * 8 + cb * 32;
    const LAS unsigned char* vb[2] = {vbase + xs * 64, vbase + (1 - xs) * 64};
    for (int kc = (c >= 8 ? c - 8 : 0); kc <= c; ++kc) {
        const bf16_t* Kb = Z + ((size_t)b * SEQ + kc * 64) * AB_IN + 1536 + h * 64; const bf16_t* Vb = Kb + 512;
#pragma unroll
        for (int hf = 0; hf < 2; ++hf) { u32x4 vr[4];
#pragma unroll
          for (int i = 0; i < 4; ++i) vr[i] = *(const u32x4*)(Vb + (size_t)((hf * 4 + i) * 8 + (l >> 3)) * AB_IN + (l & 7) * 8);
#pragma unroll
          for (int i = 0; i < 4; ++i) { const int s = (hf * 4 + i) * 8 + (l >> 3), ci = l & 7, pb = (ci >> 1) ^ (((s >> 1) & 1) << 1); *(LAS u32x4*)(Vw + s * 128 + pb * 32 + (ci & 1) * 16) = vr[i]; }
          asm volatile("" ::: "memory"); }
        asm volatile("" ::: "memory");
        bf16x8 kf[2][4];
#pragma unroll
        for (int sb = 0; sb < 2; ++sb)
#pragma unroll
            for (int ks = 0; ks < 4; ++ks) kf[sb][ks] = *(const bf16x8*)(Kb + (size_t)(sb * 32 + r) * AB_IN + ks * 16 + hh * 8);
        const int dt = (c - kc) * 64;
#pragma unroll
        for (int qb = 0; qb < 2; ++qb) {
            f32x16 st[2];
#pragma unroll
            for (int sb = 0; sb < 2; ++sb) {
#pragma unroll
                for (int i = 0; i < 16; ++i) st[sb][i] = 0.f;
#pragma unroll
                for (int ks = 0; ks < 4; ++ks) st[sb] = __builtin_amdgcn_mfma_f32_32x32x16_bf16(kf[sb][ks], qf[qb][ks], st[sb], 0, 0, 0); }
            if (dt >= 320) { const float bc = btab[512];
#pragma unroll
                for (int sb = 0; sb < 2; ++sb)
#pragma unroll
                    for (int i = 0; i < 16; ++i) st[sb][i] = st[sb][i] * SC + bc;
            } else { const int base = dt + qb * 32 + r - 4 * hh + 256;
#pragma unroll
                for (int sb = 0; sb < 2; ++sb)
#pragma unroll
                    for (int i = 0; i < 16; ++i) { int idx = base - sb * 32 - ((i & 3) + 8 * (i >> 2)); idx = idx > 512 ? 512 : idx; st[sb][i] = st[sb][i] * SC + btab[idx]; } }
            float mx = st[0][0];
#pragma unroll
            for (int sb = 0; sb < 2; ++sb)
#pragma unroll
                for (int i = 0; i < 16; ++i) mx = fmaxf(mx, st[sb][i]);
            mx = fmaxf(mx, __shfl_xor(mx, 32));
            const float mn = fmaxf(mrun[qb], mx), alpha = __builtin_amdgcn_exp2f(mrun[qb] - mn); mrun[qb] = mn;
            float rs = 0.f;
#pragma unroll
            for (int sb = 0; sb < 2; ++sb)
#pragma unroll
                for (int i = 0; i < 16; ++i) { const float pv = __builtin_amdgcn_exp2f(st[sb][i] - mn); st[sb][i] = pv; rs += pv; }
            rs += __shfl_xor(rs, 32); lsum[qb] = lsum[qb] * alpha + rs;
#pragma unroll
            for (int d = 0; d < 2; ++d)
#pragma unroll
                for (int i = 0; i < 16; ++i) o[qb][d][i] *= alpha;
            bf16x8 pf[4];
#pragma unroll
            for (int kk = 0; kk < 4; ++kk) { const int sb = kk >> 1, s2 = kk & 1; u32x4 w;
                w.x = cvt_pk_bf16(st[sb][8 * s2 + 0], st[sb][8 * s2 + 1]); w.y = cvt_pk_bf16(st[sb][8 * s2 + 2], st[sb][8 * s2 + 3]);
                w.z = cvt_pk_bf16(st[sb][8 * s2 + 4], st[sb][8 * s2 + 5]); w.w = cvt_pk_bf16(st[sb][8 * s2 + 6], st[sb][8 * s2 + 7]); pf[kk] = __builtin_bit_cast(bf16x8, w); }
#pragma unroll
            for (int d = 0; d < 2; ++d)
#pragma unroll
                for (int kk = 0; kk < 4; ++kk) { const int rowoff = ((kk >> 1) * 32 + 16 * (kk & 1)) * 128;
                    const s16x4 lo = ds_tr16(vb[d] + rowoff), hi = ds_tr16(vb[d] + rowoff + 8 * 128);
                    const bf16x8 vf = (bf16x8){lo[0], lo[1], lo[2], lo[3], hi[0], hi[1], hi[2], hi[3]};
                    o[qb][d] = __builtin_amdgcn_mfma_f32_32x32x16_bf16(vf, pf[kk], o[qb][d], 0, 0, 0); }
        }
    }
#pragma unroll
    for (int qb = 0; qb < 2; ++qb) { const float inv = 1.0f / lsum[qb]; bf16_t* op = CAT + ((size_t)b * SEQ + c * 64 + qb * 32 + r) * D + 512 + h * 64 + 4 * hh;
#pragma unroll
        for (int d = 0; d < 2; ++d)
#pragma unroll
            for (int g = 0; g < 4; ++g) { u32x2 w; w.x = cvt_pk_bf16(o[qb][d][4 * g] * inv, o[qb][d][4 * g + 1] * inv); w.y = cvt_pk_bf16(o[qb][d][4 * g + 2] * inv, o[qb][d][4 * g + 3] * inv);
                *(u32x2*)(op + d * 32 + 8 * g) = w; } }
}

constexpr int RG_XA = 0, RG_GA0 = 8704, RG_GA1 = RG_GA0 + 8192, RG_XCB = RG_GA1 + 8192, RG_WA = RG_XCB + 9216, RG_WX = RG_WA + 9216, RG_AV = RG_WX + 9216, RG_UV = RG_AV + 16384, RG_SA = RG_UV + 16384, RG_SH = RG_SA + 2048, RG_END = RG_SH + 2048;
static_assert(RG_END <= RING_BYTES, "rglru lds");
__device__ __forceinline__ float gelu_fast(float x) { const float u = 1.5957691216057308f * (x + 0.044715f * x * x * x); return x / (1.0f + __expf(-u)); }
__device__ __forceinline__ void rglru_item(Frame& F, int b, int nb) {
    const bf16_t* Z = (const bf16_t*)(F.ws + WS_Z); bf16_t* CAT = (bf16_t*)(F.ws + WS_CAT);
    LAS unsigned char* L = F.lds;
    LAS float* AV = (LAS float*)(L + RG_AV); LAS float* UV = (LAS float*)(L + RG_UV); LAS float* SA = (LAS float*)(L + RG_SA); LAS float* SH = (LAS float*)(L + RG_SH);
    const int tid = F.tid, l = F.lane, w = F.wave, i16 = l & 15, q4 = l >> 4;
    __syncthreads();
    for (int i = tid; i < 4096; i += 512) { const int c = i >> 6, d = i & 63;
        *(LAS bf16_t*)(L + RG_WA + d * 144 + c * 2) = (bf16_t)f2bf(F.in[7][nb * 4096 + i]); *(LAS bf16_t*)(L + RG_WX + d * 144 + c * 2) = (bf16_t)f2bf(F.in[9][nb * 4096 + i]); }
    const int ct = tid >> 3, ch8 = tid & 7;
    float cw[4][8], cbv[8];
#pragma unroll
    for (int j = 0; j < 8; ++j) { const int ch = nb * 64 + 8 * ch8 + j; cbv[j] = F.in[6][ch];
#pragma unroll
        for (int k = 0; k < 4; ++k) cw[k][j] = F.in[5][k * 512 + ch]; }
    const int tb = w >> 1;
    float bav[2], bxv[2], lsv[2];
#pragma unroll
    for (int cc = 0; cc < 2; ++cc) { const int d = nb * 64 + 16 * ((w & 1) * 2 + cc) + i16; bav[cc] = F.in[8][d]; bxv[cc] = F.in[10][d]; const float lam = F.in[11][d]; lsv[cc] = 8.0f * (fminf(lam, 0.f) - log1pf(__expf(-fabsf(lam)))); }
    const int sc = tid & 63, sseg = tid >> 6;
    float carry = 0.f;
    const size_t rowb = (size_t)b * SEQ;
    u32x4 px0, px1, pg;
    const u32x4 zero4 = (u32x4){0u, 0u, 0u, 0u};
#define RG_LOAD(t0_) do { { const int r = tid >> 3, tg = (t0_) - 3 + r; px0 = tg >= 0 ? *(const u32x4*)(Z + (rowb + tg) * AB_IN + nb * 64 + (tid & 7) * 8) : zero4; } \
        if (tid < 24) { const int r = 64 + (tid >> 3), tg = (t0_) - 3 + r; px1 = *(const u32x4*)(Z + (rowb + tg) * AB_IN + nb * 64 + (tid & 7) * 8); } \
        pg = *(const u32x4*)(Z + (rowb + (t0_) + (tid >> 3)) * AB_IN + 512 + nb * 64 + (tid & 7) * 8); } while (0)
    RG_LOAD(0);
#pragma unroll 1
    for (int tile = 0; tile < 32; ++tile) {
        const int t0 = tile * 64; LAS unsigned char* GA = L + ((tile & 1) ? RG_GA1 : RG_GA0);
        *(LAS u32x4*)(L + RG_XA + tid * 16) = px0; if (tid < 24) *(LAS u32x4*)(L + RG_XA + (512 + tid) * 16) = px1;
        *(LAS u32x4*)(GA + tid * 16) = pg;
        __syncthreads();
        if (tile < 31) RG_LOAD(t0 + 64);
        { float xc[8];
#pragma unroll
          for (int j = 0; j < 8; ++j) xc[j] = cbv[j];
#pragma unroll
          for (int k = 0; k < 4; ++k) { const u32x4 xv = *(const LAS u32x4*)(L + RG_XA + (ct + k) * 128 + ch8 * 16); const unsigned xa[4] = {xv.x, xv.y, xv.z, xv.w};
#pragma unroll
              for (int j = 0; j < 8; ++j) xc[j] += cw[k][j] * bf2f((j & 1) ? (xa[j >> 1] >> 16) : (xa[j >> 1] & 0xffffu)); }
          *(LAS u32x4*)(L + RG_XCB + ct * 144 + ch8 * 16) = (u32x4){cvt_pk_bf16(xc[0], xc[1]), cvt_pk_bf16(xc[2], xc[3]), cvt_pk_bf16(xc[4], xc[5]), cvt_pk_bf16(xc[6], xc[7])}; }
        __syncthreads();
#pragma unroll
        for (int cc = 0; cc < 2; ++cc) { const int db = (w & 1) * 2 + cc; f32x4 aA = (f32x4){0.f, 0.f, 0.f, 0.f}, aX = aA;
#pragma unroll
            for (int ks = 0; ks < 2; ++ks) { const bf16x8 a = *(const LAS bf16x8*)(L + RG_XCB + (16 * tb + i16) * 144 + (32 * ks + 8 * q4) * 2);
                const bf16x8 ba = *(const LAS bf16x8*)(L + RG_WA + (16 * db + i16) * 144 + (32 * ks + 8 * q4) * 2), bx = *(const LAS bf16x8*)(L + RG_WX + (16 * db + i16) * 144 + (32 * ks + 8 * q4) * 2);
                aA = MFMA16(a, ba, aA); aX = MFMA16(a, bx, aX); }
#pragma unroll
            for (int rg = 0; rg < 4; ++rg) { const int t = 16 * tb + 4 * q4 + rg, d = 16 * db + i16; const float xcv = bf2f(*(const LAS bf16_t*)(L + RG_XCB + t * 144 + d * 2));
                const float r = sigmoidf_(aA[rg] + bav[cc]), ig = sigmoidf_(aX[rg] + bxv[cc]), la = r * lsv[cc];
                AV[t * 64 + d] = __expf(la); UV[t * 64 + d] = sqrtf(fmaxf(1.0f - __expf(2.0f * la), 0.f)) * (ig * xcv); } }
        __syncthreads();
        float aj[8], uj[8];
        { float A = 1.f, H = 0.f;
#pragma unroll
          for (int j = 0; j < 8; ++j) { aj[j] = AV[(8 * sseg + j) * 64 + sc]; uj[j] = UV[(8 * sseg + j) * 64 + sc]; H = aj[j] * H + uj[j]; A *= aj[j]; }
          SA[sseg * 64 + sc] = A; SH[sseg * 64 + sc] = H; }
        __syncthreads();
        { float run = carry, hin = carry;
#pragma unroll
          for (int sg = 0; sg < 8; ++sg) { if (sg == sseg) hin = run; run = SA[sg * 64 + sc] * run + SH[sg * 64 + sc]; }
          carry = run; float hv = hin;
#pragma unroll
          for (int j = 0; j < 8; ++j) { hv = aj[j] * hv + uj[j]; const int t = 8 * sseg + j; const float g = bf2f(*(const LAS bf16_t*)(GA + t * 128 + sc * 2));
              CAT[(rowb + t0 + t) * D + nb * 64 + sc] = (bf16_t)f2bf(hv * gelu_fast(g)); } }
    }
#undef RG_LOAD
    __syncthreads();
}
__device__ __forceinline__ void p_mix0(Frame& F) {
    const int j = F.vcu;
    if (j >= 128 && j < 256) rglru_item(F, (j - 128) >> 3, (j - 128) & 7);
    attn_load_bias(F);
    if (j < 256) {
#pragma unroll 1
        for (int rep = 0; rep < 2; ++rep) attn_wave_mfma(F, j & 15, rep == 0 ? 16 + (j >> 4) : 15 - (j >> 4), F.wave);
    }
    __syncthreads();
}
__device__ __forceinline__ void mix_hgrn_item(Frame& F, int b, int h) {
    LAS float* L = (LAS float*)F.lds;
    LAS float* qs = L; LAS float* fs = L + 4096; LAS float* is = L + 8192; LAS float* gs = L + 12288; LAS float* op = L + 16384;
    const bf16_t* Z = (const bf16_t*)(F.ws + WS_Z); bf16_t* CAT = (bf16_t*)(F.ws + WS_CAT); const float* lb = (const float*)(F.ws + WS_LB); const float* ng = F.in[16];
    const int tid = F.tid, v = tid & 127, kq = tid >> 7;
    float S[32];
#pragma unroll
    for (int k = 0; k < 32; ++k) S[k] = 0.f;
    for (int t0 = 0; t0 < SEQ; t0 += 32) {
        __syncthreads();
        for (int i = tid; i < 4096; i += 512) { const int r = i >> 7, c = i & 127; const bf16_t* zr = Z + ((size_t)b * SEQ + t0 + r) * C_IN + h * 128 + c;
            qs[i] = bf2f(zr[0]); const float l = lb[h * 128 + c]; fs[i] = l + (1.f - l) * sigmoidf_(bf2f(zr[1024])); is[i] = bf2f(zr[2048]); gs[i] = bf2f(zr[3072]); }
        __syncthreads();
        for (int r = 0; r < 32; ++r) { const float iv = is[r * 128 + v]; float o = 0.f;
#pragma unroll
            for (int k4 = 0; k4 < 8; ++k4) { const f32x4 f4 = *(const LAS f32x4*)(fs + r * 128 + kq * 32 + 4 * k4), q4 = *(const LAS f32x4*)(qs + r * 128 + kq * 32 + 4 * k4);
                S[4 * k4] = f4.x * S[4 * k4] + (1.f - f4.x) * iv; o += q4.x * S[4 * k4];
                S[4 * k4 + 1] = f4.y * S[4 * k4 + 1] + (1.f - f4.y) * iv; o += q4.y * S[4 * k4 + 1];
                S[4 * k4 + 2] = f4.z * S[4 * k4 + 2] + (1.f - f4.z) * iv; o += q4.z * S[4 * k4 + 2];
                S[4 * k4 + 3] = f4.w * S[4 * k4 + 3] + (1.f - f4.w) * iv; o += q4.w * S[4 * k4 + 3]; }
            op[(r * 4 + kq) * 128 + v] = o; }
        __syncthreads();
#pragma unroll
        for (int rr = 0; rr < 4; ++rr) { const int r = F.wave * 4 + rr; const int l = F.lane;
            const float o1 = op[(r * 4 + 0) * 128 + l] + op[(r * 4 + 1) * 128 + l] + op[(r * 4 + 2) * 128 + l] + op[(r * 4 + 3) * 128 + l];
            const float o2 = op[(r * 4 + 0) * 128 + 64 + l] + op[(r * 4 + 1) * 128 + 64 + l] + op[(r * 4 + 2) * 128 + 64 + l] + op[(r * 4 + 3) * 128 + 64 + l];
            const float rinv = rsqrtf(wave_sum(o1 * o1 + o2 * o2) * (1.f / 128.f) + EPS);
            bf16_t* cp = CAT + ((size_t)b * SEQ + t0 + r) * D + h * 128;
            cp[l] = (bf16_t)f2bf(o1 * rinv * ng[h * 128 + l] * gs[r * 128 + l]); cp[64 + l] = (bf16_t)f2bf(o2 * rinv * ng[h * 128 + 64 + l] * gs[r * 128 + 64 + l]); }
    }
    __syncthreads();
}


constexpr int HG_STR = 272;
constexpr int HG_LF = 0, HG_QH = 16384, HG_KK = 32768;
constexpr int HG_QE = 49152, HG_KN = HG_QE + 32 * HG_STR, HG_KS = HG_KN + 32 * HG_STR, HG_V0 = HG_KS + 32 * HG_STR, HG_V1 = HG_V0 + 32 * HG_STR, HG_G0 = HG_V1 + 32 * HG_STR, HG_G1 = HG_G0 + 32 * HG_STR;
constexpr int HG_AT = HG_G1 + 32 * HG_STR, HG_EB = HG_AT + 2560, HG_SEG = HG_EB + 512, HG_SSQ = HG_SEG + 2048, HG_END = HG_SSQ + 1024;
static_assert(HG_END <= RING_BYTES, "hgrn lds");
__device__ __forceinline__ void hgrn_item(Frame& F, int b, int h) {
    const bf16_t* Z = (const bf16_t*)(F.ws + WS_Z); bf16_t* CAT = (bf16_t*)(F.ws + WS_CAT); const float* lbp = (const float*)(F.ws + WS_LB); const float* ngp = F.in[16];
    LAS unsigned char* L = F.lds;
    LAS float* LF = (LAS float*)(L + HG_LF); LAS float* QH = (LAS float*)(L + HG_QH); LAS float* KK = (LAS float*)(L + HG_KK);
    LAS float* EB = (LAS float*)(L + HG_EB); LAS float* SEG = (LAS float*)(L + HG_SEG); LAS float* SSQ = (LAS float*)(L + HG_SSQ);
    LAS bf16_t* AT = (LAS bf16_t*)(L + HG_AT);
    const int tid = F.tid, l = F.lane, w = F.wave;
    const int lt = tid >> 4, lkc = tid & 15, sk = tid & 127, sseg = tid >> 7, i16 = l & 15, q4 = l >> 4, qq = i16 >> 2, pp = i16 & 3;
    float lbv[8];
#pragma unroll
    for (int j = 0; j < 8; ++j) lbv[j] = lbp[h * 128 + 8 * lkc + j];
    float ngv[4];
#pragma unroll
    for (int j = 0; j < 4; ++j) ngv[j] = ngp[h * 128 + 16 * w + 4 * q4 + j];
    f32x4 S[8];
#pragma unroll
    for (int i = 0; i < 8; ++i) S[i] = (f32x4){0.f, 0.f, 0.f, 0.f};
    __syncthreads();
    for (int i = tid; i < 640; i += 512) ((LAS unsigned*)(L + HG_AT))[i] = 0u;
    const bf16_t* zrow0 = Z + ((size_t)b * SEQ + lt) * C_IN + h * 128 + 8 * lkc;
    u32x4 pq = *(const u32x4*)(zrow0), pf = *(const u32x4*)(zrow0 + 1024), pv = *(const u32x4*)(zrow0 + 2048), pg = *(const u32x4*)(zrow0 + 3072);
#pragma unroll 1
    for (int st = 0; st < 64; ++st) {
        const int par = st & 1;
        LAS unsigned char* Vb = L + (par ? HG_V1 : HG_V0); LAS unsigned char* Gb = L + (par ? HG_G1 : HG_G0);
        { const unsigned qa[4] = {pq.x, pq.y, pq.z, pq.w}, fa[4] = {pf.x, pf.y, pf.z, pf.w};
          float lf[8], kk[8], qh[8];
#pragma unroll
          for (int j = 0; j < 8; ++j) { const float fz = bf2f((j & 1) ? (fa[j >> 1] >> 16) : (fa[j >> 1] & 0xffffu)); qh[j] = bf2f((j & 1) ? (qa[j >> 1] >> 16) : (qa[j >> 1] & 0xffffu));
              const float f = lbv[j] + (1.f - lbv[j]) * sigmoidf_(fz); lf[j] = __logf(f); kk[j] = 1.f - f; }
          LAS f32x4* d0 = (LAS f32x4*)(LF + lt * 128 + 8 * lkc); d0[0] = (f32x4){lf[0], lf[1], lf[2], lf[3]}; d0[1] = (f32x4){lf[4], lf[5], lf[6], lf[7]};
          LAS f32x4* d1 = (LAS f32x4*)(QH + lt * 128 + 8 * lkc); d1[0] = (f32x4){qh[0], qh[1], qh[2], qh[3]}; d1[1] = (f32x4){qh[4], qh[5], qh[6], qh[7]};
          LAS f32x4* d2 = (LAS f32x4*)(KK + lt * 128 + 8 * lkc); d2[0] = (f32x4){kk[0], kk[1], kk[2], kk[3]}; d2[1] = (f32x4){kk[4], kk[5], kk[6], kk[7]};
          *(LAS u32x4*)(Vb + lt * HG_STR + lkc * 16) = pv; *(LAS u32x4*)(Gb + lt * HG_STR + lkc * 16) = pg; }
        if (st < 63) { const bf16_t* zr = zrow0 + (size_t)(st + 1) * 32 * C_IN; pq = *(const u32x4*)(zr); pf = *(const u32x4*)(zr + 1024); pv = *(const u32x4*)(zr + 2048); pg = *(const u32x4*)(zr + 3072); }
        __syncthreads();
        float bl[8];
        { float a = 0.f;
#pragma unroll
          for (int j = 0; j < 8; ++j) { a += LF[(8 * sseg + j) * 128 + sk]; bl[j] = a; } }
        SEG[sseg * 128 + sk] = bl[7];
        __syncthreads();
        { const float s0 = SEG[sk], s1 = SEG[128 + sk], s2 = SEG[256 + sk], s3 = SEG[384 + sk];
          const float pre = (sseg > 0 ? s0 : 0.f) + (sseg > 1 ? s1 : 0.f) + (sseg > 2 ? s2 : 0.f), Bt = (s0 + s1) + (s2 + s3);
#pragma unroll
          for (int j = 0; j < 8; ++j) { const int t = 8 * sseg + j; const float bb = pre + bl[j];
              const float e1 = __expf(bb), e2 = __expf(fminf(-bb, 80.f)), e3 = __expf(Bt - bb), qh = QH[t * 128 + sk], kk = KK[t * 128 + sk];
              *(LAS bf16_t*)(L + HG_QE + t * HG_STR + sk * 2) = (bf16_t)f2bf(qh * e1);
              *(LAS bf16_t*)(L + HG_KN + t * HG_STR + sk * 2) = (bf16_t)f2bf(kk * e2);
              *(LAS bf16_t*)(L + HG_KS + t * HG_STR + sk * 2) = (bf16_t)f2bf(kk * e3); }
          if (sseg == 0) EB[sk] = __expf(Bt); }
        __syncthreads();
        if (w < 3) { const int tb = w ? 1 : 0, sb = (w == 2) ? 1 : 0; f32x4 acc = (f32x4){0.f, 0.f, 0.f, 0.f};
#pragma unroll
            for (int ks = 0; ks < 4; ++ks) { const bf16x8 a = *(const LAS bf16x8*)(L + HG_QE + (16 * tb + i16) * HG_STR + (32 * ks + 8 * q4) * 2), bq = *(const LAS bf16x8*)(L + HG_KN + (16 * sb + i16) * HG_STR + (32 * ks + 8 * q4) * 2);
                acc = MFMA16(a, bq, acc); }
#pragma unroll
            for (int rg = 0; rg < 4; ++rg) { const int t = 16 * tb + 4 * q4 + rg, sx = 16 * sb + i16; AT[t * 40 + sx] = (bf16_t)f2bf(sx <= t ? acc[rg] : 0.f); } }
        __syncthreads();
        bf16x8 vfr;
        { const s16x4 lo = ds_tr16(Vb + (8 * q4 + qq) * HG_STR + (16 * w + 4 * pp) * 2), hi = ds_tr16(Vb + (8 * q4 + 4 + qq) * HG_STR + (16 * w + 4 * pp) * 2);
          vfr = (bf16x8){lo[0], lo[1], lo[2], lo[3], hi[0], hi[1], hi[2], hi[3]}; }
        f32x4 O[2];
#pragma unroll
        for (int tb = 0; tb < 2; ++tb) { const bf16x8 at = *(const LAS bf16x8*)(L + HG_AT + (16 * tb + i16) * 80 + 16 * q4); O[tb] = MFMA16(vfr, at, ((f32x4){0.f, 0.f, 0.f, 0.f})); }
#pragma unroll
        for (int m = 0; m < 4; ++m) { u32x4 sp; sp.x = cvt_pk_bf16(S[2 * m][0], S[2 * m][1]); sp.y = cvt_pk_bf16(S[2 * m][2], S[2 * m][3]); sp.z = cvt_pk_bf16(S[2 * m + 1][0], S[2 * m + 1][1]); sp.w = cvt_pk_bf16(S[2 * m + 1][2], S[2 * m + 1][3]);
            const bf16x8 spk = __builtin_bit_cast(bf16x8, sp);
#pragma unroll
            for (int tb = 0; tb < 2; ++tb) { const u32x2 q0 = *(const LAS u32x2*)(L + HG_QE + (16 * tb + i16) * HG_STR + (32 * m + 4 * q4) * 2), q1 = *(const LAS u32x2*)(L + HG_QE + (16 * tb + i16) * HG_STR + (32 * m + 16 + 4 * q4) * 2);
                const u32x4 qv = (u32x4){q0.x, q0.y, q1.x, q1.y}; O[tb] = MFMA16(spk, __builtin_bit_cast(bf16x8, qv), O[tb]); } }
#pragma unroll
        for (int kb = 0; kb < 8; ++kb) { const s16x4 lo = ds_tr16(L + HG_KS + (8 * q4 + qq) * HG_STR + (16 * kb + 4 * pp) * 2), hi = ds_tr16(L + HG_KS + (8 * q4 + 4 + qq) * HG_STR + (16 * kb + 4 * pp) * 2);
            const bf16x8 kfr = (bf16x8){lo[0], lo[1], lo[2], lo[3], hi[0], hi[1], hi[2], hi[3]}; const f32x4 dec = *(const LAS f32x4*)(EB + 16 * kb + 4 * q4);
            S[kb] = MFMA16(kfr, vfr, S[kb] * dec); }
#pragma unroll
        for (int tb = 0; tb < 2; ++tb) { float ss = (O[tb][0] * O[tb][0] + O[tb][1] * O[tb][1]) + (O[tb][2] * O[tb][2] + O[tb][3] * O[tb][3]); ss += __shfl_xor(ss, 16); ss += __shfl_xor(ss, 32);
            if (q4 == 0) SSQ[(16 * tb + i16) * 8 + w] = ss; }
        __syncthreads();
#pragma unroll
        for (int tb = 0; tb < 2; ++tb) { const int t = 16 * tb + i16; const f32x4 a = *(const LAS f32x4*)(SSQ + t * 8), c = *(const LAS f32x4*)(SSQ + t * 8 + 4);
            const float rinv = rsqrtf(((a.x + a.y) + (a.z + a.w) + (c.x + c.y) + (c.z + c.w)) * (1.f / 128.f) + EPS);
            const u32x2 g2 = *(const LAS u32x2*)(Gb + t * HG_STR + (16 * w + 4 * q4) * 2);
            const float o0 = O[tb][0] * rinv * ngv[0] * bf2f(g2.x & 0xffffu), o1 = O[tb][1] * rinv * ngv[1] * bf2f(g2.x >> 16), o2 = O[tb][2] * rinv * ngv[2] * bf2f(g2.y & 0xffffu), o3 = O[tb][3] * rinv * ngv[3] * bf2f(g2.y >> 16);
            *(u32x2*)(CAT + ((size_t)b * SEQ + st * 32 + t) * D + h * 128 + 16 * w + 4 * q4) = (u32x2){cvt_pk_bf16(o0, o1), cvt_pk_bf16(o2, o3)}; }
    }
    __syncthreads();
}
__device__ __forceinline__ void p_gu(Frame& F, int layer) {
    unsigned char* ws = F.ws;
    moe_tables(F, layer);
    const LAS int* ts = (const LAS int*)(F.lds + TS_OFF); LAS unsigned* tab = (LAS unsigned*)(F.lds + TAB_OFF);
    pg8::MoeOrder<true> S{ts, tab, F.G, F.vcu, D};
    { const int* ltok = (const int*)(ws + WS_LTOK); pg8::Unit u;
      for (int i = 0; i < 6 && S.next(i, u); ++i) if (F.tid < 256) { const int pos = u.rl * 256 + F.tid; const int tok = pos < ts[40 + u.e] ? ltok[(size_t)u.e * CAP + pos] : 0; tab[i * 256 + F.tid] = (unsigned)tok * (unsigned)(D * 2); }
      __syncthreads(); }
    pg8::EpiGU E{(bf16_t*)(ws + WS_HB), (const float*)(ws + WS_LRSTD), ts + 40};
    pg8::gemm_phase<pg8::EpiGU, pg8::MoeOrder<true>, true>(F.lds, (const bf16_t*)(ws + WS_XB), (const bf16_t*)(ws + WS_WGU), D, S, E);
}
__device__ __forceinline__ void p_dn(Frame& F, int layer) {
    unsigned char* ws = F.ws;
    moe_tables(F, layer);
    const LAS int* ts = (const LAS int*)(F.lds + TS_OFF);
    pg8::MoeOrder<false> S{ts, nullptr, F.G, F.vcu, DEXP};
    pg8::EpiDN E{(bf16_t*)(ws + WS_Y), (const float*)(ws + WS_LW), ts + 40};
    pg8::gemm_phase<pg8::EpiDN, pg8::MoeOrder<false>, true>(F.lds, (const bf16_t*)(ws + WS_HB), (const bf16_t*)(ws + WS_WDN), DEXP, S, E);
}

__global__ void __launch_bounds__(512, 2) fwd(Args args) {
    extern __shared__ __attribute__((aligned(16))) unsigned char lds_raw[];
    Frame F;
    F.lds = (LAS unsigned char*)lds_raw; F.tid = threadIdx.x; F.lane = F.tid & 63; F.wave = __builtin_amdgcn_readfirstlane(F.tid >> 6);
    F.G = gridDim.x; { const int bx = blockIdx.x; F.vcu = (F.G % 8 == 0) ? (bx % 8) * (F.G / 8) + bx / 8 : bx; }
    F.in = args.in; F.out = args.out; F.ws = args.ws;
    unsigned char* ws = args.ws;
    bf16_t* XB = (bf16_t*)(ws + WS_XB); bf16_t* CAT = (bf16_t*)(ws + WS_CAT); bf16_t* Z = (bf16_t*)(ws + WS_Z);
    float* RSTD = (float*)(ws + WS_RSTD);
#if MK_ONE_LAUNCH == 2
    cg::grid_group grid = cg::this_grid();
#define GRID_BAR() grid.sync()
#elif MK_ONE_LAUNCH == 1
    if (F.tid < 2) ((volatile LAS unsigned*)(F.lds + MISC_OFF))[F.tid] = 0u;
    __syncthreads();
    const XcdBarrier xbar = xcd_barrier_post((unsigned*)(ws + WS_CTL) + CW_BAR, (volatile LAS unsigned*)(F.lds + MISC_OFF));
#define GRID_BAR() xcd_barrier(xbar)
#else
#define GRID_BAR() do {} while (0)
#endif
    #ifndef PH_MASK
#define PH_MASK 0x7fff
#endif
#define PHE(p) ((PH_MASK >> (p)) & 1)
    const int lo = args.ph_lo, hi = args.ph_hi;
#ifndef PROBE_MASK
#define PROBE_MASK 0
#endif
#define REPN(k) (((PROBE_MASK >> (k)) & 1) ? 2 : 1)
#define IN(k) (PHE(k) && lo <= (k) && (k) < hi)
#define SEAM(k) do { if (lo <= (k) && (k) + 1 < hi) GRID_BAR(); } while (0)
    if (IN(PH_PRO)) { { p_prologue(F); } if (REPN(PH_PRO) == 2) { GRID_BAR(); { p_prologue(F); } } } SEAM(PH_PRO);
    if (IN(PH_IN0)) { { pg8::DenseOrder S; S.init(T, AB_IN, D, F.G, (int)blockIdx.x); pg8::EpiIn E{Z, AB_IN, RSTD, 0, 1 << 30};
        pg8::gemm_phase<pg8::EpiIn, pg8::DenseOrder, true>(F.lds, XB, (const bf16_t*)(ws + WS_WIN0), D, S, E); } if (REPN(PH_IN0) == 2) { GRID_BAR(); { pg8::DenseOrder S; S.init(T, AB_IN, D, F.G, (int)blockIdx.x); pg8::EpiIn E{Z, AB_IN, RSTD, 0, 1 << 30};
        pg8::gemm_phase<pg8::EpiIn, pg8::DenseOrder, true>(F.lds, XB, (const bf16_t*)(ws + WS_WIN0), D, S, E); } } } SEAM(PH_IN0);
    if (IN(PH_MIX0)) { { p_mix0(F); } if (REPN(PH_MIX0) == 2) { GRID_BAR(); { p_mix0(F); } } } SEAM(PH_MIX0);
    if (IN(PH_OUT0)) { { pg8::DenseOrder S; S.init(T, D, D, F.G, (int)blockIdx.x); pg8::EpiOut E{args.in[0], args.out, XB};
        pg8::gemm_phase<pg8::EpiOut, pg8::DenseOrder, true>(F.lds, CAT, (const bf16_t*)(ws + WS_WOUT0), D, S, E); } if (REPN(PH_OUT0) == 2) { GRID_BAR(); { pg8::DenseOrder S; S.init(T, D, D, F.G, (int)blockIdx.x); pg8::EpiOut E{args.in[0], args.out, XB};
        pg8::gemm_phase<pg8::EpiOut, pg8::DenseOrder, true>(F.lds, CAT, (const bf16_t*)(ws + WS_WOUT0), D, S, E); } } } SEAM(PH_OUT0);
    if (IN(PH_R1)) { p_router(F, 0); } SEAM(PH_R1);
    if (IN(PH_GU0)) { { p_gu(F, 0); } if (REPN(PH_GU0) == 2) { GRID_BAR(); { p_gu(F, 0); } } } SEAM(PH_GU0);
    if (IN(PH_DN0)) { { p_dn(F, 0); } if (REPN(PH_DN0) == 2) { GRID_BAR(); { p_dn(F, 0); } } } SEAM(PH_DN0);
    if (IN(PH_R2)) { p_combine(F, 0, 0); moe_convert(F, 1); } SEAM(PH_R2);
    if (IN(PH_IN1)) { { pg8::DenseOrder S; S.init(T, C_IN, D, F.G, (int)blockIdx.x); pg8::EpiIn E{Z, C_IN, RSTD, 1024, 3072};
        pg8::gemm_phase<pg8::EpiIn, pg8::DenseOrder, true>(F.lds, XB, (const bf16_t*)(ws + WS_WIN1), D, S, E); } if (REPN(PH_IN1) == 2) { GRID_BAR(); { pg8::DenseOrder S; S.init(T, C_IN, D, F.G, (int)blockIdx.x); pg8::EpiIn E{Z, C_IN, RSTD, 1024, 3072};
        pg8::gemm_phase<pg8::EpiIn, pg8::DenseOrder, true>(F.lds, XB, (const bf16_t*)(ws + WS_WIN1), D, S, E); } } } SEAM(PH_IN1);
    if (IN(PH_MIX1)) { { if (F.vcu < 128) hgrn_item(F, F.vcu >> 3, F.vcu & 7); } if (REPN(PH_MIX1) == 2) { GRID_BAR(); { if (F.vcu < 128) hgrn_item(F, F.vcu >> 3, F.vcu & 7); } } } SEAM(PH_MIX1);
    if (IN(PH_OUT1)) { pg8::DenseOrder S; S.init(T, D, D, F.G, (int)blockIdx.x); pg8::EpiOut E{args.out, args.out, XB};
        pg8::gemm_phase<pg8::EpiOut, pg8::DenseOrder, true>(F.lds, CAT, (const bf16_t*)(ws + WS_WOUT1), D, S, E); } SEAM(PH_OUT1);
    if (IN(PH_R3)) { p_router(F, 1); } SEAM(PH_R3);
    if (IN(PH_GU1)) { { p_gu(F, 1); } if (REPN(PH_GU1) == 2) { GRID_BAR(); { p_gu(F, 1); } } } SEAM(PH_GU1);
    if (IN(PH_DN1)) { { p_dn(F, 1); } if (REPN(PH_DN1) == 2) { GRID_BAR(); { p_dn(F, 1); } } } SEAM(PH_DN1);
    if (IN(PH_R4)) { p_combine(F, 1, 1); }
}

extern "C" void kernel_launch(void* const* d_in, const int* in_sizes, int n_in, void* d_out, int out_size, void* d_ws, size_t ws_size, hipStream_t stream) {
    static int grid = 0;
    if (grid == 0) {
        if (n_in != 23 || out_size != T * D || ws_size < WS_END) { fprintf(stderr, "kernel_launch: unexpected shapes: n_in %d out %d ws %zu (need %zu)\n", n_in, out_size, ws_size, (size_t)WS_END); grid = -1; return; }
        if (hipFuncSetAttribute((const void*)fwd, hipFuncAttributeMaxDynamicSharedMemorySize, LDS_BYTES) != hipSuccess) { fprintf(stderr, "kernel_launch: hipFuncSetAttribute failed\n"); grid = -1; return; }
        int dev = 0, cus = 0, per_cu = 0;
        hipGetDevice(&dev); hipDeviceGetAttribute(&cus, hipDeviceAttributeMultiprocessorCount, dev);
        hipOccupancyMaxActiveBlocksPerMultiprocessor(&per_cu, (const void*)fwd, 512, LDS_BYTES);
        (void)hipGetLastError();
        fprintf(stderr, "kernel_launch: cus %d per_cu %d ws %zu\n", cus, per_cu, ws_size);
        grid = cus > 0 ? cus : 256;
        if (per_cu < 1) fprintf(stderr, "kernel_launch: occupancy query says %d blocks per CU\n", per_cu);
    }
    if (grid < 0) return;
    hipMemsetAsync((char*)d_ws + WS_CTL, 0, CTL_BYTES, stream);
    Args a{};
    for (int i = 0; i < 23; ++i) a.in[i] = (const float*)d_in[i];
    a.out = (float*)d_out; a.ws = (unsigned char*)d_ws;
#if MK_ONE_LAUNCH
    a.ph_lo = 0; a.ph_hi = NPH;
    void* kargs[] = {&a};
    hipError_t e = hipLaunchCooperativeKernel((const void*)fwd, dim3(grid), dim3(512), kargs, LDS_BYTES, stream);
    if (e != hipSuccess) fprintf(stderr, "cooperative launch failed: %s (grid %d)\n", hipGetErrorString(e), grid);
#else
    for (int ph = 0; ph < NPH; ++ph) { a.ph_lo = ph; a.ph_hi = ph + 1; hipLaunchKernelGGL(fwd, dim3(grid), dim3(512), LDS_BYTES, stream, a); }
#endif
}
```

```cpp
#include <hip/hip_runtime.h>
#include <hip/hip_cooperative_groups.h>
#include <cstdio>
#include <cstdint>
namespace cg = cooperative_groups;

#ifndef PROBE_X
#define PROBE_X 0
#endif
#ifndef MK_ONE_LAUNCH
#define MK_ONE_LAUNCH 1
#endif

constexpr int T = 32768, D = 1024, SEQ = 2048, NB = 16;
constexpr int AB_IN = 2560, C_IN = 4096;
constexpr int NEXP = 32, DEXP = 512, CAP = 32768;
constexpr int MAXTILES = 288;
constexpr float EPS = 1e-6f;

#define LAS __attribute__((address_space(3)))
typedef unsigned short bf16_t;
typedef short bf16x8 __attribute__((ext_vector_type(8)));
typedef float f32x4 __attribute__((ext_vector_type(4)));
typedef unsigned u32x4 __attribute__((ext_vector_type(4)));
typedef unsigned u32x2 __attribute__((ext_vector_type(2)));

constexpr size_t MiB = 1u << 20;
constexpr size_t WS_CTL = 0, CTL_BYTES = 1 * MiB;
constexpr size_t WS_RSTD = 1 * MiB;
constexpr size_t WS_LB = WS_RSTD + 128 * 1024;
constexpr size_t WS_RWH = WS_LB + 4096;
constexpr size_t WS_RWL = WS_RWH + 2 * 36 * 1024 * 2;
constexpr size_t WS_TOKINFO = 2 * MiB;
constexpr size_t WS_LTOK = 3 * MiB, WS_LRSTD = 7 * MiB, WS_LW = 11 * MiB;
constexpr size_t WS_WIN0 = 16 * MiB, WS_WOUT0 = 21 * MiB, WS_WIN1 = 23 * MiB, WS_WOUT1 = 31 * MiB;
constexpr size_t WS_WGU = 34 * MiB, WS_WDN = 98 * MiB;
constexpr size_t WS_XB = 130 * MiB, WS_CAT = 194 * MiB;
constexpr size_t WS_Z = 258 * MiB;
constexpr size_t WS_HB = 258 * MiB, WS_Y = 330 * MiB;
constexpr size_t WS_END = 514 * MiB;
constexpr int CW_CNT = 64;
constexpr int CW_BAR = 4096;

constexpr int RING_BYTES = 131072;
constexpr int TAB_OFF = RING_BYTES;
constexpr int TS_OFF = TAB_OFF + 6 * 1024;
constexpr int LDS_BYTES = 163840;
constexpr int MISC_OFF = LDS_BYTES - 64;

__device__ __forceinline__ unsigned f2bf(float f) { unsigned u = __float_as_uint(f); return (u + 0x7fffu + ((u >> 16) & 1u)) >> 16; }
__device__ __forceinline__ float bf2f(unsigned b) { return __uint_as_float(b << 16); }
__device__ __forceinline__ unsigned pk2(float lo, float hi) { return f2bf(lo) | (f2bf(hi) << 16); }
__device__ __forceinline__ unsigned cvt_pk_bf16(float lo, float hi) { unsigned r; asm volatile("v_cvt_pk_bf16_f32 %0, %1, %2" : "=v"(r) : "v"(lo), "v"(hi)); return r; }
__device__ __forceinline__ float wave_sum(float v) {
#pragma unroll
    for (int o = 1; o < 64; o <<= 1) v += __shfl_xor(v, o);
    return v;
}
__device__ __forceinline__ float sigmoidf_(float x) { return 1.0f / (1.0f + __expf(-x)); }
__device__ __forceinline__ float siluf_(float x) { return x / (1.0f + __expf(-x)); }
__device__ __forceinline__ float gelu_tanh(float x) { const float u = 0.7978845608028654f * (x + 0.044715f * x * x * x); return 0.5f * x * (1.0f + tanhf(u)); }
#define LDS_WAIT() asm volatile("s_waitcnt lgkmcnt(0)" ::: "memory")
#define MFMA16(a, b, c) __builtin_amdgcn_mfma_f32_16x16x32_bf16((a), (b), (c), 0, 0, 0)

namespace pg8 {
constexpr int BM = 256, BK = 64, HALF = 128, HTB = HALF * BK * 2, NXCD = 8, WGM = 8;
__host__ __device__ __forceinline__ int lds_byte(int r, int c) { const int st = (r >> 4) * 2 + (c >> 5), rr = r & 15, cc = c & 31, ob = rr * 64 + cc * 2; return st * 1024 + (ob ^ (((ob >> 9) & 1) << 5)); }
__host__ __device__ __forceinline__ void stage_rc(int b, int& R, int& C) { const int st = b / 1024, sb = b % 1024, swz = sb ^ (((sb >> 9) & 1) << 5); R = (st >> 1) * 16 + swz / 64; C = (st & 1) * 32 + (swz % 64) / 2; }
__host__ __device__ __forceinline__ int perm32(int rho) { const int n = rho >> 4, i = rho & 15; return 8 * (i >> 2) + 4 * n + (i & 3); }

struct Unit { unsigned boff; int arow, orow, ocol, e, rl, slot; };

struct DenseOrder {
    int nM, nN, nwg, G, c, K;
    __device__ void init(int M, int N, int K_, int G_, int c_) { nM = M / BM; nN = N / BM; nwg = nM * nN; G = G_; c = c_; K = K_; }
    __device__ __forceinline__ bool next(int i, Unit& u) const {
        const long L = (long)i * G + c; if (L >= nwg) return false;
        int wgid = (int)L; { const int q = nwg / NXCD, r = nwg % NXCD, xcd = wgid % NXCD, off = wgid / NXCD; wgid = (xcd < r ? xcd * (q + 1) : r * (q + 1) + (xcd - r) * q) + off; }
        const int nig = WGM * nN, gid = wgid / nig, fm = gid * WGM, gsz = (nM - fm) < WGM ? (nM - fm) : WGM;
        const int pm = __builtin_amdgcn_readfirstlane(fm + ((wgid % nig) % gsz)), pn = __builtin_amdgcn_readfirstlane((wgid % nig) / gsz);
        u.arow = pm * BM; u.orow = pm * BM; u.ocol = pn * BM; u.boff = (unsigned)(pn * BM) * (unsigned)K * 2u; u.e = 0; u.rl = 0; u.slot = i; return true;
    }
    static constexpr bool GATHER = false;
    __device__ __forceinline__ size_t abase(const Unit& u) const { return (size_t)u.arow * (size_t)K * 2u; }
    __device__ __forceinline__ unsigned aoff(const Unit&, int) const { return 0u; }
};
template <bool GATHER_> struct MoeOrder {
    static constexpr bool GATHER = GATHER_;
    const LAS int* ts; const LAS unsigned* tab; int G, vcu, K;
    __device__ __forceinline__ bool next(int i, Unit& u) const {
        const int L = i * G + vcu; const int NT = __builtin_amdgcn_readfirstlane(ts[32]); if (L >= NT * 4) return false;
        const int rt = L >> 2, pn = L & 3; int e = 0;
#pragma unroll
        for (int j = 1; j < 32; ++j) e += (ts[j] <= rt) ? 1 : 0;
        e = __builtin_amdgcn_readfirstlane(e);
        u.e = e; u.rl = rt - __builtin_amdgcn_readfirstlane(ts[e]); u.orow = rt * BM; u.arow = rt * BM; u.ocol = pn * BM; u.boff = (unsigned)(e * 1024 + pn * BM) * (unsigned)K * 2u; u.slot = i; return true;
    }
    __device__ __forceinline__ size_t abase(const Unit& u) const { return GATHER ? (size_t)0 : (size_t)u.arow * (size_t)K * 2u; }
    __device__ __forceinline__ unsigned aoff(const Unit& u, int r) const { return tab[u.slot * 256 + r]; }
};

typedef f32x4 Acc[2][2][4][2];

struct EpiIn {
    static constexpr bool PERM = true;
    bf16_t* O; int ldc; const float* rstd; int silu_lo_end, silu_hi_start;
    __device__ __forceinline__ void operator()(const Acc& acc, const Unit& u, int wr, int wc, int fr, int fq) const {
        const bool act = (u.ocol < silu_lo_end) || (u.ocol >= silu_hi_start);
#pragma unroll
        for (int ai = 0; ai < 2; ++ai)
#pragma unroll
            for (int m = 0; m < 4; ++m) {
                const int row = u.orow + ai * HALF + wr * 64 + m * 16 + fr; const float rs = rstd[row];
                bf16_t* rowp = O + (size_t)row * ldc + u.ocol + wc * 32 + 8 * fq;
#pragma unroll
                for (int bj = 0; bj < 2; ++bj) { f32x4 v0 = acc[ai][bj][m][0] * rs, v1 = acc[ai][bj][m][1] * rs;
                    if (act) {
#pragma unroll
                        for (int j = 0; j < 4; ++j) { v0[j] = siluf_(v0[j]); v1[j] = siluf_(v1[j]); } }
                    u32x4 w; w.x = cvt_pk_bf16(v0[0], v0[1]); w.y = cvt_pk_bf16(v0[2], v0[3]); w.z = cvt_pk_bf16(v1[0], v1[1]); w.w = cvt_pk_bf16(v1[2], v1[3]);
                    *(u32x4*)(rowp + bj * HALF) = w; } }
    }
};
struct EpiOut {
    static constexpr bool PERM = true;
    const float* resid; float* H; bf16_t* XB; int dry;
    __device__ __forceinline__ void operator()(const Acc& acc, const Unit& u, int wr, int wc, int fr, int fq) const {
#pragma unroll
        for (int ai = 0; ai < 2; ++ai)
#pragma unroll
            for (int m = 0; m < 4; ++m) {
                const int row = u.orow + ai * HALF + wr * 64 + m * 16 + fr; const size_t off = (size_t)row * D + u.ocol + wc * 32 + 8 * fq;
#pragma unroll
                for (int bj = 0; bj < 2; ++bj) { const f32x4 r0 = *(const f32x4*)(resid + off + bj * HALF), r1 = *(const f32x4*)(resid + off + bj * HALF + 4);
                    const f32x4 v0 = dry ? r0 : acc[ai][bj][m][0] + r0, v1 = dry ? r1 : acc[ai][bj][m][1] + r1;
                    *(f32x4*)(H + off + bj * HALF) = v0; *(f32x4*)(H + off + bj * HALF + 4) = v1;
                    u32x4 w; w.x = cvt_pk_bf16(v0[0], v0[1]); w.y = cvt_pk_bf16(v0[2], v0[3]); w.z = cvt_pk_bf16(v1[0], v1[1]); w.w = cvt_pk_bf16(v1[2], v1[3]);
                    *(u32x4*)(XB + off + bj * HALF) = w; } }
    }
};
struct EpiGU {
    static constexpr bool PERM = true;
    bf16_t* HB; const float* lrstd; const LAS int* cnt;
    __device__ __forceinline__ void operator()(const Acc& acc, const Unit& u, int wr, int wc, int fr, int fq) const {
        const int n_e = cnt[u.e];
#pragma unroll
        for (int ai = 0; ai < 2; ++ai)
#pragma unroll
            for (int m = 0; m < 4; ++m) {
                const int r = ai * HALF + wr * 64 + m * 16 + fr, pos = u.rl * BM + r; const float rs = pos < n_e ? lrstd[(size_t)u.e * CAP + pos] : 0.f;
                float h[8];
#pragma unroll
                for (int n = 0; n < 2; ++n)
#pragma unroll
                    for (int j = 0; j < 4; ++j) { const float g = acc[ai][0][m][n][j] * rs, uu = acc[ai][1][m][n][j] * rs; h[n * 4 + j] = siluf_(g) * uu; }
                u32x4 w; w.x = cvt_pk_bf16(h[0], h[1]); w.y = cvt_pk_bf16(h[2], h[3]); w.z = cvt_pk_bf16(h[4], h[5]); w.w = cvt_pk_bf16(h[6], h[7]);
                *(u32x4*)(HB + (size_t)(u.orow + r) * DEXP + (u.ocol >> 1) + wc * 32 + 8 * fq) = w; }
    }
};
struct EpiDN {
    static constexpr bool PERM = true;
    bf16_t* Y; const float* lw; const LAS int* cnt;
    __device__ __forceinline__ void operator()(const Acc& acc, const Unit& u, int wr, int wc, int fr, int fq) const {
        const int n_e = cnt[u.e];
#pragma unroll
        for (int ai = 0; ai < 2; ++ai)
#pragma unroll
            for (int m = 0; m < 4; ++m) {
                const int r = ai * HALF + wr * 64 + m * 16 + fr, pos = u.rl * BM + r; const float ws = pos < n_e ? lw[(size_t)u.e * CAP + pos] : 0.f;
                bf16_t* rowp = Y + (size_t)(u.orow + r) * D + u.ocol + wc * 32 + 8 * fq;
#pragma unroll
                for (int bj = 0; bj < 2; ++bj) { const f32x4 v0 = acc[ai][bj][m][0] * ws, v1 = acc[ai][bj][m][1] * ws;
                    u32x4 w; w.x = cvt_pk_bf16(v0[0], v0[1]); w.y = cvt_pk_bf16(v0[2], v0[3]); w.z = cvt_pk_bf16(v1[0], v1[1]); w.w = cvt_pk_bf16(v1[2], v1[3]);
                    *(u32x4*)(rowp + bj * HALF) = w; } }
    }
};

template <class Epi, class Sched, bool ALIGN_EPI>
__device__ __forceinline__ void gemm_phase(LAS unsigned char* lds, const bf16_t* A, const bf16_t* Bt, const int K, const Sched& S, const Epi& E) {
    const int tid = threadIdx.x, wid = __builtin_amdgcn_readfirstlane(tid >> 6), lane = tid & 63, wr = wid >> 2, wc = wid & 3, fr = lane & 15, fq = lane >> 4;
    const int nt = K / BK;
    unsigned voffB[2], vA0[2], vA1[2];
#pragma unroll
    for (int i = 0; i < 2; ++i) { int R, C; stage_rc(tid * 16 + i * 8192, R, C); const int Rb = Epi::PERM ? ((R & ~31) + perm32(R & 31)) : R;
        vA0[i] = (unsigned)(R * K + C) * 2u; vA1[i] = vA0[i]; voffB[i] = (unsigned)(Rb * K + C) * 2u; }
#define PG8_FILL(u) do { if constexpr (Sched::GATHER) { int tv_ = tid; asm volatile("" : "+v"(tv_)); _Pragma("unroll") for (int i = 0; i < 2; ++i) { int R, C; stage_rc(tv_ * 16 + i * 8192, R, C); \
        vA0[i] = S.aoff(u, R) + (unsigned)C * 2u; vA1[i] = S.aoff(u, HALF + R) + (unsigned)C * 2u; } } } while (0)
    const size_t kstep = (size_t)(BK * 2);
    const size_t hstep = (size_t)HALF * K * 2;
    const unsigned ldsw = (unsigned)wid * 1024u;
    const int aoff = lds_byte(wr * 64 + fr, fq * 8), boff = lds_byte(wc * 32 + fr, fq * 8);
#define PG8_SA(b, h) (((b) * 2 + (h)) * HTB)
#define PG8_SB(b, h) ((4 + (b) * 2 + (h)) * HTB)
#define PG8_STAGE(bufoff, gbase, voff) do { _Pragma("unroll") for (int _i = 0; _i < 2; ++_i) \
        __builtin_amdgcn_global_load_lds((const unsigned*)((const char*)(gbase) + (voff)[_i]), (LAS unsigned*)(lds + (bufoff) + ldsw + _i * 8192), 16, 0, 0); } while (0)
#define PG8_LDA(dst, b, h) do { _Pragma("unroll") for (int m = 0; m < 4; ++m) _Pragma("unroll") for (int k = 0; k < 2; ++k) dst[m][k] = *(const LAS bf16x8*)(lds + PG8_SA(b, h) + aoff + m * 2048 + k * 1024); } while (0)
#define PG8_LDB(dst, b, h) do { _Pragma("unroll") for (int n = 0; n < 2; ++n) _Pragma("unroll") for (int k = 0; k < 2; ++k) dst[n][k] = *(const LAS bf16x8*)(lds + PG8_SB(b, h) + boff + n * 2048 + k * 1024); } while (0)
#define PG8_MMA(ai, bj, At, Bt_) do { __builtin_amdgcn_s_setprio(1); _Pragma("unroll") for (int m = 0; m < 4; ++m) _Pragma("unroll") for (int n = 0; n < 2; ++n) _Pragma("unroll") for (int k = 0; k < 2; ++k) \
        acc[ai][bj][m][n] = __builtin_amdgcn_mfma_f32_16x16x32_bf16(Bt_[n][k], At[m][k], acc[ai][bj][m][n], 0, 0, 0); __builtin_amdgcn_s_setprio(0); } while (0)
#define PG8_WAIT_V(n) asm volatile("s_waitcnt vmcnt(" #n ")" ::: "memory")
#define PG8_WAIT_L(n) asm volatile("s_waitcnt lgkmcnt(" #n ")" ::: "memory")
#define PG8_BAR __builtin_amdgcn_s_barrier()
#define PG8_SCHED __builtin_amdgcn_sched_barrier(0)
    Unit cur, nxt; int ui = 0;
    if (!S.next(0, cur)) return;
    f32x4 acc[2][2][4][2];
#pragma unroll
    for (int a = 0; a < 2; ++a)
#pragma unroll
        for (int b = 0; b < 2; ++b)
#pragma unroll
            for (int m = 0; m < 4; ++m)
#pragma unroll
                for (int n = 0; n < 2; ++n) acc[a][b][m][n] = (f32x4){0.f, 0.f, 0.f, 0.f};
    bf16x8 At[4][2], B0[2][2], B1[2][2];
    PG8_FILL(cur);
    const char* cA0 = (const char*)A + S.abase(cur); const char* cA1 = cA0 + (Sched::GATHER ? (size_t)0 : hstep); const char* cB = (const char*)Bt + cur.boff;
    PG8_STAGE(PG8_SB(0, 0), cB, voffB); PG8_STAGE(PG8_SB(0, 1), cB + hstep, voffB); PG8_STAGE(PG8_SA(0, 0), cA0, vA0); PG8_STAGE(PG8_SA(0, 1), cA1, vA1);
    if (wr == 1) PG8_BAR;
    PG8_WAIT_V(2); PG8_BAR;
    PG8_STAGE(PG8_SB(1, 0), cB + kstep, voffB); PG8_STAGE(PG8_SA(1, 0), cA0 + kstep, vA0); PG8_STAGE(PG8_SB(1, 1), cB + hstep + kstep, voffB);
    PG8_WAIT_V(6); PG8_BAR;
    for (;;) {
        const bool has_next = S.next(ui + 1, nxt);
        const char* nB = has_next ? (const char*)Bt + nxt.boff : cB;
        const char* nA0 = has_next ? (const char*)A + S.abase(nxt) : cA0; const char* nA1 = nA0 + (Sched::GATHER ? (size_t)0 : hstep);
        for (int t = 0; t < nt; t += 2) {
            const bool last = (t == nt - 2);
            const char* a1 = cA1 + (size_t)(t + 1) * kstep;
            const char* a2 = last ? nA0 : cA0 + (size_t)(t + 2) * kstep; const char* a2h = last ? nA1 : cA1 + (size_t)(t + 2) * kstep; const char* b2 = last ? nB : cB + (size_t)(t + 2) * kstep;
            const char* a3 = a2 + kstep; const char* b3 = b2 + kstep;
            PG8_LDB(B0, 0, 0); PG8_LDB(B1, 0, 1); PG8_SCHED; PG8_LDA(At, 0, 0); PG8_STAGE(PG8_SA(1, 1), a1, vA1);
            if (last && has_next) PG8_FILL(nxt);
            PG8_WAIT_V(8); PG8_WAIT_L(0); PG8_BAR; PG8_MMA(0, 0, At, B0); PG8_MMA(0, 1, At, B1); PG8_BAR; PG8_SCHED;
            PG8_LDA(At, 0, 1); PG8_STAGE(PG8_SB(0, 0), b2, voffB); PG8_STAGE(PG8_SB(0, 1), b2 + hstep, voffB); PG8_STAGE(PG8_SA(0, 0), a2, vA0);
            PG8_WAIT_V(8); PG8_WAIT_L(0); PG8_BAR; PG8_MMA(1, 0, At, B0); PG8_MMA(1, 1, At, B1); PG8_BAR; PG8_SCHED;
            PG8_LDB(B0, 1, 0); PG8_LDB(B1, 1, 1); PG8_SCHED; PG8_LDA(At, 1, 0); PG8_STAGE(PG8_SA(0, 1), a2h, vA1);
            PG8_WAIT_V(8); PG8_WAIT_L(0); PG8_BAR; PG8_MMA(0, 0, At, B0); PG8_MMA(0, 1, At, B1); PG8_BAR; PG8_SCHED;
            PG8_LDA(At, 1, 1); PG8_STAGE(PG8_SB(1, 0), b3, voffB); PG8_STAGE(PG8_SB(1, 1), b3 + hstep, voffB); PG8_STAGE(PG8_SA(1, 0), a3, vA0);
            PG8_WAIT_V(8); PG8_WAIT_L(0); PG8_BAR; PG8_MMA(1, 0, At, B0); PG8_MMA(1, 1, At, B1); PG8_BAR; PG8_SCHED;
        }
        if constexpr (ALIGN_EPI) { if (wr == 0) PG8_BAR; }
        E(acc, cur, wr, wc, fr, fq);
        if (!has_next) break;
#pragma unroll
        for (int a = 0; a < 2; ++a)
#pragma unroll
            for (int b = 0; b < 2; ++b)
#pragma unroll
                for (int m = 0; m < 4; ++m)
#pragma unroll
                    for (int n = 0; n < 2; ++n) acc[a][b][m][n] = (f32x4){0.f, 0.f, 0.f, 0.f};
        cur = nxt; cB = nB; cA0 = nA0; cA1 = nA1; ++ui;
        if constexpr (ALIGN_EPI) { if (wr == 1) PG8_BAR; }
    }
    PG8_WAIT_V(0);
    if constexpr (!ALIGN_EPI) { if (wr == 0) PG8_BAR; }
    PG8_BAR;
#undef PG8_FILL
#undef PG8_SA
#undef PG8_SB
#undef PG8_STAGE
#undef PG8_LDA
#undef PG8_LDB
#undef PG8_MMA
#undef PG8_WAIT_V
#undef PG8_WAIT_L
#undef PG8_BAR
#undef PG8_SCHED
}
}


#define XB_TMO      128
#define XB_XCNT(j)  (256  + 64 * (j))
#define XB_XSUB(j)  (1280 + 64 * (j))
#define XB_XGEN(j)  (2304 + 64 * (j))
#define XB_TOP      3328
#define XB_TOPGEN   3392
#define XB_SPIN_CAP (1u << 18)
__device__ __forceinline__ unsigned xb_ld(unsigned* p)              { return __hip_atomic_load(p, __ATOMIC_RELAXED, __HIP_MEMORY_SCOPE_AGENT); }
__device__ __forceinline__ unsigned xb_add(unsigned* p, unsigned v) { return __hip_atomic_fetch_add(p, v, __ATOMIC_RELAXED, __HIP_MEMORY_SCOPE_AGENT); }
__device__ __forceinline__ unsigned xb_xcc_id() { return (unsigned)__builtin_amdgcn_s_getreg((3 << 11) | 20) & 0xFu; }
#define XB_SPIN(cond, bar) do { unsigned _sp = 0; while (cond) { __builtin_amdgcn_s_sleep(1); \
    if ((++_sp & 255u) == 0u) { if (xb_ld(&(bar)[XB_TMO])) break; if (_sp > XB_SPIN_CAP) { atomicAdd(&(bar)[XB_TMO], 1u); break; } } } } while (0)
struct XcdBarrier { unsigned* bar; unsigned x; volatile LAS unsigned* st; };
__device__ __forceinline__ XcdBarrier xcd_barrier_post(unsigned* bar, volatile LAS unsigned* st) {
    XcdBarrier b; b.bar = bar; b.x = xb_xcc_id(); b.st = st;
    if (threadIdx.x == 0) (void)xb_add(&bar[XB_XCNT(b.x)], 1u);
    return b;
}
__device__ __forceinline__ void xcd_barrier_complete(unsigned* bar, unsigned x, unsigned& nloc, unsigned& nx) {
    const unsigned G = gridDim.x * gridDim.y * gridDim.z;
    unsigned sum, cnt, mine, sp = 0u;
    for (;;) {
        sum = 0u; cnt = 0u; mine = 0u;
#pragma unroll
        for (unsigned j = 0; j < 16; ++j) { const unsigned c = xb_ld(&bar[XB_XCNT(j)]); sum += c; cnt += (c > 0u) ? 1u : 0u; mine = (j == x) ? c : mine; }
        if (sum == G) break;
        __builtin_amdgcn_s_sleep(1);
        if ((++sp & 255u) == 0u) { if (xb_ld(&bar[XB_TMO])) break; if (sp > XB_SPIN_CAP) { atomicAdd(&bar[XB_TMO], 1u); break; } }
    }
    nloc = mine > 0u ? mine : 1u; nx = cnt > 0u ? cnt : 1u;
}
__device__ __forceinline__ void xcd_barrier(const XcdBarrier& b) {
    asm volatile("s_waitcnt vmcnt(0)" ::: "memory");
    __syncthreads();
    if (threadIdx.x == 0) {
        unsigned* bar = b.bar;
        __builtin_amdgcn_s_waitcnt(0);
        unsigned nloc = b.st[0], nx = b.st[1];
        if (nloc == 0u) { xcd_barrier_complete(bar, b.x, nloc, nx); b.st[0] = nloc; b.st[1] = nx; }
        const unsigned old = xb_add(&bar[XB_XSUB(b.x)], 1u);
        const unsigned gen = old / nloc;
        if (old + 1u == (gen + 1u) * nloc) {
            __builtin_amdgcn_fence(__ATOMIC_RELEASE, "agent");
            asm volatile("s_waitcnt vmcnt(0)" ::: "memory");
            const unsigned og = xb_add(&bar[XB_TOP], 1u);
            const unsigned tg = og / nx;
            if (og + 1u == (tg + 1u) * nx) xb_add(&bar[XB_TOPGEN], 1u);
            else XB_SPIN(xb_ld(&bar[XB_TOPGEN]) == tg, bar);
            __builtin_amdgcn_fence(__ATOMIC_ACQUIRE, "agent");
            xb_add(&bar[XB_XGEN(b.x)], 1u);
            asm volatile("s_waitcnt vmcnt(0)" ::: "memory");
        } else {
            XB_SPIN(xb_ld(&bar[XB_XGEN(b.x)]) == gen, bar);
            __builtin_amdgcn_fence(__ATOMIC_ACQUIRE, "agent");
            asm volatile("s_waitcnt vmcnt(0)" ::: "memory");
        }
    }
    __syncthreads();
}

struct Args { const float* in[23]; float* out; unsigned char* ws; int ph_lo, ph_hi; };
enum { PH_PRO = 0, PH_IN0, PH_MIX0, PH_OUT0, PH_R1, PH_GU0, PH_DN0, PH_R2, PH_IN1, PH_MIX1, PH_OUT1, PH_R3, PH_GU1, PH_DN1, PH_R4, NPH };

struct Frame {
    LAS unsigned char* lds; int tid, lane, wave, vcu, G;
    const float* const* in; float* out; unsigned char* ws;
};

__device__ __forceinline__ void transpose_item(const float* W, int K, int N, const float* kscale, bf16_t* WT, int dest_row0, LAS float* scr, int kb, int nb, int lane) {
    const int k0 = 64 * kb, n0 = 32 * nb;
    float tv[32];
#pragma unroll
    for (int i = 0; i < 32; ++i) tv[i] = W[(size_t)(k0 + 2 * i + (lane >> 5)) * N + n0 + (lane & 31)];
    if (kscale) {
#pragma unroll
        for (int i = 0; i < 32; ++i) tv[i] *= kscale[k0 + 2 * i + (lane >> 5)]; }
#pragma unroll
    for (int i = 0; i < 32; ++i) scr[(2 * i + (lane >> 5)) * 33 + (lane & 31)] = tv[i];
    LDS_WAIT(); asm volatile("" ::: "memory");
    const int c = lane & 7;
#pragma unroll
    for (int j = 0; j < 4; ++j) { const int n = (lane >> 3) + 8 * j; const LAS float* s = scr + (8 * c) * 33 + n;
        u32x4 o; o.x = pk2(s[0 * 33], s[1 * 33]); o.y = pk2(s[2 * 33], s[3 * 33]); o.z = pk2(s[4 * 33], s[5 * 33]); o.w = pk2(s[6 * 33], s[7 * 33]);
        *(u32x4*)(WT + (size_t)(dest_row0 + n) * K + k0 + 8 * c) = o; }
    LDS_WAIT(); asm volatile("" ::: "memory");
}
__device__ __forceinline__ void moe_convert(Frame& F, int layer, int wg, int nwg) {
    LAS float* scr = (LAS float*)(F.lds + F.wave * 16384);
    const int gw = wg * 8 + F.wave, NGW = nwg * 8;
    const float* gffn = F.in[2] + layer * D;
    const float* Wg = F.in[20] + (size_t)layer * NEXP * D * DEXP; const float* Wu = F.in[21] + (size_t)layer * NEXP * D * DEXP; const float* Wd = F.in[22] + (size_t)layer * NEXP * DEXP * D;
    bf16_t* WGU = (bf16_t*)(F.ws + WS_WGU); bf16_t* WDN = (bf16_t*)(F.ws + WS_WDN);
    for (int it = gw; it < 3 * 8192; it += NGW) {
        const int which = it >> 13, r = it & 8191, e = r >> 8, q = r & 255;
        if (which < 2) { const int kb = q >> 4, nb = q & 15, n0 = nb * 32;
            const int dest = e * 1024 + (n0 >> 7) * 256 + (which ? 128 : 0) + (n0 & 127);
            transpose_item((which ? Wu : Wg) + (size_t)e * D * DEXP, D, DEXP, gffn, WGU, dest, scr, kb, nb, F.lane);
        } else { const int kb = q >> 5, nb = q & 31;
            transpose_item(Wd + (size_t)e * DEXP * D, DEXP, D, nullptr, WDN, e * 1024 + nb * 32, scr, kb, nb, F.lane); }
    }
}
__device__ __forceinline__ void p_prologue(Frame& F) {
    LAS float* scr = (LAS float*)(F.lds + F.wave * 16384);
    const int gw = F.vcu * 8 + F.wave, NGW = F.G * 8;
    constexpr int I0 = 16 * 80, I1 = 16 * 32, I2 = 16 * 128, I3 = 16 * 32;
    for (int it = gw; it < I0 + I1 + I2 + I3; it += NGW) {
        int r = it;
        if (r < I0) { transpose_item(F.in[4], D, AB_IN, F.in[1], (bf16_t*)(F.ws + WS_WIN0), (r % 80) * 32, scr, r / 80, r % 80, F.lane); continue; } r -= I0;
        if (r < I1) { transpose_item(F.in[13], D, D, nullptr, (bf16_t*)(F.ws + WS_WOUT0), (r % 32) * 32, scr, r / 32, r % 32, F.lane); continue; } r -= I1;
        if (r < I2) { transpose_item(F.in[14], D, C_IN, F.in[1] + D, (bf16_t*)(F.ws + WS_WIN1), (r % 128) * 32, scr, r / 128, r % 128, F.lane); continue; } r -= I2;
        transpose_item(F.in[17], D, D, nullptr, (bf16_t*)(F.ws + WS_WOUT1), (r % 32) * 32, scr, r / 32, r % 32, F.lane);
    }
    moe_convert(F, 0, F.vcu, F.G);
    { const float* x = F.in[0]; bf16_t* XB = (bf16_t*)(F.ws + WS_XB); float* rstd = (float*)(F.ws + WS_RSTD);
      for (int m = gw; m < T; m += NGW) { const f32x4* xr = (const f32x4*)(x + (size_t)m * D) + F.lane; f32x4 v[4]; float s = 0.f;
#pragma unroll
          for (int j = 0; j < 4; ++j) { v[j] = xr[64 * j]; s += (v[j].x * v[j].x + v[j].y * v[j].y) + (v[j].z * v[j].z + v[j].w * v[j].w); }
          s = wave_sum(s); if (F.lane == 0) rstd[m] = rsqrtf(s * (1.f / D) + EPS);
          u32x2* o8 = (u32x2*)(XB + (size_t)m * D) + F.lane;
#pragma unroll
          for (int j = 0; j < 4; ++j) o8[64 * j] = (u32x2){pk2(v[j].x, v[j].y), pk2(v[j].z, v[j].w)}; } }
    const int gt = F.vcu * 512 + F.tid, NGT = F.G * 512;
    { float* lb = (float*)(F.ws + WS_LB); const float* l = F.in[15];
      for (int c = gt; c < 1024; c += NGT) { const float a = l[c], b = l[1024 + c], mx = fmaxf(a, b), ea = __expf(a - mx), eb = __expf(b - mx); lb[c] = ea / (ea + eb); } }
    { bf16_t* RWH = (bf16_t*)(F.ws + WS_RWH); bf16_t* RWL = (bf16_t*)(F.ws + WS_RWL);
      for (int i = gt; i < 2 * 36 * 1024; i += NGT) { const int l = i / (36 * 1024), r = i % (36 * 1024), j = r >> 10, c = r & 1023; const float g = F.in[2][l * D + c];
          const float wv = j < 4 ? g * F.in[18][((size_t)l * D + c) * 4 + j] : g * F.in[19][((size_t)l * D + c) * 32 + (j - 4)];
          const unsigned hi = f2bf(wv); RWH[i] = (bf16_t)hi; RWL[i] = (bf16_t)f2bf(wv - bf2f(hi)); } }
}

__device__ __forceinline__ void moe_tables(Frame& F, int layer) {
    LAS int* ts = (LAS int*)(F.lds + TS_OFF); LAS int* cn = ts + 40;
    const unsigned* cnt = (const unsigned*)(F.ws + WS_CTL) + CW_CNT + layer * 32;
    __syncthreads();
    if (F.tid < 32) cn[F.tid] = (int)__hip_atomic_load(cnt + F.tid, __ATOMIC_RELAXED, __HIP_MEMORY_SCOPE_AGENT);
    __syncthreads();
    if (F.tid == 0) { int s = 0; for (int e = 0; e < 32; ++e) { ts[e] = s; s += (cn[e] + 255) >> 8; } ts[32] = s; }
    __syncthreads();
}

__device__ __forceinline__ void p_router(Frame& F, int layer, int dummy = 0) {
    const float* H = F.out;
    unsigned* cnt = (unsigned*)(F.ws + WS_CTL) + CW_CNT + (dummy ? 64 : layer * 32);
    const size_t doff = dummy ? (WS_END - WS_TOKINFO) : 0;
    int* ltok = (int*)(F.ws + WS_LTOK + doff); float* lrstd = (float*)(F.ws + WS_LRSTD + doff); float* lw = (float*)(F.ws + WS_LW + doff); int* tokinfo = (int*)(F.ws + WS_TOKINFO + doff);
    LAS unsigned char* L = F.lds;
    const int tid = F.tid, l = F.lane, w = F.wave, i16 = l & 15, q4 = l >> 4;
    for (int tile = F.vcu; tile < T / 128; tile += F.G) {
        __syncthreads();
        { const u32x4* gh = (const u32x4*)(F.ws + WS_RWH + (size_t)layer * 36 * 2048); const u32x4* gl = (const u32x4*)(F.ws + WS_RWL + (size_t)layer * 36 * 2048);
          for (int i = tid; i < 36 * 128; i += 512) { const int n = i >> 7, c = i & 127, pc = c ^ (n & 15);
              *(LAS u32x4*)(L + n * 2048 + pc * 16) = gh[i]; *(LAS u32x4*)(L + 73728 + n * 2048 + pc * 16) = gl[i]; } }
        __syncthreads();
        const int row = tile * 128 + w * 16 + i16;
        const f32x4* hp = (const f32x4*)(H + (size_t)row * D + 8 * q4);
        f32x4 acc[3]; acc[0] = (f32x4){0.f, 0.f, 0.f, 0.f}; acc[1] = acc[0]; acc[2] = acc[0];
        int nrow[3];
#pragma unroll
        for (int nb = 0; nb < 3; ++nb) { const int n = 16 * nb + i16; nrow[nb] = n > 35 ? 35 : n; }
        float ss = 0.f;
#pragma unroll 4
        for (int ks = 0; ks < 32; ++ks) {
            const f32x4 x0 = hp[8 * ks], x1 = hp[8 * ks + 1];
            const float xv[8] = {x0.x, x0.y, x0.z, x0.w, x1.x, x1.y, x1.z, x1.w};
            unsigned hw[4], lwv[4];
#pragma unroll
            for (int p = 0; p < 4; ++p) { const float a = xv[2 * p], b = xv[2 * p + 1]; ss += a * a + b * b; const unsigned hpk = cvt_pk_bf16(a, b); hw[p] = hpk;
                lwv[p] = cvt_pk_bf16(a - __uint_as_float(hpk << 16), b - __uint_as_float(hpk & 0xffff0000u)); }
            const bf16x8 ah = __builtin_bit_cast(bf16x8, ((u32x4){hw[0], hw[1], hw[2], hw[3]})), al = __builtin_bit_cast(bf16x8, ((u32x4){lwv[0], lwv[1], lwv[2], lwv[3]}));
#pragma unroll
            for (int nb = 0; nb < 3; ++nb) { const int n = nrow[nb], pc = (4 * ks + q4) ^ (n & 15);
                const bf16x8 bh = *(const LAS bf16x8*)(L + n * 2048 + pc * 16), bl = *(const LAS bf16x8*)(L + 73728 + n * 2048 + pc * 16);
                acc[nb] = MFMA16(ah, bh, acc[nb]); acc[nb] = MFMA16(al, bh, acc[nb]); acc[nb] = MFMA16(ah, bl, acc[nb]); }
        }
        ss += __shfl_xor(ss, 16); ss += __shfl_xor(ss, 32);
        __syncthreads();
        LAS float* sc = (LAS float*)(L + w * 4096);
#pragma unroll
        for (int nb = 0; nb < 3; ++nb)
#pragma unroll
            for (int rg = 0; rg < 4; ++rg) sc[(4 * q4 + rg) * 49 + 16 * nb + i16] = acc[nb][rg];
        const float rstd = rsqrtf(ss * (1.f / D) + EPS);
        if (l < 16) {
            const LAS float* lr = sc + l * 49;
            float lg[4];
#pragma unroll
            for (int gi = 0; gi < 4; ++gi) lg[gi] = lr[gi] * rstd;
            int gidx = 0; float gmax = lg[0];
#pragma unroll
            for (int gi = 1; gi < 4; ++gi) if (lg[gi] > gmax) { gmax = lg[gi]; gidx = gi; }
            float gs = 0.f;
#pragma unroll
            for (int gi = 0; gi < 4; ++gi) gs += __expf(lg[gi] - gmax);
            const float ggate = 1.f / gs;
            float le[8];
#pragma unroll
            for (int e = 0; e < 8; ++e) le[e] = lr[4 + gidx * 8 + e] * rstd;
            int i0 = 0; float v0 = le[0];
#pragma unroll
            for (int e = 1; e < 8; ++e) if (le[e] > v0) { v0 = le[e]; i0 = e; }
            int i1 = -1; float v1 = -3.0e38f;
#pragma unroll
            for (int e = 0; e < 8; ++e) if (e != i0 && le[e] > v1) { v1 = le[e]; i1 = e; }
            const float ex = __expf(v1 - v0), w0 = ggate / (1.f + ex), w1 = ggate * ex / (1.f + ex);
            const int m = row;
            if (!dummy) ((float*)(F.ws + WS_RSTD))[m] = rstd;
            const int e0 = gidx * 8 + i0, e1 = gidx * 8 + i1;
            const unsigned p0 = atomicAdd(cnt + e0, 1u), p1 = atomicAdd(cnt + e1, 1u);
            ltok[(size_t)e0 * CAP + p0] = m; lrstd[(size_t)e0 * CAP + p0] = rstd; lw[(size_t)e0 * CAP + p0] = w0;
            ltok[(size_t)e1 * CAP + p1] = m; lrstd[(size_t)e1 * CAP + p1] = rstd; lw[(size_t)e1 * CAP + p1] = w1;
            tokinfo[2 * m] = e0 * CAP + (int)p0; tokinfo[2 * m + 1] = e1 * CAP + (int)p1;
        }
    }
    __syncthreads();
}
__device__ __forceinline__ void p_combine(Frame& F, int layer, int mode, int dry = 0) {
    moe_tables(F, layer);
    const LAS int* ts = (const LAS int*)(F.lds + TS_OFF);
    const int gw = F.vcu * 8 + F.wave, NGW = F.G * 8;
    float* H = F.out; const bf16_t* Y = (const bf16_t*)(F.ws + WS_Y); const int* tokinfo = (const int*)(F.ws + WS_TOKINFO);
    bf16_t* XB = (bf16_t*)(F.ws + WS_XB); float* rstd = (float*)(F.ws + WS_RSTD); const float* gfin = F.in[3];
    for (int m = gw; m < T; m += NGW) {
        const int t0 = tokinfo[2 * m], t1 = tokinfo[2 * m + 1];
        const size_t s0 = (size_t)ts[t0 >> 15] * 256 + (t0 & (CAP - 1)), s1 = (size_t)ts[t1 >> 15] * 256 + (t1 & (CAP - 1));
        f32x4* hr = (f32x4*)(H + (size_t)m * D) + F.lane; const u32x2* y0 = (const u32x2*)(Y + s0 * D) + F.lane; const u32x2* y1 = (const u32x2*)(Y + s1 * D) + F.lane;
        f32x4 v[4]; float s = 0.f;
#pragma unroll
        for (int j = 0; j < 4; ++j) { v[j] = hr[64 * j]; u32x2 a = y0[64 * j], b = y1[64 * j]; if (dry) { a = (u32x2){0u, 0u}; b = a; }
            v[j].x += bf2f(a.x & 0xffffu) + bf2f(b.x & 0xffffu); v[j].y += bf2f(a.x >> 16) + bf2f(b.x >> 16); v[j].z += bf2f(a.y & 0xffffu) + bf2f(b.y & 0xffffu); v[j].w += bf2f(a.y >> 16) + bf2f(b.y >> 16);
            s += (v[j].x * v[j].x + v[j].y * v[j].y) + (v[j].z * v[j].z + v[j].w * v[j].w); }
        const float rs = rsqrtf(wave_sum(s) * (1.f / D) + EPS);
        if (mode == 0) {
            if (F.lane == 0) rstd[m] = rs;
            u32x2* o8 = (u32x2*)(XB + (size_t)m * D) + F.lane;
#pragma unroll
            for (int j = 0; j < 4; ++j) { hr[64 * j] = v[j]; o8[64 * j] = (u32x2){pk2(v[j].x, v[j].y), pk2(v[j].z, v[j].w)}; }
        } else {
            const f32x4* g4 = (const f32x4*)gfin + F.lane;
#pragma unroll
            for (int j = 0; j < 4; ++j) { const f32x4 g = g4[64 * j]; hr[64 * j] = dry ? v[j] : (f32x4){v[j].x * rs * g.x, v[j].y * rs * g.y, v[j].z * rs * g.z, v[j].w * rs * g.w}; }
        }
    }
}

__device__ __forceinline__ void mix_rglru_item(Frame& F, int b, int nb) {
    LAS float* L = (LAS float*)F.lds;
    LAS float* wa = L; LAS float* wx = L + 4096; LAS float* xat = L + 8192;   LAS float* xc = xat + 67 * 64; LAS float* ga = xc + 4096; LAS float* av = ga + 4096; LAS float* uv = av + 4096; LAS float* prm = uv + 4096;
    const bf16_t* Z = (const bf16_t*)(F.ws + WS_Z); bf16_t* CAT = (bf16_t*)(F.ws + WS_CAT);
    const int tid = F.tid;
    __syncthreads();
    for (int i = tid; i < 4096; i += 512) { wa[i] = F.in[7][nb * 4096 + i]; wx[i] = F.in[9][nb * 4096 + i]; }
    if (tid < 64) { const int c = nb * 64 + tid; prm[tid] = F.in[6][c]; prm[64 + tid] = F.in[5][c]; prm[128 + tid] = F.in[5][512 + c]; prm[192 + tid] = F.in[5][1024 + c]; prm[256 + tid] = F.in[5][1536 + c];
        prm[320 + tid] = F.in[8][c]; prm[384 + tid] = F.in[10][c]; const float lam = F.in[11][c]; prm[448 + tid] = fminf(lam, 0.f) - log1pf(__expf(-fabsf(lam))); }
    float hcar = 0.f;
    for (int t0 = 0; t0 < SEQ; t0 += 64) {
        __syncthreads();
        for (int i = tid; i < 67 * 64; i += 512) { const int r = i >> 6, c = i & 63, tg = t0 - 3 + r; xat[i] = tg >= 0 ? bf2f(Z[((size_t)b * SEQ + tg) * AB_IN + nb * 64 + c]) : 0.f; }
        for (int i = tid; i < 4096; i += 512) { const int r = i >> 6, c = i & 63; ga[i] = bf2f(Z[((size_t)b * SEQ + t0 + r) * AB_IN + 512 + nb * 64 + c]); }
        __syncthreads();
        for (int i = tid; i < 4096; i += 512) { const int r = i >> 6, c = i & 63; xc[i] = prm[c] + prm[64 + c] * xat[r * 64 + c] + prm[128 + c] * xat[(r + 1) * 64 + c] + prm[192 + c] * xat[(r + 2) * 64 + c] + prm[256 + c] * xat[(r + 3) * 64 + c]; }
        __syncthreads();
        { const int tok = tid >> 3, dg = tid & 7; float aa[8], ax[8];
#pragma unroll
          for (int j = 0; j < 8; ++j) { aa[j] = 0.f; ax[j] = 0.f; }
          for (int c = 0; c < 64; ++c) { const float xv = xc[tok * 64 + c]; const LAS f32x4* pa = (const LAS f32x4*)(wa + c * 64 + dg * 8); const LAS f32x4* px = (const LAS f32x4*)(wx + c * 64 + dg * 8);
              const f32x4 a0 = pa[0], a1 = pa[1], x0 = px[0], x1 = px[1];
              aa[0] += xv * a0.x; aa[1] += xv * a0.y; aa[2] += xv * a0.z; aa[3] += xv * a0.w; aa[4] += xv * a1.x; aa[5] += xv * a1.y; aa[6] += xv * a1.z; aa[7] += xv * a1.w;
              ax[0] += xv * x0.x; ax[1] += xv * x0.y; ax[2] += xv * x0.z; ax[3] += xv * x0.w; ax[4] += xv * x1.x; ax[5] += xv * x1.y; ax[6] += xv * x1.z; ax[7] += xv * x1.w; }
#pragma unroll
          for (int j = 0; j < 8; ++j) { const int d = dg * 8 + j; const float r = sigmoidf_(aa[j] + prm[320 + d]), ig = sigmoidf_(ax[j] + prm[384 + d]);
              const float la = 8.0f * r * prm[448 + d]; av[tok * 64 + d] = __expf(la); uv[tok * 64 + d] = sqrtf(fmaxf(-expm1f(2.0f * la), 0.f)) * (ig * xc[tok * 64 + d]); } }
        __syncthreads();
        if (tid < 64) { for (int r = 0; r < 64; ++r) { hcar = av[r * 64 + tid] * hcar + uv[r * 64 + tid]; av[r * 64 + tid] = hcar; } }
        __syncthreads();
        for (int i = tid; i < 4096; i += 512) { const int r = i >> 6, c = i & 63; CAT[((size_t)b * SEQ + t0 + r) * D + nb * 64 + c] = (bf16_t)f2bf(av[i] * gelu_tanh(ga[i])); }
    }
    __syncthreads();
}
__device__ __forceinline__ void mix_attn_item(Frame& F, int b, int c, int h) {
    LAS float* Ks = (LAS float*)F.lds;   LAS float* Vs = Ks + 64 * 68;   LAS float* bs = Vs + 4096;   LAS float* Ss = bs + 520;
    const bf16_t* Z = (const bf16_t*)(F.ws + WS_Z); bf16_t* CAT = (bf16_t*)(F.ws + WS_CAT);
    const int tid = F.tid, t = tid >> 3, sub = tid & 7;
    __syncthreads();
    for (int i = tid; i < 513; i += 512) bs[i] = F.in[12][h * 513 + i];
    unsigned q2[32]; float o[64];
    { const unsigned* qp = (const unsigned*)(Z + ((size_t)b * SEQ + c * 64 + t) * AB_IN + 1024 + h * 64);
#pragma unroll
      for (int d = 0; d < 32; ++d) q2[d] = qp[d];
#pragma unroll
      for (int d = 0; d < 64; ++d) o[d] = 0.f; }
    float mrun = -3.0e38f, lrun = 0.f;
    for (int kc = (c >= 8 ? c - 8 : 0); kc <= c; ++kc) {
        __syncthreads();
        for (int i = tid; i < 4096; i += 512) { const int s = i >> 6, d = i & 63; const size_t base = ((size_t)b * SEQ + kc * 64 + s) * AB_IN + h * 64 + d;
            Ks[s * 68 + d] = bf2f(Z[base + 1536]); Vs[s * 64 + d] = bf2f(Z[base + 2048]); }
        __syncthreads();
        float tmax = -3.0e38f;
#pragma unroll 1
        for (int jj = 0; jj < 8; ++jj) { const int s = sub + 8 * jj; const LAS f32x4* kp = (const LAS f32x4*)(Ks + s * 68); float a = 0.f;
#pragma unroll
            for (int d4 = 0; d4 < 16; ++d4) { const f32x4 kv = kp[d4]; a += bf2f(q2[2 * d4] & 0xffffu) * kv.x + bf2f(q2[2 * d4] >> 16) * kv.y + bf2f(q2[2 * d4 + 1] & 0xffffu) * kv.z + bf2f(q2[2 * d4 + 1] >> 16) * kv.w; }
            a *= 0.125f;
            int rel = t - ((kc - c) * 64 + s); rel = rel < -256 ? -256 : (rel > 256 ? 256 : rel);
            a += bs[rel + 256]; Ss[t * 65 + s] = a; tmax = fmaxf(tmax, a); }
        const float mnew = fmaxf(mrun, tmax), f = __expf(mrun - mnew);
        lrun *= f;
#pragma unroll
        for (int d = 0; d < 64; ++d) o[d] *= f;
#pragma unroll 1
        for (int jj = 0; jj < 8; ++jj) { const int s = sub + 8 * jj; const float p = __expf(Ss[t * 65 + s] - mnew); lrun += p; const LAS f32x4* vp = (const LAS f32x4*)(Vs + s * 64);
#pragma unroll
            for (int d4 = 0; d4 < 16; ++d4) { const f32x4 vv = vp[d4]; o[4 * d4] += p * vv.x; o[4 * d4 + 1] += p * vv.y; o[4 * d4 + 2] += p * vv.z; o[4 * d4 + 3] += p * vv.w; } }
        mrun = mnew;
    }
    float mall = mrun;
    mall = fmaxf(mall, __shfl_xor(mall, 1)); mall = fmaxf(mall, __shfl_xor(mall, 2)); mall = fmaxf(mall, __shfl_xor(mall, 4));
    const float f = __expf(mrun - mall); lrun *= f;
    lrun += __shfl_xor(lrun, 1); lrun += __shfl_xor(lrun, 2); lrun += __shfl_xor(lrun, 4);
    const float inv = 1.0f / lrun;
    bf16_t* op = CAT + ((size_t)b * SEQ + c * 64 + t) * D + 512 + h * 64;
#pragma unroll
    for (int d = 0; d < 64; ++d) { float v = o[d] * f; v += __shfl_xor(v, 1); v += __shfl_xor(v, 2); v += __shfl_xor(v, 4); if ((d >> 3) == sub) op[d] = (bf16_t)f2bf(v * inv); }
}

typedef float f32x16 __attribute__((ext_vector_type(16)));
typedef short s16x4 __attribute__((ext_vector_type(4)));
__device__ __forceinline__ s16x4 ds_tr16(const LAS unsigned char* p) { return __builtin_bit_cast(s16x4, __builtin_amdgcn_ds_read_tr16_b64_v4i16((LAS s16x4*)p)); }
constexpr int ATT_BT_BYTES = 8 * 520 * 4;
__device__ __forceinline__ void attn_load_bias(Frame& F) {
    LAS float* bt = (LAS float*)F.lds;
    __syncthreads();
    for (int i = F.tid; i < 8 * 513; i += 512) { const int h = i / 513, j = i % 513; bt[h * 520 + j] = F.in[12][i] * 1.4426950408889634f; }
    __syncthreads();
}
__device__ __forceinline__ void attn_wave_mfma(Frame& F, int b, int c, int h) {
    const bf16_t* Z = (const bf16_t*)(F.ws + WS_Z); bf16_t* CAT = (bf16_t*)(F.ws + WS_CAT);
    const int l = F.lane, r = l & 31, hh = l >> 5;
    const LAS float* btab = (const LAS float*)F.lds + h * 520;
    LAS unsigned char* Vw = F.lds + ATT_BT_BYTES + F.wave * 8192;
    const float SC = 0.125f * 1.4426950408889634f;
    bf16x8 qf[2][4];
    { const bf16_t* Qb = Z + ((size_t)b * SEQ + c * 64) * AB_IN + 1024 + h * 64;
#pragma unroll
      for (int qb = 0; qb < 2; ++qb)
#pragma unroll
          for (int ks = 0; ks < 4; ++ks) qf[qb][ks] = *(const bf16x8*)(Qb + (size_t)(qb * 32 + r) * AB_IN + ks * 16 + hh * 8); }
    f32x16 o[2][2];
#pragma unroll
    for (int a = 0; a < 2; ++a)
#pragma unroll
        for (int d = 0; d < 2; ++d)
#pragma unroll
            for (int i = 0; i < 16; ++i) o[a][d][i] = 0.f;
    float mrun[2] = {-1.0e30f, -1.0e30f}, lsum[2] = {0.f, 0.f};
    const int q4 = (l & 15) >> 2, p4 = l & 3, cb = (l >> 4) & 1, xs = (q4 >> 1) & 1;
    const LAS unsigned char* vbase = Vw + (4 * hh + q4) * 128 + p4 * 8 + cb * 32;
    const LAS unsigned char* vb[2] = {vbase + xs * 64, vbase + (1 - xs) * 64};
    for (int kc = (c >= 8 ? c - 8 : 0); kc <= c; ++kc) {
        const bf16_t* Kb = Z + ((size_t)b * SEQ + kc * 64) * AB_IN + 1536 + h * 64; const bf16_t* Vb = Kb + 512;
#pragma unroll
        for (int hf = 0; hf < 2; ++hf) { u32x4 vr[4];
#pragma unroll
          for (int i = 0; i < 4; ++i) vr[i] = *(const u32x4*)(Vb + (size_t)((hf * 4 + i) * 8 + (l >> 3)) * AB_IN + (l & 7) * 8);
#pragma unroll
          for (int i = 0; i < 4; ++i) { const int s = (hf * 4 + i) * 8 + (l >> 3), ci = l & 7, pb = (ci >> 1) ^ (((s >> 1) & 1) << 1); *(LAS u32x4*)(Vw + s * 128 + pb * 32 + (ci & 1) * 16) = vr[i]; }
          asm volatile("" ::: "memory"); }
        asm volatile("" ::: "memory");
        bf16x8 kf[2][4];
#pragma unroll
        for (int sb = 0; sb < 2; ++sb)
#pragma unroll
            for (int ks = 0; ks < 4; ++ks) kf[sb][ks] = *(const bf16x8*)(Kb + (size_t)(sb * 32 + r) * AB_IN + ks * 16 + hh * 8);
        const int dt = (c - kc) * 64;
#pragma unroll
        for (int qb = 0; qb < 2; ++qb) {
            f32x16 st[2];
#pragma unroll
            for (int sb = 0; sb < 2; ++sb) {
#pragma unroll
                for (int i = 0; i < 16; ++i) st[sb][i] = 0.f;
#pragma unroll
                for (int ks = 0; ks < 4; ++ks) st[sb] = __builtin_amdgcn_mfma_f32_32x32x16_bf16(kf[sb][ks], qf[qb][ks], st[sb], 0, 0, 0); }
            if (dt >= 320) { const float bc = btab[512];
#pragma unroll
                for (int sb = 0; sb < 2; ++sb)
#pragma unroll
                    for (int i = 0; i < 16; ++i) st[sb][i] = st[sb][i] * SC + bc;
            } else { const int base = dt + qb * 32 + r - 4 * hh + 256;
#pragma unroll
                for (int sb = 0; sb < 2; ++sb)
#pragma unroll
                    for (int i = 0; i < 16; ++i) { int idx = base - sb * 32 - ((i & 3) + 8 * (i >> 2)); idx = idx > 512 ? 512 : idx; st[sb][i] = st[sb][i] * SC + btab[idx]; } }
            float mx = st[0][0];
#pragma unroll
            for (int sb = 0; sb < 2; ++sb)
#pragma unroll
                for (int i = 0; i < 16; ++i) mx = fmaxf(mx, st[sb][i]);
            mx = fmaxf(mx, __shfl_xor(mx, 32));
            const float mn = fmaxf(mrun[qb], mx), alpha = __builtin_amdgcn_exp2f(mrun[qb] - mn); mrun[qb] = mn;
            float rs = 0.f;
#pragma unroll
            for (int sb = 0; sb < 2; ++sb)
#pragma unroll
                for (int i = 0; i < 16; ++i) { const float pv = __builtin_amdgcn_exp2f(st[sb][i] - mn); st[sb][i] = pv; rs += pv; }
            rs += __shfl_xor(rs, 32); lsum[qb] = lsum[qb] * alpha + rs;
#pragma unroll
            for (int d = 0; d < 2; ++d)
#pragma unroll
                for (int i = 0; i < 16; ++i) o[qb][d][i] *= alpha;
            bf16x8 pf[4];
#pragma unroll
            for (int kk = 0; kk < 4; ++kk) { const int sb = kk >> 1, s2 = kk & 1; u32x4 w;
                w.x = cvt_pk_bf16(st[sb][8 * s2 + 0], st[sb][8 * s2 + 1]); w.y = cvt_pk_bf16(st[sb][8 * s2 + 2], st[sb][8 * s2 + 3]);
                w.z = cvt_pk_bf16(st[sb][8 * s2 + 4], st[sb][8 * s2 + 5]); w.w = cvt_pk_bf16(st[sb][8 * s2 + 6], st[sb][8 * s2 + 7]); pf[kk] = __builtin_bit_cast(bf16x8, w); }
#pragma unroll
            for (int d = 0; d < 2; ++d)
#pragma unroll
                for (int kk = 0; kk < 4; ++kk) { const int rowoff = ((kk >> 1) * 32 + 16 * (kk & 1)) * 128;
                    const s16x4 lo = ds_tr16(vb[d] + rowoff), hi = ds_tr16(vb[d] + rowoff + 8 * 128);
                    const bf16x8 vf = (bf16x8){lo[0], lo[1], lo[2], lo[3], hi[0], hi[1], hi[2], hi[3]};
                    o[qb][d] = __builtin_amdgcn_mfma_f32_32x32x16_bf16(vf, pf[kk], o[qb][d], 0, 0, 0); }
        }
    }
#pragma unroll
    for (int qb = 0; qb < 2; ++qb) { const float inv = 1.0f / lsum[qb]; bf16_t* op = CAT + ((size_t)b * SEQ + c * 64 + qb * 32 + r) * D + 512 + h * 64 + 4 * hh;
#pragma unroll
        for (int d = 0; d < 2; ++d)
#pragma unroll
            for (int g = 0; g < 4; ++g) { u32x2 w; w.x = cvt_pk_bf16(o[qb][d][4 * g] * inv, o[qb][d][4 * g + 1] * inv); w.y = cvt_pk_bf16(o[qb][d][4 * g + 2] * inv, o[qb][d][4 * g + 3] * inv);
                *(u32x2*)(op + d * 32 + 8 * g) = w; } }
}

constexpr int RG_XA = 0, RG_GA0 = 8704, RG_GA1 = RG_GA0 + 8192, RG_XCB = RG_GA1 + 8192, RG_WA = RG_XCB + 9216, RG_WX = RG_WA + 9216, RG_AV = RG_WX + 9216, RG_UV = RG_AV + 16384, RG_SA = RG_UV + 16384, RG_SH = RG_SA + 2048, RG_END = RG_SH + 2048;
static_assert(RG_END <= RING_BYTES, "rglru lds");
__device__ __forceinline__ float gelu_fast(float x) { const float u = 1.5957691216057308f * (x + 0.044715f * x * x * x); return x / (1.0f + __expf(-u)); }
__device__ __forceinline__ void rglru_item(Frame& F, int b, int nb) {
    const bf16_t* Z = (const bf16_t*)(F.ws + WS_Z); bf16_t* CAT = (bf16_t*)(F.ws + WS_CAT);
    LAS unsigned char* L = F.lds;
    LAS float* AV = (LAS float*)(L + RG_AV); LAS float* UV = (LAS float*)(L + RG_UV); LAS float* SA = (LAS float*)(L + RG_SA); LAS float* SH = (LAS float*)(L + RG_SH);
    const int tid = F.tid, l = F.lane, w = F.wave, i16 = l & 15, q4 = l >> 4;
    __syncthreads();
    for (int i = tid; i < 4096; i += 512) { const int c = i >> 6, d = i & 63;
        *(LAS bf16_t*)(L + RG_WA + d * 144 + c * 2) = (bf16_t)f2bf(F.in[7][nb * 4096 + i]); *(LAS bf16_t*)(L + RG_WX + d * 144 + c * 2) = (bf16_t)f2bf(F.in[9][nb * 4096 + i]); }
    const int ct = tid >> 3, ch8 = tid & 7;
    float cw[4][8], cbv[8];
#pragma unroll
    for (int j = 0; j < 8; ++j) { const int ch = nb * 64 + 8 * ch8 + j; cbv[j] = F.in[6][ch];
#pragma unroll
        for (int k = 0; k < 4; ++k) cw[k][j] = F.in[5][k * 512 + ch]; }
    const int tb = w >> 1;
    float bav[2], bxv[2], lsv[2];
#pragma unroll
    for (int cc = 0; cc < 2; ++cc) { const int d = nb * 64 + 16 * ((w & 1) * 2 + cc) + i16; bav[cc] = F.in[8][d]; bxv[cc] = F.in[10][d]; const float lam = F.in[11][d]; lsv[cc] = 8.0f * (fminf(lam, 0.f) - log1pf(__expf(-fabsf(lam)))); }
    const int sc = tid & 63, sseg = tid >> 6;
    float carry = 0.f;
    const size_t rowb = (size_t)b * SEQ;
    u32x4 px0, px1, pg;
    const u32x4 zero4 = (u32x4){0u, 0u, 0u, 0u};
#define RG_LOAD(t0_) do { { const int r = tid >> 3, tg = (t0_) - 3 + r; px0 = tg >= 0 ? *(const u32x4*)(Z + (rowb + tg) * AB_IN + nb * 64 + (tid & 7) * 8) : zero4; } \
        if (tid < 24) { const int r = 64 + (tid >> 3), tg = (t0_) - 3 + r; px1 = *(const u32x4*)(Z + (rowb + tg) * AB_IN + nb * 64 + (tid & 7) * 8); } \
        pg = *(const u32x4*)(Z + (rowb + (t0_) + (tid >> 3)) * AB_IN + 512 + nb * 64 + (tid & 7) * 8); } while (0)
    RG_LOAD(0);
#pragma unroll 1
    for (int tile = 0; tile < 32; ++tile) {
        const int t0 = tile * 64; LAS unsigned char* GA = L + ((tile & 1) ? RG_GA1 : RG_GA0);
        *(LAS u32x4*)(L + RG_XA + tid * 16) = px0; if (tid < 24) *(LAS u32x4*)(L + RG_XA + (512 + tid) * 16) = px1;
        *(LAS u32x4*)(GA + tid * 16) = pg;
        __syncthreads();
        if (tile < 31) RG_LOAD(t0 + 64);
        { float xc[8];
#pragma unroll
          for (int j = 0; j < 8; ++j) xc[j] = cbv[j];
#pragma unroll
          for (int k = 0; k < 4; ++k) { const u32x4 xv = *(const LAS u32x4*)(L + RG_XA + (ct + k) * 128 + ch8 * 16); const unsigned xa[4] = {xv.x, xv.y, xv.z, xv.w};
#pragma unroll
              for (int j = 0; j < 8; ++j) xc[j] += cw[k][j] * bf2f((j & 1) ? (xa[j >> 1] >> 16) : (xa[j >> 1] & 0xffffu)); }
          *(LAS u32x4*)(L + RG_XCB + ct * 144 + ch8 * 16) = (u32x4){cvt_pk_bf16(xc[0], xc[1]), cvt_pk_bf16(xc[2], xc[3]), cvt_pk_bf16(xc[4], xc[5]), cvt_pk_bf16(xc[6], xc[7])}; }
        __syncthreads();
#pragma unroll
        for (int cc = 0; cc < 2; ++cc) { const int db = (w & 1) * 2 + cc; f32x4 aA = (f32x4){0.f, 0.f, 0.f, 0.f}, aX = aA;
#pragma unroll
            for (int ks = 0; ks < 2; ++ks) { const bf16x8 a = *(const LAS bf16x8*)(L + RG_XCB + (16 * tb + i16) * 144 + (32 * ks + 8 * q4) * 2);
                const bf16x8 ba = *(const LAS bf16x8*)(L + RG_WA + (16 * db + i16) * 144 + (32 * ks + 8 * q4) * 2), bx = *(const LAS bf16x8*)(L + RG_WX + (16 * db + i16) * 144 + (32 * ks + 8 * q4) * 2);
                aA = MFMA16(a, ba, aA); aX = MFMA16(a, bx, aX); }
#pragma unroll
            for (int rg = 0; rg < 4; ++rg) { const int t = 16 * tb + 4 * q4 + rg, d = 16 * db + i16; const float xcv = bf2f(*(const LAS bf16_t*)(L + RG_XCB + t * 144 + d * 2));
                const float r = sigmoidf_(aA[rg] + bav[cc]), ig = sigmoidf_(aX[rg] + bxv[cc]), la = r * lsv[cc];
                AV[t * 64 + d] = __expf(la); UV[t * 64 + d] = sqrtf(fmaxf(1.0f - __expf(2.0f * la), 0.f)) * (ig * xcv); } }
        __syncthreads();
        float aj[8], uj[8];
        { float A = 1.f, H = 0.f;
#pragma unroll
          for (int j = 0; j < 8; ++j) { aj[j] = AV[(8 * sseg + j) * 64 + sc]; uj[j] = UV[(8 * sseg + j) * 64 + sc]; H = aj[j] * H + uj[j]; A *= aj[j]; }
          SA[sseg * 64 + sc] = A; SH[sseg * 64 + sc] = H; }
        __syncthreads();
        { float run = carry, hin = carry;
#pragma unroll
          for (int sg = 0; sg < 8; ++sg) { if (sg == sseg) hin = run; run = SA[sg * 64 + sc] * run + SH[sg * 64 + sc]; }
          carry = run; float hv = hin;
#pragma unroll
          for (int j = 0; j < 8; ++j) { hv = aj[j] * hv + uj[j]; const int t = 8 * sseg + j; const float g = bf2f(*(const LAS bf16_t*)(GA + t * 128 + sc * 2));
              CAT[(rowb + t0 + t) * D + nb * 64 + sc] = (bf16_t)f2bf(hv * gelu_fast(g)); } }
    }
#undef RG_LOAD
    __syncthreads();
}
__device__ __forceinline__ void p_mix0(Frame& F) {
    const int j = F.vcu;
    if (j >= 128 && j < 256) rglru_item(F, (j - 128) >> 3, (j - 128) & 7);
#if PROBE_X & 32
    if (j >= 128 && j < 256) rglru_item(F, (j - 128) >> 3, (j - 128) & 7);
#endif
    attn_load_bias(F);
    if (j < 256) {
#pragma unroll 1
        for (int rep = 0; rep < ((PROBE_X & 64) ? 4 : 2); ++rep) attn_wave_mfma(F, j & 15, (rep & 1) == 0 ? 16 + (j >> 4) : 15 - (j >> 4), F.wave);
    }
    __syncthreads();
}
__device__ __forceinline__ void mix_hgrn_item(Frame& F, int b, int h) {
    LAS float* L = (LAS float*)F.lds;
    LAS float* qs = L; LAS float* fs = L + 4096; LAS float* is = L + 8192; LAS float* gs = L + 12288; LAS float* op = L + 16384;
    const bf16_t* Z = (const bf16_t*)(F.ws + WS_Z); bf16_t* CAT = (bf16_t*)(F.ws + WS_CAT); const float* lb = (const float*)(F.ws + WS_LB); const float* ng = F.in[16];
    const int tid = F.tid, v = tid & 127, kq = tid >> 7;
    float S[32];
#pragma unroll
    for (int k = 0; k < 32; ++k) S[k] = 0.f;
    for (int t0 = 0; t0 < SEQ; t0 += 32) {
        __syncthreads();
        for (int i = tid; i < 4096; i += 512) { const int r = i >> 7, c = i & 127; const bf16_t* zr = Z + ((size_t)b * SEQ + t0 + r) * C_IN + h * 128 + c;
            qs[i] = bf2f(zr[0]); const float l = lb[h * 128 + c]; fs[i] = l + (1.f - l) * sigmoidf_(bf2f(zr[1024])); is[i] = bf2f(zr[2048]); gs[i] = bf2f(zr[3072]); }
        __syncthreads();
        for (int r = 0; r < 32; ++r) { const float iv = is[r * 128 + v]; float o = 0.f;
#pragma unroll
            for (int k4 = 0; k4 < 8; ++k4) { const f32x4 f4 = *(const LAS f32x4*)(fs + r * 128 + kq * 32 + 4 * k4), q4 = *(const LAS f32x4*)(qs + r * 128 + kq * 32 + 4 * k4);
                S[4 * k4] = f4.x * S[4 * k4] + (1.f - f4.x) * iv; o += q4.x * S[4 * k4];
                S[4 * k4 + 1] = f4.y * S[4 * k4 + 1] + (1.f - f4.y) * iv; o += q4.y * S[4 * k4 + 1];
                S[4 * k4 + 2] = f4.z * S[4 * k4 + 2] + (1.f - f4.z) * iv; o += q4.z * S[4 * k4 + 2];
                S[4 * k4 + 3] = f4.w * S[4 * k4 + 3] + (1.f - f4.w) * iv; o += q4.w * S[4 * k4 + 3]; }
            op[(r * 4 + kq) * 128 + v] = o; }
        __syncthreads();
#pragma unroll
        for (int rr = 0; rr < 4; ++rr) { const int r = F.wave * 4 + rr; const int l = F.lane;
            const float o1 = op[(r * 4 + 0) * 128 + l] + op[(r * 4 + 1) * 128 + l] + op[(r * 4 + 2) * 128 + l] + op[(r * 4 + 3) * 128 + l];
            const float o2 = op[(r * 4 + 0) * 128 + 64 + l] + op[(r * 4 + 1) * 128 + 64 + l] + op[(r * 4 + 2) * 128 + 64 + l] + op[(r * 4 + 3) * 128 + 64 + l];
            const float rinv = rsqrtf(wave_sum(o1 * o1 + o2 * o2) * (1.f / 128.f) + EPS);
            bf16_t* cp = CAT + ((size_t)b * SEQ + t0 + r) * D + h * 128;
            cp[l] = (bf16_t)f2bf(o1 * rinv * ng[h * 128 + l] * gs[r * 128 + l]); cp[64 + l] = (bf16_t)f2bf(o2 * rinv * ng[h * 128 + 64 + l] * gs[r * 128 + 64 + l]); }
    }
    __syncthreads();
}


constexpr int HG_STR = 272;
constexpr int HG_LF = 0, HG_QH = 16384, HG_KK = 32768;
constexpr int HG_QE = 49152, HG_KN = HG_QE + 32 * HG_STR, HG_KS = HG_KN + 32 * HG_STR, HG_V0 = HG_KS + 32 * HG_STR, HG_V1 = HG_V0 + 32 * HG_STR, HG_G0 = HG_V1 + 32 * HG_STR, HG_G1 = HG_G0 + 32 * HG_STR;
constexpr int HG_AT = HG_G1 + 32 * HG_STR, HG_EB = HG_AT + 2560, HG_SEG = HG_EB + 512, HG_SSQ = HG_SEG + 2048, HG_END = HG_SSQ + 1024;
static_assert(HG_END <= RING_BYTES, "hgrn lds");
__device__ __forceinline__ void hgrn_item(Frame& F, int b, int h) {
    const bf16_t* Z = (const bf16_t*)(F.ws + WS_Z); bf16_t* CAT = (bf16_t*)(F.ws + WS_CAT); const float* lbp = (const float*)(F.ws + WS_LB); const float* ngp = F.in[16];
    LAS unsigned char* L = F.lds;
    LAS float* LF = (LAS float*)(L + HG_LF); LAS float* QH = (LAS float*)(L + HG_QH); LAS float* KK = (LAS float*)(L + HG_KK);
    LAS float* EB = (LAS float*)(L + HG_EB); LAS float* SEG = (LAS float*)(L + HG_SEG); LAS float* SSQ = (LAS float*)(L + HG_SSQ);
    LAS bf16_t* AT = (LAS bf16_t*)(L + HG_AT);
    const int tid = F.tid, l = F.lane, w = F.wave;
    const int lt = tid >> 4, lkc = tid & 15, sk = tid & 127, sseg = tid >> 7, i16 = l & 15, q4 = l >> 4, qq = i16 >> 2, pp = i16 & 3;
    float lbv[8];
#pragma unroll
    for (int j = 0; j < 8; ++j) lbv[j] = lbp[h * 128 + 8 * lkc + j];
    float ngv[4];
#pragma unroll
    for (int j = 0; j < 4; ++j) ngv[j] = ngp[h * 128 + 16 * w + 4 * q4 + j];
    f32x4 S[8];
#pragma unroll
    for (int i = 0; i < 8; ++i) S[i] = (f32x4){0.f, 0.f, 0.f, 0.f};
    __syncthreads();
    for (int i = tid; i < 640; i += 512) ((LAS unsigned*)(L + HG_AT))[i] = 0u;
    const bf16_t* zrow0 = Z + ((size_t)b * SEQ + lt) * C_IN + h * 128 + 8 * lkc;
    u32x4 pq = *(const u32x4*)(zrow0), pf = *(const u32x4*)(zrow0 + 1024), pv = *(const u32x4*)(zrow0 + 2048), pg = *(const u32x4*)(zrow0 + 3072);
#pragma unroll 1
    for (int st = 0; st < 64; ++st) {
        const int par = st & 1;
        LAS unsigned char* Vb = L + (par ? HG_V1 : HG_V0); LAS unsigned char* Gb = L + (par ? HG_G1 : HG_G0);
        { const unsigned qa[4] = {pq.x, pq.y, pq.z, pq.w}, fa[4] = {pf.x, pf.y, pf.z, pf.w};
          float lf[8], kk[8], qh[8];
#pragma unroll
          for (int j = 0; j < 8; ++j) { const float fz = bf2f((j & 1) ? (fa[j >> 1] >> 16) : (fa[j >> 1] & 0xffffu)); qh[j] = bf2f((j & 1) ? (qa[j >> 1] >> 16) : (qa[j >> 1] & 0xffffu));
              const float f = lbv[j] + (1.f - lbv[j]) * sigmoidf_(fz); lf[j] = __logf(f); kk[j] = 1.f - f; }
          LAS f32x4* d0 = (LAS f32x4*)(LF + lt * 128 + 8 * lkc); d0[0] = (f32x4){lf[0], lf[1], lf[2], lf[3]}; d0[1] = (f32x4){lf[4], lf[5], lf[6], lf[7]};
          LAS f32x4* d1 = (LAS f32x4*)(QH + lt * 128 + 8 * lkc); d1[0] = (f32x4){qh[0], qh[1], qh[2], qh[3]}; d1[1] = (f32x4){qh[4], qh[5], qh[6], qh[7]};
          LAS f32x4* d2 = (LAS f32x4*)(KK + lt * 128 + 8 * lkc); d2[0] = (f32x4){kk[0], kk[1], kk[2], kk[3]}; d2[1] = (f32x4){kk[4], kk[5], kk[6], kk[7]};
          *(LAS u32x4*)(Vb + lt * HG_STR + lkc * 16) = pv; *(LAS u32x4*)(Gb + lt * HG_STR + lkc * 16) = pg; }
        if (st < 63) { const bf16_t* zr = zrow0 + (size_t)(st + 1) * 32 * C_IN; pq = *(const u32x4*)(zr); pf = *(const u32x4*)(zr + 1024); pv = *(const u32x4*)(zr + 2048); pg = *(const u32x4*)(zr + 3072); }
        __syncthreads();
        float bl[8];
        { float a = 0.f;
#pragma unroll
          for (int j = 0; j < 8; ++j) { a += LF[(8 * sseg + j) * 128 + sk]; bl[j] = a; } }
        SEG[sseg * 128 + sk] = bl[7];
        __syncthreads();
        { const float s0 = SEG[sk], s1 = SEG[128 + sk], s2 = SEG[256 + sk], s3 = SEG[384 + sk];
          const float pre = (sseg > 0 ? s0 : 0.f) + (sseg > 1 ? s1 : 0.f) + (sseg > 2 ? s2 : 0.f), Bt = (s0 + s1) + (s2 + s3);
#pragma unroll
          for (int j = 0; j < 8; ++j) { const int t = 8 * sseg + j; const float bb = pre + bl[j];
              const float e1 = __expf(bb), e2 = __expf(fminf(-bb, 80.f)), e3 = __expf(Bt - bb), qh = QH[t * 128 + sk], kk = KK[t * 128 + sk];
              *(LAS bf16_t*)(L + HG_QE + t * HG_STR + sk * 2) = (bf16_t)f2bf(qh * e1);
              *(LAS bf16_t*)(L + HG_KN + t * HG_STR + sk * 2) = (bf16_t)f2bf(kk * e2);
              *(LAS bf16_t*)(L + HG_KS + t * HG_STR + sk * 2) = (bf16_t)f2bf(kk * e3); }
          if (sseg == 0) EB[sk] = __expf(Bt); }
        __syncthreads();
        if (w < 3) { const int tb = w ? 1 : 0, sb = (w == 2) ? 1 : 0; f32x4 acc = (f32x4){0.f, 0.f, 0.f, 0.f};
#pragma unroll
            for (int ks = 0; ks < 4; ++ks) { const bf16x8 a = *(const LAS bf16x8*)(L + HG_QE + (16 * tb + i16) * HG_STR + (32 * ks + 8 * q4) * 2), bq = *(const LAS bf16x8*)(L + HG_KN + (16 * sb + i16) * HG_STR + (32 * ks + 8 * q4) * 2);
                acc = MFMA16(a, bq, acc); }
#pragma unroll
            for (int rg = 0; rg < 4; ++rg) { const int t = 16 * tb + 4 * q4 + rg, sx = 16 * sb + i16; AT[t * 40 + sx] = (bf16_t)f2bf(sx <= t ? acc[rg] : 0.f); } }
        __syncthreads();
        bf16x8 vfr;
        { const s16x4 lo = ds_tr16(Vb + (8 * q4 + qq) * HG_STR + (16 * w + 4 * pp) * 2), hi = ds_tr16(Vb + (8 * q4 + 4 + qq) * HG_STR + (16 * w + 4 * pp) * 2);
          vfr = (bf16x8){lo[0], lo[1], lo[2], lo[3], hi[0], hi[1], hi[2], hi[3]}; }
        f32x4 O[2];
#pragma unroll
        for (int tb = 0; tb < 2; ++tb) { const bf16x8 at = *(const LAS bf16x8*)(L + HG_AT + (16 * tb + i16) * 80 + 16 * q4); O[tb] = MFMA16(vfr, at, ((f32x4){0.f, 0.f, 0.f, 0.f})); }
#pragma unroll
        for (int m = 0; m < 4; ++m) { u32x4 sp; sp.x = cvt_pk_bf16(S[2 * m][0], S[2 * m][1]); sp.y = cvt_pk_bf16(S[2 * m][2], S[2 * m][3]); sp.z = cvt_pk_bf16(S[2 * m + 1][0], S[2 * m + 1][1]); sp.w = cvt_pk_bf16(S[2 * m + 1][2], S[2 * m + 1][3]);
            const bf16x8 spk = __builtin_bit_cast(bf16x8, sp);
#pragma unroll
            for (int tb = 0; tb < 2; ++tb) { const u32x2 q0 = *(const LAS u32x2*)(L + HG_QE + (16 * tb + i16) * HG_STR + (32 * m + 4 * q4) * 2), q1 = *(const LAS u32x2*)(L + HG_QE + (16 * tb + i16) * HG_STR + (32 * m + 16 + 4 * q4) * 2);
                const u32x4 qv = (u32x4){q0.x, q0.y, q1.x, q1.y}; O[tb] = MFMA16(spk, __builtin_bit_cast(bf16x8, qv), O[tb]); } }
#pragma unroll
        for (int kb = 0; kb < 8; ++kb) { const s16x4 lo = ds_tr16(L + HG_KS + (8 * q4 + qq) * HG_STR + (16 * kb + 4 * pp) * 2), hi = ds_tr16(L + HG_KS + (8 * q4 + 4 + qq) * HG_STR + (16 * kb + 4 * pp) * 2);
            const bf16x8 kfr = (bf16x8){lo[0], lo[1], lo[2], lo[3], hi[0], hi[1], hi[2], hi[3]}; const f32x4 dec = *(const LAS f32x4*)(EB + 16 * kb + 4 * q4);
            S[kb] = MFMA16(kfr, vfr, S[kb] * dec); }
#pragma unroll
        for (int tb = 0; tb < 2; ++tb) { float ss = (O[tb][0] * O[tb][0] + O[tb][1] * O[tb][1]) + (O[tb][2] * O[tb][2] + O[tb][3] * O[tb][3]); ss += __shfl_xor(ss, 16); ss += __shfl_xor(ss, 32);
            if (q4 == 0) SSQ[(16 * tb + i16) * 8 + w] = ss; }
        __syncthreads();
#pragma unroll
        for (int tb = 0; tb < 2; ++tb) { const int t = 16 * tb + i16; const f32x4 a = *(const LAS f32x4*)(SSQ + t * 8), c = *(const LAS f32x4*)(SSQ + t * 8 + 4);
            const float rinv = rsqrtf(((a.x + a.y) + (a.z + a.w) + (c.x + c.y) + (c.z + c.w)) * (1.f / 128.f) + EPS);
            const u32x2 g2 = *(const LAS u32x2*)(Gb + t * HG_STR + (16 * w + 4 * q4) * 2);
            const float o0 = O[tb][0] * rinv * ngv[0] * bf2f(g2.x & 0xffffu), o1 = O[tb][1] * rinv * ngv[1] * bf2f(g2.x >> 16), o2 = O[tb][2] * rinv * ngv[2] * bf2f(g2.y & 0xffffu), o3 = O[tb][3] * rinv * ngv[3] * bf2f(g2.y >> 16);
            *(u32x2*)(CAT + ((size_t)b * SEQ + st * 32 + t) * D + h * 128 + 16 * w + 4 * q4) = (u32x2){cvt_pk_bf16(o0, o1), cvt_pk_bf16(o2, o3)}; }
    }
    __syncthreads();
}
__device__ __forceinline__ void p_gu(Frame& F, int layer) {
    unsigned char* ws = F.ws;
    moe_tables(F, layer);
    const LAS int* ts = (const LAS int*)(F.lds + TS_OFF); LAS unsigned* tab = (LAS unsigned*)(F.lds + TAB_OFF);
    pg8::MoeOrder<true> S{ts, tab, F.G, F.vcu, D};
    { const int* ltok = (const int*)(ws + WS_LTOK); pg8::Unit u;
      for (int i = 0; i < 6 && S.next(i, u); ++i) if (F.tid < 256) { const int pos = u.rl * 256 + F.tid; const int tok = pos < ts[40 + u.e] ? ltok[(size_t)u.e * CAP + pos] : 0; tab[i * 256 + F.tid] = (unsigned)tok * (unsigned)(D * 2); }
      __syncthreads(); }
    pg8::EpiGU E{(bf16_t*)(ws + WS_HB), (const float*)(ws + WS_LRSTD), ts + 40};
    pg8::gemm_phase<pg8::EpiGU, pg8::MoeOrder<true>, true>(F.lds, (const bf16_t*)(ws + WS_XB), (const bf16_t*)(ws + WS_WGU), D, S, E);
}
__device__ __forceinline__ void p_dn(Frame& F, int layer) {
    unsigned char* ws = F.ws;
    moe_tables(F, layer);
    const LAS int* ts = (const LAS int*)(F.lds + TS_OFF);
    pg8::MoeOrder<false> S{ts, nullptr, F.G, F.vcu, DEXP};
    pg8::EpiDN E{(bf16_t*)(ws + WS_Y), (const float*)(ws + WS_LW), ts + 40};
    pg8::gemm_phase<pg8::EpiDN, pg8::MoeOrder<false>, true>(F.lds, (const bf16_t*)(ws + WS_HB), (const bf16_t*)(ws + WS_WDN), DEXP, S, E);
}

__global__ void __launch_bounds__(512, 2) fwd(Args args) {
    extern __shared__ __attribute__((aligned(16))) unsigned char lds_raw[];
    Frame F;
    F.lds = (LAS unsigned char*)lds_raw; F.tid = threadIdx.x; F.lane = F.tid & 63; F.wave = __builtin_amdgcn_readfirstlane(F.tid >> 6);
    F.G = gridDim.x; { const int bx = blockIdx.x; F.vcu = (F.G % 8 == 0) ? (bx % 8) * (F.G / 8) + bx / 8 : bx; }
    F.in = args.in; F.out = args.out; F.ws = args.ws;
    unsigned char* ws = args.ws;
    bf16_t* XB = (bf16_t*)(ws + WS_XB); bf16_t* CAT = (bf16_t*)(ws + WS_CAT); bf16_t* Z = (bf16_t*)(ws + WS_Z);
    float* RSTD = (float*)(ws + WS_RSTD);
#if MK_ONE_LAUNCH == 2
    cg::grid_group grid = cg::this_grid();
#define GRID_BAR() grid.sync()
#elif MK_ONE_LAUNCH == 1
    if (F.tid < 2) ((volatile LAS unsigned*)(F.lds + MISC_OFF))[F.tid] = 0u;
    __syncthreads();
    const XcdBarrier xbar = xcd_barrier_post((unsigned*)(ws + WS_CTL) + CW_BAR, (volatile LAS unsigned*)(F.lds + MISC_OFF));
#define GRID_BAR() xcd_barrier(xbar)
#else
#define GRID_BAR() do {} while (0)
#endif
    #ifndef PH_MASK
#define PH_MASK 0x7fff
#endif
#define PHE(p) ((PH_MASK >> (p)) & 1)
    const int lo = args.ph_lo, hi = args.ph_hi;
#ifndef PROBE_MASK
#define PROBE_MASK 0
#endif
#define REPN(k) (((PROBE_MASK >> (k)) & 1) ? 2 : 1)
#define IN(k) (PHE(k) && lo <= (k) && (k) < hi)
#define SEAM(k) do { if (lo <= (k) && (k) + 1 < hi) GRID_BAR(); } while (0)
    if (IN(PH_PRO)) { { p_prologue(F); } if (REPN(PH_PRO) == 2) { GRID_BAR(); { p_prologue(F); } } } SEAM(PH_PRO);
    if (IN(PH_IN0)) { { pg8::DenseOrder S; S.init(T, AB_IN, D, F.G, (int)blockIdx.x); pg8::EpiIn E{Z, AB_IN, RSTD, 0, 1 << 30};
        pg8::gemm_phase<pg8::EpiIn, pg8::DenseOrder, true>(F.lds, XB, (const bf16_t*)(ws + WS_WIN0), D, S, E); } if (REPN(PH_IN0) == 2) { GRID_BAR(); { pg8::DenseOrder S; S.init(T, AB_IN, D, F.G, (int)blockIdx.x); pg8::EpiIn E{Z, AB_IN, RSTD, 0, 1 << 30};
        pg8::gemm_phase<pg8::EpiIn, pg8::DenseOrder, true>(F.lds, XB, (const bf16_t*)(ws + WS_WIN0), D, S, E); } } } SEAM(PH_IN0);
    if (IN(PH_MIX0)) { { p_mix0(F); } if (REPN(PH_MIX0) == 2) { GRID_BAR(); { p_mix0(F); } } } SEAM(PH_MIX0);
    if (IN(PH_OUT0)) { { pg8::DenseOrder S; S.init(T, D, D, F.G, (int)blockIdx.x); pg8::EpiOut E{args.in[0], args.out, XB, 0};
        pg8::gemm_phase<pg8::EpiOut, pg8::DenseOrder, true>(F.lds, CAT, (const bf16_t*)(ws + WS_WOUT0), D, S, E); } if (REPN(PH_OUT0) == 2) { GRID_BAR(); { pg8::DenseOrder S; S.init(T, D, D, F.G, (int)blockIdx.x); pg8::EpiOut E{args.in[0], args.out, XB, 0};
        pg8::gemm_phase<pg8::EpiOut, pg8::DenseOrder, true>(F.lds, CAT, (const bf16_t*)(ws + WS_WOUT0), D, S, E); } } } SEAM(PH_OUT0);
    if (IN(PH_R1)) { p_router(F, 0); if (PROBE_X & 1) { GRID_BAR(); p_router(F, 0, 1); } } SEAM(PH_R1);
    if (IN(PH_GU0)) { { p_gu(F, 0); } if (REPN(PH_GU0) == 2) { GRID_BAR(); { p_gu(F, 0); } } } SEAM(PH_GU0);
    if (IN(PH_DN0)) { { p_dn(F, 0); } if (REPN(PH_DN0) == 2) { GRID_BAR(); { p_dn(F, 0); } } } SEAM(PH_DN0);
    if (IN(PH_R2)) { if (PROBE_X & 2) { p_combine(F, 0, 0, 1); GRID_BAR(); } p_combine(F, 0, 0); } SEAM(PH_R2);
    if (IN(PH_IN1)) { { pg8::DenseOrder S; S.init(T, C_IN, D, F.G, (int)blockIdx.x); pg8::EpiIn E{Z, C_IN, RSTD, 1024, 3072};
        pg8::gemm_phase<pg8::EpiIn, pg8::DenseOrder, true>(F.lds, XB, (const bf16_t*)(ws + WS_WIN1), D, S, E); } if (REPN(PH_IN1) == 2) { GRID_BAR(); { pg8::DenseOrder S; S.init(T, C_IN, D, F.G, (int)blockIdx.x); pg8::EpiIn E{Z, C_IN, RSTD, 1024, 3072};
        pg8::gemm_phase<pg8::EpiIn, pg8::DenseOrder, true>(F.lds, XB, (const bf16_t*)(ws + WS_WIN1), D, S, E); } } } SEAM(PH_IN1);
    if (IN(PH_MIX1)) { { if (F.vcu < 128) hgrn_item(F, F.vcu >> 3, F.vcu & 7); else { __syncthreads(); moe_convert(F, 1, F.vcu - 128, F.G - 128); if (PROBE_X & 4) moe_convert(F, 1, F.vcu - 128, F.G - 128); } } if (REPN(PH_MIX1) == 2) { GRID_BAR(); { if (F.vcu < 128) hgrn_item(F, F.vcu >> 3, F.vcu & 7); else { __syncthreads(); moe_convert(F, 1, F.vcu - 128, F.G - 128); if (PROBE_X & 4) moe_convert(F, 1, F.vcu - 128, F.G - 128); } } } } SEAM(PH_MIX1);
    if (IN(PH_OUT1)) { if (PROBE_X & 16) { pg8::DenseOrder S; S.init(T, D, D, F.G, (int)blockIdx.x); pg8::EpiOut E{args.out, args.out, XB, 1};
        pg8::gemm_phase<pg8::EpiOut, pg8::DenseOrder, true>(F.lds, CAT, (const bf16_t*)(ws + WS_WOUT1), D, S, E); GRID_BAR(); }
 pg8::DenseOrder S; S.init(T, D, D, F.G, (int)blockIdx.x); pg8::EpiOut E{args.out, args.out, XB, 0};
        pg8::gemm_phase<pg8::EpiOut, pg8::DenseOrder, true>(F.lds, CAT, (const bf16_t*)(ws + WS_WOUT1), D, S, E); } SEAM(PH_OUT1);
    if (IN(PH_R3)) { p_router(F, 1); } SEAM(PH_R3);
    if (IN(PH_GU1)) { { p_gu(F, 1); } if (REPN(PH_GU1) == 2) { GRID_BAR(); { p_gu(F, 1); } } } SEAM(PH_GU1);
    if (IN(PH_DN1)) { { p_dn(F, 1); } if (REPN(PH_DN1) == 2) { GRID_BAR(); { p_dn(F, 1); } } } SEAM(PH_DN1);
    if (IN(PH_R4)) { if (PROBE_X & 8) { p_combine(F, 1, 1, 1); GRID_BAR(); } p_combine(F, 1, 1); }
}

extern "C" void kernel_launch(void* const* d_in, const int* in_sizes, int n_in, void* d_out, int out_size, void* d_ws, size_t ws_size, hipStream_t stream) {
    static int grid = 0;
    if (grid == 0) {
        if (n_in != 23 || out_size != T * D || ws_size < WS_END) { fprintf(stderr, "kernel_launch: unexpected shapes: n_in %d out %d ws %zu (need %zu)\n", n_in, out_size, ws_size, (size_t)WS_END); grid = -1; return; }
        if (hipFuncSetAttribute((const void*)fwd, hipFuncAttributeMaxDynamicSharedMemorySize, LDS_BYTES) != hipSuccess) { fprintf(stderr, "kernel_launch: hipFuncSetAttribute failed\n"); grid = -1; return; }
        int dev = 0, cus = 0, per_cu = 0;
        hipGetDevice(&dev); hipDeviceGetAttribute(&cus, hipDeviceAttributeMultiprocessorCount, dev);
        hipOccupancyMaxActiveBlocksPerMultiprocessor(&per_cu, (const void*)fwd, 512, LDS_BYTES);
        (void)hipGetLastError();
        fprintf(stderr, "kernel_launch: cus %d per_cu %d ws %zu\n", cus, per_cu, ws_size);
        grid = cus > 0 ? cus : 256;
        if (per_cu < 1) fprintf(stderr, "kernel_launch: occupancy query says %d blocks per CU\n", per_cu);
    }
    if (grid < 0) return;
    hipMemsetAsync((char*)d_ws + WS_CTL, 0, CTL_BYTES, stream);
    Args a{};
    for (int i = 0; i < 23; ++i) a.in[i] = (const float*)d_in[i];
    a.out = (float*)d_out; a.ws = (unsigned char*)d_ws;
#if MK_ONE_LAUNCH
    a.ph_lo = 0; a.ph_hi = NPH;
    void* kargs[] = {&a};
    hipError_t e = hipLaunchCooperativeKernel((const void*)fwd, dim3(grid), dim3(512), kargs, LDS_BYTES, stream);
    if (e != hipSuccess) fprintf(stderr, "cooperative launch failed: %s (grid %d)\n", hipGetErrorString(e), grid);
#else
    for (int ph = 0; ph < NPH; ++ph) { a.ph_lo = ph; a.ph_hi = ph + 1; hipLaunchKernelGGL(fwd, dim3(grid), dim3(512), LDS_BYTES, stream, a); }
#endif
}
```

```cpp
#include <hip/hip_runtime.h>
#include <hip/hip_cooperative_groups.h>
#include <cstdio>
#include <cstdint>
namespace cg = cooperative_groups;

#ifndef PROBE_X
#define PROBE_X 0
#endif
#ifndef MK_ONE_LAUNCH
#define MK_ONE_LAUNCH 1
#endif

constexpr int T = 32768, D = 1024, SEQ = 2048, NB = 16;
constexpr int AB_IN = 2560, C_IN = 4096;
constexpr int NEXP = 32, DEXP = 512, CAP = 32768;
constexpr int MAXTILES = 288;
constexpr float EPS = 1e-6f;

#define LAS __attribute__((address_space(3)))
typedef unsigned short bf16_t;
typedef short bf16x8 __attribute__((ext_vector_type(8)));
typedef float f32x4 __attribute__((ext_vector_type(4)));
typedef unsigned u32x4 __attribute__((ext_vector_type(4)));
typedef unsigned u32x2 __attribute__((ext_vector_type(2)));

constexpr size_t MiB = 1u << 20;
constexpr size_t WS_CTL = 0, CTL_BYTES = 1 * MiB;
constexpr size_t WS_RSTD = 1 * MiB;
constexpr size_t WS_LB = WS_RSTD + 128 * 1024;
constexpr size_t WS_RWH = WS_LB + 4096;
constexpr size_t WS_RWL = WS_RWH + 2 * 36 * 1024 * 2;
constexpr size_t WS_TOKINFO = 2 * MiB;
constexpr size_t WS_LTOK = 3 * MiB, WS_LRSTD = 7 * MiB, WS_LW = 11 * MiB;
constexpr size_t WS_WIN0 = 16 * MiB, WS_WOUT0 = 21 * MiB, WS_WIN1 = 23 * MiB, WS_WOUT1 = 31 * MiB;
constexpr size_t WS_WGU = 34 * MiB, WS_WDN = 98 * MiB;
constexpr size_t WS_XB = 130 * MiB, WS_CAT = 194 * MiB;
constexpr size_t WS_Z = 258 * MiB;
constexpr size_t WS_HB = 258 * MiB, WS_Y = 330 * MiB;
constexpr size_t WS_END = 514 * MiB;
constexpr int CW_CNT = 8192;
constexpr int CW_BAR = 4096;

constexpr int RING_BYTES = 131072;
constexpr int TAB_OFF = RING_BYTES;
constexpr int TS_OFF = TAB_OFF + 6 * 1024;
constexpr int LDS_BYTES = 163840;
constexpr int MISC_OFF = LDS_BYTES - 64;

__device__ __forceinline__ unsigned f2bf(float f) { unsigned u = __float_as_uint(f); return (u + 0x7fffu + ((u >> 16) & 1u)) >> 16; }
__device__ __forceinline__ float bf2f(unsigned b) { return __uint_as_float(b << 16); }
__device__ __forceinline__ unsigned pk2(float lo, float hi) { return f2bf(lo) | (f2bf(hi) << 16); }
__device__ __forceinline__ unsigned cvt_pk_bf16(float lo, float hi) { unsigned r; asm volatile("v_cvt_pk_bf16_f32 %0, %1, %2" : "=v"(r) : "v"(lo), "v"(hi)); return r; }
__device__ __forceinline__ float wave_sum(float v) {
#pragma unroll
    for (int o = 1; o < 64; o <<= 1) v += __shfl_xor(v, o);
    return v;
}
__device__ __forceinline__ float sigmoidf_(float x) { return 1.0f / (1.0f + __expf(-x)); }
__device__ __forceinline__ float siluf_(float x) { return x / (1.0f + __expf(-x)); }
__device__ __forceinline__ float gelu_tanh(float x) { const float u = 0.7978845608028654f * (x + 0.044715f * x * x * x); return 0.5f * x * (1.0f + tanhf(u)); }
#define LDS_WAIT() asm volatile("s_waitcnt lgkmcnt(0)" ::: "memory")
#define MFMA16(a, b, c) __builtin_amdgcn_mfma_f32_16x16x32_bf16((a), (b), (c), 0, 0, 0)

namespace pg8 {
constexpr int BM = 256, BK = 64, HALF = 128, HTB = HALF * BK * 2, NXCD = 8, WGM = 8;
__host__ __device__ __forceinline__ int lds_byte(int r, int c) { const int st = (r >> 4) * 2 + (c >> 5), rr = r & 15, cc = c & 31, ob = rr * 64 + cc * 2; return st * 1024 + (ob ^ (((ob >> 9) & 1) << 5)); }
__host__ __device__ __forceinline__ void stage_rc(int b, int& R, int& C) { const int st = b / 1024, sb = b % 1024, swz = sb ^ (((sb >> 9) & 1) << 5); R = (st >> 1) * 16 + swz / 64; C = (st & 1) * 32 + (swz % 64) / 2; }
__host__ __device__ __forceinline__ int perm32(int rho) { const int n = rho >> 4, i = rho & 15; return 8 * (i >> 2) + 4 * n + (i & 3); }

struct Unit { unsigned boff; int arow, orow, ocol, e, rl, slot; };

struct DenseOrder {
    int nM, nN, nwg, G, c, K;
    __device__ void init(int M, int N, int K_, int G_, int c_) { nM = M / BM; nN = N / BM; nwg = nM * nN; G = G_; c = c_; K = K_; }
    __device__ __forceinline__ bool next(int i, Unit& u) const {
        const long L = (long)i * G + c; if (L >= nwg) return false;
        int wgid = (int)L; { const int q = nwg / NXCD, r = nwg % NXCD, xcd = wgid % NXCD, off = wgid / NXCD; wgid = (xcd < r ? xcd * (q + 1) : r * (q + 1) + (xcd - r) * q) + off; }
        const int nig = WGM * nN, gid = wgid / nig, fm = gid * WGM, gsz = (nM - fm) < WGM ? (nM - fm) : WGM;
        const int pm = __builtin_amdgcn_readfirstlane(fm + ((wgid % nig) % gsz)), pn = __builtin_amdgcn_readfirstlane((wgid % nig) / gsz);
        u.arow = pm * BM; u.orow = pm * BM; u.ocol = pn * BM; u.boff = (unsigned)(pn * BM) * (unsigned)K * 2u; u.e = 0; u.rl = 0; u.slot = i; return true;
    }
    static constexpr bool GATHER = false;
    __device__ __forceinline__ size_t abase(const Unit& u) const { return (size_t)u.arow * (size_t)K * 2u; }
    __device__ __forceinline__ unsigned aoff(const Unit&, int) const { return 0u; }
};
template <bool GATHER_> struct MoeOrder {
    static constexpr bool GATHER = GATHER_;
    const LAS int* ts; const LAS unsigned* tab; int G, vcu, K;
    __device__ __forceinline__ bool next(int i, Unit& u) const {
        const int L = i * G + vcu; const int NT = __builtin_amdgcn_readfirstlane(ts[32]); if (L >= NT * 4) return false;
        const int rt = L >> 2, pn = L & 3; int e = 0;
#pragma unroll
        for (int j = 1; j < 32; ++j) e += (ts[j] <= rt) ? 1 : 0;
        e = __builtin_amdgcn_readfirstlane(e);
        u.e = e; u.rl = rt - __builtin_amdgcn_readfirstlane(ts[e]); u.orow = rt * BM; u.arow = rt * BM; u.ocol = pn * BM; u.boff = (unsigned)(e * 1024 + pn * BM) * (unsigned)K * 2u; u.slot = i; return true;
    }
    __device__ __forceinline__ size_t abase(const Unit& u) const { return GATHER ? (size_t)0 : (size_t)u.arow * (size_t)K * 2u; }
    __device__ __forceinline__ unsigned aoff(const Unit& u, int r) const { return tab[u.slot * 256 + r]; }
};

typedef f32x4 Acc[2][2][4][2];

struct EpiIn {
    static constexpr bool PERM = true;
    bf16_t* O; int ldc; const float* rstd; int silu_lo_end, silu_hi_start;
    __device__ __forceinline__ void operator()(const Acc& acc, const Unit& u, int wr, int wc, int fr, int fq) const {
        const bool act = (u.ocol < silu_lo_end) || (u.ocol >= silu_hi_start);
#pragma unroll
        for (int ai = 0; ai < 2; ++ai)
#pragma unroll
            for (int m = 0; m < 4; ++m) {
                const int row = u.orow + ai * HALF + wr * 64 + m * 16 + fr; const float rs = rstd[row];
                bf16_t* rowp = O + (size_t)row * ldc + u.ocol + wc * 32 + 8 * fq;
#pragma unroll
                for (int bj = 0; bj < 2; ++bj) { f32x4 v0 = acc[ai][bj][m][0] * rs, v1 = acc[ai][bj][m][1] * rs;
                    if (act) {
#pragma unroll
                        for (int j = 0; j < 4; ++j) { v0[j] = siluf_(v0[j]); v1[j] = siluf_(v1[j]); } }
                    u32x4 w; w.x = cvt_pk_bf16(v0[0], v0[1]); w.y = cvt_pk_bf16(v0[2], v0[3]); w.z = cvt_pk_bf16(v1[0], v1[1]); w.w = cvt_pk_bf16(v1[2], v1[3]);
                    *(u32x4*)(rowp + bj * HALF) = w; } }
    }
};
struct EpiOut {
    static constexpr bool PERM = true;
    const float* resid; float* H; bf16_t* XB; int dry;
    __device__ __forceinline__ void operator()(const Acc& acc, const Unit& u, int wr, int wc, int fr, int fq) const {
#pragma unroll
        for (int ai = 0; ai < 2; ++ai)
#pragma unroll
            for (int m = 0; m < 4; ++m) {
                const int row = u.orow + ai * HALF + wr * 64 + m * 16 + fr; const size_t off = (size_t)row * D + u.ocol + wc * 32 + 8 * fq;
#pragma unroll
                for (int bj = 0; bj < 2; ++bj) { const f32x4 r0 = *(const f32x4*)(resid + off + bj * HALF), r1 = *(const f32x4*)(resid + off + bj * HALF + 4);
                    const f32x4 v0 = dry ? r0 : acc[ai][bj][m][0] + r0, v1 = dry ? r1 : acc[ai][bj][m][1] + r1;
                    *(f32x4*)(H + off + bj * HALF) = v0; *(f32x4*)(H + off + bj * HALF + 4) = v1;
                    u32x4 w; w.x = cvt_pk_bf16(v0[0], v0[1]); w.y = cvt_pk_bf16(v0[2], v0[3]); w.z = cvt_pk_bf16(v1[0], v1[1]); w.w = cvt_pk_bf16(v1[2], v1[3]);
                    *(u32x4*)(XB + off + bj * HALF) = w; } }
    }
};
struct EpiGU {
    static constexpr bool PERM = true;
    bf16_t* HB; const float* lrstd; const LAS int* cnt;
    __device__ __forceinline__ void operator()(const Acc& acc, const Unit& u, int wr, int wc, int fr, int fq) const {
        const int n_e = cnt[u.e];
#pragma unroll
        for (int ai = 0; ai < 2; ++ai)
#pragma unroll
            for (int m = 0; m < 4; ++m) {
                const int r = ai * HALF + wr * 64 + m * 16 + fr, pos = u.rl * BM + r; const float rs = pos < n_e ? lrstd[(size_t)u.e * CAP + pos] : 0.f;
                float h[8];
#pragma unroll
                for (int n = 0; n < 2; ++n)
#pragma unroll
                    for (int j = 0; j < 4; ++j) { const float g = acc[ai][0][m][n][j] * rs, uu = acc[ai][1][m][n][j] * rs; h[n * 4 + j] = siluf_(g) * uu; }
                u32x4 w; w.x = cvt_pk_bf16(h[0], h[1]); w.y = cvt_pk_bf16(h[2], h[3]); w.z = cvt_pk_bf16(h[4], h[5]); w.w = cvt_pk_bf16(h[6], h[7]);
                *(u32x4*)(HB + (size_t)(u.orow + r) * DEXP + (u.ocol >> 1) + wc * 32 + 8 * fq) = w; }
    }
};
struct EpiDN {
    static constexpr bool PERM = true;
    bf16_t* Y; const float* lw; const LAS int* cnt;
    __device__ __forceinline__ void operator()(const Acc& acc, const Unit& u, int wr, int wc, int fr, int fq) const {
        const int n_e = cnt[u.e];
#pragma unroll
        for (int ai = 0; ai < 2; ++ai)
#pragma unroll
            for (int m = 0; m < 4; ++m) {
                const int r = ai * HALF + wr * 64 + m * 16 + fr, pos = u.rl * BM + r; const float ws = pos < n_e ? lw[(size_t)u.e * CAP + pos] : 0.f;
                bf16_t* rowp = Y + (size_t)(u.orow + r) * D + u.ocol + wc * 32 + 8 * fq;
#pragma unroll
                for (int bj = 0; bj < 2; ++bj) { const f32x4 v0 = acc[ai][bj][m][0] * ws, v1 = acc[ai][bj][m][1] * ws;
                    u32x4 w; w.x = cvt_pk_bf16(v0[0], v0[1]); w.y = cvt_pk_bf16(v0[2], v0[3]); w.z = cvt_pk_bf16(v1[0], v1[1]); w.w = cvt_pk_bf16(v1[2], v1[3]);
                    *(u32x4*)(rowp + bj * HALF) = w; } }
    }
};

template <class Epi, class Sched, bool ALIGN_EPI>
__device__ __forceinline__ void gemm_phase(LAS unsigned char* lds, const bf16_t* A, const bf16_t* Bt, const int K, const Sched& S, const Epi& E) {
    const int tid = threadIdx.x, wid = __builtin_amdgcn_readfirstlane(tid >> 6), lane = tid & 63, wr = wid >> 2, wc = wid & 3, fr = lane & 15, fq = lane >> 4;
    const int nt = K / BK;
    unsigned voffB[2], vA0[2], vA1[2];
#pragma unroll
    for (int i = 0; i < 2; ++i) { int R, C; stage_rc(tid * 16 + i * 8192, R, C); const int Rb = Epi::PERM ? ((R & ~31) + perm32(R & 31)) : R;
        vA0[i] = (unsigned)(R * K + C) * 2u; vA1[i] = vA0[i]; voffB[i] = (unsigned)(Rb * K + C) * 2u; }
#define PG8_FILL(u) do { if constexpr (Sched::GATHER) { int tv_ = tid; asm volatile("" : "+v"(tv_)); _Pragma("unroll") for (int i = 0; i < 2; ++i) { int R, C; stage_rc(tv_ * 16 + i * 8192, R, C); \
        vA0[i] = S.aoff(u, R) + (unsigned)C * 2u; vA1[i] = S.aoff(u, HALF + R) + (unsigned)C * 2u; } } } while (0)
    const size_t kstep = (size_t)(BK * 2);
    const size_t hstep = (size_t)HALF * K * 2;
    const unsigned ldsw = (unsigned)wid * 1024u;
    const int aoff = lds_byte(wr * 64 + fr, fq * 8), boff = lds_byte(wc * 32 + fr, fq * 8);
#define PG8_SA(b, h) (((b) * 2 + (h)) * HTB)
#define PG8_SB(b, h) ((4 + (b) * 2 + (h)) * HTB)
#define PG8_STAGE(bufoff, gbase, voff) do { _Pragma("unroll") for (int _i = 0; _i < 2; ++_i) \
        __builtin_amdgcn_global_load_lds((const unsigned*)((const char*)(gbase) + (voff)[_i]), (LAS unsigned*)(lds + (bufoff) + ldsw + _i * 8192), 16, 0, 0); } while (0)
#define PG8_LDA(dst, b, h) do { _Pragma("unroll") for (int m = 0; m < 4; ++m) _Pragma("unroll") for (int k = 0; k < 2; ++k) dst[m][k] = *(const LAS bf16x8*)(lds + PG8_SA(b, h) + aoff + m * 2048 + k * 1024); } while (0)
#define PG8_LDB(dst, b, h) do { _Pragma("unroll") for (int n = 0; n < 2; ++n) _Pragma("unroll") for (int k = 0; k < 2; ++k) dst[n][k] = *(const LAS bf16x8*)(lds + PG8_SB(b, h) + boff + n * 2048 + k * 1024); } while (0)
#define PG8_MMA(ai, bj, At, Bt_) do { __builtin_amdgcn_s_setprio(1); _Pragma("unroll") for (int m = 0; m < 4; ++m) _Pragma("unroll") for (int n = 0; n < 2; ++n) _Pragma("unroll") for (int k = 0; k < 2; ++k) \
        acc[ai][bj][m][n] = __builtin_amdgcn_mfma_f32_16x16x32_bf16(Bt_[n][k], At[m][k], acc[ai][bj][m][n], 0, 0, 0); __builtin_amdgcn_s_setprio(0); } while (0)
#define PG8_WAIT_V(n) asm volatile("s_waitcnt vmcnt(" #n ")" ::: "memory")
#define PG8_WAIT_L(n) asm volatile("s_waitcnt lgkmcnt(" #n ")" ::: "memory")
#define PG8_BAR __builtin_amdgcn_s_barrier()
#define PG8_SCHED __builtin_amdgcn_sched_barrier(0)
    Unit cur, nxt; int ui = 0;
    if (!S.next(0, cur)) return;
    f32x4 acc[2][2][4][2];
#pragma unroll
    for (int a = 0; a < 2; ++a)
#pragma unroll
        for (int b = 0; b < 2; ++b)
#pragma unroll
            for (int m = 0; m < 4; ++m)
#pragma unroll
                for (int n = 0; n < 2; ++n) acc[a][b][m][n] = (f32x4){0.f, 0.f, 0.f, 0.f};
    bf16x8 At[4][2], B0[2][2], B1[2][2];
    PG8_FILL(cur);
    const char* cA0 = (const char*)A + S.abase(cur); const char* cA1 = cA0 + (Sched::GATHER ? (size_t)0 : hstep); const char* cB = (const char*)Bt + cur.boff;
    PG8_STAGE(PG8_SB(0, 0), cB, voffB); PG8_STAGE(PG8_SB(0, 1), cB + hstep, voffB); PG8_STAGE(PG8_SA(0, 0), cA0, vA0); PG8_STAGE(PG8_SA(0, 1), cA1, vA1);
    if (wr == 1) PG8_BAR;
    PG8_WAIT_V(2); PG8_BAR;
    PG8_STAGE(PG8_SB(1, 0), cB + kstep, voffB); PG8_STAGE(PG8_SA(1, 0), cA0 + kstep, vA0); PG8_STAGE(PG8_SB(1, 1), cB + hstep + kstep, voffB);
    PG8_WAIT_V(6); PG8_BAR;
    for (;;) {
        const bool has_next = S.next(ui + 1, nxt);
        const char* nB = has_next ? (const char*)Bt + nxt.boff : cB;
        const char* nA0 = has_next ? (const char*)A + S.abase(nxt) : cA0; const char* nA1 = nA0 + (Sched::GATHER ? (size_t)0 : hstep);
        for (int t = 0; t < nt; t += 2) {
            const bool last = (t == nt - 2);
            const char* a1 = cA1 + (size_t)(t + 1) * kstep;
            const char* a2 = last ? nA0 : cA0 + (size_t)(t + 2) * kstep; const char* a2h = last ? nA1 : cA1 + (size_t)(t + 2) * kstep; const char* b2 = last ? nB : cB + (size_t)(t + 2) * kstep;
            const char* a3 = a2 + kstep; const char* b3 = b2 + kstep;
            PG8_LDB(B0, 0, 0); PG8_LDB(B1, 0, 1); PG8_SCHED; PG8_LDA(At, 0, 0); PG8_STAGE(PG8_SA(1, 1), a1, vA1);
            if (last && has_next) PG8_FILL(nxt);
            PG8_WAIT_V(8); PG8_WAIT_L(0); PG8_BAR; PG8_MMA(0, 0, At, B0); PG8_MMA(0, 1, At, B1); PG8_BAR; PG8_SCHED;
            PG8_LDA(At, 0, 1); PG8_STAGE(PG8_SB(0, 0), b2, voffB); PG8_STAGE(PG8_SB(0, 1), b2 + hstep, voffB); PG8_STAGE(PG8_SA(0, 0), a2, vA0);
            PG8_WAIT_V(8); PG8_WAIT_L(0); PG8_BAR; PG8_MMA(1, 0, At, B0); PG8_MMA(1, 1, At, B1); PG8_BAR; PG8_SCHED;
            PG8_LDB(B0, 1, 0); PG8_LDB(B1, 1, 1); PG8_SCHED; PG8_LDA(At, 1, 0); PG8_STAGE(PG8_SA(0, 1), a2h, vA1);
            PG8_WAIT_V(8); PG8_WAIT_L(0); PG8_BAR; PG8_MMA(0, 0, At, B0); PG8_MMA(0, 1, At, B1); PG8_BAR; PG8_SCHED;
            PG8_LDA(At, 1, 1); PG8_STAGE(PG8_SB(1, 0), b3, voffB); PG8_STAGE(PG8_SB(1, 1), b3 + hstep, voffB); PG8_STAGE(PG8_SA(1, 0), a3, vA0);
            PG8_WAIT_V(8); PG8_WAIT_L(0); PG8_BAR; PG8_MMA(1, 0, At, B0); PG8_MMA(1, 1, At, B1); PG8_BAR; PG8_SCHED;
        }
        if constexpr (ALIGN_EPI) { if (wr == 0) PG8_BAR; }
        E(acc, cur, wr, wc, fr, fq);
        if (!has_next) break;
#pragma unroll
        for (int a = 0; a < 2; ++a)
#pragma unroll
            for (int b = 0; b < 2; ++b)
#pragma unroll
                for (int m = 0; m < 4; ++m)
#pragma unroll
                    for (int n = 0; n < 2; ++n) acc[a][b][m][n] = (f32x4){0.f, 0.f, 0.f, 0.f};
        cur = nxt; cB = nB; cA0 = nA0; cA1 = nA1; ++ui;
        if constexpr (ALIGN_EPI) { if (wr == 1) PG8_BAR; }
    }
    PG8_WAIT_V(0);
    if constexpr (!ALIGN_EPI) { if (wr == 0) PG8_BAR; }
    PG8_BAR;
#undef PG8_FILL
#undef PG8_SA
#undef PG8_SB
#undef PG8_STAGE
#undef PG8_LDA
#undef PG8_LDB
#undef PG8_MMA
#undef PG8_WAIT_V
#undef PG8_WAIT_L
#undef PG8_BAR
#undef PG8_SCHED
}
}


#define XB_TMO      128
#define XB_XCNT(j)  (256  + 64 * (j))
#define XB_XSUB(j)  (1280 + 64 * (j))
#define XB_XGEN(j)  (2304 + 64 * (j))
#define XB_TOP      3328
#define XB_TOPGEN   3392
#define XB_SPIN_CAP (1u << 18)
__device__ __forceinline__ unsigned xb_ld(unsigned* p)              { return __hip_atomic_load(p, __ATOMIC_RELAXED, __HIP_MEMORY_SCOPE_AGENT); }
__device__ __forceinline__ unsigned xb_add(unsigned* p, unsigned v) { return __hip_atomic_fetch_add(p, v, __ATOMIC_RELAXED, __HIP_MEMORY_SCOPE_AGENT); }
__device__ __forceinline__ unsigned xb_xcc_id() { return (unsigned)__builtin_amdgcn_s_getreg((3 << 11) | 20) & 0xFu; }
#define XB_SPIN(cond, bar) do { unsigned _sp = 0; while (cond) { __builtin_amdgcn_s_sleep(1); \
    if ((++_sp & 255u) == 0u) { if (xb_ld(&(bar)[XB_TMO])) break; if (_sp > XB_SPIN_CAP) { atomicAdd(&(bar)[XB_TMO], 1u); break; } } } } while (0)
struct XcdBarrier { unsigned* bar; unsigned x; volatile LAS unsigned* st; };
__device__ __forceinline__ XcdBarrier xcd_barrier_post(unsigned* bar, volatile LAS unsigned* st) {
    XcdBarrier b; b.bar = bar; b.x = xb_xcc_id(); b.st = st;
    if (threadIdx.x == 0) (void)xb_add(&bar[XB_XCNT(b.x)], 1u);
    return b;
}
__device__ __forceinline__ void xcd_barrier_complete(unsigned* bar, unsigned x, unsigned& nloc, unsigned& nx) {
    const unsigned G = gridDim.x * gridDim.y * gridDim.z;
    unsigned sum, cnt, mine, sp = 0u;
    for (;;) {
        sum = 0u; cnt = 0u; mine = 0u;
#pragma unroll
        for (unsigned j = 0; j < 16; ++j) { const unsigned c = xb_ld(&bar[XB_XCNT(j)]); sum += c; cnt += (c > 0u) ? 1u : 0u; mine = (j == x) ? c : mine; }
        if (sum == G) break;
        __builtin_amdgcn_s_sleep(1);
        if ((++sp & 255u) == 0u) { if (xb_ld(&bar[XB_TMO])) break; if (sp > XB_SPIN_CAP) { atomicAdd(&bar[XB_TMO], 1u); break; } }
    }
    nloc = mine > 0u ? mine : 1u; nx = cnt > 0u ? cnt : 1u;
}
__device__ __forceinline__ void xcd_barrier(const XcdBarrier& b) {
    asm volatile("s_waitcnt vmcnt(0)" ::: "memory");
    __syncthreads();
    if (threadIdx.x == 0) {
        unsigned* bar = b.bar;
        __builtin_amdgcn_s_waitcnt(0);
        unsigned nloc = b.st[0], nx = b.st[1];
        if (nloc == 0u) { xcd_barrier_complete(bar, b.x, nloc, nx); b.st[0] = nloc; b.st[1] = nx; }
        const unsigned old = xb_add(&bar[XB_XSUB(b.x)], 1u);
        const unsigned gen = old / nloc;
        if (old + 1u == (gen + 1u) * nloc) {
            __builtin_amdgcn_fence(__ATOMIC_RELEASE, "agent");
            asm volatile("s_waitcnt vmcnt(0)" ::: "memory");
            const unsigned og = xb_add(&bar[XB_TOP], 1u);
            const unsigned tg = og / nx;
            if (og + 1u == (tg + 1u) * nx) xb_add(&bar[XB_TOPGEN], 1u);
            else XB_SPIN(xb_ld(&bar[XB_TOPGEN]) == tg, bar);
            __builtin_amdgcn_fence(__ATOMIC_ACQUIRE, "agent");
            xb_add(&bar[XB_XGEN(b.x)], 1u);
            asm volatile("s_waitcnt vmcnt(0)" ::: "memory");
        } else {
            XB_SPIN(xb_ld(&bar[XB_XGEN(b.x)]) == gen, bar);
            __builtin_amdgcn_fence(__ATOMIC_ACQUIRE, "agent");
            asm volatile("s_waitcnt vmcnt(0)" ::: "memory");
        }
    }
    __syncthreads();
}

struct Args { const float* in[23]; float* out; unsigned char* ws; int ph_lo, ph_hi; };
enum { PH_PRO = 0, PH_IN0, PH_MIX0, PH_OUT0, PH_R1, PH_GU0, PH_DN0, PH_R2, PH_IN1, PH_MIX1, PH_OUT1, PH_R3, PH_GU1, PH_DN1, PH_R4, NPH };

struct Frame {
    LAS unsigned char* lds; int tid, lane, wave, vcu, G;
    const float* const* in; float* out; unsigned char* ws;
};

__device__ __forceinline__ void transpose_item(const float* W, int K, int N, const float* kscale, bf16_t* WT, int dest_row0, LAS float* scr, int kb, int nb, int lane) {
    const int k0 = 64 * kb, n0 = 32 * nb;
    float tv[32];
#pragma unroll
    for (int i = 0; i < 32; ++i) tv[i] = W[(size_t)(k0 + 2 * i + (lane >> 5)) * N + n0 + (lane & 31)];
    if (kscale) {
#pragma unroll
        for (int i = 0; i < 32; ++i) tv[i] *= kscale[k0 + 2 * i + (lane >> 5)]; }
#pragma unroll
    for (int i = 0; i < 32; ++i) scr[(2 * i + (lane >> 5)) * 33 + (lane & 31)] = tv[i];
    LDS_WAIT(); asm volatile("" ::: "memory");
    const int c = lane & 7;
#pragma unroll
    for (int j = 0; j < 4; ++j) { const int n = (lane >> 3) + 8 * j; const LAS float* s = scr + (8 * c) * 33 + n;
        u32x4 o; o.x = pk2(s[0 * 33], s[1 * 33]); o.y = pk2(s[2 * 33], s[3 * 33]); o.z = pk2(s[4 * 33], s[5 * 33]); o.w = pk2(s[6 * 33], s[7 * 33]);
        *(u32x4*)(WT + (size_t)(dest_row0 + n) * K + k0 + 8 * c) = o; }
    LDS_WAIT(); asm volatile("" ::: "memory");
}
__device__ __forceinline__ void moe_convert(Frame& F, int layer, int wg, int nwg) {
    LAS float* scr = (LAS float*)(F.lds + F.wave * 16384);
    const int gw = wg * 8 + F.wave, NGW = nwg * 8;
    const float* gffn = F.in[2] + layer * D;
    const float* Wg = F.in[20] + (size_t)layer * NEXP * D * DEXP; const float* Wu = F.in[21] + (size_t)layer * NEXP * D * DEXP; const float* Wd = F.in[22] + (size_t)layer * NEXP * DEXP * D;
    bf16_t* WGU = (bf16_t*)(F.ws + WS_WGU); bf16_t* WDN = (bf16_t*)(F.ws + WS_WDN);
    for (int it = gw; it < 3 * 8192; it += NGW) {
        const int which = it >> 13, r = it & 8191, e = r >> 8, q = r & 255;
        if (which < 2) { const int kb = q >> 4, nb = q & 15, n0 = nb * 32;
            const int dest = e * 1024 + (n0 >> 7) * 256 + (which ? 128 : 0) + (n0 & 127);
            transpose_item((which ? Wu : Wg) + (size_t)e * D * DEXP, D, DEXP, gffn, WGU, dest, scr, kb, nb, F.lane);
        } else { const int kb = q >> 5, nb = q & 31;
            transpose_item(Wd + (size_t)e * DEXP * D, DEXP, D, nullptr, WDN, e * 1024 + nb * 32, scr, kb, nb, F.lane); }
    }
}
__device__ __forceinline__ void p_prologue(Frame& F) {
    LAS float* scr = (LAS float*)(F.lds + F.wave * 16384);
    const int gw = F.vcu * 8 + F.wave, NGW = F.G * 8;
    constexpr int I0 = 16 * 80, I1 = 16 * 32, I2 = 16 * 128, I3 = 16 * 32;
    for (int it = gw; it < I0 + I1 + I2 + I3; it += NGW) {
        int r = it;
        if (r < I0) { transpose_item(F.in[4], D, AB_IN, F.in[1], (bf16_t*)(F.ws + WS_WIN0), (r % 80) * 32, scr, r / 80, r % 80, F.lane); continue; } r -= I0;
        if (r < I1) { transpose_item(F.in[13], D, D, nullptr, (bf16_t*)(F.ws + WS_WOUT0), (r % 32) * 32, scr, r / 32, r % 32, F.lane); continue; } r -= I1;
        if (r < I2) { transpose_item(F.in[14], D, C_IN, F.in[1] + D, (bf16_t*)(F.ws + WS_WIN1), (r % 128) * 32, scr, r / 128, r % 128, F.lane); continue; } r -= I2;
        transpose_item(F.in[17], D, D, nullptr, (bf16_t*)(F.ws + WS_WOUT1), (r % 32) * 32, scr, r / 32, r % 32, F.lane);
    }
    moe_convert(F, 0, F.vcu, F.G);
    { const float* x = F.in[0]; bf16_t* XB = (bf16_t*)(F.ws + WS_XB); float* rstd = (float*)(F.ws + WS_RSTD);
      for (int m = gw; m < T; m += NGW) { const f32x4* xr = (const f32x4*)(x + (size_t)m * D) + F.lane; f32x4 v[4]; float s = 0.f;
#pragma unroll
          for (int j = 0; j < 4; ++j) { v[j] = xr[64 * j]; s += (v[j].x * v[j].x + v[j].y * v[j].y) + (v[j].z * v[j].z + v[j].w * v[j].w); }
          s = wave_sum(s); if (F.lane == 0) rstd[m] = rsqrtf(s * (1.f / D) + EPS);
          u32x2* o8 = (u32x2*)(XB + (size_t)m * D) + F.lane;
#pragma unroll
          for (int j = 0; j < 4; ++j) o8[64 * j] = (u32x2){pk2(v[j].x, v[j].y), pk2(v[j].z, v[j].w)}; } }
    const int gt = F.vcu * 512 + F.tid, NGT = F.G * 512;
    { float* lb = (float*)(F.ws + WS_LB); const float* l = F.in[15];
      for (int c = gt; c < 1024; c += NGT) { const float a = l[c], b = l[1024 + c], mx = fmaxf(a, b), ea = __expf(a - mx), eb = __expf(b - mx); lb[c] = ea / (ea + eb); } }
    { bf16_t* RWH = (bf16_t*)(F.ws + WS_RWH); bf16_t* RWL = (bf16_t*)(F.ws + WS_RWL);
      for (int i = gt; i < 2 * 36 * 1024; i += NGT) { const int l = i / (36 * 1024), r = i % (36 * 1024), j = r >> 10, c = r & 1023; const float g = F.in[2][l * D + c];
          const float wv = j < 4 ? g * F.in[18][((size_t)l * D + c) * 4 + j] : g * F.in[19][((size_t)l * D + c) * 32 + (j - 4)];
          const unsigned hi = f2bf(wv); RWH[i] = (bf16_t)hi; RWL[i] = (bf16_t)f2bf(wv - bf2f(hi)); } }
}

__device__ __forceinline__ void moe_tables(Frame& F, int layer) {
    LAS int* ts = (LAS int*)(F.lds + TS_OFF); LAS int* cn = ts + 40;
    const unsigned* cnt = (const unsigned*)(F.ws + WS_CTL) + CW_CNT + layer * 32 * 64;
    __syncthreads();
    if (F.tid < 32) cn[F.tid] = (int)__hip_atomic_load(cnt + F.tid * 64, __ATOMIC_RELAXED, __HIP_MEMORY_SCOPE_AGENT);
    __syncthreads();
    if (F.tid == 0) { int s = 0; for (int e = 0; e < 32; ++e) { ts[e] = s; s += (cn[e] + 255) >> 8; } ts[32] = s; }
    __syncthreads();
}

__device__ __forceinline__ void p_router(Frame& F, int layer, int dummy = 0) {
    const float* H = F.out;
    unsigned* cnt = (unsigned*)(F.ws + WS_CTL) + CW_CNT + (dummy ? 2 : layer) * 32 * 64;
    const size_t doff = dummy ? (WS_END - WS_TOKINFO) : 0;
    int* ltok = (int*)(F.ws + WS_LTOK + doff); float* lrstd = (float*)(F.ws + WS_LRSTD + doff); float* lw = (float*)(F.ws + WS_LW + doff); int* tokinfo = (int*)(F.ws + WS_TOKINFO + doff);
    LAS unsigned char* L = F.lds;
    const int tid = F.tid, l = F.lane, w = F.wave, i16 = l & 15, q4 = l >> 4;
    for (int tile = F.vcu; tile < T / 128; tile += F.G) {
        __syncthreads();
        { const u32x4* gh = (const u32x4*)(F.ws + WS_RWH + (size_t)layer * 36 * 2048); const u32x4* gl = (const u32x4*)(F.ws + WS_RWL + (size_t)layer * 36 * 2048);
          for (int i = tid; i < 36 * 128; i += 512) { const int n = i >> 7, c = i & 127, pc = c ^ (n & 15);
              *(LAS u32x4*)(L + n * 2048 + pc * 16) = gh[i]; *(LAS u32x4*)(L + 73728 + n * 2048 + pc * 16) = gl[i]; } }
        __syncthreads();
        const int row = tile * 128 + w * 16 + i16;
        const f32x4* hp = (const f32x4*)(H + (size_t)row * D + 8 * q4);
        f32x4 acc[3]; acc[0] = (f32x4){0.f, 0.f, 0.f, 0.f}; acc[1] = acc[0]; acc[2] = acc[0];
        int nrow[3];
#pragma unroll
        for (int nb = 0; nb < 3; ++nb) { const int n = 16 * nb + i16; nrow[nb] = n > 35 ? 35 : n; }
        float ss = 0.f;
#pragma unroll 4
        for (int ks = 0; ks < 32; ++ks) {
            const f32x4 x0 = hp[8 * ks], x1 = hp[8 * ks + 1];
            const float xv[8] = {x0.x, x0.y, x0.z, x0.w, x1.x, x1.y, x1.z, x1.w};
            unsigned hw[4], lwv[4];
#pragma unroll
            for (int p = 0; p < 4; ++p) { const float a = xv[2 * p], b = xv[2 * p + 1]; ss += a * a + b * b; const unsigned hpk = cvt_pk_bf16(a, b); hw[p] = hpk;
                lwv[p] = cvt_pk_bf16(a - __uint_as_float(hpk << 16), b - __uint_as_float(hpk & 0xffff0000u)); }
            const bf16x8 ah = __builtin_bit_cast(bf16x8, ((u32x4){hw[0], hw[1], hw[2], hw[3]})), al = __builtin_bit_cast(bf16x8, ((u32x4){lwv[0], lwv[1], lwv[2], lwv[3]}));
#pragma unroll
            for (int nb = 0; nb < 3; ++nb) { const int n = nrow[nb], pc = (4 * ks + q4) ^ (n & 15);
                const bf16x8 bh = *(const LAS bf16x8*)(L + n * 2048 + pc * 16), bl = *(const LAS bf16x8*)(L + 73728 + n * 2048 + pc * 16);
                acc[nb] = MFMA16(ah, bh, acc[nb]); acc[nb] = MFMA16(al, bh, acc[nb]); acc[nb] = MFMA16(ah, bl, acc[nb]); }
        }
        ss += __shfl_xor(ss, 16); ss += __shfl_xor(ss, 32);
        __syncthreads();
        LAS float* sc = (LAS float*)(L + w * 4096);
#pragma unroll
        for (int nb = 0; nb < 3; ++nb)
#pragma unroll
            for (int rg = 0; rg < 4; ++rg) sc[(4 * q4 + rg) * 49 + 16 * nb + i16] = acc[nb][rg];
        const float rstd = rsqrtf(ss * (1.f / D) + EPS);
        LAS unsigned* lc = (LAS unsigned*)(L + 32768);
        if (tid < 32) lc[tid] = 0u;
        int e0 = 0, e1 = 0; float w0 = 0.f, w1 = 0.f;
        if (l < 16) {
            const LAS float* lr = sc + l * 49;
            float lg[4];
#pragma unroll
            for (int gi = 0; gi < 4; ++gi) lg[gi] = lr[gi] * rstd;
            int gidx = 0; float gmax = lg[0];
#pragma unroll
            for (int gi = 1; gi < 4; ++gi) if (lg[gi] > gmax) { gmax = lg[gi]; gidx = gi; }
            float gs = 0.f;
#pragma unroll
            for (int gi = 0; gi < 4; ++gi) gs += __expf(lg[gi] - gmax);
            const float ggate = 1.f / gs;
            float le[8];
#pragma unroll
            for (int e = 0; e < 8; ++e) le[e] = lr[4 + gidx * 8 + e] * rstd;
            int i0 = 0; float v0 = le[0];
#pragma unroll
            for (int e = 1; e < 8; ++e) if (le[e] > v0) { v0 = le[e]; i0 = e; }
            int i1 = -1; float v1 = -3.0e38f;
#pragma unroll
            for (int e = 0; e < 8; ++e) if (e != i0 && le[e] > v1) { v1 = le[e]; i1 = e; }
            const float ex = __expf(v1 - v0); w0 = ggate / (1.f + ex); w1 = ggate * ex / (1.f + ex);
            e0 = gidx * 8 + i0; e1 = gidx * 8 + i1;
        }
        __syncthreads();
        unsigned r0 = 0u, r1 = 0u;
        if (l < 16) { r0 = __hip_atomic_fetch_add((unsigned*)(lc + e0), 1u, __ATOMIC_RELAXED, __HIP_MEMORY_SCOPE_WORKGROUP); r1 = __hip_atomic_fetch_add((unsigned*)(lc + e1), 1u, __ATOMIC_RELAXED, __HIP_MEMORY_SCOPE_WORKGROUP); }
        __syncthreads();
        if (tid < 32) { const unsigned c = lc[tid]; lc[32 + tid] = c ? atomicAdd(cnt + tid * 64, c) : 0u; }
        __syncthreads();
        if (l < 16) {
            const int m = row; const unsigned p0 = lc[32 + e0] + r0, p1 = lc[32 + e1] + r1;
            if (!dummy) ((float*)(F.ws + WS_RSTD))[m] = rstd;
            ltok[(size_t)e0 * CAP + p0] = m; lrstd[(size_t)e0 * CAP + p0] = rstd; lw[(size_t)e0 * CAP + p0] = w0;
            ltok[(size_t)e1 * CAP + p1] = m; lrstd[(size_t)e1 * CAP + p1] = rstd; lw[(size_t)e1 * CAP + p1] = w1;
            tokinfo[2 * m] = e0 * CAP + (int)p0; tokinfo[2 * m + 1] = e1 * CAP + (int)p1;
        }
    }
    __syncthreads();
}
__device__ __forceinline__ void p_combine(Frame& F, int layer, int mode, int dry = 0) {
    moe_tables(F, layer);
    const LAS int* ts = (const LAS int*)(F.lds + TS_OFF);
    const int gw = F.vcu * 8 + F.wave, NGW = F.G * 8;
    float* H = F.out; const bf16_t* Y = (const bf16_t*)(F.ws + WS_Y); const int* tokinfo = (const int*)(F.ws + WS_TOKINFO);
    bf16_t* XB = (bf16_t*)(F.ws + WS_XB); float* rstd = (float*)(F.ws + WS_RSTD); const float* gfin = F.in[3];
    for (int m = gw; m < T; m += NGW) {
        const int t0 = tokinfo[2 * m], t1 = tokinfo[2 * m + 1];
        const size_t s0 = (size_t)ts[t0 >> 15] * 256 + (t0 & (CAP - 1)), s1 = (size_t)ts[t1 >> 15] * 256 + (t1 & (CAP - 1));
        f32x4* hr = (f32x4*)(H + (size_t)m * D) + F.lane; const u32x2* y0 = (const u32x2*)(Y + s0 * D) + F.lane; const u32x2* y1 = (const u32x2*)(Y + s1 * D) + F.lane;
        f32x4 v[4]; float s = 0.f;
#pragma unroll
        for (int j = 0; j < 4; ++j) { v[j] = hr[64 * j]; u32x2 a = y0[64 * j], b = y1[64 * j]; if (dry) { a = (u32x2){0u, 0u}; b = a; }
            v[j].x += bf2f(a.x & 0xffffu) + bf2f(b.x & 0xffffu); v[j].y += bf2f(a.x >> 16) + bf2f(b.x >> 16); v[j].z += bf2f(a.y & 0xffffu) + bf2f(b.y & 0xffffu); v[j].w += bf2f(a.y >> 16) + bf2f(b.y >> 16);
            s += (v[j].x * v[j].x + v[j].y * v[j].y) + (v[j].z * v[j].z + v[j].w * v[j].w); }
        const float rs = rsqrtf(wave_sum(s) * (1.f / D) + EPS);
        if (mode == 0) {
            if (F.lane == 0) rstd[m] = rs;
            u32x2* o8 = (u32x2*)(XB + (size_t)m * D) + F.lane;
#pragma unroll
            for (int j = 0; j < 4; ++j) { hr[64 * j] = v[j]; o8[64 * j] = (u32x2){pk2(v[j].x, v[j].y), pk2(v[j].z, v[j].w)}; }
        } else {
            const f32x4* g4 = (const f32x4*)gfin + F.lane;
#pragma unroll
            for (int j = 0; j < 4; ++j) { const f32x4 g = g4[64 * j]; hr[64 * j] = dry ? v[j] : (f32x4){v[j].x * rs * g.x, v[j].y * rs * g.y, v[j].z * rs * g.z, v[j].w * rs * g.w}; }
        }
    }
}

__device__ __forceinline__ void mix_rglru_item(Frame& F, int b, int nb) {
    LAS float* L = (LAS float*)F.lds;
    LAS float* wa = L; LAS float* wx = L + 4096; LAS float* xat = L + 8192;   LAS float* xc = xat + 67 * 64; LAS float* ga = xc + 4096; LAS float* av = ga + 4096; LAS float* uv = av + 4096; LAS float* prm = uv + 4096;
    const bf16_t* Z = (const bf16_t*)(F.ws + WS_Z); bf16_t* CAT = (bf16_t*)(F.ws + WS_CAT);
    const int tid = F.tid;
    __syncthreads();
    for (int i = tid; i < 4096; i += 512) { wa[i] = F.in[7][nb * 4096 + i]; wx[i] = F.in[9][nb * 4096 + i]; }
    if (tid < 64) { const int c = nb * 64 + tid; prm[tid] = F.in[6][c]; prm[64 + tid] = F.in[5][c]; prm[128 + tid] = F.in[5][512 + c]; prm[192 + tid] = F.in[5][1024 + c]; prm[256 + tid] = F.in[5][1536 + c];
        prm[320 + tid] = F.in[8][c]; prm[384 + tid] = F.in[10][c]; const float lam = F.in[11][c]; prm[448 + tid] = fminf(lam, 0.f) - log1pf(__expf(-fabsf(lam))); }
    float hcar = 0.f;
    for (int t0 = 0; t0 < SEQ; t0 += 64) {
        __syncthreads();
        for (int i = tid; i < 67 * 64; i += 512) { const int r = i >> 6, c = i & 63, tg = t0 - 3 + r; xat[i] = tg >= 0 ? bf2f(Z[((size_t)b * SEQ + tg) * AB_IN + nb * 64 + c]) : 0.f; }
        for (int i = tid; i < 4096; i += 512) { const int r = i >> 6, c = i & 63; ga[i] = bf2f(Z[((size_t)b * SEQ + t0 + r) * AB_IN + 512 + nb * 64 + c]); }
        __syncthreads();
        for (int i = tid; i < 4096; i += 512) { const int r = i >> 6, c = i & 63; xc[i] = prm[c] + prm[64 + c] * xat[r * 64 + c] + prm[128 + c] * xat[(r + 1) * 64 + c] + prm[192 + c] * xat[(r + 2) * 64 + c] + prm[256 + c] * xat[(r + 3) * 64 + c]; }
        __syncthreads();
        { const int tok = tid >> 3, dg = tid & 7; float aa[8], ax[8];
#pragma unroll
          for (int j = 0; j < 8; ++j) { aa[j] = 0.f; ax[j] = 0.f; }
          for (int c = 0; c < 64; ++c) { const float xv = xc[tok * 64 + c]; const LAS f32x4* pa = (const LAS f32x4*)(wa + c * 64 + dg * 8); const LAS f32x4* px = (const LAS f32x4*)(wx + c * 64 + dg * 8);
              const f32x4 a0 = pa[0], a1 = pa[1], x0 = px[0], x1 = px[1];
              aa[0] += xv * a0.x; aa[1] += xv * a0.y; aa[2] += xv * a0.z; aa[3] += xv * a0.w; aa[4] += xv * a1.x; aa[5] += xv * a1.y; aa[6] += xv * a1.z; aa[7] += xv * a1.w;
              ax[0] += xv * x0.x; ax[1] += xv * x0.y; ax[2] += xv * x0.z; ax[3] += xv * x0.w; ax[4] += xv * x1.x; ax[5] += xv * x1.y; ax[6] += xv * x1.z; ax[7] += xv * x1.w; }
#pragma unroll
          for (int j = 0; j < 8; ++j) { const int d = dg * 8 + j; const float r = sigmoidf_(aa[j] + prm[320 + d]), ig = sigmoidf_(ax[j] + prm[384 + d]);
              const float la = 8.0f * r * prm[448 + d]; av[tok * 64 + d] = __expf(la); uv[tok * 64 + d] = sqrtf(fmaxf(-expm1f(2.0f * la), 0.f)) * (ig * xc[tok * 64 + d]); } }
        __syncthreads();
        if (tid < 64) { for (int r = 0; r < 64; ++r) { hcar = av[r * 64 + tid] * hcar + uv[r * 64 + tid]; av[r * 64 + tid] = hcar; } }
        __syncthreads();
        for (int i = tid; i < 4096; i += 512) { const int r = i >> 6, c = i & 63; CAT[((size_t)b * SEQ + t0 + r) * D + nb * 64 + c] = (bf16_t)f2bf(av[i] * gelu_tanh(ga[i])); }
    }
    __syncthreads();
}
__device__ __forceinline__ void mix_attn_item(Frame& F, int b, int c, int h) {
    LAS float* Ks = (LAS float*)F.lds;   LAS float* Vs = Ks + 64 * 68;   LAS float* bs = Vs + 4096;   LAS float* Ss = bs + 520;
    const bf16_t* Z = (const bf16_t*)(F.ws + WS_Z); bf16_t* CAT = (bf16_t*)(F.ws + WS_CAT);
    const int tid = F.tid, t = tid >> 3, sub = tid & 7;
    __syncthreads();
    for (int i = tid; i < 513; i += 512) bs[i] = F.in[12][h * 513 + i];
    unsigned q2[32]; float o[64];
    { const unsigned* qp = (const unsigned*)(Z + ((size_t)b * SEQ + c * 64 + t) * AB_IN + 1024 + h * 64);
#pragma unroll
      for (int d = 0; d < 32; ++d) q2[d] = qp[d];
#pragma unroll
      for (int d = 0; d < 64; ++d) o[d] = 0.f; }
    float mrun = -3.0e38f, lrun = 0.f;
    for (int kc = (c >= 8 ? c - 8 : 0); kc <= c; ++kc) {
        __syncthreads();
        for (int i = tid; i < 4096; i += 512) { const int s = i >> 6, d = i & 63; const size_t base = ((size_t)b * SEQ + kc * 64 + s) * AB_IN + h * 64 + d;
            Ks[s * 68 + d] = bf2f(Z[base + 1536]); Vs[s * 64 + d] = bf2f(Z[base + 2048]); }
        __syncthreads();
        float tmax = -3.0e38f;
#pragma unroll 1
        for (int jj = 0; jj < 8; ++jj) { const int s = sub + 8 * jj; const LAS f32x4* kp = (const LAS f32x4*)(Ks + s * 68); float a = 0.f;
#pragma unroll
            for (int d4 = 0; d4 < 16; ++d4) { const f32x4 kv = kp[d4]; a += bf2f(q2[2 * d4] & 0xffffu) * kv.x + bf2f(q2[2 * d4] >> 16) * kv.y + bf2f(q2[2 * d4 + 1] & 0xffffu) * kv.z + bf2f(q2[2 * d4 + 1] >> 16) * kv.w; }
            a *= 0.125f;
            int rel = t - ((kc - c) * 64 + s); rel = rel < -256 ? -256 : (rel > 256 ? 256 : rel);
            a += bs[rel + 256]; Ss[t * 65 + s] = a; tmax = fmaxf(tmax, a); }
        const float mnew = fmaxf(mrun, tmax), f = __expf(mrun - mnew);
        lrun *= f;
#pragma unroll
        for (int d = 0; d < 64; ++d) o[d] *= f;
#pragma unroll 1
        for (int jj = 0; jj < 8; ++jj) { const int s = sub + 8 * jj; const float p = __expf(Ss[t * 65 + s] - mnew); lrun += p; const LAS f32x4* vp = (const LAS f32x4*)(Vs + s * 64);
#pragma unroll
            for (int d4 = 0; d4 < 16; ++d4) { const f32x4 vv = vp[d4]; o[4 * d4] += p * vv.x; o[4 * d4 + 1] += p * vv.y; o[4 * d4 + 2] += p * vv.z; o[4 * d4 + 3] += p * vv.w; } }
        mrun = mnew;
    }
    float mall = mrun;
    mall = fmaxf(mall, __shfl_xor(mall, 1)); mall = fmaxf(mall, __shfl_xor(mall, 2)); mall = fmaxf(mall, __shfl_xor(mall, 4));
    const float f = __expf(mrun - mall); lrun *= f;
    lrun += __shfl_xor(lrun, 1); lrun += __shfl_xor(lrun, 2); lrun += __shfl_xor(lrun, 4);
    const float inv = 1.0f / lrun;
    bf16_t* op = CAT + ((size_t)b * SEQ + c * 64 + t) * D + 512 + h * 64;
#pragma unroll
    for (int d = 0; d < 64; ++d) { float v = o[d] * f; v += __shfl_xor(v, 1); v += __shfl_xor(v, 2); v += __shfl_xor(v, 4); if ((d >> 3) == sub) op[d] = (bf16_t)f2bf(v * inv); }
}

typedef float f32x16 __attribute__((ext_vector_type(16)));
typedef short s16x4 __attribute__((ext_vector_type(4)));
__device__ __forceinline__ s16x4 ds_tr16(const LAS unsigned char* p) { return __builtin_bit_cast(s16x4, __builtin_amdgcn_ds_read_tr16_b64_v4i16((LAS s16x4*)p)); }
constexpr int ATT_BT_BYTES = 8 * 520 * 4;
__device__ __forceinline__ void attn_load_bias(Frame& F) {
    LAS float* bt = (LAS float*)F.lds;
    __syncthreads();
    for (int i = F.tid; i < 8 * 513; i += 512) { const int h = i / 513, j = i % 513; bt[h * 520 + j] = F.in[12][i] * 1.4426950408889634f; }
    __syncthreads();
}
__device__ __forceinline__ void attn_wave_mfma(Frame& F, int b, int c, int h) {
    const bf16_t* Z = (const bf16_t*)(F.ws + WS_Z); bf16_t* CAT = (bf16_t*)(F.ws + WS_CAT);
    const int l = F.lane, r = l & 31, hh = l >> 5;
    const LAS float* btab = (const LAS float*)F.lds + h * 520;
    LAS unsigned char* Vw = F.lds + ATT_BT_BYTES + F.wave * 8192;
    const float SC = 0.125f * 1.4426950408889634f;
    bf16x8 qf[2][4];
    { const bf16_t* Qb = Z + ((size_t)b * SEQ + c * 64) * AB_IN + 1024 + h * 64;
#pragma unroll
      for (int qb = 0; qb < 2; ++qb)
#pragma unroll
          for (int ks = 0; ks < 4; ++ks) qf[qb][ks] = *(const bf16x8*)(Qb + (size_t)(qb * 32 + r) * AB_IN + ks * 16 + hh * 8); }
    f32x16 o[2][2];
#pragma unroll
    for (int a = 0; a < 2; ++a)
#pragma unroll
        for (int d = 0; d < 2; ++d)
#pragma unroll
            for (int i = 0; i < 16; ++i) o[a][d][i] = 0.f;
    float mrun[2] = {-1.0e30f, -1.0e30f}, lsum[2] = {0.f, 0.f};
    const int q4 = (l & 15) >> 2, p4 = l & 3, cb = (l >> 4) & 1, xs = (q4 >> 1) & 1;
    const LAS unsigned char* vbase = Vw + (4 * hh + q4) * 128 + p4 * 8 + cb * 32;
    const LAS unsigned char* vb[2] = {vbase + xs * 64, vbase + (1 - xs) * 64};
    for (int kc = (c >= 8 ? c - 8 : 0); kc <= c; ++kc) {
        const bf16_t* Kb = Z + ((size_t)b * SEQ + kc * 64) * AB_IN + 1536 + h * 64; const bf16_t* Vb = Kb + 512;
#pragma unroll
        for (int hf = 0; hf < 2; ++hf) { u32x4 vr[4];
#pragma unroll
          for (int i = 0; i < 4; ++i) vr[i] = *(const u32x4*)(Vb + (size_t)((hf * 4 + i) * 8 + (l >> 3)) * AB_IN + (l & 7) * 8);
#pragma unroll
          for (int i = 0; i < 4; ++i) { const int s = (hf * 4 + i) * 8 + (l >> 3), ci = l & 7, pb = (ci >> 1) ^ (((s >> 1) & 1) << 1); *(LAS u32x4*)(Vw + s * 128 + pb * 32 + (ci & 1) * 16) = vr[i]; }
          asm volatile("" ::: "memory"); }
        asm volatile("" ::: "memory");
        bf16x8 kf[2][4];
#pragma unroll
        for (int sb = 0; sb < 2; ++sb)
#pragma unroll
            for (int ks = 0; ks < 4; ++ks) kf[sb][ks] = *(const bf16x8*)(Kb + (size_t)(sb * 32 + r) * AB_IN + ks * 16 + hh * 8);
        const int dt = (c - kc) * 64;
#pragma unroll
        for (int qb = 0; qb < 2; ++qb) {
            f32x16 st[2];
#pragma unroll
            for (int sb = 0; sb < 2; ++sb) {
#pragma unroll
                for (int i = 0; i < 16; ++i) st[sb][i] = 0.f;
#pragma unroll
                for (int ks = 0; ks < 4; ++ks) st[sb] = __builtin_amdgcn_mfma_f32_32x32x16_bf16(kf[sb][ks], qf[qb][ks], st[sb], 0, 0, 0); }
            if (dt >= 320) { const float bc = btab[512];
#pragma unroll
                for (int sb = 0; sb < 2; ++sb)
#pragma unroll
                    for (int i = 0; i < 16; ++i) st[sb][i] = st[sb][i] * SC + bc;
            } else { const int base = dt + qb * 32 + r - 4 * hh + 256;
#pragma unroll
                for (int sb = 0; sb < 2; ++sb)
#pragma unroll
                    for (int i = 0; i < 16; ++i) { int idx = base - sb * 32 - ((i & 3) + 8 * (i >> 2)); idx = idx > 512 ? 512 : idx; st[sb][i] = st[sb][i] * SC + btab[idx]; } }
            float mx = st[0][0];
#pragma unroll
            for (int sb = 0; sb < 2; ++sb)
#pragma unroll
                for (int i = 0; i < 16; ++i) mx = fmaxf(mx, st[sb][i]);
            mx = fmaxf(mx, __shfl_xor(mx, 32));
            const float mn = fmaxf(mrun[qb], mx), alpha = __builtin_amdgcn_exp2f(mrun[qb] - mn); mrun[qb] = mn;
            float rs = 0.f;
#pragma unroll
            for (int sb = 0; sb < 2; ++sb)
#pragma unroll
                for (int i = 0; i < 16; ++i) { const float pv = __builtin_amdgcn_exp2f(st[sb][i] - mn); st[sb][i] = pv; rs += pv; }
            rs += __shfl_xor(rs, 32); lsum[qb] = lsum[qb] * alpha + rs;
#pragma unroll
            for (int d = 0; d < 2; ++d)
#pragma unroll
                for (int i = 0; i < 16; ++i) o[qb][d][i] *= alpha;
            bf16x8 pf[4];
#pragma unroll
            for (int kk = 0; kk < 4; ++kk) { const int sb = kk >> 1, s2 = kk & 1; u32x4 w;
                w.x = cvt_pk_bf16(st[sb][8 * s2 + 0], st[sb][8 * s2 + 1]); w.y = cvt_pk_bf16(st[sb][8 * s2 + 2], st[sb][8 * s2 + 3]);
                w.z = cvt_pk_bf16(st[sb][8 * s2 + 4], st[sb][8 * s2 + 5]); w.w = cvt_pk_bf16(st[sb][8 * s2 + 6], st[sb][8 * s2 + 7]); pf[kk] = __builtin_bit_cast(bf16x8, w); }
#pragma unroll
            for (int d = 0; d < 2; ++d)
#pragma unroll
                for (int kk = 0; kk < 4; ++kk) { const int rowoff = ((kk >> 1) * 32 + 16 * (kk & 1)) * 128;
                    const s16x4 lo = ds_tr16(vb[d] + rowoff), hi = ds_tr16(vb[d] + rowoff + 8 * 128);
                    const bf16x8 vf = (bf16x8){lo[0], lo[1], lo[2], lo[3], hi[0], hi[1], hi[2], hi[3]};
                    o[qb][d] = __builtin_amdgcn_mfma_f32_32x32x16_bf16(vf, pf[kk], o[qb][d], 0, 0, 0); }
        }
    }
#pragma unroll
    for (int qb = 0; qb < 2; ++qb) { const float inv = 1.0f / lsum[qb]; bf16_t* op = CAT + ((size_t)b * SEQ + c * 64 + qb * 32 + r) * D + 512 + h * 64 + 4 * hh;
#pragma unroll
        for (int d = 0; d < 2; ++d)
#pragma unroll
            for (int g = 0; g < 4; ++g) { u32x2 w; w.x = cvt_pk_bf16(o[qb][d][4 * g] * inv, o[qb][d][4 * g + 1] * inv); w.y = cvt_pk_bf16(o[qb][d][4 * g + 2] * inv, o[qb][d][4 * g + 3] * inv);
                *(u32x2*)(op + d * 32 + 8 * g) = w; } }
}

constexpr int RG_XA = 0, RG_GA0 = 8704, RG_GA1 = RG_GA0 + 8192, RG_XCB = RG_GA1 + 8192, RG_WA = RG_XCB + 9216, RG_WX = RG_WA + 9216, RG_AV = RG_WX + 9216, RG_UV = RG_AV + 16384, RG_SA = RG_UV + 16384, RG_SH = RG_SA + 2048, RG_END = RG_SH + 2048;
static_assert(RG_END <= RING_BYTES, "rglru lds");
__device__ __forceinline__ float gelu_fast(float x) { const float u = 1.5957691216057308f * (x + 0.044715f * x * x * x); return x / (1.0f + __expf(-u)); }
__device__ __forceinline__ void rglru_item(Frame& F, int b, int nb) {
    const bf16_t* Z = (const bf16_t*)(F.ws + WS_Z); bf16_t* CAT = (bf16_t*)(F.ws + WS_CAT);
    LAS unsigned char* L = F.lds;
    LAS float* AV = (LAS float*)(L + RG_AV); LAS float* UV = (LAS float*)(L + RG_UV); LAS float* SA = (LAS float*)(L + RG_SA); LAS float* SH = (LAS float*)(L + RG_SH);
    const int tid = F.tid, l = F.lane, w = F.wave, i16 = l & 15, q4 = l >> 4;
    __syncthreads();
    for (int i = tid; i < 4096; i += 512) { const int c = i >> 6, d = i & 63;
        *(LAS bf16_t*)(L + RG_WA + d * 144 + c * 2) = (bf16_t)f2bf(F.in[7][nb * 4096 + i]); *(LAS bf16_t*)(L + RG_WX + d * 144 + c * 2) = (bf16_t)f2bf(F.in[9][nb * 4096 + i]); }
    const int ct = tid >> 3, ch8 = tid & 7;
    float cw[4][8], cbv[8];
#pragma unroll
    for (int j = 0; j < 8; ++j) { const int ch = nb * 64 + 8 * ch8 + j; cbv[j] = F.in[6][ch];
#pragma unroll
        for (int k = 0; k < 4; ++k) cw[k][j] = F.in[5][k * 512 + ch]; }
    const int tb = w >> 1;
    float bav[2], bxv[2], lsv[2];
#pragma unroll
    for (int cc = 0; cc < 2; ++cc) { const int d = nb * 64 + 16 * ((w & 1) * 2 + cc) + i16; bav[cc] = F.in[8][d]; bxv[cc] = F.in[10][d]; const float lam = F.in[11][d]; lsv[cc] = 8.0f * (fminf(lam, 0.f) - log1pf(__expf(-fabsf(lam)))); }
    const int sc = tid & 63, sseg = tid >> 6;
    float carry = 0.f;
    const size_t rowb = (size_t)b * SEQ;
    u32x4 px0, px1, pg;
    const u32x4 zero4 = (u32x4){0u, 0u, 0u, 0u};
#define RG_LOAD(t0_) do { { const int r = tid >> 3, tg = (t0_) - 3 + r; px0 = tg >= 0 ? *(const u32x4*)(Z + (rowb + tg) * AB_IN + nb * 64 + (tid & 7) * 8) : zero4; } \
        if (tid < 24) { const int r = 64 + (tid >> 3), tg = (t0_) - 3 + r; px1 = *(const u32x4*)(Z + (rowb + tg) * AB_IN + nb * 64 + (tid & 7) * 8); } \
        pg = *(const u32x4*)(Z + (rowb + (t0_) + (tid >> 3)) * AB_IN + 512 + nb * 64 + (tid & 7) * 8); } while (0)
    RG_LOAD(0);
#pragma unroll 1
    for (int tile = 0; tile < 32; ++tile) {
        const int t0 = tile * 64; LAS unsigned char* GA = L + ((tile & 1) ? RG_GA1 : RG_GA0);
        *(LAS u32x4*)(L + RG_XA + tid * 16) = px0; if (tid < 24) *(LAS u32x4*)(L + RG_XA + (512 + tid) * 16) = px1;
        *(LAS u32x4*)(GA + tid * 16) = pg;
        __syncthreads();
        if (tile < 31) RG_LOAD(t0 + 64);
        { float xc[8];
#pragma unroll
          for (int j = 0; j < 8; ++j) xc[j] = cbv[j];
#pragma unroll
          for (int k = 0; k < 4; ++k) { const u32x4 xv = *(const LAS u32x4*)(L + RG_XA + (ct + k) * 128 + ch8 * 16); const unsigned xa[4] = {xv.x, xv.y, xv.z, xv.w};
#pragma unroll
              for (int j = 0; j < 8; ++j) xc[j] += cw[k][j] * bf2f((j & 1) ? (xa[j >> 1] >> 16) : (xa[j >> 1] & 0xffffu)); }
          *(LAS u32x4*)(L + RG_XCB + ct * 144 + ch8 * 16) = (u32x4){cvt_pk_bf16(xc[0], xc[1]), cvt_pk_bf16(xc[2], xc[3]), cvt_pk_bf16(xc[4], xc[5]), cvt_pk_bf16(xc[6], xc[7])}; }
        __syncthreads();
#pragma unroll
        for (int cc = 0; cc < 2; ++cc) { const int db = (w & 1) * 2 + cc; f32x4 aA = (f32x4){0.f, 0.f, 0.f, 0.f}, aX = aA;
#pragma unroll
            for (int ks = 0; ks < 2; ++ks) { const bf16x8 a = *(const LAS bf16x8*)(L + RG_XCB + (16 * tb + i16) * 144 + (32 * ks + 8 * q4) * 2);
                const bf16x8 ba = *(const LAS bf16x8*)(L + RG_WA + (16 * db + i16) * 144 + (32 * ks + 8 * q4) * 2), bx = *(const LAS bf16x8*)(L + RG_WX + (16 * db + i16) * 144 + (32 * ks + 8 * q4) * 2);
                aA = MFMA16(a, ba, aA); aX = MFMA16(a, bx, aX); }
#pragma unroll
            for (int rg = 0; rg < 4; ++rg) { const int t = 16 * tb + 4 * q4 + rg, d = 16 * db + i16; const float xcv = bf2f(*(const LAS bf16_t*)(L + RG_XCB + t * 144 + d * 2));
                const float r = sigmoidf_(aA[rg] + bav[cc]), ig = sigmoidf_(aX[rg] + bxv[cc]), la = r * lsv[cc];
                AV[t * 64 + d] = __expf(la); UV[t * 64 + d] = sqrtf(fmaxf(1.0f - __expf(2.0f * la), 0.f)) * (ig * xcv); } }
        __syncthreads();
        float aj[8], uj[8];
        { float A = 1.f, H = 0.f;
#pragma unroll
          for (int j = 0; j < 8; ++j) { aj[j] = AV[(8 * sseg + j) * 64 + sc]; uj[j] = UV[(8 * sseg + j) * 64 + sc]; H = aj[j] * H + uj[j]; A *= aj[j]; }
          SA[sseg * 64 + sc] = A; SH[sseg * 64 + sc] = H; }
        __syncthreads();
        { float run = carry, hin = carry;
#pragma unroll
          for (int sg = 0; sg < 8; ++sg) { if (sg == sseg) hin = run; run = SA[sg * 64 + sc] * run + SH[sg * 64 + sc]; }
          carry = run; float hv = hin;
#pragma unroll
          for (int j = 0; j < 8; ++j) { hv = aj[j] * hv + uj[j]; const int t = 8 * sseg + j; const float g = bf2f(*(const LAS bf16_t*)(GA + t * 128 + sc * 2));
              CAT[(rowb + t0 + t) * D + nb * 64 + sc] = (bf16_t)f2bf(hv * gelu_fast(g)); } }
    }
#undef RG_LOAD
    __syncthreads();
}
__device__ __forceinline__ void p_mix0(Frame& F) {
    const int j = F.vcu;
    if (j >= 128 && j < 256) rglru_item(F, (j - 128) >> 3, (j - 128) & 7);
#if PROBE_X & 32
    if (j >= 128 && j < 256) rglru_item(F, (j - 128) >> 3, (j - 128) & 7);
#endif
    attn_load_bias(F);
    if (j < 256) {
#pragma unroll 1
        for (int rep = 0; rep < ((PROBE_X & 64) ? 4 : 2); ++rep) attn_wave_mfma(F, j & 15, (rep & 1) == 0 ? 16 + (j >> 4) : 15 - (j >> 4), F.wave);
    }
    __syncthreads();
}
__device__ __forceinline__ void mix_hgrn_item(Frame& F, int b, int h) {
    LAS float* L = (LAS float*)F.lds;
    LAS float* qs = L; LAS float* fs = L + 4096; LAS float* is = L + 8192; LAS float* gs = L + 12288; LAS float* op = L + 16384;
    const bf16_t* Z = (const bf16_t*)(F.ws + WS_Z); bf16_t* CAT = (bf16_t*)(F.ws + WS_CAT); const float* lb = (const float*)(F.ws + WS_LB); const float* ng = F.in[16];
    const int tid = F.tid, v = tid & 127, kq = tid >> 7;
    float S[32];
#pragma unroll
    for (int k = 0; k < 32; ++k) S[k] = 0.f;
    for (int t0 = 0; t0 < SEQ; t0 += 32) {
        __syncthreads();
        for (int i = tid; i < 4096; i += 512) { const int r = i >> 7, c = i & 127; const bf16_t* zr = Z + ((size_t)b * SEQ + t0 + r) * C_IN + h * 128 + c;
            qs[i] = bf2f(zr[0]); const float l = lb[h * 128 + c]; fs[i] = l + (1.f - l) * sigmoidf_(bf2f(zr[1024])); is[i] = bf2f(zr[2048]); gs[i] = bf2f(zr[3072]); }
        __syncthreads();
        for (int r = 0; r < 32; ++r) { const float iv = is[r * 128 + v]; float o = 0.f;
#pragma unroll
            for (int k4 = 0; k4 < 8; ++k4) { const f32x4 f4 = *(const LAS f32x4*)(fs + r * 128 + kq * 32 + 4 * k4), q4 = *(const LAS f32x4*)(qs + r * 128 + kq * 32 + 4 * k4);
                S[4 * k4] = f4.x * S[4 * k4] + (1.f - f4.x) * iv; o += q4.x * S[4 * k4];
                S[4 * k4 + 1] = f4.y * S[4 * k4 + 1] + (1.f - f4.y) * iv; o += q4.y * S[4 * k4 + 1];
                S[4 * k4 + 2] = f4.z * S[4 * k4 + 2] + (1.f - f4.z) * iv; o += q4.z * S[4 * k4 + 2];
                S[4 * k4 + 3] = f4.w * S[4 * k4 + 3] + (1.f - f4.w) * iv; o += q4.w * S[4 * k4 + 3]; }
            op[(r * 4 + kq) * 128 + v] = o; }
        __syncthreads();
#pragma unroll
        for (int rr = 0; rr < 4; ++rr) { const int r = F.wave * 4 + rr; const int l = F.lane;
            const float o1 = op[(r * 4 + 0) * 128 + l] + op[(r * 4 + 1) * 128 + l] + op[(r * 4 + 2) * 128 + l] + op[(r * 4 + 3) * 128 + l];
            const float o2 = op[(r * 4 + 0) * 128 + 64 + l] + op[(r * 4 + 1) * 128 + 64 + l] + op[(r * 4 + 2) * 128 + 64 + l] + op[(r * 4 + 3) * 128 + 64 + l];
            const float rinv = rsqrtf(wave_sum(o1 * o1 + o2 * o2) * (1.f / 128.f) + EPS);
            bf16_t* cp = CAT + ((size_t)b * SEQ + t0 + r) * D + h * 128;
            cp[l] = (bf16_t)f2bf(o1 * rinv * ng[h * 128 + l] * gs[r * 128 + l]); cp[64 + l] = (bf16_t)f2bf(o2 * rinv * ng[h * 128 + 64 + l] * gs[r * 128 + 64 + l]); }
    }
    __syncthreads();
}


constexpr int HG_STR = 272;
constexpr int HG_LF = 0, HG_QH = 16384, HG_KK = 32768;
constexpr int HG_QE = 49152, HG_KN = HG_QE + 32 * HG_STR, HG_KS = HG_KN + 32 * HG_STR, HG_V0 = HG_KS + 32 * HG_STR, HG_V1 = HG_V0 + 32 * HG_STR, HG_G0 = HG_V1 + 32 * HG_STR, HG_G1 = HG_G0 + 32 * HG_STR;
constexpr int HG_AT = HG_G1 + 32 * HG_STR, HG_EB = HG_AT + 2560, HG_SEG = HG_EB + 512, HG_SSQ = HG_SEG + 2048, HG_END = HG_SSQ + 1024;
static_assert(HG_END <= RING_BYTES, "hgrn lds");
__device__ __forceinline__ void hgrn_item(Frame& F, int b, int h) {
    const bf16_t* Z = (const bf16_t*)(F.ws + WS_Z); bf16_t* CAT = (bf16_t*)(F.ws + WS_CAT); const float* lbp = (const float*)(F.ws + WS_LB); const float* ngp = F.in[16];
    LAS unsigned char* L = F.lds;
    LAS float* LF = (LAS float*)(L + HG_LF); LAS float* QH = (LAS float*)(L + HG_QH); LAS float* KK = (LAS float*)(L + HG_KK);
    LAS float* EB = (LAS float*)(L + HG_EB); LAS float* SEG = (LAS float*)(L + HG_SEG); LAS float* SSQ = (LAS float*)(L + HG_SSQ);
    LAS bf16_t* AT = (LAS bf16_t*)(L + HG_AT);
    const int tid = F.tid, l = F.lane, w = F.wave;
    const int lt = tid >> 4, lkc = tid & 15, sk = tid & 127, sseg = tid >> 7, i16 = l & 15, q4 = l >> 4, qq = i16 >> 2, pp = i16 & 3;
    float lbv[8];
#pragma unroll
    for (int j = 0; j < 8; ++j) lbv[j] = lbp[h * 128 + 8 * lkc + j];
    float ngv[4];
#pragma unroll
    for (int j = 0; j < 4; ++j) ngv[j] = ngp[h * 128 + 16 * w + 4 * q4 + j];
    f32x4 S[8];
#pragma unroll
    for (int i = 0; i < 8; ++i) S[i] = (f32x4){0.f, 0.f, 0.f, 0.f};
    __syncthreads();
    for (int i = tid; i < 640; i += 512) ((LAS unsigned*)(L + HG_AT))[i] = 0u;
    const bf16_t* zrow0 = Z + ((size_t)b * SEQ + lt) * C_IN + h * 128 + 8 * lkc;
    u32x4 pq = *(const u32x4*)(zrow0), pf = *(const u32x4*)(zrow0 + 1024), pv = *(const u32x4*)(zrow0 + 2048), pg = *(const u32x4*)(zrow0 + 3072);
#pragma unroll 1
    for (int st = 0; st < 64; ++st) {
        const int par = st & 1;
        LAS unsigned char* Vb = L + (par ? HG_V1 : HG_V0); LAS unsigned char* Gb = L + (par ? HG_G1 : HG_G0);
        { const unsigned qa[4] = {pq.x, pq.y, pq.z, pq.w}, fa[4] = {pf.x, pf.y, pf.z, pf.w};
          float lf[8], kk[8], qh[8];
#pragma unroll
          for (int j = 0; j < 8; ++j) { const float fz = bf2f((j & 1) ? (fa[j >> 1] >> 16) : (fa[j >> 1] & 0xffffu)); qh[j] = bf2f((j & 1) ? (qa[j >> 1] >> 16) : (qa[j >> 1] & 0xffffu));
              const float f = lbv[j] + (1.f - lbv[j]) * sigmoidf_(fz); lf[j] = __logf(f); kk[j] = 1.f - f; }
          LAS f32x4* d0 = (LAS f32x4*)(LF + lt * 128 + 8 * lkc); d0[0] = (f32x4){lf[0], lf[1], lf[2], lf[3]}; d0[1] = (f32x4){lf[4], lf[5], lf[6], lf[7]};
          LAS f32x4* d1 = (LAS f32x4*)(QH + lt * 128 + 8 * lkc); d1[0] = (f32x4){qh[0], qh[1], qh[2], qh[3]}; d1[1] = (f32x4){qh[4], qh[5], qh[6], qh[7]};
          LAS f32x4* d2 = (LAS f32x4*)(KK + lt * 128 + 8 * lkc); d2[0] = (f32x4){kk[0], kk[1], kk[2], kk[3]}; d2[1] = (f32x4){kk[4], kk[5], kk[6], kk[7]};
          *(LAS u32x4*)(Vb + lt * HG_STR + lkc * 16) = pv; *(LAS u32x4*)(Gb + lt * HG_STR + lkc * 16) = pg; }
        if (st < 63) { const bf16_t* zr = zrow0 + (size_t)(st + 1) * 32 * C_IN; pq = *(const u32x4*)(zr); pf = *(const u32x4*)(zr + 1024); pv = *(const u32x4*)(zr + 2048); pg = *(const u32x4*)(zr + 3072); }
        __syncthreads();
        float bl[8];
        { float a = 0.f;
#pragma unroll
          for (int j = 0; j < 8; ++j) { a += LF[(8 * sseg + j) * 128 + sk]; bl[j] = a; } }
        SEG[sseg * 128 + sk] = bl[7];
        __syncthreads();
        { const float s0 = SEG[sk], s1 = SEG[128 + sk], s2 = SEG[256 + sk], s3 = SEG[384 + sk];
          const float pre = (sseg > 0 ? s0 : 0.f) + (sseg > 1 ? s1 : 0.f) + (sseg > 2 ? s2 : 0.f), Bt = (s0 + s1) + (s2 + s3);
#pragma unroll
          for (int j = 0; j < 8; ++j) { const int t = 8 * sseg + j; const float bb = pre + bl[j];
              const float e1 = __expf(bb), e2 = __expf(fminf(-bb, 80.f)), e3 = __expf(Bt - bb), qh = QH[t * 128 + sk], kk = KK[t * 128 + sk];
              *(LAS bf16_t*)(L + HG_QE + t * HG_STR + sk * 2) = (bf16_t)f2bf(qh * e1);
              *(LAS bf16_t*)(L + HG_KN + t * HG_STR + sk * 2) = (bf16_t)f2bf(kk * e2);
              *(LAS bf16_t*)(L + HG_KS + t * HG_STR + sk * 2) = (bf16_t)f2bf(kk * e3); }
          if (sseg == 0) EB[sk] = __expf(Bt); }
        __syncthreads();
        if (w < 3) { const int tb = w ? 1 : 0, sb = (w == 2) ? 1 : 0; f32x4 acc = (f32x4){0.f, 0.f, 0.f, 0.f};
#pragma unroll
            for (int ks = 0; ks < 4; ++ks) { const bf16x8 a = *(const LAS bf16x8*)(L + HG_QE + (16 * tb + i16) * HG_STR + (32 * ks + 8 * q4) * 2), bq = *(const LAS bf16x8*)(L + HG_KN + (16 * sb + i16) * HG_STR + (32 * ks + 8 * q4) * 2);
                acc = MFMA16(a, bq, acc); }
#pragma unroll
            for (int rg = 0; rg < 4; ++rg) { const int t = 16 * tb + 4 * q4 + rg, sx = 16 * sb + i16; AT[t * 40 + sx] = (bf16_t)f2bf(sx <= t ? acc[rg] : 0.f); } }
        __syncthreads();
        bf16x8 vfr;
        { const s16x4 lo = ds_tr16(Vb + (8 * q4 + qq) * HG_STR + (16 * w + 4 * pp) * 2), hi = ds_tr16(Vb + (8 * q4 + 4 + qq) * HG_STR + (16 * w + 4 * pp) * 2);
          vfr = (bf16x8){lo[0], lo[1], lo[2], lo[3], hi[0], hi[1], hi[2], hi[3]}; }
        f32x4 O[2];
#pragma unroll
        for (int tb = 0; tb < 2; ++tb) { const bf16x8 at = *(const LAS bf16x8*)(L + HG_AT + (16 * tb + i16) * 80 + 16 * q4); O[tb] = MFMA16(vfr, at, ((f32x4){0.f, 0.f, 0.f, 0.f})); }
#pragma unroll
        for (int m = 0; m < 4; ++m) { u32x4 sp; sp.x = cvt_pk_bf16(S[2 * m][0], S[2 * m][1]); sp.y = cvt_pk_bf16(S[2 * m][2], S[2 * m][3]); sp.z = cvt_pk_bf16(S[2 * m + 1][0], S[2 * m + 1][1]); sp.w = cvt_pk_bf16(S[2 * m + 1][2], S[2 * m + 1][3]);
            const bf16x8 spk = __builtin_bit_cast(bf16x8, sp);
#pragma unroll
            for (int tb = 0; tb < 2; ++tb) { const u32x2 q0 = *(const LAS u32x2*)(L + HG_QE + (16 * tb + i16) * HG_STR + (32 * m + 4 * q4) * 2), q1 = *(const LAS u32x2*)(L + HG_QE + (16 * tb + i16) * HG_STR + (32 * m + 16 + 4 * q4) * 2);
                const u32x4 qv = (u32x4){q0.x, q0.y, q1.x, q1.y}; O[tb] = MFMA16(spk, __builtin_bit_cast(bf16x8, qv), O[tb]); } }
#pragma unroll
        for (int kb = 0; kb < 8; ++kb) { const s16x4 lo = ds_tr16(L + HG_KS + (8 * q4 + qq) * HG_STR + (16 * kb + 4 * pp) * 2), hi = ds_tr16(L + HG_KS + (8 * q4 + 4 + qq) * HG_STR + (16 * kb + 4 * pp) * 2);
            const bf16x8 kfr = (bf16x8){lo[0], lo[1], lo[2], lo[3], hi[0], hi[1], hi[2], hi[3]}; const f32x4 dec = *(const LAS f32x4*)(EB + 16 * kb + 4 * q4);
            S[kb] = MFMA16(kfr, vfr, S[kb] * dec); }
#pragma unroll
        for (int tb = 0; tb < 2; ++tb) { float ss = (O[tb][0] * O[tb][0] + O[tb][1] * O[tb][1]) + (O[tb][2] * O[tb][2] + O[tb][3] * O[tb][3]); ss += __shfl_xor(ss, 16); ss += __shfl_xor(ss, 32);
            if (q4 == 0) SSQ[(16 * tb + i16) * 8 + w] = ss; }
        __syncthreads();
#pragma unroll
        for (int tb = 0; tb < 2; ++tb) { const int t = 16 * tb + i16; const f32x4 a = *(const LAS f32x4*)(SSQ + t * 8), c = *(const LAS f32x4*)(SSQ + t * 8 + 4);
            const float rinv = rsqrtf(((a.x + a.y) + (a.z + a.w) + (c.x + c.y) + (c.z + c.w)) * (1.f / 128.f) + EPS);
            const u32x2 g2 = *(const LAS u32x2*)(Gb + t * HG_STR + (16 * w + 4 * q4) * 2);
            const float o0 = O[tb][0] * rinv * ngv[0] * bf2f(g2.x & 0xffffu), o1 = O[tb][1] * rinv * ngv[1] * bf2f(g2.x >> 16), o2 = O[tb][2] * rinv * ngv[2] * bf2f(g2.y & 0xffffu), o3 = O[tb][3] * rinv * ngv[3] * bf2f(g2.y >> 16);
            *(u32x2*)(CAT + ((size_t)b * SEQ + st * 32 + t) * D + h * 128 + 16 * w + 4 * q4) = (u32x2){cvt_pk_bf16(o0, o1), cvt_pk_bf16(o2, o3)}; }
    }
    __syncthreads();
}
__device__ __forceinline__ void p_gu(Frame& F, int layer) {
    unsigned char* ws = F.ws;
    moe_tables(F, layer);
    const LAS int* ts = (const LAS int*)(F.lds + TS_OFF); LAS unsigned* tab = (LAS unsigned*)(F.lds + TAB_OFF);
    pg8::MoeOrder<true> S{ts, tab, F.G, F.vcu, D};
    { const int* ltok = (const int*)(ws + WS_LTOK); pg8::Unit u;
      for (int i = 0; i < 6 && S.next(i, u); ++i) if (F.tid < 256) { const int pos = u.rl * 256 + F.tid; const int tok = pos < ts[40 + u.e] ? ltok[(size_t)u.e * CAP + pos] : 0; tab[i * 256 + F.tid] = (unsigned)tok * (unsigned)(D * 2); }
      __syncthreads(); }
    pg8::EpiGU E{(bf16_t*)(ws + WS_HB), (const float*)(ws + WS_LRSTD), ts + 40};
    pg8::gemm_phase<pg8::EpiGU, pg8::MoeOrder<true>, true>(F.lds, (const bf16_t*)(ws + WS_XB), (const bf16_t*)(ws + WS_WGU), D, S, E);
}
__device__ __forceinline__ void p_dn(Frame& F, int layer) {
    unsigned char* ws = F.ws;
    moe_tables(F, layer);
    const LAS int* ts = (const LAS int*)(F.lds + TS_OFF);
    pg8::MoeOrder<false> S{ts, nullptr, F.G, F.vcu, DEXP};
    pg8::EpiDN E{(bf16_t*)(ws + WS_Y), (const float*)(ws + WS_LW), ts + 40};
    pg8::gemm_phase<pg8::EpiDN, pg8::MoeOrder<false>, true>(F.lds, (const bf16_t*)(ws + WS_HB), (const bf16_t*)(ws + WS_WDN), DEXP, S, E);
}

__global__ void __launch_bounds__(512, 2) fwd(Args args) {
    extern __shared__ __attribute__((aligned(16))) unsigned char lds_raw[];
    Frame F;
    F.lds = (LAS unsigned char*)lds_raw; F.tid = threadIdx.x; F.lane = F.tid & 63; F.wave = __builtin_amdgcn_readfirstlane(F.tid >> 6);
    F.G = gridDim.x; { const int bx = blockIdx.x; F.vcu = (F.G % 8 == 0) ? (bx % 8) * (F.G / 8) + bx / 8 : bx; }
    F.in = args.in; F.out = args.out; F.ws = args.ws;
    unsigned char* ws = args.ws;
    bf16_t* XB = (bf16_t*)(ws + WS_XB); bf16_t* CAT = (bf16_t*)(ws + WS_CAT); bf16_t* Z = (bf16_t*)(ws + WS_Z);
    float* RSTD = (float*)(ws + WS_RSTD);
#if MK_ONE_LAUNCH == 2
    cg::grid_group grid = cg::this_grid();
#define GRID_BAR() grid.sync()
#elif MK_ONE_LAUNCH == 1
    if (F.tid < 2) ((volatile LAS unsigned*)(F.lds + MISC_OFF))[F.tid] = 0u;
    __syncthreads();
    const XcdBarrier xbar = xcd_barrier_post((unsigned*)(ws + WS_CTL) + CW_BAR, (volatile LAS unsigned*)(F.lds + MISC_OFF));
#define GRID_BAR() xcd_barrier(xbar)
#else
#define GRID_BAR() do {} while (0)
#endif
    #ifndef PH_MASK
#define PH_MASK 0x7fff
#endif
#define PHE(p) ((PH_MASK >> (p)) & 1)
    const int lo = args.ph_lo, hi = args.ph_hi;
#ifndef PROBE_MASK
#define PROBE_MASK 0
#endif
#define REPN(k) (((PROBE_MASK >> (k)) & 1) ? 2 : 1)
#define IN(k) (PHE(k) && lo <= (k) && (k) < hi)
#define SEAM(k) do { if (lo <= (k) && (k) + 1 < hi) GRID_BAR(); } while (0)
    if (IN(PH_PRO)) { { p_prologue(F); } if (REPN(PH_PRO) == 2) { GRID_BAR(); { p_prologue(F); } } } SEAM(PH_PRO);
    if (IN(PH_IN0)) { { pg8::DenseOrder S; S.init(T, AB_IN, D, F.G, (int)blockIdx.x); pg8::EpiIn E{Z, AB_IN, RSTD, 0, 1 << 30};
        pg8::gemm_phase<pg8::EpiIn, pg8::DenseOrder, true>(F.lds, XB, (const bf16_t*)(ws + WS_WIN0), D, S, E); } if (REPN(PH_IN0) == 2) { GRID_BAR(); { pg8::DenseOrder S; S.init(T, AB_IN, D, F.G, (int)blockIdx.x); pg8::EpiIn E{Z, AB_IN, RSTD, 0, 1 << 30};
        pg8::gemm_phase<pg8::EpiIn, pg8::DenseOrder, true>(F.lds, XB, (const bf16_t*)(ws + WS_WIN0), D, S, E); } } } SEAM(PH_IN0);
    if (IN(PH_MIX0)) { { p_mix0(F); } if (REPN(PH_MIX0) == 2) { GRID_BAR(); { p_mix0(F); } } } SEAM(PH_MIX0);
    if (IN(PH_OUT0)) { { pg8::DenseOrder S; S.init(T, D, D, F.G, (int)blockIdx.x); pg8::EpiOut E{args.in[0], args.out, XB, 0};
        pg8::gemm_phase<pg8::EpiOut, pg8::DenseOrder, true>(F.lds, CAT, (const bf16_t*)(ws + WS_WOUT0), D, S, E); } if (REPN(PH_OUT0) == 2) { GRID_BAR(); { pg8::DenseOrder S; S.init(T, D, D, F.G, (int)blockIdx.x); pg8::EpiOut E{args.in[0], args.out, XB, 0};
        pg8::gemm_phase<pg8::EpiOut, pg8::DenseOrder, true>(F.lds, CAT, (const bf16_t*)(ws + WS_WOUT0), D, S, E); } } } SEAM(PH_OUT0);
    if (IN(PH_R1)) { p_router(F, 0); if (PROBE_X & 1) { GRID_BAR(); p_router(F, 0, 1); } } SEAM(PH_R1);
    if (IN(PH_GU0)) { { p_gu(F, 0); } if (REPN(PH_GU0) == 2) { GRID_BAR(); { p_gu(F, 0); } } } SEAM(PH_GU0);
    if (IN(PH_DN0)) { { p_dn(F, 0); } if (REPN(PH_DN0) == 2) { GRID_BAR(); { p_dn(F, 0); } } } SEAM(PH_DN0);
    if (IN(PH_R2)) { if (PROBE_X & 2) { p_combine(F, 0, 0, 1); GRID_BAR(); } p_combine(F, 0, 0); } SEAM(PH_R2);
    if (IN(PH_IN1)) { { pg8::DenseOrder S; S.init(T, C_IN, D, F.G, (int)blockIdx.x); pg8::EpiIn E{Z, C_IN, RSTD, 1024, 3072};
        pg8::gemm_phase<pg8::EpiIn, pg8::DenseOrder, true>(F.lds, XB, (const bf16_t*)(ws + WS_WIN1), D, S, E); } if (REPN(PH_IN1) == 2) { GRID_BAR(); { pg8::DenseOrder S; S.init(T, C_IN, D, F.G, (int)blockIdx.x); pg8::EpiIn E{Z, C_IN, RSTD, 1024, 3072};
        pg8::gemm_phase<pg8::EpiIn, pg8::DenseOrder, true>(F.lds, XB, (const bf16_t*)(ws + WS_WIN1), D, S, E); } } } SEAM(PH_IN1);
    if (IN(PH_MIX1)) { { if (F.vcu < 128) hgrn_item(F, F.vcu >> 3, F.vcu & 7); else { __syncthreads(); moe_convert(F, 1, F.vcu - 128, F.G - 128); if (PROBE_X & 4) moe_convert(F, 1, F.vcu - 128, F.G - 128); } } if (REPN(PH_MIX1) == 2) { GRID_BAR(); { if (F.vcu < 128) hgrn_item(F, F.vcu >> 3, F.vcu & 7); else { __syncthreads(); moe_convert(F, 1, F.vcu - 128, F.G - 128); if (PROBE_X & 4) moe_convert(F, 1, F.vcu - 128, F.G - 128); } } } } SEAM(PH_MIX1);
    if (IN(PH_OUT1)) { if (PROBE_X & 16) { pg8::DenseOrder S; S.init(T, D, D, F.G, (int)blockIdx.x); pg8::EpiOut E{args.out, args.out, XB, 1};
        pg8::gemm_phase<pg8::EpiOut, pg8::DenseOrder, true>(F.lds, CAT, (const bf16_t*)(ws + WS_WOUT1), D, S, E); GRID_BAR(); }
 pg8::DenseOrder S; S.init(T, D, D, F.G, (int)blockIdx.x); pg8::EpiOut E{args.out, args.out, XB, 0};
        pg8::gemm_phase<pg8::EpiOut, pg8::DenseOrder, true>(F.lds, CAT, (const bf16_t*)(ws + WS_WOUT1), D, S, E); } SEAM(PH_OUT1);
    if (IN(PH_R3)) { p_router(F, 1); } SEAM(PH_R3);
    if (IN(PH_GU1)) { { p_gu(F, 1); } if (REPN(PH_GU1) == 2) { GRID_BAR(); { p_gu(F, 1); } } } SEAM(PH_GU1);
    if (IN(PH_DN1)) { { p_dn(F, 1); } if (REPN(PH_DN1) == 2) { GRID_BAR(); { p_dn(F, 1); } } } SEAM(PH_DN1);
    if (IN(PH_R4)) { if (PROBE_X & 8) { p_combine(F, 1, 1, 1); GRID_BAR(); } p_combine(F, 1, 1); }
}

extern "C" void kernel_launch(void* const* d_in, const int* in_sizes, int n_in, void* d_out, int out_size, void* d_ws, size_t ws_size, hipStream_t stream) {
    static int grid = 0;
    if (grid == 0) {
        if (n_in != 23 || out_size != T * D || ws_size < WS_END) { fprintf(stderr, "kernel_launch: unexpected shapes: n_in %d out %d ws %zu (need %zu)\n", n_in, out_size, ws_size, (size_t)WS_END); grid = -1; return; }
        if (hipFuncSetAttribute((const void*)fwd, hipFuncAttributeMaxDynamicSharedMemorySize, LDS_BYTES) != hipSuccess) { fprintf(stderr, "kernel_launch: hipFuncSetAttribute failed\n"); grid = -1; return; }
        int dev = 0, cus = 0, per_cu = 0;
        hipGetDevice(&dev); hipDeviceGetAttribute(&cus, hipDeviceAttributeMultiprocessorCount, dev);
        hipOccupancyMaxActiveBlocksPerMultiprocessor(&per_cu, (const void*)fwd, 512, LDS_BYTES);
        (void)hipGetLastError();
        fprintf(stderr, "kernel_launch: cus %d per_cu %d ws %zu\n", cus, per_cu, ws_size);
        grid = cus > 0 ? cus : 256;
        if (per_cu < 1) fprintf(stderr, "kernel_launch: occupancy query says %d blocks per CU\n", per_cu);
    }
    if (grid < 0) return;
    hipMemsetAsync((char*)d_ws + WS_CTL, 0, CTL_BYTES, stream);
    Args a{};
    for (int i = 0; i < 23; ++i) a.in[i] = (const float*)d_in[i];
    a.out = (float*)d_out; a.ws = (unsigned char*)d_ws;
#if MK_ONE_LAUNCH
    a.ph_lo = 0; a.ph_hi = NPH;
    void* kargs[] = {&a};
    hipError_t e = hipLaunchCooperativeKernel((const void*)fwd, dim3(grid), dim3(512), kargs, LDS_BYTES, stream);
    if (e != hipSuccess) fprintf(stderr, "cooperative launch failed: %s (grid %d)\n", hipGetErrorString(e), grid);
#else
    for (int ph = 0; ph < NPH; ++ph) { a.ph_lo = ph; a.ph_hi = ph + 1; hipLaunchKernelGGL(fwd, dim3(grid), dim3(512), LDS_BYTES, stream, a); }
#endif
}
```

```cpp
#include <hip/hip_runtime.h>
#include <hip/hip_cooperative_groups.h>
#include <cstdio>
#include <cstdint>
namespace cg = cooperative_groups;

#ifndef PROBE_X
#define PROBE_X 0
#endif
#ifndef MK_ONE_LAUNCH
#define MK_ONE_LAUNCH 1
#endif

constexpr int T = 32768, D = 1024, SEQ = 2048, NB = 16;
constexpr int AB_IN = 2560, C_IN = 4096;
constexpr int NEXP = 32, DEXP = 512, CAP = 32768;
constexpr int MAXTILES = 288;
constexpr float EPS = 1e-6f;

#define LAS __attribute__((address_space(3)))
typedef unsigned short bf16_t;
typedef short bf16x8 __attribute__((ext_vector_type(8)));
typedef float f32x4 __attribute__((ext_vector_type(4)));
typedef unsigned u32x4 __attribute__((ext_vector_type(4)));
typedef unsigned u32x2 __attribute__((ext_vector_type(2)));
typedef float f32x2v __attribute__((ext_vector_type(2)));

constexpr size_t MiB = 1u << 20;
constexpr size_t WS_CTL = 0, CTL_BYTES = 1 * MiB;
constexpr size_t WS_RSTD = 1 * MiB;
constexpr size_t WS_LB = WS_RSTD + 128 * 1024;
constexpr size_t WS_RWH = WS_LB + 4096;
constexpr size_t WS_RWL = WS_RWH + 2 * 36 * 1024 * 2;
constexpr size_t WS_TOKINFO = 2 * MiB;
constexpr size_t WS_LTOK = 3 * MiB, WS_LRSTD = 7 * MiB, WS_LW = 11 * MiB;
constexpr size_t WS_WIN0 = 16 * MiB, WS_WOUT0 = 21 * MiB, WS_WIN1 = 23 * MiB, WS_WOUT1 = 31 * MiB;
constexpr size_t WS_WGU = 34 * MiB, WS_WDN = 98 * MiB;
constexpr size_t WS_XB = 130 * MiB, WS_CAT = 194 * MiB;
constexpr size_t WS_Z = 258 * MiB;
constexpr size_t WS_HB = 258 * MiB, WS_Y = 330 * MiB;
constexpr size_t WS_END = 514 * MiB;
constexpr int CW_CNT = 8192;
constexpr int CW_BAR = 4096;
constexpr int CW_Q0 = 512;

constexpr int RING_BYTES = 131072;
constexpr int TAB_OFF = RING_BYTES;
constexpr int TS_OFF = TAB_OFF + 6 * 1024;
constexpr int LDS_BYTES = 163840;
constexpr int MISC_OFF = LDS_BYTES - 64;

__device__ __forceinline__ unsigned f2bf(float f) { unsigned u = __float_as_uint(f); return (u + 0x7fffu + ((u >> 16) & 1u)) >> 16; }
__device__ __forceinline__ float bf2f(unsigned b) { return __uint_as_float(b << 16); }
__device__ __forceinline__ unsigned pk2(float lo, float hi) { return f2bf(lo) | (f2bf(hi) << 16); }
__device__ __forceinline__ unsigned cvt_pk_bf16(float lo, float hi) { unsigned r; asm volatile("v_cvt_pk_bf16_f32 %0, %1, %2" : "=v"(r) : "v"(lo), "v"(hi)); return r; }
__device__ __forceinline__ float wave_sum(float v) {
#pragma unroll
    for (int o = 1; o < 64; o <<= 1) v += __shfl_xor(v, o);
    return v;
}
__device__ __forceinline__ float sigmoidf_(float x) { return 1.0f / (1.0f + __expf(-x)); }
__device__ __forceinline__ float siluf_(float x) { return x / (1.0f + __expf(-x)); }
__device__ __forceinline__ float gelu_tanh(float x) { const float u = 0.7978845608028654f * (x + 0.044715f * x * x * x); return 0.5f * x * (1.0f + tanhf(u)); }
#define LDS_WAIT() asm volatile("s_waitcnt lgkmcnt(0)" ::: "memory")
#define MFMA16(a, b, c) __builtin_amdgcn_mfma_f32_16x16x32_bf16((a), (b), (c), 0, 0, 0)

namespace pg8 {
constexpr int BM = 256, BK = 64, HALF = 128, HTB = HALF * BK * 2, NXCD = 8, WGM = 8;
__host__ __device__ __forceinline__ int lds_byte(int r, int c) { const int st = (r >> 4) * 2 + (c >> 5), rr = r & 15, cc = c & 31, ob = rr * 64 + cc * 2; return st * 1024 + (ob ^ (((ob >> 9) & 1) << 5)); }
__host__ __device__ __forceinline__ void stage_rc(int b, int& R, int& C) { const int st = b / 1024, sb = b % 1024, swz = sb ^ (((sb >> 9) & 1) << 5); R = (st >> 1) * 16 + swz / 64; C = (st & 1) * 32 + (swz % 64) / 2; }
__host__ __device__ __forceinline__ int perm32(int rho) { const int n = rho >> 4, i = rho & 15; return 8 * (i >> 2) + 4 * n + (i & 3); }

struct Unit { unsigned boff; int arow, orow, ocol, e, rl, slot; };

struct DenseOrder {
    int nM, nN, nwg, G, c, K;
    __device__ void init(int M, int N, int K_, int G_, int c_) { nM = M / BM; nN = N / BM; nwg = nM * nN; G = G_; c = c_; K = K_; }
    __device__ __forceinline__ bool next(int i, Unit& u) const {
        const long L = (long)i * G + c; if (L >= nwg) return false;
        int wgid = (int)L; { const int q = nwg / NXCD, r = nwg % NXCD, xcd = wgid % NXCD, off = wgid / NXCD; wgid = (xcd < r ? xcd * (q + 1) : r * (q + 1) + (xcd - r) * q) + off; }
        const int nig = WGM * nN, gid = wgid / nig, fm = gid * WGM, gsz = (nM - fm) < WGM ? (nM - fm) : WGM;
        const int pm = __builtin_amdgcn_readfirstlane(fm + ((wgid % nig) % gsz)), pn = __builtin_amdgcn_readfirstlane((wgid % nig) / gsz);
        u.arow = pm * BM; u.orow = pm * BM; u.ocol = pn * BM; u.boff = (unsigned)(pn * BM) * (unsigned)K * 2u; u.e = 0; u.rl = 0; u.slot = i; return true;
    }
    static constexpr bool GATHER = false;
    __device__ __forceinline__ size_t abase(const Unit& u) const { return (size_t)u.arow * (size_t)K * 2u; }
    __device__ __forceinline__ unsigned aoff(const Unit&, int) const { return 0u; }
};
template <bool GATHER_> struct MoeOrder {
    static constexpr bool GATHER = GATHER_;
    const LAS int* ts; const LAS unsigned* tab; int G, vcu, K;
    __device__ __forceinline__ bool next(int i, Unit& u) const {
        const int L = i * G + vcu; const int NT = __builtin_amdgcn_readfirstlane(ts[32]); if (L >= NT * 4) return false;
        const int rt = L >> 2, pn = L & 3; int e = 0;
#pragma unroll
        for (int j = 1; j < 32; ++j) e += (ts[j] <= rt) ? 1 : 0;
        e = __builtin_amdgcn_readfirstlane(e);
        u.e = e; u.rl = rt - __builtin_amdgcn_readfirstlane(ts[e]); u.orow = rt * BM; u.arow = rt * BM; u.ocol = pn * BM; u.boff = (unsigned)(e * 1024 + pn * BM) * (unsigned)K * 2u; u.slot = i; return true;
    }
    __device__ __forceinline__ size_t abase(const Unit& u) const { return GATHER ? (size_t)0 : (size_t)u.arow * (size_t)K * 2u; }
    __device__ __forceinline__ unsigned aoff(const Unit& u, int r) const { return tab[u.slot * 256 + r]; }
};

typedef f32x4 Acc[2][2][4][2];

struct EpiIn {
    static constexpr bool PERM = true;
    bf16_t* O; int ldc; const float* rstd; int silu_lo_end, silu_hi_start;
    __device__ __forceinline__ void operator()(const Acc& acc, const Unit& u, int wr, int wc, int fr, int fq) const {
        const bool act = (u.ocol < silu_lo_end) || (u.ocol >= silu_hi_start);
#pragma unroll
        for (int ai = 0; ai < 2; ++ai)
#pragma unroll
            for (int m = 0; m < 4; ++m) {
                const int row = u.orow + ai * HALF + wr * 64 + m * 16 + fr; const float rs = rstd[row];
                bf16_t* rowp = O + (size_t)row * ldc + u.ocol + wc * 32 + 8 * fq;
#pragma unroll
                for (int bj = 0; bj < 2; ++bj) { f32x4 v0 = acc[ai][bj][m][0] * rs, v1 = acc[ai][bj][m][1] * rs;
                    if (act) {
#pragma unroll
                        for (int j = 0; j < 4; ++j) { v0[j] = siluf_(v0[j]); v1[j] = siluf_(v1[j]); } }
                    u32x4 w; w.x = cvt_pk_bf16(v0[0], v0[1]); w.y = cvt_pk_bf16(v0[2], v0[3]); w.z = cvt_pk_bf16(v1[0], v1[1]); w.w = cvt_pk_bf16(v1[2], v1[3]);
                    *(u32x4*)(rowp + bj * HALF) = w; } }
    }
};
struct EpiOut {
    static constexpr bool PERM = true;
    const float* resid; float* H; bf16_t* XB; int dry;
    __device__ __forceinline__ void operator()(const Acc& acc, const Unit& u, int wr, int wc, int fr, int fq) const {
#pragma unroll
        for (int ai = 0; ai < 2; ++ai)
#pragma unroll
            for (int m = 0; m < 4; ++m) {
                const int row = u.orow + ai * HALF + wr * 64 + m * 16 + fr; const size_t off = (size_t)row * D + u.ocol + wc * 32 + 8 * fq;
#pragma unroll
                for (int bj = 0; bj < 2; ++bj) { const f32x4 r0 = *(const f32x4*)(resid + off + bj * HALF), r1 = *(const f32x4*)(resid + off + bj * HALF + 4);
                    const f32x4 v0 = dry ? r0 : acc[ai][bj][m][0] + r0, v1 = dry ? r1 : acc[ai][bj][m][1] + r1;
                    *(f32x4*)(H + off + bj * HALF) = v0; *(f32x4*)(H + off + bj * HALF + 4) = v1;
                    u32x4 w; w.x = cvt_pk_bf16(v0[0], v0[1]); w.y = cvt_pk_bf16(v0[2], v0[3]); w.z = cvt_pk_bf16(v1[0], v1[1]); w.w = cvt_pk_bf16(v1[2], v1[3]);
                    *(u32x4*)(XB + off + bj * HALF) = w; } }
    }
};
struct EpiGU {
    static constexpr bool PERM = true;
    bf16_t* HB; const float* lrstd; const LAS int* cnt;
    __device__ __forceinline__ void operator()(const Acc& acc, const Unit& u, int wr, int wc, int fr, int fq) const {
        const int n_e = cnt[u.e];
#pragma unroll
        for (int ai = 0; ai < 2; ++ai)
#pragma unroll
            for (int m = 0; m < 4; ++m) {
                const int r = ai * HALF + wr * 64 + m * 16 + fr, pos = u.rl * BM + r; const float rs = pos < n_e ? lrstd[(size_t)u.e * CAP + pos] : 0.f;
                float h[8];
#pragma unroll
                for (int n = 0; n < 2; ++n)
#pragma unroll
                    for (int j = 0; j < 4; ++j) { const float g = acc[ai][0][m][n][j] * rs, uu = acc[ai][1][m][n][j] * rs; h[n * 4 + j] = siluf_(g) * uu; }
                u32x4 w; w.x = cvt_pk_bf16(h[0], h[1]); w.y = cvt_pk_bf16(h[2], h[3]); w.z = cvt_pk_bf16(h[4], h[5]); w.w = cvt_pk_bf16(h[6], h[7]);
                *(u32x4*)(HB + (size_t)(u.orow + r) * DEXP + (u.ocol >> 1) + wc * 32 + 8 * fq) = w; }
    }
};
struct EpiDN {
    static constexpr bool PERM = true;
    bf16_t* Y; const float* lw; const LAS int* cnt;
    __device__ __forceinline__ void operator()(const Acc& acc, const Unit& u, int wr, int wc, int fr, int fq) const {
        const int n_e = cnt[u.e];
#pragma unroll
        for (int ai = 0; ai < 2; ++ai)
#pragma unroll
            for (int m = 0; m < 4; ++m) {
                const int r = ai * HALF + wr * 64 + m * 16 + fr, pos = u.rl * BM + r; const float ws = pos < n_e ? lw[(size_t)u.e * CAP + pos] : 0.f;
                bf16_t* rowp = Y + (size_t)(u.orow + r) * D + u.ocol + wc * 32 + 8 * fq;
#pragma unroll
                for (int bj = 0; bj < 2; ++bj) { const f32x4 v0 = acc[ai][bj][m][0] * ws, v1 = acc[ai][bj][m][1] * ws;
                    u32x4 w; w.x = cvt_pk_bf16(v0[0], v0[1]); w.y = cvt_pk_bf16(v0[2], v0[3]); w.z = cvt_pk_bf16(v1[0], v1[1]); w.w = cvt_pk_bf16(v1[2], v1[3]);
                    *(u32x4*)(rowp + bj * HALF) = w; } }
    }
};

template <class Epi, class Sched, bool ALIGN_EPI>
__device__ __forceinline__ void gemm_phase(LAS unsigned char* lds, const bf16_t* A, const bf16_t* Bt, const int K, const Sched& S, const Epi& E) {
    const int tid = threadIdx.x, wid = __builtin_amdgcn_readfirstlane(tid >> 6), lane = tid & 63, wr = wid >> 2, wc = wid & 3, fr = lane & 15, fq = lane >> 4;
    const int nt = K / BK;
    unsigned voffB[2], vA0[2], vA1[2];
#pragma unroll
    for (int i = 0; i < 2; ++i) { int R, C; stage_rc(tid * 16 + i * 8192, R, C); const int Rb = Epi::PERM ? ((R & ~31) + perm32(R & 31)) : R;
        vA0[i] = (unsigned)(R * K + C) * 2u; vA1[i] = vA0[i]; voffB[i] = (unsigned)(Rb * K + C) * 2u; }
#define PG8_FILL(u) do { if constexpr (Sched::GATHER) { int tv_ = tid; asm volatile("" : "+v"(tv_)); _Pragma("unroll") for (int i = 0; i < 2; ++i) { int R, C; stage_rc(tv_ * 16 + i * 8192, R, C); \
        vA0[i] = S.aoff(u, R) + (unsigned)C * 2u; vA1[i] = S.aoff(u, HALF + R) + (unsigned)C * 2u; } } } while (0)
    const size_t kstep = (size_t)(BK * 2);
    const size_t hstep = (size_t)HALF * K * 2;
    const unsigned ldsw = (unsigned)wid * 1024u;
    const int aoff = lds_byte(wr * 64 + fr, fq * 8), boff = lds_byte(wc * 32 + fr, fq * 8);
#define PG8_SA(b, h) (((b) * 2 + (h)) * HTB)
#define PG8_SB(b, h) ((4 + (b) * 2 + (h)) * HTB)
#define PG8_STAGE(bufoff, gbase, voff) do { _Pragma("unroll") for (int _i = 0; _i < 2; ++_i) \
        __builtin_amdgcn_global_load_lds((const unsigned*)((const char*)(gbase) + (voff)[_i]), (LAS unsigned*)(lds + (bufoff) + ldsw + _i * 8192), 16, 0, 0); } while (0)
#define PG8_LDA(dst, b, h) do { _Pragma("unroll") for (int m = 0; m < 4; ++m) _Pragma("unroll") for (int k = 0; k < 2; ++k) dst[m][k] = *(const LAS bf16x8*)(lds + PG8_SA(b, h) + aoff + m * 2048 + k * 1024); } while (0)
#define PG8_LDB(dst, b, h) do { _Pragma("unroll") for (int n = 0; n < 2; ++n) _Pragma("unroll") for (int k = 0; k < 2; ++k) dst[n][k] = *(const LAS bf16x8*)(lds + PG8_SB(b, h) + boff + n * 2048 + k * 1024); } while (0)
#define PG8_MMA(ai, bj, At, Bt_) do { __builtin_amdgcn_s_setprio(1); _Pragma("unroll") for (int m = 0; m < 4; ++m) _Pragma("unroll") for (int n = 0; n < 2; ++n) _Pragma("unroll") for (int k = 0; k < 2; ++k) \
        acc[ai][bj][m][n] = __builtin_amdgcn_mfma_f32_16x16x32_bf16(Bt_[n][k], At[m][k], acc[ai][bj][m][n], 0, 0, 0); __builtin_amdgcn_s_setprio(0); } while (0)
#define PG8_WAIT_V(n) asm volatile("s_waitcnt vmcnt(" #n ")" ::: "memory")
#define PG8_WAIT_L(n) asm volatile("s_waitcnt lgkmcnt(" #n ")" ::: "memory")
#define PG8_BAR __builtin_amdgcn_s_barrier()
#define PG8_SCHED __builtin_amdgcn_sched_barrier(0)
    Unit cur, nxt; int ui = 0;
    if (!S.next(0, cur)) return;
    f32x4 acc[2][2][4][2];
#pragma unroll
    for (int a = 0; a < 2; ++a)
#pragma unroll
        for (int b = 0; b < 2; ++b)
#pragma unroll
            for (int m = 0; m < 4; ++m)
#pragma unroll
                for (int n = 0; n < 2; ++n) acc[a][b][m][n] = (f32x4){0.f, 0.f, 0.f, 0.f};
    bf16x8 At[4][2], B0[2][2], B1[2][2];
    PG8_FILL(cur);
    const char* cA0 = (const char*)A + S.abase(cur); const char* cA1 = cA0 + (Sched::GATHER ? (size_t)0 : hstep); const char* cB = (const char*)Bt + cur.boff;
    PG8_STAGE(PG8_SB(0, 0), cB, voffB); PG8_STAGE(PG8_SB(0, 1), cB + hstep, voffB); PG8_STAGE(PG8_SA(0, 0), cA0, vA0); PG8_STAGE(PG8_SA(0, 1), cA1, vA1);
    if (wr == 1) PG8_BAR;
    PG8_WAIT_V(2); PG8_BAR;
    PG8_STAGE(PG8_SB(1, 0), cB + kstep, voffB); PG8_STAGE(PG8_SA(1, 0), cA0 + kstep, vA0); PG8_STAGE(PG8_SB(1, 1), cB + hstep + kstep, voffB);
    PG8_WAIT_V(6); PG8_BAR;
    for (;;) {
        const bool has_next = S.next(ui + 1, nxt);
        const char* nB = has_next ? (const char*)Bt + nxt.boff : cB;
        const char* nA0 = has_next ? (const char*)A + S.abase(nxt) : cA0; const char* nA1 = nA0 + (Sched::GATHER ? (size_t)0 : hstep);
        for (int t = 0; t < nt; t += 2) {
            const bool last = (t == nt - 2);
            const char* a1 = cA1 + (size_t)(t + 1) * kstep;
            const char* a2 = last ? nA0 : cA0 + (size_t)(t + 2) * kstep; const char* a2h = last ? nA1 : cA1 + (size_t)(t + 2) * kstep; const char* b2 = last ? nB : cB + (size_t)(t + 2) * kstep;
            const char* a3 = a2 + kstep; const char* b3 = b2 + kstep;
            PG8_LDB(B0, 0, 0); PG8_LDB(B1, 0, 1); PG8_SCHED; PG8_LDA(At, 0, 0); PG8_STAGE(PG8_SA(1, 1), a1, vA1);
            if (last && has_next) PG8_FILL(nxt);
            PG8_WAIT_V(8); PG8_WAIT_L(0); PG8_BAR; PG8_MMA(0, 0, At, B0); PG8_MMA(0, 1, At, B1); PG8_BAR; PG8_SCHED;
            PG8_LDA(At, 0, 1); PG8_STAGE(PG8_SB(0, 0), b2, voffB); PG8_STAGE(PG8_SB(0, 1), b2 + hstep, voffB); PG8_STAGE(PG8_SA(0, 0), a2, vA0);
            PG8_WAIT_V(8); PG8_WAIT_L(0); PG8_BAR; PG8_MMA(1, 0, At, B0); PG8_MMA(1, 1, At, B1); PG8_BAR; PG8_SCHED;
            PG8_LDB(B0, 1, 0); PG8_LDB(B1, 1, 1); PG8_SCHED; PG8_LDA(At, 1, 0); PG8_STAGE(PG8_SA(0, 1), a2h, vA1);
            PG8_WAIT_V(8); PG8_WAIT_L(0); PG8_BAR; PG8_MMA(0, 0, At, B0); PG8_MMA(0, 1, At, B1); PG8_BAR; PG8_SCHED;
            PG8_LDA(At, 1, 1); PG8_STAGE(PG8_SB(1, 0), b3, voffB); PG8_STAGE(PG8_SB(1, 1), b3 + hstep, voffB); PG8_STAGE(PG8_SA(1, 0), a3, vA0);
            PG8_WAIT_V(8); PG8_WAIT_L(0); PG8_BAR; PG8_MMA(1, 0, At, B0); PG8_MMA(1, 1, At, B1); PG8_BAR; PG8_SCHED;
        }
        if constexpr (ALIGN_EPI) { if (wr == 0) PG8_BAR; }
        E(acc, cur, wr, wc, fr, fq);
        if (!has_next) break;
#pragma unroll
        for (int a = 0; a < 2; ++a)
#pragma unroll
            for (int b = 0; b < 2; ++b)
#pragma unroll
                for (int m = 0; m < 4; ++m)
#pragma unroll
                    for (int n = 0; n < 2; ++n) acc[a][b][m][n] = (f32x4){0.f, 0.f, 0.f, 0.f};
        cur = nxt; cB = nB; cA0 = nA0; cA1 = nA1; ++ui;
        if constexpr (ALIGN_EPI) { if (wr == 1) PG8_BAR; }
    }
    PG8_WAIT_V(0);
    if constexpr (!ALIGN_EPI) { if (wr == 0) PG8_BAR; }
    PG8_BAR;
#undef PG8_FILL
#undef PG8_SA
#undef PG8_SB
#undef PG8_STAGE
#undef PG8_LDA
#undef PG8_LDB
#undef PG8_MMA
#undef PG8_WAIT_V
#undef PG8_WAIT_L
#undef PG8_BAR
#undef PG8_SCHED
}
}


#define XB_TMO      128
#define XB_XCNT(j)  (256  + 64 * (j))
#define XB_XSUB(j)  (1280 + 64 * (j))
#define XB_XGEN(j)  (2304 + 64 * (j))
#define XB_TOP      3328
#define XB_TOPGEN   3392
#define XB_SPIN_CAP (1u << 18)
__device__ __forceinline__ unsigned xb_ld(unsigned* p)              { return __hip_atomic_load(p, __ATOMIC_RELAXED, __HIP_MEMORY_SCOPE_AGENT); }
__device__ __forceinline__ unsigned xb_add(unsigned* p, unsigned v) { return __hip_atomic_fetch_add(p, v, __ATOMIC_RELAXED, __HIP_MEMORY_SCOPE_AGENT); }
__device__ __forceinline__ unsigned xb_xcc_id() { return (unsigned)__builtin_amdgcn_s_getreg((3 << 11) | 20) & 0xFu; }
#define XB_SPIN(cond, bar) do { unsigned _sp = 0; while (cond) { __builtin_amdgcn_s_sleep(1); \
    if ((++_sp & 255u) == 0u) { if (xb_ld(&(bar)[XB_TMO])) break; if (_sp > XB_SPIN_CAP) { atomicAdd(&(bar)[XB_TMO], 1u); break; } } } } while (0)
struct XcdBarrier { unsigned* bar; unsigned x; volatile LAS unsigned* st; };
__device__ __forceinline__ XcdBarrier xcd_barrier_post(unsigned* bar, volatile LAS unsigned* st) {
    XcdBarrier b; b.bar = bar; b.x = xb_xcc_id(); b.st = st;
    if (threadIdx.x == 0) (void)xb_add(&bar[XB_XCNT(b.x)], 1u);
    return b;
}
__device__ __forceinline__ void xcd_barrier_complete(unsigned* bar, unsigned x, unsigned& nloc, unsigned& nx) {
    const unsigned G = gridDim.x * gridDim.y * gridDim.z;
    unsigned sum, cnt, mine, sp = 0u;
    for (;;) {
        sum = 0u; cnt = 0u; mine = 0u;
#pragma unroll
        for (unsigned j = 0; j < 16; ++j) { const unsigned c = xb_ld(&bar[XB_XCNT(j)]); sum += c; cnt += (c > 0u) ? 1u : 0u; mine = (j == x) ? c : mine; }
        if (sum == G) break;
        __builtin_amdgcn_s_sleep(1);
        if ((++sp & 255u) == 0u) { if (xb_ld(&bar[XB_TMO])) break; if (sp > XB_SPIN_CAP) { atomicAdd(&bar[XB_TMO], 1u); break; } }
    }
    nloc = mine > 0u ? mine : 1u; nx = cnt > 0u ? cnt : 1u;
}
__device__ __forceinline__ void xcd_barrier(const XcdBarrier& b) {
    asm volatile("s_waitcnt vmcnt(0)" ::: "memory");
    __syncthreads();
    if (threadIdx.x == 0) {
        unsigned* bar = b.bar;
        __builtin_amdgcn_s_waitcnt(0);
        unsigned nloc = b.st[0], nx = b.st[1];
        if (nloc == 0u) { xcd_barrier_complete(bar, b.x, nloc, nx); b.st[0] = nloc; b.st[1] = nx; }
        const unsigned old = xb_add(&bar[XB_XSUB(b.x)], 1u);
        const unsigned gen = old / nloc;
        if (old + 1u == (gen + 1u) * nloc) {
            __builtin_amdgcn_fence(__ATOMIC_RELEASE, "agent");
            asm volatile("s_waitcnt vmcnt(0)" ::: "memory");
            const unsigned og = xb_add(&bar[XB_TOP], 1u);
            const unsigned tg = og / nx;
            if (og + 1u == (tg + 1u) * nx) xb_add(&bar[XB_TOPGEN], 1u);
            else XB_SPIN(xb_ld(&bar[XB_TOPGEN]) == tg, bar);
            __builtin_amdgcn_fence(__ATOMIC_ACQUIRE, "agent");
            xb_add(&bar[XB_XGEN(b.x)], 1u);
            asm volatile("s_waitcnt vmcnt(0)" ::: "memory");
        } else {
            XB_SPIN(xb_ld(&bar[XB_XGEN(b.x)]) == gen, bar);
            __builtin_amdgcn_fence(__ATOMIC_ACQUIRE, "agent");
            asm volatile("s_waitcnt vmcnt(0)" ::: "memory");
        }
    }
    __syncthreads();
}

struct Args { const float* in[23]; float* out; unsigned char* ws; int ph_lo, ph_hi; };
enum { PH_PRO = 0, PH_IN0, PH_MIX0, PH_OUT0, PH_R1, PH_GU0, PH_DN0, PH_R2, PH_IN1, PH_MIX1, PH_OUT1, PH_R3, PH_GU1, PH_DN1, PH_R4, NPH };

struct Frame {
    LAS unsigned char* lds; int tid, lane, wave, vcu, G;
    const float* const* in; float* out; unsigned char* ws;
};

__device__ __forceinline__ void transpose_item(const float* W, int K, int N, const float* kscale, bf16_t* WT, int dest_row0, LAS float* scr, int kb, int nb, int lane) {
    const int k0 = 64 * kb, n0 = 32 * nb;
    float tv[32];
#pragma unroll
    for (int i = 0; i < 32; ++i) tv[i] = W[(size_t)(k0 + 2 * i + (lane >> 5)) * N + n0 + (lane & 31)];
    if (kscale) {
#pragma unroll
        for (int i = 0; i < 32; ++i) tv[i] *= kscale[k0 + 2 * i + (lane >> 5)]; }
#pragma unroll
    for (int i = 0; i < 32; ++i) scr[(2 * i + (lane >> 5)) * 33 + (lane & 31)] = tv[i];
    LDS_WAIT(); asm volatile("" ::: "memory");
    const int c = lane & 7;
#pragma unroll
    for (int j = 0; j < 4; ++j) { const int n = (lane >> 3) + 8 * j; const LAS float* s = scr + (8 * c) * 33 + n;
        u32x4 o; o.x = pk2(s[0 * 33], s[1 * 33]); o.y = pk2(s[2 * 33], s[3 * 33]); o.z = pk2(s[4 * 33], s[5 * 33]); o.w = pk2(s[6 * 33], s[7 * 33]);
        *(u32x4*)(WT + (size_t)(dest_row0 + n) * K + k0 + 8 * c) = o; }
    LDS_WAIT(); asm volatile("" ::: "memory");
}
__device__ __forceinline__ void moe_convert(Frame& F, int layer, int wg, int nwg) {
    LAS float* scr = (LAS float*)(F.lds + F.wave * 16384);
    const int gw = wg * 8 + F.wave, NGW = nwg * 8;
    const float* gffn = F.in[2] + layer * D;
    const float* Wg = F.in[20] + (size_t)layer * NEXP * D * DEXP; const float* Wu = F.in[21] + (size_t)layer * NEXP * D * DEXP; const float* Wd = F.in[22] + (size_t)layer * NEXP * DEXP * D;
    bf16_t* WGU = (bf16_t*)(F.ws + WS_WGU); bf16_t* WDN = (bf16_t*)(F.ws + WS_WDN);
    for (int it = gw; it < 3 * 8192; it += NGW) {
        const int which = it >> 13, r = it & 8191, e = r >> 8, q = r & 255;
        if (which < 2) { const int kb = q >> 4, nb = q & 15, n0 = nb * 32;
            const int dest = e * 1024 + (n0 >> 7) * 256 + (which ? 128 : 0) + (n0 & 127);
            transpose_item((which ? Wu : Wg) + (size_t)e * D * DEXP, D, DEXP, gffn, WGU, dest, scr, kb, nb, F.lane);
        } else { const int kb = q >> 5, nb = q & 31;
            transpose_item(Wd + (size_t)e * DEXP * D, DEXP, D, nullptr, WDN, e * 1024 + nb * 32, scr, kb, nb, F.lane); }
    }
}
__device__ __forceinline__ void p_prologue(Frame& F) {
    LAS float* scr = (LAS float*)(F.lds + F.wave * 16384);
    const int gw = F.vcu * 8 + F.wave, NGW = F.G * 8;
    constexpr int I0 = 16 * 80, I1 = 16 * 32, I2 = 16 * 128, I3 = 16 * 32;
    for (int it = gw; it < I0 + I1 + I2 + I3; it += NGW) {
        int r = it;
        if (r < I0) { transpose_item(F.in[4], D, AB_IN, F.in[1], (bf16_t*)(F.ws + WS_WIN0), (r % 80) * 32, scr, r / 80, r % 80, F.lane); continue; } r -= I0;
        if (r < I1) { transpose_item(F.in[13], D, D, nullptr, (bf16_t*)(F.ws + WS_WOUT0), (r % 32) * 32, scr, r / 32, r % 32, F.lane); continue; } r -= I1;
        if (r < I2) { transpose_item(F.in[14], D, C_IN, F.in[1] + D, (bf16_t*)(F.ws + WS_WIN1), (r % 128) * 32, scr, r / 128, r % 128, F.lane); continue; } r -= I2;
        transpose_item(F.in[17], D, D, nullptr, (bf16_t*)(F.ws + WS_WOUT1), (r % 32) * 32, scr, r / 32, r % 32, F.lane);
    }
    moe_convert(F, 0, F.vcu, F.G);
    { const float* x = F.in[0]; bf16_t* XB = (bf16_t*)(F.ws + WS_XB); float* rstd = (float*)(F.ws + WS_RSTD);
      for (int m = gw; m < T; m += NGW) { const f32x4* xr = (const f32x4*)(x + (size_t)m * D) + F.lane; f32x4 v[4]; float s = 0.f;
#pragma unroll
          for (int j = 0; j < 4; ++j) { v[j] = xr[64 * j]; s += (v[j].x * v[j].x + v[j].y * v[j].y) + (v[j].z * v[j].z + v[j].w * v[j].w); }
          s = wave_sum(s); if (F.lane == 0) rstd[m] = rsqrtf(s * (1.f / D) + EPS);
          u32x2* o8 = (u32x2*)(XB + (size_t)m * D) + F.lane;
#pragma unroll
          for (int j = 0; j < 4; ++j) o8[64 * j] = (u32x2){pk2(v[j].x, v[j].y), pk2(v[j].z, v[j].w)}; } }
    const int gt = F.vcu * 512 + F.tid, NGT = F.G * 512;
    { float* lb = (float*)(F.ws + WS_LB); const float* l = F.in[15];
      for (int c = gt; c < 1024; c += NGT) { const float a = l[c], b = l[1024 + c], mx = fmaxf(a, b), ea = __expf(a - mx), eb = __expf(b - mx); lb[c] = ea / (ea + eb); } }
    { bf16_t* RWH = (bf16_t*)(F.ws + WS_RWH); bf16_t* RWL = (bf16_t*)(F.ws + WS_RWL);
      for (int i = gt; i < 2 * 36 * 1024; i += NGT) { const int l = i / (36 * 1024), r = i % (36 * 1024), j = r >> 10, c = r & 1023; const float g = F.in[2][l * D + c];
          const float wv = j < 4 ? g * F.in[18][((size_t)l * D + c) * 4 + j] : g * F.in[19][((size_t)l * D + c) * 32 + (j - 4)];
          const unsigned hi = f2bf(wv); RWH[i] = (bf16_t)hi; RWL[i] = (bf16_t)f2bf(wv - bf2f(hi)); } }
}

__device__ __forceinline__ void moe_tables(Frame& F, int layer) {
    LAS int* ts = (LAS int*)(F.lds + TS_OFF); LAS int* cn = ts + 40;
    const unsigned* cnt = (const unsigned*)(F.ws + WS_CTL) + CW_CNT + layer * 32 * 64;
    __syncthreads();
    if (F.tid < 32) cn[F.tid] = (int)__hip_atomic_load(cnt + F.tid * 64, __ATOMIC_RELAXED, __HIP_MEMORY_SCOPE_AGENT);
    __syncthreads();
    if (F.tid == 0) { int s = 0; for (int e = 0; e < 32; ++e) { ts[e] = s; s += (cn[e] + 255) >> 8; } ts[32] = s; }
    __syncthreads();
}

__device__ __forceinline__ void p_router(Frame& F, int layer, int dummy = 0) {
    const float* H = F.out;
    unsigned* cnt = (unsigned*)(F.ws + WS_CTL) + CW_CNT + (dummy ? 2 : layer) * 32 * 64;
    const size_t doff = dummy ? (WS_END - WS_TOKINFO) : 0;
    int* ltok = (int*)(F.ws + WS_LTOK + doff); float* lrstd = (float*)(F.ws + WS_LRSTD + doff); float* lw = (float*)(F.ws + WS_LW + doff); int* tokinfo = (int*)(F.ws + WS_TOKINFO + doff);
    LAS unsigned char* L = F.lds;
    const int tid = F.tid, l = F.lane, w = F.wave, i16 = l & 15, q4 = l >> 4;
    for (int tile = F.vcu; tile < T / 128; tile += F.G) {
        __syncthreads();
        { const u32x4* gh = (const u32x4*)(F.ws + WS_RWH + (size_t)layer * 36 * 2048); const u32x4* gl = (const u32x4*)(F.ws + WS_RWL + (size_t)layer * 36 * 2048);
          for (int i = tid; i < 36 * 128; i += 512) { const int n = i >> 7, c = i & 127, pc = c ^ (n & 15);
              *(LAS u32x4*)(L + n * 2048 + pc * 16) = gh[i]; *(LAS u32x4*)(L + 73728 + n * 2048 + pc * 16) = gl[i]; } }
        __syncthreads();
        const int row = tile * 128 + w * 16 + i16;
        const f32x4* hp = (const f32x4*)(H + (size_t)row * D + 8 * q4);
        f32x4 acc[3]; acc[0] = (f32x4){0.f, 0.f, 0.f, 0.f}; acc[1] = acc[0]; acc[2] = acc[0];
        int nrow[3];
#pragma unroll
        for (int nb = 0; nb < 3; ++nb) { const int n = 16 * nb + i16; nrow[nb] = n > 35 ? 35 : n; }
        float ss = 0.f;
#pragma unroll 4
        for (int ks = 0; ks < 32; ++ks) {
            const f32x4 x0 = hp[8 * ks], x1 = hp[8 * ks + 1];
            const float xv[8] = {x0.x, x0.y, x0.z, x0.w, x1.x, x1.y, x1.z, x1.w};
            unsigned hw[4], lwv[4];
#pragma unroll
            for (int p = 0; p < 4; ++p) { const float a = xv[2 * p], b = xv[2 * p + 1]; ss += a * a + b * b; const unsigned hpk = cvt_pk_bf16(a, b); hw[p] = hpk;
                lwv[p] = cvt_pk_bf16(a - __uint_as_float(hpk << 16), b - __uint_as_float(hpk & 0xffff0000u)); }
            const bf16x8 ah = __builtin_bit_cast(bf16x8, ((u32x4){hw[0], hw[1], hw[2], hw[3]})), al = __builtin_bit_cast(bf16x8, ((u32x4){lwv[0], lwv[1], lwv[2], lwv[3]}));
#pragma unroll
            for (int nb = 0; nb < 3; ++nb) { const int n = nrow[nb], pc = (4 * ks + q4) ^ (n & 15);
                const bf16x8 bh = *(const LAS bf16x8*)(L + n * 2048 + pc * 16), bl = *(const LAS bf16x8*)(L + 73728 + n * 2048 + pc * 16);
                acc[nb] = MFMA16(ah, bh, acc[nb]); acc[nb] = MFMA16(al, bh, acc[nb]); acc[nb] = MFMA16(ah, bl, acc[nb]); }
        }
        ss += __shfl_xor(ss, 16); ss += __shfl_xor(ss, 32);
        __syncthreads();
        LAS float* sc = (LAS float*)(L + w * 4096);
#pragma unroll
        for (int nb = 0; nb < 3; ++nb)
#pragma unroll
            for (int rg = 0; rg < 4; ++rg) sc[(4 * q4 + rg) * 49 + 16 * nb + i16] = acc[nb][rg];
        const float rstd = rsqrtf(ss * (1.f / D) + EPS);
        LAS unsigned* lc = (LAS unsigned*)(L + 32768);
        if (tid < 32) lc[tid] = 0u;
        int e0 = 0, e1 = 0; float w0 = 0.f, w1 = 0.f;
        if (l < 16) {
            const LAS float* lr = sc + l * 49;
            float lg[4];
#pragma unroll
            for (int gi = 0; gi < 4; ++gi) lg[gi] = lr[gi] * rstd;
            int gidx = 0; float gmax = lg[0];
#pragma unroll
            for (int gi = 1; gi < 4; ++gi) if (lg[gi] > gmax) { gmax = lg[gi]; gidx = gi; }
            float gs = 0.f;
#pragma unroll
            for (int gi = 0; gi < 4; ++gi) gs += __expf(lg[gi] - gmax);
            const float ggate = 1.f / gs;
            float le[8];
#pragma unroll
            for (int e = 0; e < 8; ++e) le[e] = lr[4 + gidx * 8 + e] * rstd;
            int i0 = 0; float v0 = le[0];
#pragma unroll
            for (int e = 1; e < 8; ++e) if (le[e] > v0) { v0 = le[e]; i0 = e; }
            int i1 = -1; float v1 = -3.0e38f;
#pragma unroll
            for (int e = 0; e < 8; ++e) if (e != i0 && le[e] > v1) { v1 = le[e]; i1 = e; }
            const float ex = __expf(v1 - v0); w0 = ggate / (1.f + ex); w1 = ggate * ex / (1.f + ex);
            e0 = gidx * 8 + i0; e1 = gidx * 8 + i1;
        }
        __syncthreads();
        unsigned r0 = 0u, r1 = 0u;
        if (l < 16) { r0 = __hip_atomic_fetch_add((unsigned*)(lc + e0), 1u, __ATOMIC_RELAXED, __HIP_MEMORY_SCOPE_WORKGROUP); r1 = __hip_atomic_fetch_add((unsigned*)(lc + e1), 1u, __ATOMIC_RELAXED, __HIP_MEMORY_SCOPE_WORKGROUP); }
        __syncthreads();
        if (tid < 32) { const unsigned c = lc[tid]; lc[32 + tid] = c ? atomicAdd(cnt + tid * 64, c) : 0u; }
        __syncthreads();
        if (l < 16) {
            const int m = row; const unsigned p0 = lc[32 + e0] + r0, p1 = lc[32 + e1] + r1;
            if (!dummy) ((float*)(F.ws + WS_RSTD))[m] = rstd;
            ltok[(size_t)e0 * CAP + p0] = m; lrstd[(size_t)e0 * CAP + p0] = rstd; lw[(size_t)e0 * CAP + p0] = w0;
            ltok[(size_t)e1 * CAP + p1] = m; lrstd[(size_t)e1 * CAP + p1] = rstd; lw[(size_t)e1 * CAP + p1] = w1;
            tokinfo[2 * m] = e0 * CAP + (int)p0; tokinfo[2 * m + 1] = e1 * CAP + (int)p1;
        }
    }
    __syncthreads();
}
__device__ __forceinline__ void p_combine(Frame& F, int layer, int mode, int dry = 0) {
    moe_tables(F, layer);
    const LAS int* ts = (const LAS int*)(F.lds + TS_OFF);
    const int gw = F.vcu * 8 + F.wave, NGW = F.G * 8;
    float* H = F.out; const bf16_t* Y = (const bf16_t*)(F.ws + WS_Y); const int* tokinfo = (const int*)(F.ws + WS_TOKINFO);
    bf16_t* XB = (bf16_t*)(F.ws + WS_XB); float* rstd = (float*)(F.ws + WS_RSTD); const float* gfin = F.in[3];
    for (int m = gw; m < T; m += NGW) {
        const int t0 = tokinfo[2 * m], t1 = tokinfo[2 * m + 1];
        const size_t s0 = (size_t)ts[t0 >> 15] * 256 + (t0 & (CAP - 1)), s1 = (size_t)ts[t1 >> 15] * 256 + (t1 & (CAP - 1));
        f32x4* hr = (f32x4*)(H + (size_t)m * D) + F.lane; const u32x2* y0 = (const u32x2*)(Y + s0 * D) + F.lane; const u32x2* y1 = (const u32x2*)(Y + s1 * D) + F.lane;
        f32x4 v[4]; float s = 0.f;
#pragma unroll
        for (int j = 0; j < 4; ++j) { v[j] = hr[64 * j]; u32x2 a = y0[64 * j], b = y1[64 * j]; if (dry) { a = (u32x2){0u, 0u}; b = a; }
            v[j].x += bf2f(a.x & 0xffffu) + bf2f(b.x & 0xffffu); v[j].y += bf2f(a.x >> 16) + bf2f(b.x >> 16); v[j].z += bf2f(a.y & 0xffffu) + bf2f(b.y & 0xffffu); v[j].w += bf2f(a.y >> 16) + bf2f(b.y >> 16);
            s += (v[j].x * v[j].x + v[j].y * v[j].y) + (v[j].z * v[j].z + v[j].w * v[j].w); }
        const float rs = rsqrtf(wave_sum(s) * (1.f / D) + EPS);
        if (mode == 0) {
            if (F.lane == 0) rstd[m] = rs;
            u32x2* o8 = (u32x2*)(XB + (size_t)m * D) + F.lane;
#pragma unroll
            for (int j = 0; j < 4; ++j) { hr[64 * j] = v[j]; o8[64 * j] = (u32x2){pk2(v[j].x, v[j].y), pk2(v[j].z, v[j].w)}; }
        } else {
            const f32x4* g4 = (const f32x4*)gfin + F.lane;
#pragma unroll
            for (int j = 0; j < 4; ++j) { const f32x4 g = g4[64 * j]; hr[64 * j] = dry ? v[j] : (f32x4){v[j].x * rs * g.x, v[j].y * rs * g.y, v[j].z * rs * g.z, v[j].w * rs * g.w}; }
        }
    }
}

__device__ __forceinline__ void mix_rglru_item(Frame& F, int b, int nb) {
    LAS float* L = (LAS float*)F.lds;
    LAS float* wa = L; LAS float* wx = L + 4096; LAS float* xat = L + 8192;   LAS float* xc = xat + 67 * 64; LAS float* ga = xc + 4096; LAS float* av = ga + 4096; LAS float* uv = av + 4096; LAS float* prm = uv + 4096;
    const bf16_t* Z = (const bf16_t*)(F.ws + WS_Z); bf16_t* CAT = (bf16_t*)(F.ws + WS_CAT);
    const int tid = F.tid;
    __syncthreads();
    for (int i = tid; i < 4096; i += 512) { wa[i] = F.in[7][nb * 4096 + i]; wx[i] = F.in[9][nb * 4096 + i]; }
    if (tid < 64) { const int c = nb * 64 + tid; prm[tid] = F.in[6][c]; prm[64 + tid] = F.in[5][c]; prm[128 + tid] = F.in[5][512 + c]; prm[192 + tid] = F.in[5][1024 + c]; prm[256 + tid] = F.in[5][1536 + c];
        prm[320 + tid] = F.in[8][c]; prm[384 + tid] = F.in[10][c]; const float lam = F.in[11][c]; prm[448 + tid] = fminf(lam, 0.f) - log1pf(__expf(-fabsf(lam))); }
    float hcar = 0.f;
    for (int t0 = 0; t0 < SEQ; t0 += 64) {
        __syncthreads();
        for (int i = tid; i < 67 * 64; i += 512) { const int r = i >> 6, c = i & 63, tg = t0 - 3 + r; xat[i] = tg >= 0 ? bf2f(Z[((size_t)b * SEQ + tg) * AB_IN + nb * 64 + c]) : 0.f; }
        for (int i = tid; i < 4096; i += 512) { const int r = i >> 6, c = i & 63; ga[i] = bf2f(Z[((size_t)b * SEQ + t0 + r) * AB_IN + 512 + nb * 64 + c]); }
        __syncthreads();
        for (int i = tid; i < 4096; i += 512) { const int r = i >> 6, c = i & 63; xc[i] = prm[c] + prm[64 + c] * xat[r * 64 + c] + prm[128 + c] * xat[(r + 1) * 64 + c] + prm[192 + c] * xat[(r + 2) * 64 + c] + prm[256 + c] * xat[(r + 3) * 64 + c]; }
        __syncthreads();
        { const int tok = tid >> 3, dg = tid & 7; float aa[8], ax[8];
#pragma unroll
          for (int j = 0; j < 8; ++j) { aa[j] = 0.f; ax[j] = 0.f; }
          for (int c = 0; c < 64; ++c) { const float xv = xc[tok * 64 + c]; const LAS f32x4* pa = (const LAS f32x4*)(wa + c * 64 + dg * 8); const LAS f32x4* px = (const LAS f32x4*)(wx + c * 64 + dg * 8);
              const f32x4 a0 = pa[0], a1 = pa[1], x0 = px[0], x1 = px[1];
              aa[0] += xv * a0.x; aa[1] += xv * a0.y; aa[2] += xv * a0.z; aa[3] += xv * a0.w; aa[4] += xv * a1.x; aa[5] += xv * a1.y; aa[6] += xv * a1.z; aa[7] += xv * a1.w;
              ax[0] += xv * x0.x; ax[1] += xv * x0.y; ax[2] += xv * x0.z; ax[3] += xv * x0.w; ax[4] += xv * x1.x; ax[5] += xv * x1.y; ax[6] += xv * x1.z; ax[7] += xv * x1.w; }
#pragma unroll
          for (int j = 0; j < 8; ++j) { const int d = dg * 8 + j; const float r = sigmoidf_(aa[j] + prm[320 + d]), ig = sigmoidf_(ax[j] + prm[384 + d]);
              const float la = 8.0f * r * prm[448 + d]; av[tok * 64 + d] = __expf(la); uv[tok * 64 + d] = sqrtf(fmaxf(-expm1f(2.0f * la), 0.f)) * (ig * xc[tok * 64 + d]); } }
        __syncthreads();
        if (tid < 64) { for (int r = 0; r < 64; ++r) { hcar = av[r * 64 + tid] * hcar + uv[r * 64 + tid]; av[r * 64 + tid] = hcar; } }
        __syncthreads();
        for (int i = tid; i < 4096; i += 512) { const int r = i >> 6, c = i & 63; CAT[((size_t)b * SEQ + t0 + r) * D + nb * 64 + c] = (bf16_t)f2bf(av[i] * gelu_tanh(ga[i])); }
    }
    __syncthreads();
}
__device__ __forceinline__ void mix_attn_item(Frame& F, int b, int c, int h) {
    LAS float* Ks = (LAS float*)F.lds;   LAS float* Vs = Ks + 64 * 68;   LAS float* bs = Vs + 4096;   LAS float* Ss = bs + 520;
    const bf16_t* Z = (const bf16_t*)(F.ws + WS_Z); bf16_t* CAT = (bf16_t*)(F.ws + WS_CAT);
    const int tid = F.tid, t = tid >> 3, sub = tid & 7;
    __syncthreads();
    for (int i = tid; i < 513; i += 512) bs[i] = F.in[12][h * 513 + i];
    unsigned q2[32]; float o[64];
    { const unsigned* qp = (const unsigned*)(Z + ((size_t)b * SEQ + c * 64 + t) * AB_IN + 1024 + h * 64);
#pragma unroll
      for (int d = 0; d < 32; ++d) q2[d] = qp[d];
#pragma unroll
      for (int d = 0; d < 64; ++d) o[d] = 0.f; }
    float mrun = -3.0e38f, lrun = 0.f;
    for (int kc = (c >= 8 ? c - 8 : 0); kc <= c; ++kc) {
        __syncthreads();
        for (int i = tid; i < 4096; i += 512) { const int s = i >> 6, d = i & 63; const size_t base = ((size_t)b * SEQ + kc * 64 + s) * AB_IN + h * 64 + d;
            Ks[s * 68 + d] = bf2f(Z[base + 1536]); Vs[s * 64 + d] = bf2f(Z[base + 2048]); }
        __syncthreads();
        float tmax = -3.0e38f;
#pragma unroll 1
        for (int jj = 0; jj < 8; ++jj) { const int s = sub + 8 * jj; const LAS f32x4* kp = (const LAS f32x4*)(Ks + s * 68); float a = 0.f;
#pragma unroll
            for (int d4 = 0; d4 < 16; ++d4) { const f32x4 kv = kp[d4]; a += bf2f(q2[2 * d4] & 0xffffu) * kv.x + bf2f(q2[2 * d4] >> 16) * kv.y + bf2f(q2[2 * d4 + 1] & 0xffffu) * kv.z + bf2f(q2[2 * d4 + 1] >> 16) * kv.w; }
            a *= 0.125f;
            int rel = t - ((kc - c) * 64 + s); rel = rel < -256 ? -256 : (rel > 256 ? 256 : rel);
            a += bs[rel + 256]; Ss[t * 65 + s] = a; tmax = fmaxf(tmax, a); }
        const float mnew = fmaxf(mrun, tmax), f = __expf(mrun - mnew);
        lrun *= f;
#pragma unroll
        for (int d = 0; d < 64; ++d) o[d] *= f;
#pragma unroll 1
        for (int jj = 0; jj < 8; ++jj) { const int s = sub + 8 * jj; const float p = __expf(Ss[t * 65 + s] - mnew); lrun += p; const LAS f32x4* vp = (const LAS f32x4*)(Vs + s * 64);
#pragma unroll
            for (int d4 = 0; d4 < 16; ++d4) { const f32x4 vv = vp[d4]; o[4 * d4] += p * vv.x; o[4 * d4 + 1] += p * vv.y; o[4 * d4 + 2] += p * vv.z; o[4 * d4 + 3] += p * vv.w; } }
        mrun = mnew;
    }
    float mall = mrun;
    mall = fmaxf(mall, __shfl_xor(mall, 1)); mall = fmaxf(mall, __shfl_xor(mall, 2)); mall = fmaxf(mall, __shfl_xor(mall, 4));
    const float f = __expf(mrun - mall); lrun *= f;
    lrun += __shfl_xor(lrun, 1); lrun += __shfl_xor(lrun, 2); lrun += __shfl_xor(lrun, 4);
    const float inv = 1.0f / lrun;
    bf16_t* op = CAT + ((size_t)b * SEQ + c * 64 + t) * D + 512 + h * 64;
#pragma unroll
    for (int d = 0; d < 64; ++d) { float v = o[d] * f; v += __shfl_xor(v, 1); v += __shfl_xor(v, 2); v += __shfl_xor(v, 4); if ((d >> 3) == sub) op[d] = (bf16_t)f2bf(v * inv); }
}

typedef float f32x16 __attribute__((ext_vector_type(16)));
typedef short s16x4 __attribute__((ext_vector_type(4)));
__device__ __forceinline__ s16x4 ds_tr16(const LAS unsigned char* p) { return __builtin_bit_cast(s16x4, __builtin_amdgcn_ds_read_tr16_b64_v4i16((LAS s16x4*)p)); }
constexpr int ATT_BT_BYTES = 8 * 520 * 4;
__device__ __forceinline__ void attn_load_bias(Frame& F) {
    LAS float* bt = (LAS float*)F.lds;
    __syncthreads();
    for (int i = F.tid; i < 8 * 513; i += 512) { const int h = i / 513, j = i % 513; bt[h * 520 + j] = F.in[12][i] * 1.4426950408889634f; }
    __syncthreads();
}
__device__ __forceinline__ void attn_wave_mfma(Frame& F, int b, int c, int h) {
    const bf16_t* Z = (const bf16_t*)(F.ws + WS_Z); bf16_t* CAT = (bf16_t*)(F.ws + WS_CAT);
    const int l = F.lane, r = l & 31, hh = l >> 5;
    const LAS float* btab = (const LAS float*)F.lds + h * 520;
    LAS unsigned char* Vw = F.lds + ATT_BT_BYTES + F.wave * 8192;
    const float SC = 0.125f * 1.4426950408889634f;
    bf16x8 qf[2][4];
    { const bf16_t* Qb = Z + ((size_t)b * SEQ + c * 64) * AB_IN + 1024 + h * 64;
#pragma unroll
      for (int qb = 0; qb < 2; ++qb)
#pragma unroll
          for (int ks = 0; ks < 4; ++ks) qf[qb][ks] = *(const bf16x8*)(Qb + (size_t)(qb * 32 + r) * AB_IN + ks * 16 + hh * 8); }
    f32x16 o[2][2];
#pragma unroll
    for (int a = 0; a < 2; ++a)
#pragma unroll
        for (int d = 0; d < 2; ++d)
#pragma unroll
            for (int i = 0; i < 16; ++i) o[a][d][i] = 0.f;
    float mrun[2] = {-1.0e30f, -1.0e30f}, lsum[2] = {0.f, 0.f};
    const int q4 = (l & 15) >> 2, p4 = l & 3, cb = (l >> 4) & 1, xs = (q4 >> 1) & 1;
    const LAS unsigned char* vbase = Vw + (4 * hh + q4) * 128 + p4 * 8 + cb * 32;
    const LAS unsigned char* vb[2] = {vbase + xs * 64, vbase + (1 - xs) * 64};
    for (int kc = (c >= 8 ? c - 8 : 0); kc <= c; ++kc) {
        const bf16_t* Kb = Z + ((size_t)b * SEQ + kc * 64) * AB_IN + 1536 + h * 64; const bf16_t* Vb = Kb + 512;
#pragma unroll
        for (int hf = 0; hf < 2; ++hf) { u32x4 vr[4];
#pragma unroll
          for (int i = 0; i < 4; ++i) vr[i] = *(const u32x4*)(Vb + (size_t)((hf * 4 + i) * 8 + (l >> 3)) * AB_IN + (l & 7) * 8);
#pragma unroll
          for (int i = 0; i < 4; ++i) { const int s = (hf * 4 + i) * 8 + (l >> 3), ci = l & 7, pb = (ci >> 1) ^ (((s >> 1) & 1) << 1); *(LAS u32x4*)(Vw + s * 128 + pb * 32 + (ci & 1) * 16) = vr[i]; }
          asm volatile("" ::: "memory"); }
        asm volatile("" ::: "memory");
        bf16x8 kf[2][4];
#pragma unroll
        for (int sb = 0; sb < 2; ++sb)
#pragma unroll
            for (int ks = 0; ks < 4; ++ks) kf[sb][ks] = *(const bf16x8*)(Kb + (size_t)(sb * 32 + r) * AB_IN + ks * 16 + hh * 8);
        const int dt = (c - kc) * 64;
#pragma unroll
        for (int qb = 0; qb < 2; ++qb) {
            f32x16 st[2];
#pragma unroll
            for (int sb = 0; sb < 2; ++sb) {
#pragma unroll
                for (int i = 0; i < 16; ++i) st[sb][i] = 0.f;
#pragma unroll
                for (int ks = 0; ks < 4; ++ks) st[sb] = __builtin_amdgcn_mfma_f32_32x32x16_bf16(kf[sb][ks], qf[qb][ks], st[sb], 0, 0, 0); }
            if (dt >= 320) { const float bc = btab[512];
#pragma unroll
                for (int sb = 0; sb < 2; ++sb)
#pragma unroll
                    for (int i = 0; i < 16; ++i) st[sb][i] = st[sb][i] * SC + bc;
            } else { const int base = dt + qb * 32 + r - 4 * hh + 256;
#pragma unroll
                for (int sb = 0; sb < 2; ++sb)
#pragma unroll
                    for (int i = 0; i < 16; ++i) { int idx = base - sb * 32 - ((i & 3) + 8 * (i >> 2)); idx = idx > 512 ? 512 : idx; st[sb][i] = st[sb][i] * SC + btab[idx]; } }
            float mx = st[0][0];
#pragma unroll
            for (int sb = 0; sb < 2; ++sb)
#pragma unroll
                for (int i = 0; i < 16; ++i) mx = fmaxf(mx, st[sb][i]);
            mx = fmaxf(mx, __shfl_xor(mx, 32));
            const float mn = fmaxf(mrun[qb], mx), alpha = __builtin_amdgcn_exp2f(mrun[qb] - mn); mrun[qb] = mn;
            float rs = 0.f;
#pragma unroll
            for (int sb = 0; sb < 2; ++sb)
#pragma unroll
                for (int i = 0; i < 16; ++i) { const float pv = __builtin_amdgcn_exp2f(st[sb][i] - mn); st[sb][i] = pv; rs += pv; }
            rs += __shfl_xor(rs, 32); lsum[qb] = lsum[qb] * alpha + rs;
#pragma unroll
            for (int d = 0; d < 2; ++d)
#pragma unroll
                for (int i = 0; i < 16; ++i) o[qb][d][i] *= alpha;
            bf16x8 pf[4];
#pragma unroll
            for (int kk = 0; kk < 4; ++kk) { const int sb = kk >> 1, s2 = kk & 1; u32x4 w;
                w.x = cvt_pk_bf16(st[sb][8 * s2 + 0], st[sb][8 * s2 + 1]); w.y = cvt_pk_bf16(st[sb][8 * s2 + 2], st[sb][8 * s2 + 3]);
                w.z = cvt_pk_bf16(st[sb][8 * s2 + 4], st[sb][8 * s2 + 5]); w.w = cvt_pk_bf16(st[sb][8 * s2 + 6], st[sb][8 * s2 + 7]); pf[kk] = __builtin_bit_cast(bf16x8, w); }
#pragma unroll
            for (int d = 0; d < 2; ++d)
#pragma unroll
                for (int kk = 0; kk < 4; ++kk) { const int rowoff = ((kk >> 1) * 32 + 16 * (kk & 1)) * 128;
                    const s16x4 lo = ds_tr16(vb[d] + rowoff), hi = ds_tr16(vb[d] + rowoff + 8 * 128);
                    const bf16x8 vf = (bf16x8){lo[0], lo[1], lo[2], lo[3], hi[0], hi[1], hi[2], hi[3]};
                    o[qb][d] = __builtin_amdgcn_mfma_f32_32x32x16_bf16(vf, pf[kk], o[qb][d], 0, 0, 0); }
        }
    }
#pragma unroll
    for (int qb = 0; qb < 2; ++qb) { const float inv = 1.0f / lsum[qb]; bf16_t* op = CAT + ((size_t)b * SEQ + c * 64 + qb * 32 + r) * D + 512 + h * 64 + 4 * hh;
#pragma unroll
        for (int d = 0; d < 2; ++d)
#pragma unroll
            for (int g = 0; g < 4; ++g) { u32x2 w; w.x = cvt_pk_bf16(o[qb][d][4 * g] * inv, o[qb][d][4 * g + 1] * inv); w.y = cvt_pk_bf16(o[qb][d][4 * g + 2] * inv, o[qb][d][4 * g + 3] * inv);
                *(u32x2*)(op + d * 32 + 8 * g) = w; } }
}

constexpr int RG_XA = 0, RG_GA0 = 8704, RG_GA1 = RG_GA0 + 8192, RG_XCB = RG_GA1 + 8192, RG_WA = RG_XCB + 9216, RG_WX = RG_WA + 9216, RG_AV = RG_WX + 9216, RG_UV = RG_AV + 16384, RG_SA = RG_UV + 16384, RG_SH = RG_SA + 2048, RG_END = RG_SH + 2048;
static_assert(RG_END <= RING_BYTES, "rglru lds");
__device__ __forceinline__ float gelu_fast(float x) { const float u = 1.5957691216057308f * (x + 0.044715f * x * x * x); return x / (1.0f + __expf(-u)); }
__device__ __forceinline__ void rglru_item(Frame& F, int b, int nb) {
    const bf16_t* Z = (const bf16_t*)(F.ws + WS_Z); bf16_t* CAT = (bf16_t*)(F.ws + WS_CAT);
    LAS unsigned char* L = F.lds;
    LAS float* AV = (LAS float*)(L + RG_AV); LAS float* UV = (LAS float*)(L + RG_UV); LAS float* SA = (LAS float*)(L + RG_SA); LAS float* SH = (LAS float*)(L + RG_SH);
    const int tid = F.tid, l = F.lane, w = F.wave, i16 = l & 15, q4 = l >> 4;
    __syncthreads();
    for (int i = tid; i < 4096; i += 512) { const int c = i >> 6, d = i & 63;
        *(LAS bf16_t*)(L + RG_WA + d * 144 + c * 2) = (bf16_t)f2bf(F.in[7][nb * 4096 + i]); *(LAS bf16_t*)(L + RG_WX + d * 144 + c * 2) = (bf16_t)f2bf(F.in[9][nb * 4096 + i]); }
    const int ct = tid >> 3, ch8 = tid & 7;
    float cw[4][8], cbv[8];
#pragma unroll
    for (int j = 0; j < 8; ++j) { const int ch = nb * 64 + 8 * ch8 + j; cbv[j] = F.in[6][ch];
#pragma unroll
        for (int k = 0; k < 4; ++k) cw[k][j] = F.in[5][k * 512 + ch]; }
    const int tb = w >> 1;
    float bav[2], bxv[2], lsv[2];
#pragma unroll
    for (int cc = 0; cc < 2; ++cc) { const int d = nb * 64 + 16 * ((w & 1) * 2 + cc) + i16; bav[cc] = F.in[8][d]; bxv[cc] = F.in[10][d]; const float lam = F.in[11][d]; lsv[cc] = 8.0f * (fminf(lam, 0.f) - log1pf(__expf(-fabsf(lam)))); }
    const int sc = tid & 63, sseg = tid >> 6;
    float carry = 0.f;
    const size_t rowb = (size_t)b * SEQ;
    u32x4 px0, px1, pg;
    const u32x4 zero4 = (u32x4){0u, 0u, 0u, 0u};
#define RG_LOAD(t0_) do { { const int r = tid >> 3, tg = (t0_) - 3 + r; px0 = tg >= 0 ? *(const u32x4*)(Z + (rowb + tg) * AB_IN + nb * 64 + (tid & 7) * 8) : zero4; } \
        if (tid < 24) { const int r = 64 + (tid >> 3), tg = (t0_) - 3 + r; px1 = *(const u32x4*)(Z + (rowb + tg) * AB_IN + nb * 64 + (tid & 7) * 8); } \
        pg = *(const u32x4*)(Z + (rowb + (t0_) + (tid >> 3)) * AB_IN + 512 + nb * 64 + (tid & 7) * 8); } while (0)
    RG_LOAD(0);
#pragma unroll 1
    for (int tile = 0; tile < 32; ++tile) {
        const int t0 = tile * 64; LAS unsigned char* GA = L + ((tile & 1) ? RG_GA1 : RG_GA0);
        *(LAS u32x4*)(L + RG_XA + tid * 16) = px0; if (tid < 24) *(LAS u32x4*)(L + RG_XA + (512 + tid) * 16) = px1;
        *(LAS u32x4*)(GA + tid * 16) = pg;
        __syncthreads();
        if (tile < 31) RG_LOAD(t0 + 64);
        { float xc[8];
#pragma unroll
          for (int j = 0; j < 8; ++j) xc[j] = cbv[j];
#pragma unroll
          for (int k = 0; k < 4; ++k) { const u32x4 xv = *(const LAS u32x4*)(L + RG_XA + (ct + k) * 128 + ch8 * 16); const unsigned xa[4] = {xv.x, xv.y, xv.z, xv.w};
#pragma unroll
              for (int j = 0; j < 8; ++j) xc[j] += cw[k][j] * bf2f((j & 1) ? (xa[j >> 1] >> 16) : (xa[j >> 1] & 0xffffu)); }
          *(LAS u32x4*)(L + RG_XCB + ct * 144 + ch8 * 16) = (u32x4){cvt_pk_bf16(xc[0], xc[1]), cvt_pk_bf16(xc[2], xc[3]), cvt_pk_bf16(xc[4], xc[5]), cvt_pk_bf16(xc[6], xc[7])}; }
        __syncthreads();
#pragma unroll
        for (int cc = 0; cc < 2; ++cc) { const int db = (w & 1) * 2 + cc; f32x4 aA = (f32x4){0.f, 0.f, 0.f, 0.f}, aX = aA;
#pragma unroll
            for (int ks = 0; ks < 2; ++ks) { const bf16x8 a = *(const LAS bf16x8*)(L + RG_XCB + (16 * tb + i16) * 144 + (32 * ks + 8 * q4) * 2);
                const bf16x8 ba = *(const LAS bf16x8*)(L + RG_WA + (16 * db + i16) * 144 + (32 * ks + 8 * q4) * 2), bx = *(const LAS bf16x8*)(L + RG_WX + (16 * db + i16) * 144 + (32 * ks + 8 * q4) * 2);
                aA = MFMA16(a, ba, aA); aX = MFMA16(a, bx, aX); }
#pragma unroll
            for (int rg = 0; rg < 4; ++rg) { const int t = 16 * tb + 4 * q4 + rg, d = 16 * db + i16; const float xcv = bf2f(*(const LAS bf16_t*)(L + RG_XCB + t * 144 + d * 2));
                const float r = sigmoidf_(aA[rg] + bav[cc]), ig = sigmoidf_(aX[rg] + bxv[cc]), la = r * lsv[cc];
                AV[t * 64 + d] = __expf(la); UV[t * 64 + d] = sqrtf(fmaxf(1.0f - __expf(2.0f * la), 0.f)) * (ig * xcv); } }
        __syncthreads();
        float aj[8], uj[8];
        { float A = 1.f, H = 0.f;
#pragma unroll
          for (int j = 0; j < 8; ++j) { aj[j] = AV[(8 * sseg + j) * 64 + sc]; uj[j] = UV[(8 * sseg + j) * 64 + sc]; H = aj[j] * H + uj[j]; A *= aj[j]; }
          SA[sseg * 64 + sc] = A; SH[sseg * 64 + sc] = H; }
        __syncthreads();
        { float run = carry, hin = carry;
#pragma unroll
          for (int sg = 0; sg < 8; ++sg) { if (sg == sseg) hin = run; run = SA[sg * 64 + sc] * run + SH[sg * 64 + sc]; }
          carry = run; float hv = hin;
#pragma unroll
          for (int j = 0; j < 8; ++j) { hv = aj[j] * hv + uj[j]; const int t = 8 * sseg + j; const float g = bf2f(*(const LAS bf16_t*)(GA + t * 128 + sc * 2));
              CAT[(rowb + t0 + t) * D + nb * 64 + sc] = (bf16_t)f2bf(hv * gelu_fast(g)); } }
    }
#undef RG_LOAD
    __syncthreads();
}
__device__ __forceinline__ void p_mix0(Frame& F) {
    unsigned* ctr = (unsigned*)(F.ws + WS_CTL) + CW_Q0;
    volatile LAS int* slot = (volatile LAS int*)(F.lds + TS_OFF);
#define MIX0_PULL() do { __syncthreads(); if (F.tid == 0) *slot = (int)atomicAdd(ctr, 1u); __syncthreads(); it = __builtin_amdgcn_readfirstlane(*slot); } while (0)
    int it; MIX0_PULL();
#pragma unroll 1
    while (it < 128) { rglru_item(F, it >> 3, it & 7); MIX0_PULL(); }
    attn_load_bias(F);
#pragma unroll 1
    while (it < 640) { const int a = it - 128; const int c = a < 384 ? 8 + (a >> 4) : 7 - ((a - 384) >> 4); attn_wave_mfma(F, a & 15, c, F.wave); MIX0_PULL(); }
#undef MIX0_PULL
    __syncthreads();
}
__device__ __forceinline__ void mix_hgrn_item(Frame& F, int b, int h) {
    LAS float* L = (LAS float*)F.lds;
    LAS float* qs = L; LAS float* fs = L + 4096; LAS float* is = L + 8192; LAS float* gs = L + 12288; LAS float* op = L + 16384;
    const bf16_t* Z = (const bf16_t*)(F.ws + WS_Z); bf16_t* CAT = (bf16_t*)(F.ws + WS_CAT); const float* lb = (const float*)(F.ws + WS_LB); const float* ng = F.in[16];
    const int tid = F.tid, v = tid & 127, kq = tid >> 7;
    float S[32];
#pragma unroll
    for (int k = 0; k < 32; ++k) S[k] = 0.f;
    for (int t0 = 0; t0 < SEQ; t0 += 32) {
        __syncthreads();
        for (int i = tid; i < 4096; i += 512) { const int r = i >> 7, c = i & 127; const bf16_t* zr = Z + ((size_t)b * SEQ + t0 + r) * C_IN + h * 128 + c;
            qs[i] = bf2f(zr[0]); const float l = lb[h * 128 + c]; fs[i] = l + (1.f - l) * sigmoidf_(bf2f(zr[1024])); is[i] = bf2f(zr[2048]); gs[i] = bf2f(zr[3072]); }
        __syncthreads();
        for (int r = 0; r < 32; ++r) { const float iv = is[r * 128 + v]; float o = 0.f;
#pragma unroll
            for (int k4 = 0; k4 < 8; ++k4) { const f32x4 f4 = *(const LAS f32x4*)(fs + r * 128 + kq * 32 + 4 * k4), q4 = *(const LAS f32x4*)(qs + r * 128 + kq * 32 + 4 * k4);
                S[4 * k4] = f4.x * S[4 * k4] + (1.f - f4.x) * iv; o += q4.x * S[4 * k4];
                S[4 * k4 + 1] = f4.y * S[4 * k4 + 1] + (1.f - f4.y) * iv; o += q4.y * S[4 * k4 + 1];
                S[4 * k4 + 2] = f4.z * S[4 * k4 + 2] + (1.f - f4.z) * iv; o += q4.z * S[4 * k4 + 2];
                S[4 * k4 + 3] = f4.w * S[4 * k4 + 3] + (1.f - f4.w) * iv; o += q4.w * S[4 * k4 + 3]; }
            op[(r * 4 + kq) * 128 + v] = o; }
        __syncthreads();
#pragma unroll
        for (int rr = 0; rr < 4; ++rr) { const int r = F.wave * 4 + rr; const int l = F.lane;
            const float o1 = op[(r * 4 + 0) * 128 + l] + op[(r * 4 + 1) * 128 + l] + op[(r * 4 + 2) * 128 + l] + op[(r * 4 + 3) * 128 + l];
            const float o2 = op[(r * 4 + 0) * 128 + 64 + l] + op[(r * 4 + 1) * 128 + 64 + l] + op[(r * 4 + 2) * 128 + 64 + l] + op[(r * 4 + 3) * 128 + 64 + l];
            const float rinv = rsqrtf(wave_sum(o1 * o1 + o2 * o2) * (1.f / 128.f) + EPS);
            bf16_t* cp = CAT + ((size_t)b * SEQ + t0 + r) * D + h * 128;
            cp[l] = (bf16_t)f2bf(o1 * rinv * ng[h * 128 + l] * gs[r * 128 + l]); cp[64 + l] = (bf16_t)f2bf(o2 * rinv * ng[h * 128 + 64 + l] * gs[r * 128 + 64 + l]); }
    }
    __syncthreads();
}


constexpr size_t WS_EB = WS_LTOK;
__device__ __forceinline__ void hgrn_prep(Frame& F, int dry = 0) {
    bf16_t* Z = (bf16_t*)(F.ws + WS_Z); const float* lbp = (const float*)(F.ws + WS_LB); float* EBG = (float*)(F.ws + WS_EB);
    const int c2 = F.tid;
    const float lb0 = lbp[2 * c2], lb1 = lbp[2 * c2 + 1];
    for (int blk = F.vcu; blk < T / 32; blk += F.G) {
        unsigned* zq = (unsigned*)(Z + (size_t)blk * 32 * C_IN) + c2; unsigned* zf = zq + 512;
        float P0 = 1.f, P1 = 1.f;
#pragma unroll 8
        for (int t = 0; t < 32; ++t) { const unsigned qv = zq[(size_t)t * (C_IN / 2)], fv = zf[(size_t)t * (C_IN / 2)];
            const float f0 = lb0 + (1.f - lb0) * __builtin_amdgcn_rcpf(1.f + __expf(-bf2f(fv & 0xffffu))), f1 = lb1 + (1.f - lb1) * __builtin_amdgcn_rcpf(1.f + __expf(-bf2f(fv >> 16)));
            P0 *= f0; P1 *= f1;
            const float r0 = fminf(__builtin_amdgcn_rcpf(P0), 1.0e30f), r1 = fminf(__builtin_amdgcn_rcpf(P1), 1.0e30f);
            const unsigned nq = cvt_pk_bf16(bf2f(qv & 0xffffu) * P0, bf2f(qv >> 16) * P1), nf = cvt_pk_bf16((1.f - f0) * r0, (1.f - f1) * r1);
            zq[(size_t)t * (C_IN / 2)] = dry ? qv : nq; zf[(size_t)t * (C_IN / 2)] = dry ? fv : nf; }
        *(f32x2v*)(EBG + (size_t)blk * 1024 + 2 * c2) = (f32x2v){P0, P1};
    }
}
constexpr int HG_STR = 272, HG_TILE = 32 * HG_STR;
constexpr int HG_BUF = 4 * HG_TILE + 512;
constexpr int HG_AT = 2 * HG_BUF, HG_SSQ = HG_AT + 2560, HG_END = HG_SSQ + 1024;
static_assert(HG_END <= RING_BYTES, "hgrn lds");
__device__ __forceinline__ float xor16_add(float v) { const auto r = __builtin_amdgcn_permlane16_swap(__float_as_uint(v), __float_as_uint(v), false, false); return __uint_as_float(r[0]) + __uint_as_float(r[1]); }
__device__ __forceinline__ float xor32_add(float v) { const auto r = __builtin_amdgcn_permlane32_swap(__float_as_uint(v), __float_as_uint(v), false, false); return __uint_as_float(r[0]) + __uint_as_float(r[1]); }
__device__ __forceinline__ void hgrn_item(Frame& F, int b, int h, int nsteps = 64) {
    const bf16_t* Z = (const bf16_t*)(F.ws + WS_Z); bf16_t* CAT = (bf16_t*)(F.ws + WS_CAT); const float* EBG = (const float*)(F.ws + WS_EB); const float* ngp = F.in[16];
    LAS unsigned char* L = F.lds;
    LAS float* SSQ = (LAS float*)(L + HG_SSQ); LAS bf16_t* AT = (LAS bf16_t*)(L + HG_AT);
    const int tid = F.tid, l = F.lane, w = F.wave;
    const int lt = tid >> 4, lkc = tid & 15, i16 = l & 15, q4 = l >> 4, qq = i16 >> 2, pp = i16 & 3;
    float ngv[4];
#pragma unroll
    for (int j = 0; j < 4; ++j) ngv[j] = ngp[h * 128 + 16 * w + 4 * q4 + j];
    f32x4 S[8];
#pragma unroll
    for (int i = 0; i < 8; ++i) S[i] = (f32x4){0.f, 0.f, 0.f, 0.f};
    __syncthreads();
    for (int i = tid; i < 640; i += 512) ((LAS unsigned*)(L + HG_AT))[i] = 0u;
    const bf16_t* zrow0 = Z + ((size_t)b * SEQ + lt) * C_IN + h * 128 + 8 * lkc;
    const float* eb0 = EBG + (size_t)b * (SEQ / 32) * 1024 + h * 128 + 4 * (tid & 31);
    struct TileRegs { u32x4 q, f, v, g; f32x4 e; };
    TileRegs RA;
#define HG_LOAD(R_, st_) do { const bf16_t* zr = zrow0 + (size_t)(st_) * 32 * C_IN; R_.q = *(const u32x4*)(zr); R_.f = *(const u32x4*)(zr + 1024); R_.v = *(const u32x4*)(zr + 2048); R_.g = *(const u32x4*)(zr + 3072); \
        R_.e = *(const f32x4*)(eb0 + (size_t)(st_) * 1024); } while (0)
#define HG_PUT(R_, par_) do { LAS unsigned char* B_ = L + (par_) * HG_BUF + lt * HG_STR + lkc * 16; *(LAS u32x4*)(B_) = R_.q; *(LAS u32x4*)(B_ + HG_TILE) = R_.f; *(LAS u32x4*)(B_ + 2 * HG_TILE) = R_.v; *(LAS u32x4*)(B_ + 3 * HG_TILE) = R_.g; \
        if (tid < 32) *(LAS f32x4*)(L + (par_) * HG_BUF + 4 * HG_TILE + 16 * tid) = R_.e; } while (0)
    HG_LOAD(RA, 0); HG_PUT(RA, 0); HG_LOAD(RA, 1);
#define HG_STEP(stx, R_) do { const int st = (stx); \
        LAS unsigned char* QEb = L + (st & 1) * HG_BUF; LAS unsigned char* KNb = QEb + HG_TILE; LAS unsigned char* Vb = QEb + 2 * HG_TILE; LAS unsigned char* Gb = QEb + 3 * HG_TILE; LAS float* EB = (LAS float*)(QEb + 4 * HG_TILE); \
        __syncthreads(); \
        s16x4 vlo = ds_tr16(Vb + (8 * q4 + qq) * HG_STR + (16 * w + 4 * pp) * 2), vhi = ds_tr16(Vb + (8 * q4 + 4 + qq) * HG_STR + (16 * w + 4 * pp) * 2); \
        u32x2 qf0[4][2], qf1[4][2]; \
        _Pragma("unroll") \
        for (int m = 0; m < 4; ++m) \
        _Pragma("unroll") \
            for (int tb = 0; tb < 2; ++tb) { qf0[m][tb] = *(const LAS u32x2*)(QEb + (16 * tb + i16) * HG_STR + (32 * m + 4 * q4) * 2); qf1[m][tb] = *(const LAS u32x2*)(QEb + (16 * tb + i16) * HG_STR + (32 * m + 16 + 4 * q4) * 2); } \
        if (w < 3) { const int tb = w ? 1 : 0, sb = (w == 2) ? 1 : 0; f32x4 acc = (f32x4){0.f, 0.f, 0.f, 0.f}; \
            bf16x8 qa[4], kb4[4]; \
        _Pragma("unroll") \
            for (int ks = 0; ks < 4; ++ks) { qa[ks] = *(const LAS bf16x8*)(QEb + (16 * tb + i16) * HG_STR + (32 * ks + 8 * q4) * 2); kb4[ks] = *(const LAS bf16x8*)(KNb + (16 * sb + i16) * HG_STR + (32 * ks + 8 * q4) * 2); } \
        _Pragma("unroll") \
            for (int ks = 0; ks < 4; ++ks) acc = MFMA16(qa[ks], kb4[ks], acc); \
        _Pragma("unroll") \
            for (int rg = 0; rg < 4; ++rg) { const int t = 16 * tb + 4 * q4 + rg, sx = 16 * sb + i16; AT[t * 40 + sx] = (bf16_t)f2bf(sx <= t ? acc[rg] : 0.f); } } \
        const bf16x8 vfr = (bf16x8){vlo[0], vlo[1], vlo[2], vlo[3], vhi[0], vhi[1], vhi[2], vhi[3]}; \
        f32x4 O[2]; O[0] = (f32x4){0.f, 0.f, 0.f, 0.f}; O[1] = O[0]; \
        _Pragma("unroll") \
        for (int m = 0; m < 4; ++m) { u32x4 sp; sp.x = cvt_pk_bf16(S[2 * m][0], S[2 * m][1]); sp.y = cvt_pk_bf16(S[2 * m][2], S[2 * m][3]); sp.z = cvt_pk_bf16(S[2 * m + 1][0], S[2 * m + 1][1]); sp.w = cvt_pk_bf16(S[2 * m + 1][2], S[2 * m + 1][3]); \
            const bf16x8 spk = __builtin_bit_cast(bf16x8, sp); \
        _Pragma("unroll") \
            for (int tb = 0; tb < 2; ++tb) { const u32x4 qv = (u32x4){qf0[m][tb].x, qf0[m][tb].y, qf1[m][tb].x, qf1[m][tb].y}; O[tb] = MFMA16(spk, __builtin_bit_cast(bf16x8, qv), O[tb]); } } \
        _Pragma("unroll") \
        for (int kb = 0; kb < 8; ++kb) { const s16x4 klo = ds_tr16(KNb + (8 * q4 + qq) * HG_STR + (16 * kb + 4 * pp) * 2), khi = ds_tr16(KNb + (8 * q4 + 4 + qq) * HG_STR + (16 * kb + 4 * pp) * 2); const bf16x8 kfr = (bf16x8){klo[0], klo[1], klo[2], klo[3], khi[0], khi[1], khi[2], khi[3]}; \
            S[kb] = MFMA16(kfr, vfr, S[kb]) * *(const LAS f32x4*)(EB + 16 * kb + 4 * q4); } \
        __syncthreads(); \
        _Pragma("unroll") \
        for (int tb = 0; tb < 2; ++tb) { const bf16x8 at = *(const LAS bf16x8*)(L + HG_AT + (16 * tb + i16) * 80 + 16 * q4); O[tb] = MFMA16(vfr, at, O[tb]); } \
        _Pragma("unroll") \
        for (int tb = 0; tb < 2; ++tb) { float ss = (O[tb][0] * O[tb][0] + O[tb][1] * O[tb][1]) + (O[tb][2] * O[tb][2] + O[tb][3] * O[tb][3]); ss = xor16_add(ss); ss = xor32_add(ss); \
            if (q4 == 0) SSQ[(16 * tb + i16) * 8 + w] = ss; } \
        __syncthreads(); \
        _Pragma("unroll") \
        for (int tb = 0; tb < 2; ++tb) { const int t = 16 * tb + i16; const f32x4 a = *(const LAS f32x4*)(SSQ + t * 8), c = *(const LAS f32x4*)(SSQ + t * 8 + 4); \
            const float rinv = rsqrtf(((a.x + a.y) + (a.z + a.w) + (c.x + c.y) + (c.z + c.w)) * (1.f / 128.f) + EPS); \
            const u32x2 g2 = *(const LAS u32x2*)(Gb + t * HG_STR + (16 * w + 4 * q4) * 2); \
            const float o0 = O[tb][0] * rinv * ngv[0] * bf2f(g2.x & 0xffffu), o1 = O[tb][1] * rinv * ngv[1] * bf2f(g2.x >> 16), o2 = O[tb][2] * rinv * ngv[2] * bf2f(g2.y & 0xffffu), o3 = O[tb][3] * rinv * ngv[3] * bf2f(g2.y >> 16); \
            *(u32x2*)(CAT + ((size_t)b * SEQ + st * 32 + t) * D + h * 128 + 16 * w + 4 * q4) = (u32x2){cvt_pk_bf16(o0, o1), cvt_pk_bf16(o2, o3)}; } \
        if (st < nsteps - 1) { HG_PUT(R_, (st + 1) & 1); if (st < nsteps - 2) HG_LOAD(R_, st + 2); } \
    } while (0)
#pragma unroll 1
    for (int st1 = 0; st1 < nsteps; ++st1) { HG_STEP(st1, RA); }
#undef HG_STEP
#undef HG_LOAD
#undef HG_PUT
    __syncthreads();
}
__device__ __forceinline__ void p_gu(Frame& F, int layer) {
    unsigned char* ws = F.ws;
    moe_tables(F, layer);
    const LAS int* ts = (const LAS int*)(F.lds + TS_OFF); LAS unsigned* tab = (LAS unsigned*)(F.lds + TAB_OFF);
    pg8::MoeOrder<true> S{ts, tab, F.G, F.vcu, D};
    { const int* ltok = (const int*)(ws + WS_LTOK); pg8::Unit u;
      for (int i = 0; i < 6 && S.next(i, u); ++i) if (F.tid < 256) { const int pos = u.rl * 256 + F.tid; const int tok = pos < ts[40 + u.e] ? ltok[(size_t)u.e * CAP + pos] : 0; tab[i * 256 + F.tid] = (unsigned)tok * (unsigned)(D * 2); }
      __syncthreads(); }
    pg8::EpiGU E{(bf16_t*)(ws + WS_HB), (const float*)(ws + WS_LRSTD), ts + 40};
    pg8::gemm_phase<pg8::EpiGU, pg8::MoeOrder<true>, true>(F.lds, (const bf16_t*)(ws + WS_XB), (const bf16_t*)(ws + WS_WGU), D, S, E);
}
__device__ __forceinline__ void p_dn(Frame& F, int layer) {
    unsigned char* ws = F.ws;
    moe_tables(F, layer);
    const LAS int* ts = (const LAS int*)(F.lds + TS_OFF);
    pg8::MoeOrder<false> S{ts, nullptr, F.G, F.vcu, DEXP};
    pg8::EpiDN E{(bf16_t*)(ws + WS_Y), (const float*)(ws + WS_LW), ts + 40};
    pg8::gemm_phase<pg8::EpiDN, pg8::MoeOrder<false>, true>(F.lds, (const bf16_t*)(ws + WS_HB), (const bf16_t*)(ws + WS_WDN), DEXP, S, E);
}

__global__ void __launch_bounds__(512, 2) fwd(Args args) {
    extern __shared__ __attribute__((aligned(16))) unsigned char lds_raw[];
    Frame F;
    F.lds = (LAS unsigned char*)lds_raw; F.tid = threadIdx.x; F.lane = F.tid & 63; F.wave = __builtin_amdgcn_readfirstlane(F.tid >> 6);
    F.G = gridDim.x; { const int bx = blockIdx.x; F.vcu = (F.G % 8 == 0) ? (bx % 8) * (F.G / 8) + bx / 8 : bx; }
    F.in = args.in; F.out = args.out; F.ws = args.ws;
    unsigned char* ws = args.ws;
    bf16_t* XB = (bf16_t*)(ws + WS_XB); bf16_t* CAT = (bf16_t*)(ws + WS_CAT); bf16_t* Z = (bf16_t*)(ws + WS_Z);
    float* RSTD = (float*)(ws + WS_RSTD);
#if MK_ONE_LAUNCH == 2
    cg::grid_group grid = cg::this_grid();
#define GRID_BAR() grid.sync()
#elif MK_ONE_LAUNCH == 1
    if (F.tid < 2) ((volatile LAS unsigned*)(F.lds + MISC_OFF))[F.tid] = 0u;
    __syncthreads();
    const XcdBarrier xbar = xcd_barrier_post((unsigned*)(ws + WS_CTL) + CW_BAR, (volatile LAS unsigned*)(F.lds + MISC_OFF));
#define GRID_BAR() xcd_barrier(xbar)
#else
#define GRID_BAR() do {} while (0)
#endif
    #ifndef PH_MASK
#define PH_MASK 0x7fff
#endif
#define PHE(p) ((PH_MASK >> (p)) & 1)
    const int lo = args.ph_lo, hi = args.ph_hi;
#ifndef PROBE_MASK
#define PROBE_MASK 0
#endif
#define REPN(k) (((PROBE_MASK >> (k)) & 1) ? 2 : 1)
#define IN(k) (PHE(k) && lo <= (k) && (k) < hi)
#define SEAM(k) do { if (lo <= (k) && (k) + 1 < hi) GRID_BAR(); } while (0)
    if (IN(PH_PRO)) { { p_prologue(F); } if (REPN(PH_PRO) == 2) { GRID_BAR(); { p_prologue(F); } } } SEAM(PH_PRO);
    if (IN(PH_IN0)) { { pg8::DenseOrder S; S.init(T, AB_IN, D, F.G, (int)blockIdx.x); pg8::EpiIn E{Z, AB_IN, RSTD, 0, 1 << 30};
        pg8::gemm_phase<pg8::EpiIn, pg8::DenseOrder, true>(F.lds, XB, (const bf16_t*)(ws + WS_WIN0), D, S, E); } if (REPN(PH_IN0) == 2) { GRID_BAR(); { pg8::DenseOrder S; S.init(T, AB_IN, D, F.G, (int)blockIdx.x); pg8::EpiIn E{Z, AB_IN, RSTD, 0, 1 << 30};
        pg8::gemm_phase<pg8::EpiIn, pg8::DenseOrder, true>(F.lds, XB, (const bf16_t*)(ws + WS_WIN0), D, S, E); } } } SEAM(PH_IN0);
    if (IN(PH_MIX0)) { { p_mix0(F); } if (REPN(PH_MIX0) == 2) { GRID_BAR(); { p_mix0(F); } } } SEAM(PH_MIX0);
    if (IN(PH_OUT0)) { { pg8::DenseOrder S; S.init(T, D, D, F.G, (int)blockIdx.x); pg8::EpiOut E{args.in[0], args.out, XB, 0};
        pg8::gemm_phase<pg8::EpiOut, pg8::DenseOrder, true>(F.lds, CAT, (const bf16_t*)(ws + WS_WOUT0), D, S, E); } if (REPN(PH_OUT0) == 2) { GRID_BAR(); { pg8::DenseOrder S; S.init(T, D, D, F.G, (int)blockIdx.x); pg8::EpiOut E{args.in[0], args.out, XB, 0};
        pg8::gemm_phase<pg8::EpiOut, pg8::DenseOrder, true>(F.lds, CAT, (const bf16_t*)(ws + WS_WOUT0), D, S, E); } } } SEAM(PH_OUT0);
    if (IN(PH_R1)) { p_router(F, 0); if (PROBE_X & 1) { GRID_BAR(); p_router(F, 0, 1); } } SEAM(PH_R1);
    if (IN(PH_GU0)) { { p_gu(F, 0); } if (REPN(PH_GU0) == 2) { GRID_BAR(); { p_gu(F, 0); } } } SEAM(PH_GU0);
    if (IN(PH_DN0)) { { p_dn(F, 0); } if (REPN(PH_DN0) == 2) { GRID_BAR(); { p_dn(F, 0); } } } SEAM(PH_DN0);
    if (IN(PH_R2)) { if (PROBE_X & 2) { p_combine(F, 0, 0, 1); GRID_BAR(); } p_combine(F, 0, 0); } SEAM(PH_R2);
    if (IN(PH_IN1)) { { pg8::DenseOrder S; S.init(T, C_IN, D, F.G, (int)blockIdx.x); pg8::EpiIn E{Z, C_IN, RSTD, 1024, 3072};
        pg8::gemm_phase<pg8::EpiIn, pg8::DenseOrder, true>(F.lds, XB, (const bf16_t*)(ws + WS_WIN1), D, S, E); } if (REPN(PH_IN1) == 2) { GRID_BAR(); { pg8::DenseOrder S; S.init(T, C_IN, D, F.G, (int)blockIdx.x); pg8::EpiIn E{Z, C_IN, RSTD, 1024, 3072};
        pg8::gemm_phase<pg8::EpiIn, pg8::DenseOrder, true>(F.lds, XB, (const bf16_t*)(ws + WS_WIN1), D, S, E); } } } SEAM(PH_IN1);
    if (IN(PH_MIX1)) { if (PROBE_X & 512) moe_convert(F, 1, F.vcu, F.G); if (PROBE_X & 128) hgrn_prep(F, 1); hgrn_prep(F); GRID_BAR(); if (F.vcu < 128) {
#pragma unroll 1
        for (int rep_ = 0; rep_ < ((PROBE_X & 256) ? 2 : 1); ++rep_) hgrn_item(F, F.vcu >> 3, F.vcu & 7, (rep_ && (PROBE_X >> 12)) ? (PROBE_X >> 12) : 64); } else { __syncthreads(); if (!(PROBE_X & 512)) moe_convert(F, 1, F.vcu - 128, F.G - 128); if (PROBE_X & 4) moe_convert(F, 1, F.vcu - 128, F.G - 128); } } SEAM(PH_MIX1);
    if (IN(PH_OUT1)) { if (PROBE_X & 16) { pg8::DenseOrder S; S.init(T, D, D, F.G, (int)blockIdx.x); pg8::EpiOut E{args.out, args.out, XB, 1};
        pg8::gemm_phase<pg8::EpiOut, pg8::DenseOrder, true>(F.lds, CAT, (const bf16_t*)(ws + WS_WOUT1), D, S, E); GRID_BAR(); }
 pg8::DenseOrder S; S.init(T, D, D, F.G, (int)blockIdx.x); pg8::EpiOut E{args.out, args.out, XB, 0};
        pg8::gemm_phase<pg8::EpiOut, pg8::DenseOrder, true>(F.lds, CAT, (const bf16_t*)(ws + WS_WOUT1), D, S, E); } SEAM(PH_OUT1);
    if (IN(PH_R3)) { p_router(F, 1); } SEAM(PH_R3);
    if (IN(PH_GU1)) { { p_gu(F, 1); } if (REPN(PH_GU1) == 2) { GRID_BAR(); { p_gu(F, 1); } } } SEAM(PH_GU1);
    if (IN(PH_DN1)) { { p_dn(F, 1); } if (REPN(PH_DN1) == 2) { GRID_BAR(); { p_dn(F, 1); } } } SEAM(PH_DN1);
    if (IN(PH_R4)) { if (PROBE_X & 8) { p_combine(F, 1, 1, 1); GRID_BAR(); } p_combine(F, 1, 1); }
}

extern "C" void kernel_launch(void* const* d_in, const int* in_sizes, int n_in, void* d_out, int out_size, void* d_ws, size_t ws_size, hipStream_t stream) {
    static int grid = 0;
    if (grid == 0) {
        if (n_in != 23 || out_size != T * D || ws_size < WS_END) { fprintf(stderr, "kernel_launch: unexpected shapes: n_in %d out %d ws %zu (need %zu)\n", n_in, out_size, ws_size, (size_t)WS_END); grid = -1; return; }
        if (hipFuncSetAttribute((const void*)fwd, hipFuncAttributeMaxDynamicSharedMemorySize, LDS_BYTES) != hipSuccess) { fprintf(stderr, "kernel_launch: hipFuncSetAttribute failed\n"); grid = -1; return; }
        int dev = 0, cus = 0, per_cu = 0;
        hipGetDevice(&dev); hipDeviceGetAttribute(&cus, hipDeviceAttributeMultiprocessorCount, dev);
        hipOccupancyMaxActiveBlocksPerMultiprocessor(&per_cu, (const void*)fwd, 512, LDS_BYTES);
        (void)hipGetLastError();
        fprintf(stderr, "kernel_launch: cus %d per_cu %d ws %zu\n", cus, per_cu, ws_size);
        grid = cus > 0 ? cus : 256;
        if (per_cu < 1) fprintf(stderr, "kernel_launch: occupancy query says %d blocks per CU\n", per_cu);
    }
    if (grid < 0) return;
    hipMemsetAsync((char*)d_ws + WS_CTL, 0, CTL_BYTES, stream);
    Args a{};
    for (int i = 0; i < 23; ++i) a.in[i] = (const float*)d_in[i];
    a.out = (float*)d_out; a.ws = (unsigned char*)d_ws;
#if MK_ONE_LAUNCH
    a.ph_lo = 0; a.ph_hi = NPH;
    void* kargs[] = {&a};
    hipError_t e = hipLaunchCooperativeKernel((const void*)fwd, dim3(grid), dim3(512), kargs, LDS_BYTES, stream);
    if (e != hipSuccess) fprintf(stderr, "cooperative launch failed: %s (grid %d)\n", hipGetErrorString(e), grid);
#else
    for (int ph = 0; ph < NPH; ++ph) { a.ph_lo = ph; a.ph_hi = ph + 1; hipLaunchKernelGGL(fwd, dim3(grid), dim3(512), LDS_BYTES, stream, a); }
#endif
}
```

```cpp
#include <hip/hip_runtime.h>
#include <hip/hip_cooperative_groups.h>
#include <cstdio>
#include <cstdint>
namespace cg = cooperative_groups;

#ifndef PROBE_X
#define PROBE_X 0
#endif
#ifndef MK_ONE_LAUNCH
#define MK_ONE_LAUNCH 1
#endif

constexpr int T = 32768, D = 1024, SEQ = 2048, NB = 16;
constexpr int AB_IN = 2560, C_IN = 4096;
constexpr int NEXP = 32, DEXP = 512, CAP = 32768;
constexpr int MAXTILES = 288;
constexpr float EPS = 1e-6f;

#define LAS __attribute__((address_space(3)))
typedef unsigned short bf16_t;
typedef short bf16x8 __attribute__((ext_vector_type(8)));
typedef float f32x4 __attribute__((ext_vector_type(4)));
typedef unsigned u32x4 __attribute__((ext_vector_type(4)));
typedef unsigned u32x2 __attribute__((ext_vector_type(2)));
typedef float f32x2v __attribute__((ext_vector_type(2)));

constexpr size_t MiB = 1u << 20;
constexpr size_t WS_CTL = 0, CTL_BYTES = 1 * MiB;
constexpr size_t WS_RSTD = 1 * MiB;
constexpr size_t WS_LB = WS_RSTD + 128 * 1024;
constexpr size_t WS_RWH = WS_LB + 4096;
constexpr size_t WS_RWL = WS_RWH + 2 * 36 * 1024 * 2;
constexpr size_t WS_TOKINFO = 2 * MiB;
constexpr size_t WS_LTOK = 3 * MiB, WS_LRSTD = 7 * MiB, WS_LW = 11 * MiB;
constexpr size_t WS_WIN0 = 16 * MiB, WS_WOUT0 = 21 * MiB, WS_WIN1 = 23 * MiB, WS_WOUT1 = 31 * MiB;
constexpr size_t WS_WGU = 34 * MiB, WS_WDN = 98 * MiB;
constexpr size_t WS_XB = 130 * MiB, WS_CAT = 194 * MiB;
constexpr size_t WS_Z = 258 * MiB;
constexpr size_t WS_HB = 258 * MiB, WS_Y = 330 * MiB;
constexpr size_t WS_END = 514 * MiB;
constexpr int CW_CNT = 8192;
constexpr int CW_BAR = 4096;
constexpr int CW_Q0 = 512;

constexpr int RING_BYTES = 131072;
constexpr int TAB_OFF = RING_BYTES;
constexpr int TS_OFF = TAB_OFF + 6 * 1024;
constexpr int LDS_BYTES = 163840;
constexpr int MISC_OFF = LDS_BYTES - 64;

__device__ __forceinline__ unsigned f2bf(float f) { unsigned u = __float_as_uint(f); return (u + 0x7fffu + ((u >> 16) & 1u)) >> 16; }
__device__ __forceinline__ float bf2f(unsigned b) { return __uint_as_float(b << 16); }
__device__ __forceinline__ unsigned pk2(float lo, float hi) { return f2bf(lo) | (f2bf(hi) << 16); }
__device__ __forceinline__ unsigned cvt_pk_bf16(float lo, float hi) { unsigned r; asm volatile("v_cvt_pk_bf16_f32 %0, %1, %2" : "=v"(r) : "v"(lo), "v"(hi)); return r; }
__device__ __forceinline__ float wave_sum(float v) {
#pragma unroll
    for (int o = 1; o < 64; o <<= 1) v += __shfl_xor(v, o);
    return v;
}
__device__ __forceinline__ float sigmoidf_(float x) { return 1.0f / (1.0f + __expf(-x)); }
__device__ __forceinline__ float siluf_(float x) { return x / (1.0f + __expf(-x)); }
__device__ __forceinline__ float gelu_tanh(float x) { const float u = 0.7978845608028654f * (x + 0.044715f * x * x * x); return 0.5f * x * (1.0f + tanhf(u)); }
#define LDS_WAIT() asm volatile("s_waitcnt lgkmcnt(0)" ::: "memory")
#define MFMA16(a, b, c) __builtin_amdgcn_mfma_f32_16x16x32_bf16((a), (b), (c), 0, 0, 0)

namespace pg8 {
constexpr int BM = 256, BK = 64, HALF = 128, HTB = HALF * BK * 2, NXCD = 8, WGM = 8;
__host__ __device__ __forceinline__ int lds_byte(int r, int c) { const int st = (r >> 4) * 2 + (c >> 5), rr = r & 15, cc = c & 31, ob = rr * 64 + cc * 2; return st * 1024 + (ob ^ (((ob >> 9) & 1) << 5)); }
__host__ __device__ __forceinline__ void stage_rc(int b, int& R, int& C) { const int st = b / 1024, sb = b % 1024, swz = sb ^ (((sb >> 9) & 1) << 5); R = (st >> 1) * 16 + swz / 64; C = (st & 1) * 32 + (swz % 64) / 2; }
__host__ __device__ __forceinline__ int perm32(int rho) { const int n = rho >> 4, i = rho & 15; return 8 * (i >> 2) + 4 * n + (i & 3); }

struct Unit { unsigned boff; int arow, orow, ocol, e, rl, slot; };

struct DenseOrder {
    int nM, nN, nwg, G, c, K;
    __device__ void init(int M, int N, int K_, int G_, int c_) { nM = M / BM; nN = N / BM; nwg = nM * nN; G = G_; c = c_; K = K_; }
    __device__ __forceinline__ bool next(int i, Unit& u) const {
        const long L = (long)i * G + c; if (L >= nwg) return false;
        int wgid = (int)L; { const int q = nwg / NXCD, r = nwg % NXCD, xcd = wgid % NXCD, off = wgid / NXCD; wgid = (xcd < r ? xcd * (q + 1) : r * (q + 1) + (xcd - r) * q) + off; }
        const int nig = WGM * nN, gid = wgid / nig, fm = gid * WGM, gsz = (nM - fm) < WGM ? (nM - fm) : WGM;
        const int pm = __builtin_amdgcn_readfirstlane(fm + ((wgid % nig) % gsz)), pn = __builtin_amdgcn_readfirstlane((wgid % nig) / gsz);
        u.arow = pm * BM; u.orow = pm * BM; u.ocol = pn * BM; u.boff = (unsigned)(pn * BM) * (unsigned)K * 2u; u.e = 0; u.rl = 0; u.slot = i; return true;
    }
    static constexpr bool GATHER = false;
    __device__ __forceinline__ size_t abase(const Unit& u) const { return (size_t)u.arow * (size_t)K * 2u; }
    __device__ __forceinline__ unsigned aoff(const Unit&, int) const { return 0u; }
};
template <bool GATHER_> struct MoeOrder {
    static constexpr bool GATHER = GATHER_;
    const LAS int* ts; const LAS unsigned* tab; int G, vcu, K;
    __device__ __forceinline__ bool next(int i, Unit& u) const {
        const int L = i * G + vcu; const int NT = __builtin_amdgcn_readfirstlane(ts[32]); if (L >= NT * 4) return false;
        const int rt = L >> 2, pn = L & 3; int e = 0;
#pragma unroll
        for (int j = 1; j < 32; ++j) e += (ts[j] <= rt) ? 1 : 0;
        e = __builtin_amdgcn_readfirstlane(e);
        u.e = e; u.rl = rt - __builtin_amdgcn_readfirstlane(ts[e]); u.orow = rt * BM; u.arow = rt * BM; u.ocol = pn * BM; u.boff = (unsigned)(e * 1024 + pn * BM) * (unsigned)K * 2u; u.slot = i; return true;
    }
    __device__ __forceinline__ size_t abase(const Unit& u) const { return GATHER ? (size_t)0 : (size_t)u.arow * (size_t)K * 2u; }
    __device__ __forceinline__ unsigned aoff(const Unit& u, int r) const { return tab[u.slot * 256 + r]; }
};

typedef f32x4 Acc[2][2][4][2];

struct EpiIn {
    static constexpr bool PERM = true;
    bf16_t* O; int ldc; const float* rstd; int silu_lo_end, silu_hi_start;
    __device__ __forceinline__ void operator()(const Acc& acc, const Unit& u, int wr, int wc, int fr, int fq) const {
        const bool act = (u.ocol < silu_lo_end) || (u.ocol >= silu_hi_start);
#pragma unroll
        for (int ai = 0; ai < 2; ++ai)
#pragma unroll
            for (int m = 0; m < 4; ++m) {
                const int row = u.orow + ai * HALF + wr * 64 + m * 16 + fr; const float rs = rstd[row];
                bf16_t* rowp = O + (size_t)row * ldc + u.ocol + wc * 32 + 8 * fq;
#pragma unroll
                for (int bj = 0; bj < 2; ++bj) { f32x4 v0 = acc[ai][bj][m][0] * rs, v1 = acc[ai][bj][m][1] * rs;
                    if (act) {
#pragma unroll
                        for (int j = 0; j < 4; ++j) { v0[j] = siluf_(v0[j]); v1[j] = siluf_(v1[j]); } }
                    u32x4 w; w.x = cvt_pk_bf16(v0[0], v0[1]); w.y = cvt_pk_bf16(v0[2], v0[3]); w.z = cvt_pk_bf16(v1[0], v1[1]); w.w = cvt_pk_bf16(v1[2], v1[3]);
                    *(u32x4*)(rowp + bj * HALF) = w; } }
    }
};
struct EpiOut {
    static constexpr bool PERM = true;
    bf16_t* XB; int dry;
    __device__ __forceinline__ void operator()(const Acc& acc, const Unit& u, int wr, int wc, int fr, int fq) const {
#pragma unroll
        for (int ai = 0; ai < 2; ++ai)
#pragma unroll
            for (int m = 0; m < 4; ++m) {
                const int row = u.orow + ai * HALF + wr * 64 + m * 16 + fr; const size_t off = (size_t)row * D + u.ocol + wc * 32 + 8 * fq;
#pragma unroll
                for (int bj = 0; bj < 2; ++bj) { const u32x4 r = *(const u32x4*)(XB + off + bj * HALF);
                    f32x4 v0 = (f32x4){bf2f(r.x & 0xffffu), bf2f(r.x >> 16), bf2f(r.y & 0xffffu), bf2f(r.y >> 16)}, v1 = (f32x4){bf2f(r.z & 0xffffu), bf2f(r.z >> 16), bf2f(r.w & 0xffffu), bf2f(r.w >> 16)};
                    if (!dry) { v0 += acc[ai][bj][m][0]; v1 += acc[ai][bj][m][1]; }
                    u32x4 w; w.x = cvt_pk_bf16(v0[0], v0[1]); w.y = cvt_pk_bf16(v0[2], v0[3]); w.z = cvt_pk_bf16(v1[0], v1[1]); w.w = cvt_pk_bf16(v1[2], v1[3]);
                    *(u32x4*)(XB + off + bj * HALF) = w; } }
    }
};
struct EpiGU {
    static constexpr bool PERM = true;
    bf16_t* HB; const float* lrstd; const LAS int* cnt;
    __device__ __forceinline__ void operator()(const Acc& acc, const Unit& u, int wr, int wc, int fr, int fq) const {
        const int n_e = cnt[u.e];
#pragma unroll
        for (int ai = 0; ai < 2; ++ai)
#pragma unroll
            for (int m = 0; m < 4; ++m) {
                const int r = ai * HALF + wr * 64 + m * 16 + fr, pos = u.rl * BM + r; const float rs = pos < n_e ? lrstd[(size_t)u.e * CAP + pos] : 0.f;
                float h[8];
#pragma unroll
                for (int n = 0; n < 2; ++n)
#pragma unroll
                    for (int j = 0; j < 4; ++j) { const float g = acc[ai][0][m][n][j] * rs, uu = acc[ai][1][m][n][j] * rs; h[n * 4 + j] = siluf_(g) * uu; }
                u32x4 w; w.x = cvt_pk_bf16(h[0], h[1]); w.y = cvt_pk_bf16(h[2], h[3]); w.z = cvt_pk_bf16(h[4], h[5]); w.w = cvt_pk_bf16(h[6], h[7]);
                *(u32x4*)(HB + (size_t)(u.orow + r) * DEXP + (u.ocol >> 1) + wc * 32 + 8 * fq) = w; }
    }
};
struct EpiDN {
    static constexpr bool PERM = true;
    bf16_t* Y; const float* lw; const LAS int* cnt;
    __device__ __forceinline__ void operator()(const Acc& acc, const Unit& u, int wr, int wc, int fr, int fq) const {
        const int n_e = cnt[u.e];
#pragma unroll
        for (int ai = 0; ai < 2; ++ai)
#pragma unroll
            for (int m = 0; m < 4; ++m) {
                const int r = ai * HALF + wr * 64 + m * 16 + fr, pos = u.rl * BM + r; const float ws = pos < n_e ? lw[(size_t)u.e * CAP + pos] : 0.f;
                bf16_t* rowp = Y + (size_t)(u.orow + r) * D + u.ocol + wc * 32 + 8 * fq;
#pragma unroll
                for (int bj = 0; bj < 2; ++bj) { const f32x4 v0 = acc[ai][bj][m][0] * ws, v1 = acc[ai][bj][m][1] * ws;
                    u32x4 w; w.x = cvt_pk_bf16(v0[0], v0[1]); w.y = cvt_pk_bf16(v0[2], v0[3]); w.z = cvt_pk_bf16(v1[0], v1[1]); w.w = cvt_pk_bf16(v1[2], v1[3]);
                    *(u32x4*)(rowp + bj * HALF) = w; } }
    }
};

template <class Epi, class Sched, bool ALIGN_EPI>
__device__ __forceinline__ void gemm_phase(LAS unsigned char* lds, const bf16_t* A, const bf16_t* Bt, const int K, const Sched& S, const Epi& E) {
    const int tid = threadIdx.x, wid = __builtin_amdgcn_readfirstlane(tid >> 6), lane = tid & 63, wr = wid >> 2, wc = wid & 3, fr = lane & 15, fq = lane >> 4;
    const int nt = K / BK;
    unsigned voffB[2], vA0[2], vA1[2];
#pragma unroll
    for (int i = 0; i < 2; ++i) { int R, C; stage_rc(tid * 16 + i * 8192, R, C); const int Rb = Epi::PERM ? ((R & ~31) + perm32(R & 31)) : R;
        vA0[i] = (unsigned)(R * K + C) * 2u; vA1[i] = vA0[i]; voffB[i] = (unsigned)(Rb * K + C) * 2u; }
#define PG8_FILL(u) do { if constexpr (Sched::GATHER) { int tv_ = tid; asm volatile("" : "+v"(tv_)); _Pragma("unroll") for (int i = 0; i < 2; ++i) { int R, C; stage_rc(tv_ * 16 + i * 8192, R, C); \
        vA0[i] = S.aoff(u, R) + (unsigned)C * 2u; vA1[i] = S.aoff(u, HALF + R) + (unsigned)C * 2u; } } } while (0)
    const size_t kstep = (size_t)(BK * 2);
    const size_t hstep = (size_t)HALF * K * 2;
    const unsigned ldsw = (unsigned)wid * 1024u;
    const int aoff = lds_byte(wr * 64 + fr, fq * 8), boff = lds_byte(wc * 32 + fr, fq * 8);
#define PG8_SA(b, h) (((b) * 2 + (h)) * HTB)
#define PG8_SB(b, h) ((4 + (b) * 2 + (h)) * HTB)
#define PG8_STAGE(bufoff, gbase, voff) do { _Pragma("unroll") for (int _i = 0; _i < 2; ++_i) \
        __builtin_amdgcn_global_load_lds((const unsigned*)((const char*)(gbase) + (voff)[_i]), (LAS unsigned*)(lds + (bufoff) + ldsw + _i * 8192), 16, 0, 0); } while (0)
#define PG8_LDA(dst, b, h) do { _Pragma("unroll") for (int m = 0; m < 4; ++m) _Pragma("unroll") for (int k = 0; k < 2; ++k) dst[m][k] = *(const LAS bf16x8*)(lds + PG8_SA(b, h) + aoff + m * 2048 + k * 1024); } while (0)
#define PG8_LDB(dst, b, h) do { _Pragma("unroll") for (int n = 0; n < 2; ++n) _Pragma("unroll") for (int k = 0; k < 2; ++k) dst[n][k] = *(const LAS bf16x8*)(lds + PG8_SB(b, h) + boff + n * 2048 + k * 1024); } while (0)
#define PG8_MMA(ai, bj, At, Bt_) do { __builtin_amdgcn_s_setprio(1); _Pragma("unroll") for (int m = 0; m < 4; ++m) _Pragma("unroll") for (int n = 0; n < 2; ++n) _Pragma("unroll") for (int k = 0; k < 2; ++k) \
        acc[ai][bj][m][n] = __builtin_amdgcn_mfma_f32_16x16x32_bf16(Bt_[n][k], At[m][k], acc[ai][bj][m][n], 0, 0, 0); __builtin_amdgcn_s_setprio(0); } while (0)
#define PG8_WAIT_V(n) asm volatile("s_waitcnt vmcnt(" #n ")" ::: "memory")
#define PG8_WAIT_L(n) asm volatile("s_waitcnt lgkmcnt(" #n ")" ::: "memory")
#define PG8_BAR __builtin_amdgcn_s_barrier()
#define PG8_SCHED __builtin_amdgcn_sched_barrier(0)
    Unit cur, nxt; int ui = 0;
    if (!S.next(0, cur)) return;
    f32x4 acc[2][2][4][2];
#pragma unroll
    for (int a = 0; a < 2; ++a)
#pragma unroll
        for (int b = 0; b < 2; ++b)
#pragma unroll
            for (int m = 0; m < 4; ++m)
#pragma unroll
                for (int n = 0; n < 2; ++n) acc[a][b][m][n] = (f32x4){0.f, 0.f, 0.f, 0.f};
    bf16x8 At[4][2], B0[2][2], B1[2][2];
    PG8_FILL(cur);
    const char* cA0 = (const char*)A + S.abase(cur); const char* cA1 = cA0 + (Sched::GATHER ? (size_t)0 : hstep); const char* cB = (const char*)Bt + cur.boff;
    PG8_STAGE(PG8_SB(0, 0), cB, voffB); PG8_STAGE(PG8_SB(0, 1), cB + hstep, voffB); PG8_STAGE(PG8_SA(0, 0), cA0, vA0); PG8_STAGE(PG8_SA(0, 1), cA1, vA1);
    if (wr == 1) PG8_BAR;
    PG8_WAIT_V(2); PG8_BAR;
    PG8_STAGE(PG8_SB(1, 0), cB + kstep, voffB); PG8_STAGE(PG8_SA(1, 0), cA0 + kstep, vA0); PG8_STAGE(PG8_SB(1, 1), cB + hstep + kstep, voffB);
    PG8_WAIT_V(6); PG8_BAR;
    for (;;) {
        const bool has_next = S.next(ui + 1, nxt);
        const char* nB = has_next ? (const char*)Bt + nxt.boff : cB;
        const char* nA0 = has_next ? (const char*)A + S.abase(nxt) : cA0; const char* nA1 = nA0 + (Sched::GATHER ? (size_t)0 : hstep);
        for (int t = 0; t < nt; t += 2) {
            const bool last = (t == nt - 2);
            const char* a1 = cA1 + (size_t)(t + 1) * kstep;
            const char* a2 = last ? nA0 : cA0 + (size_t)(t + 2) * kstep; const char* a2h = last ? nA1 : cA1 + (size_t)(t + 2) * kstep; const char* b2 = last ? nB : cB + (size_t)(t + 2) * kstep;
            const char* a3 = a2 + kstep; const char* b3 = b2 + kstep;
            PG8_LDB(B0, 0, 0); PG8_LDB(B1, 0, 1); PG8_SCHED; PG8_LDA(At, 0, 0); PG8_STAGE(PG8_SA(1, 1), a1, vA1);
            if (last && has_next) PG8_FILL(nxt);
            PG8_WAIT_V(8); PG8_WAIT_L(0); PG8_BAR; PG8_MMA(0, 0, At, B0); PG8_MMA(0, 1, At, B1); PG8_BAR; PG8_SCHED;
            PG8_LDA(At, 0, 1); PG8_STAGE(PG8_SB(0, 0), b2, voffB); PG8_STAGE(PG8_SB(0, 1), b2 + hstep, voffB); PG8_STAGE(PG8_SA(0, 0), a2, vA0);
            PG8_WAIT_V(8); PG8_WAIT_L(0); PG8_BAR; PG8_MMA(1, 0, At, B0); PG8_MMA(1, 1, At, B1); PG8_BAR; PG8_SCHED;
            PG8_LDB(B0, 1, 0); PG8_LDB(B1, 1, 1); PG8_SCHED; PG8_LDA(At, 1, 0); PG8_STAGE(PG8_SA(0, 1), a2h, vA1);
            PG8_WAIT_V(8); PG8_WAIT_L(0); PG8_BAR; PG8_MMA(0, 0, At, B0); PG8_MMA(0, 1, At, B1); PG8_BAR; PG8_SCHED;
            PG8_LDA(At, 1, 1); PG8_STAGE(PG8_SB(1, 0), b3, voffB); PG8_STAGE(PG8_SB(1, 1), b3 + hstep, voffB); PG8_STAGE(PG8_SA(1, 0), a3, vA0);
            PG8_WAIT_V(8); PG8_WAIT_L(0); PG8_BAR; PG8_MMA(1, 0, At, B0); PG8_MMA(1, 1, At, B1); PG8_BAR; PG8_SCHED;
        }
        if constexpr (ALIGN_EPI) { if (wr == 0) PG8_BAR; }
        E(acc, cur, wr, wc, fr, fq);
        if (!has_next) break;
#pragma unroll
        for (int a = 0; a < 2; ++a)
#pragma unroll
            for (int b = 0; b < 2; ++b)
#pragma unroll
                for (int m = 0; m < 4; ++m)
#pragma unroll
                    for (int n = 0; n < 2; ++n) acc[a][b][m][n] = (f32x4){0.f, 0.f, 0.f, 0.f};
        cur = nxt; cB = nB; cA0 = nA0; cA1 = nA1; ++ui;
        if constexpr (ALIGN_EPI) { if (wr == 1) PG8_BAR; }
    }
    PG8_WAIT_V(0);
    if constexpr (!ALIGN_EPI) { if (wr == 0) PG8_BAR; }
    PG8_BAR;
#undef PG8_FILL
#undef PG8_SA
#undef PG8_SB
#undef PG8_STAGE
#undef PG8_LDA
#undef PG8_LDB
#undef PG8_MMA
#undef PG8_WAIT_V
#undef PG8_WAIT_L
#undef PG8_BAR
#undef PG8_SCHED
}
}


#define XB_TMO      128
#define XB_XCNT(j)  (256  + 64 * (j))
#define XB_XSUB(j)  (1280 + 64 * (j))
#define XB_XGEN(j)  (2304 + 64 * (j))
#define XB_TOP      3328
#define XB_TOPGEN   3392
#define XB_SPIN_CAP (1u << 18)
__device__ __forceinline__ unsigned xb_ld(unsigned* p)              { return __hip_atomic_load(p, __ATOMIC_RELAXED, __HIP_MEMORY_SCOPE_AGENT); }
__device__ __forceinline__ unsigned xb_add(unsigned* p, unsigned v) { return __hip_atomic_fetch_add(p, v, __ATOMIC_RELAXED, __HIP_MEMORY_SCOPE_AGENT); }
__device__ __forceinline__ unsigned xb_xcc_id() { return (unsigned)__builtin_amdgcn_s_getreg((3 << 11) | 20) & 0xFu; }
#define XB_SPIN(cond, bar) do { unsigned _sp = 0; while (cond) { __builtin_amdgcn_s_sleep(1); \
    if ((++_sp & 255u) == 0u) { if (xb_ld(&(bar)[XB_TMO])) break; if (_sp > XB_SPIN_CAP) { atomicAdd(&(bar)[XB_TMO], 1u); break; } } } } while (0)
struct XcdBarrier { unsigned* bar; unsigned x; volatile LAS unsigned* st; };
__device__ __forceinline__ XcdBarrier xcd_barrier_post(unsigned* bar, volatile LAS unsigned* st) {
    XcdBarrier b; b.bar = bar; b.x = xb_xcc_id(); b.st = st;
    if (threadIdx.x == 0) (void)xb_add(&bar[XB_XCNT(b.x)], 1u);
    return b;
}
__device__ __forceinline__ void xcd_barrier_complete(unsigned* bar, unsigned x, unsigned& nloc, unsigned& nx) {
    const unsigned G = gridDim.x * gridDim.y * gridDim.z;
    unsigned sum, cnt, mine, sp = 0u;
    for (;;) {
        sum = 0u; cnt = 0u; mine = 0u;
#pragma unroll
        for (unsigned j = 0; j < 16; ++j) { const unsigned c = xb_ld(&bar[XB_XCNT(j)]); sum += c; cnt += (c > 0u) ? 1u : 0u; mine = (j == x) ? c : mine; }
        if (sum == G) break;
        __builtin_amdgcn_s_sleep(1);
        if ((++sp & 255u) == 0u) { if (xb_ld(&bar[XB_TMO])) break; if (sp > XB_SPIN_CAP) { atomicAdd(&bar[XB_TMO], 1u); break; } }
    }
    nloc = mine > 0u ? mine : 1u; nx = cnt > 0u ? cnt : 1u;
}
__device__ __forceinline__ void xcd_barrier(const XcdBarrier& b) {
    asm volatile("s_waitcnt vmcnt(0)" ::: "memory");
    __syncthreads();
    if (threadIdx.x == 0) {
        unsigned* bar = b.bar;
        __builtin_amdgcn_s_waitcnt(0);
        unsigned nloc = b.st[0], nx = b.st[1];
        if (nloc == 0u) { xcd_barrier_complete(bar, b.x, nloc, nx); b.st[0] = nloc; b.st[1] = nx; }
        const unsigned old = xb_add(&bar[XB_XSUB(b.x)], 1u);
        const unsigned gen = old / nloc;
        if (old + 1u == (gen + 1u) * nloc) {
            __builtin_amdgcn_fence(__ATOMIC_RELEASE, "agent");
            asm volatile("s_waitcnt vmcnt(0)" ::: "memory");
            const unsigned og = xb_add(&bar[XB_TOP], 1u);
            const unsigned tg = og / nx;
            if (og + 1u == (tg + 1u) * nx) xb_add(&bar[XB_TOPGEN], 1u);
            else XB_SPIN(xb_ld(&bar[XB_TOPGEN]) == tg, bar);
            __builtin_amdgcn_fence(__ATOMIC_ACQUIRE, "agent");
            xb_add(&bar[XB_XGEN(b.x)], 1u);
            asm volatile("s_waitcnt vmcnt(0)" ::: "memory");
        } else {
            XB_SPIN(xb_ld(&bar[XB_XGEN(b.x)]) == gen, bar);
            __builtin_amdgcn_fence(__ATOMIC_ACQUIRE, "agent");
            asm volatile("s_waitcnt vmcnt(0)" ::: "memory");
        }
    }
    __syncthreads();
}

struct Args { const float* in[23]; float* out; unsigned char* ws; int ph_lo, ph_hi; };
enum { PH_PRO = 0, PH_IN0, PH_MIX0, PH_OUT0, PH_R1, PH_GU0, PH_DN0, PH_R2, PH_IN1, PH_MIX1, PH_OUT1, PH_R3, PH_GU1, PH_DN1, PH_R4, NPH };

struct Frame {
    LAS unsigned char* lds; int tid, lane, wave, vcu, G;
    const float* const* in; float* out; unsigned char* ws;
};

__device__ __forceinline__ void transpose_item(const float* W, int K, int N, const float* kscale, bf16_t* WT, int dest_row0, LAS float* scr, int kb, int nb, int lane) {
    const int k0 = 64 * kb, n0 = 32 * nb;
    float tv[32];
#pragma unroll
    for (int i = 0; i < 32; ++i) tv[i] = W[(size_t)(k0 + 2 * i + (lane >> 5)) * N + n0 + (lane & 31)];
    if (kscale) {
#pragma unroll
        for (int i = 0; i < 32; ++i) tv[i] *= kscale[k0 + 2 * i + (lane >> 5)]; }
#pragma unroll
    for (int i = 0; i < 32; ++i) scr[(2 * i + (lane >> 5)) * 33 + (lane & 31)] = tv[i];
    LDS_WAIT(); asm volatile("" ::: "memory");
    const int c = lane & 7;
#pragma unroll
    for (int j = 0; j < 4; ++j) { const int n = (lane >> 3) + 8 * j; const LAS float* s = scr + (8 * c) * 33 + n;
        u32x4 o; o.x = pk2(s[0 * 33], s[1 * 33]); o.y = pk2(s[2 * 33], s[3 * 33]); o.z = pk2(s[4 * 33], s[5 * 33]); o.w = pk2(s[6 * 33], s[7 * 33]);
        *(u32x4*)(WT + (size_t)(dest_row0 + n) * K + k0 + 8 * c) = o; }
    LDS_WAIT(); asm volatile("" ::: "memory");
}
__device__ __forceinline__ void moe_convert(Frame& F, int layer, int wg, int nwg) {
    LAS float* scr = (LAS float*)(F.lds + F.wave * 16384);
    const int gw = wg * 8 + F.wave, NGW = nwg * 8;
    const float* gffn = F.in[2] + layer * D;
    const float* Wg = F.in[20] + (size_t)layer * NEXP * D * DEXP; const float* Wu = F.in[21] + (size_t)layer * NEXP * D * DEXP; const float* Wd = F.in[22] + (size_t)layer * NEXP * DEXP * D;
    bf16_t* WGU = (bf16_t*)(F.ws + WS_WGU); bf16_t* WDN = (bf16_t*)(F.ws + WS_WDN);
    for (int it = gw; it < 3 * 8192; it += NGW) {
        const int which = it >> 13, r = it & 8191, e = r >> 8, q = r & 255;
        if (which < 2) { const int kb = q >> 4, nb = q & 15, n0 = nb * 32;
            const int dest = e * 1024 + (n0 >> 7) * 256 + (which ? 128 : 0) + (n0 & 127);
            transpose_item((which ? Wu : Wg) + (size_t)e * D * DEXP, D, DEXP, gffn, WGU, dest, scr, kb, nb, F.lane);
        } else { const int kb = q >> 5, nb = q & 31;
            transpose_item(Wd + (size_t)e * DEXP * D, DEXP, D, nullptr, WDN, e * 1024 + nb * 32, scr, kb, nb, F.lane); }
    }
}
__device__ __forceinline__ void p_prologue(Frame& F) {
    LAS float* scr = (LAS float*)(F.lds + F.wave * 16384);
    const int gw = F.vcu * 8 + F.wave, NGW = F.G * 8;
    constexpr int I0 = 16 * 80, I1 = 16 * 32, I2 = 16 * 128, I3 = 16 * 32;
    for (int it = gw; it < I0 + I1 + I2 + I3; it += NGW) {
        int r = it;
        if (r < I0) { transpose_item(F.in[4], D, AB_IN, F.in[1], (bf16_t*)(F.ws + WS_WIN0), (r % 80) * 32, scr, r / 80, r % 80, F.lane); continue; } r -= I0;
        if (r < I1) { transpose_item(F.in[13], D, D, nullptr, (bf16_t*)(F.ws + WS_WOUT0), (r % 32) * 32, scr, r / 32, r % 32, F.lane); continue; } r -= I1;
        if (r < I2) { transpose_item(F.in[14], D, C_IN, F.in[1] + D, (bf16_t*)(F.ws + WS_WIN1), (r % 128) * 32, scr, r / 128, r % 128, F.lane); continue; } r -= I2;
        transpose_item(F.in[17], D, D, nullptr, (bf16_t*)(F.ws + WS_WOUT1), (r % 32) * 32, scr, r / 32, r % 32, F.lane);
    }
    moe_convert(F, 0, F.vcu, F.G);
    { const float* x = F.in[0]; bf16_t* XB = (bf16_t*)(F.ws + WS_XB); float* rstd = (float*)(F.ws + WS_RSTD);
      for (int m = gw; m < T; m += NGW) { const f32x4* xr = (const f32x4*)(x + (size_t)m * D) + F.lane; f32x4 v[4]; float s = 0.f;
#pragma unroll
          for (int j = 0; j < 4; ++j) { v[j] = xr[64 * j]; s += (v[j].x * v[j].x + v[j].y * v[j].y) + (v[j].z * v[j].z + v[j].w * v[j].w); }
          s = wave_sum(s); if (F.lane == 0) rstd[m] = rsqrtf(s * (1.f / D) + EPS);
          u32x2* o8 = (u32x2*)(XB + (size_t)m * D) + F.lane;
#pragma unroll
          for (int j = 0; j < 4; ++j) o8[64 * j] = (u32x2){pk2(v[j].x, v[j].y), pk2(v[j].z, v[j].w)}; } }
    const int gt = F.vcu * 512 + F.tid, NGT = F.G * 512;
    { float* lb = (float*)(F.ws + WS_LB); const float* l = F.in[15];
      for (int c = gt; c < 1024; c += NGT) { const float a = l[c], b = l[1024 + c], mx = fmaxf(a, b), ea = __expf(a - mx), eb = __expf(b - mx); lb[c] = ea / (ea + eb); } }
    { bf16_t* RWH = (bf16_t*)(F.ws + WS_RWH); bf16_t* RWL = (bf16_t*)(F.ws + WS_RWL);
      for (int i = gt; i < 2 * 36 * 1024; i += NGT) { const int l = i / (36 * 1024), r = i % (36 * 1024), j = r >> 10, c = r & 1023; const float g = F.in[2][l * D + c];
          const float wv = j < 4 ? g * F.in[18][((size_t)l * D + c) * 4 + j] : g * F.in[19][((size_t)l * D + c) * 32 + (j - 4)];
          const unsigned hi = f2bf(wv); RWH[i] = (bf16_t)hi; RWL[i] = (bf16_t)f2bf(wv - bf2f(hi)); } }
}

__device__ __forceinline__ void moe_tables(Frame& F, int layer) {
    LAS int* ts = (LAS int*)(F.lds + TS_OFF); LAS int* cn = ts + 40;
    const unsigned* cnt = (const unsigned*)(F.ws + WS_CTL) + CW_CNT + layer * 32 * 64;
    __syncthreads();
    if (F.tid < 32) cn[F.tid] = (int)__hip_atomic_load(cnt + F.tid * 64, __ATOMIC_RELAXED, __HIP_MEMORY_SCOPE_AGENT);
    __syncthreads();
    if (F.tid == 0) { int s = 0; for (int e = 0; e < 32; ++e) { ts[e] = s; s += (cn[e] + 255) >> 8; } ts[32] = s; }
    __syncthreads();
}

__device__ __forceinline__ void p_router(Frame& F, int layer, int dummy = 0) {
    const bf16_t* XBp = (const bf16_t*)(F.ws + WS_XB);
    unsigned* cnt = (unsigned*)(F.ws + WS_CTL) + CW_CNT + (dummy ? 2 : layer) * 32 * 64;
    const size_t doff = dummy ? (WS_END - WS_TOKINFO) : 0;
    int* ltok = (int*)(F.ws + WS_LTOK + doff); float* lrstd = (float*)(F.ws + WS_LRSTD + doff); float* lw = (float*)(F.ws + WS_LW + doff); int* tokinfo = (int*)(F.ws + WS_TOKINFO + doff);
    LAS unsigned char* L = F.lds;
    const int tid = F.tid, l = F.lane, w = F.wave, i16 = l & 15, q4 = l >> 4;
    for (int tile = F.vcu; tile < T / 128; tile += F.G) {
        __syncthreads();
        { const u32x4* gh = (const u32x4*)(F.ws + WS_RWH + (size_t)layer * 36 * 2048); const u32x4* gl = (const u32x4*)(F.ws + WS_RWL + (size_t)layer * 36 * 2048);
          for (int i = tid; i < 36 * 128; i += 512) { const int n = i >> 7, c = i & 127, pc = c ^ (n & 15);
              *(LAS u32x4*)(L + n * 2048 + pc * 16) = gh[i]; *(LAS u32x4*)(L + 73728 + n * 2048 + pc * 16) = gl[i]; } }
        __syncthreads();
        const int row = tile * 128 + w * 16 + i16;
        const u32x4* hp = (const u32x4*)(XBp + (size_t)row * D + 8 * q4);
        f32x4 acc[3]; acc[0] = (f32x4){0.f, 0.f, 0.f, 0.f}; acc[1] = acc[0]; acc[2] = acc[0];
        int nrow[3];
#pragma unroll
        for (int nb = 0; nb < 3; ++nb) { const int n = 16 * nb + i16; nrow[nb] = n > 35 ? 35 : n; }
        float ss = 0.f;
#pragma unroll 8
        for (int ks = 0; ks < 32; ++ks) {
            const u32x4 xw = hp[4 * ks]; const unsigned xa[4] = {xw.x, xw.y, xw.z, xw.w};
#pragma unroll
            for (int p = 0; p < 4; ++p) { const float a = bf2f(xa[p] & 0xffffu), b = __uint_as_float(xa[p] & 0xffff0000u); ss += a * a + b * b; }
            const bf16x8 ah = __builtin_bit_cast(bf16x8, xw);
#pragma unroll
            for (int nb = 0; nb < 3; ++nb) { const int n = nrow[nb], pc = (4 * ks + q4) ^ (n & 15);
                const bf16x8 bh = *(const LAS bf16x8*)(L + n * 2048 + pc * 16), bl = *(const LAS bf16x8*)(L + 73728 + n * 2048 + pc * 16);
                acc[nb] = MFMA16(ah, bh, acc[nb]); acc[nb] = MFMA16(ah, bl, acc[nb]); }
        }
        ss += __shfl_xor(ss, 16); ss += __shfl_xor(ss, 32);
        __syncthreads();
        LAS float* sc = (LAS float*)(L + w * 4096);
#pragma unroll
        for (int nb = 0; nb < 3; ++nb)
#pragma unroll
            for (int rg = 0; rg < 4; ++rg) sc[(4 * q4 + rg) * 49 + 16 * nb + i16] = acc[nb][rg];
        const float rstd = rsqrtf(ss * (1.f / D) + EPS);
        LAS unsigned* lc = (LAS unsigned*)(L + 32768);
        if (tid < 32) lc[tid] = 0u;
        int e0 = 0, e1 = 0; float w0 = 0.f, w1 = 0.f;
        if (l < 16) {
            const LAS float* lr = sc + l * 49;
            float lg[4];
#pragma unroll
            for (int gi = 0; gi < 4; ++gi) lg[gi] = lr[gi] * rstd;
            int gidx = 0; float gmax = lg[0];
#pragma unroll
            for (int gi = 1; gi < 4; ++gi) if (lg[gi] > gmax) { gmax = lg[gi]; gidx = gi; }
            float gs = 0.f;
#pragma unroll
            for (int gi = 0; gi < 4; ++gi) gs += __expf(lg[gi] - gmax);
            const float ggate = 1.f / gs;
            float le[8];
#pragma unroll
            for (int e = 0; e < 8; ++e) le[e] = lr[4 + gidx * 8 + e] * rstd;
            int i0 = 0; float v0 = le[0];
#pragma unroll
            for (int e = 1; e < 8; ++e) if (le[e] > v0) { v0 = le[e]; i0 = e; }
            int i1 = -1; float v1 = -3.0e38f;
#pragma unroll
            for (int e = 0; e < 8; ++e) if (e != i0 && le[e] > v1) { v1 = le[e]; i1 = e; }
            const float ex = __expf(v1 - v0); w0 = ggate / (1.f + ex); w1 = ggate * ex / (1.f + ex);
            e0 = gidx * 8 + i0; e1 = gidx * 8 + i1;
        }
        __syncthreads();
        unsigned r0 = 0u, r1 = 0u;
        if (l < 16) { r0 = __hip_atomic_fetch_add((unsigned*)(lc + e0), 1u, __ATOMIC_RELAXED, __HIP_MEMORY_SCOPE_WORKGROUP); r1 = __hip_atomic_fetch_add((unsigned*)(lc + e1), 1u, __ATOMIC_RELAXED, __HIP_MEMORY_SCOPE_WORKGROUP); }
        __syncthreads();
        if (tid < 32) { const unsigned c = lc[tid]; lc[32 + tid] = c ? atomicAdd(cnt + tid * 64, c) : 0u; }
        __syncthreads();
        if (l < 16) {
            const int m = row; const unsigned p0 = lc[32 + e0] + r0, p1 = lc[32 + e1] + r1;
            if (!dummy) ((float*)(F.ws + WS_RSTD))[m] = rstd;
            ltok[(size_t)e0 * CAP + p0] = m; lrstd[(size_t)e0 * CAP + p0] = rstd; lw[(size_t)e0 * CAP + p0] = w0;
            ltok[(size_t)e1 * CAP + p1] = m; lrstd[(size_t)e1 * CAP + p1] = rstd; lw[(size_t)e1 * CAP + p1] = w1;
            tokinfo[2 * m] = e0 * CAP + (int)p0; tokinfo[2 * m + 1] = e1 * CAP + (int)p1;
        }
    }
    __syncthreads();
}
__device__ __forceinline__ void p_combine(Frame& F, int layer, int mode, int dry = 0) {
    moe_tables(F, layer);
    const LAS int* ts = (const LAS int*)(F.lds + TS_OFF);
    const int gw = F.vcu * 8 + F.wave, NGW = F.G * 8;
    float* OUT = F.out; const bf16_t* Y = (const bf16_t*)(F.ws + WS_Y); const int* tokinfo = (const int*)(F.ws + WS_TOKINFO);
    bf16_t* XB = (bf16_t*)(F.ws + WS_XB); float* rstd = (float*)(F.ws + WS_RSTD); const float* gfin = F.in[3];
    for (int m = gw; m < T; m += NGW) {
        const int t0 = tokinfo[2 * m], t1 = tokinfo[2 * m + 1];
        const size_t s0 = (size_t)ts[t0 >> 15] * 256 + (t0 & (CAP - 1)), s1 = (size_t)ts[t1 >> 15] * 256 + (t1 & (CAP - 1));
        u32x4* xr = (u32x4*)(XB + (size_t)m * D) + F.lane; const u32x4* y0 = (const u32x4*)(Y + s0 * D) + F.lane; const u32x4* y1 = (const u32x4*)(Y + s1 * D) + F.lane;
        float v[2][8]; float s = 0.f;
#pragma unroll
        for (int j = 0; j < 2; ++j) { const u32x4 x = xr[64 * j]; u32x4 a = y0[64 * j], b = y1[64 * j]; if (dry) { a = (u32x4){0u, 0u, 0u, 0u}; b = a; }
            const unsigned xa[4] = {x.x, x.y, x.z, x.w}, aa[4] = {a.x, a.y, a.z, a.w}, ba[4] = {b.x, b.y, b.z, b.w};
#pragma unroll
            for (int p = 0; p < 4; ++p) { const float lo = bf2f(xa[p] & 0xffffu) + bf2f(aa[p] & 0xffffu) + bf2f(ba[p] & 0xffffu), hi = bf2f(xa[p] >> 16) + bf2f(aa[p] >> 16) + bf2f(ba[p] >> 16);
                v[j][2 * p] = lo; v[j][2 * p + 1] = hi; s += lo * lo + hi * hi; } }
        const float rs = rsqrtf(wave_sum(s) * (1.f / D) + EPS);
        if (mode == 0) {
            if (F.lane == 0) rstd[m] = rs;
#pragma unroll
            for (int j = 0; j < 2; ++j) xr[64 * j] = (u32x4){cvt_pk_bf16(v[j][0], v[j][1]), cvt_pk_bf16(v[j][2], v[j][3]), cvt_pk_bf16(v[j][4], v[j][5]), cvt_pk_bf16(v[j][6], v[j][7])};
        } else {
#pragma unroll
            for (int j = 0; j < 2; ++j) { const f32x4* g4 = (const f32x4*)(gfin + 512 * j) + 2 * F.lane; f32x4* o4 = (f32x4*)(OUT + (size_t)m * D + 512 * j) + 2 * F.lane; const f32x4 g0 = g4[0], g1 = g4[1];
                if (!dry) { o4[0] = (f32x4){v[j][0] * rs * g0.x, v[j][1] * rs * g0.y, v[j][2] * rs * g0.z, v[j][3] * rs * g0.w}; o4[1] = (f32x4){v[j][4] * rs * g1.x, v[j][5] * rs * g1.y, v[j][6] * rs * g1.z, v[j][7] * rs * g1.w}; } }
        }
    }
}

__device__ __forceinline__ void mix_rglru_item(Frame& F, int b, int nb) {
    LAS float* L = (LAS float*)F.lds;
    LAS float* wa = L; LAS float* wx = L + 4096; LAS float* xat = L + 8192;   LAS float* xc = xat + 67 * 64; LAS float* ga = xc + 4096; LAS float* av = ga + 4096; LAS float* uv = av + 4096; LAS float* prm = uv + 4096;
    const bf16_t* Z = (const bf16_t*)(F.ws + WS_Z); bf16_t* CAT = (bf16_t*)(F.ws + WS_CAT);
    const int tid = F.tid;
    __syncthreads();
    for (int i = tid; i < 4096; i += 512) { wa[i] = F.in[7][nb * 4096 + i]; wx[i] = F.in[9][nb * 4096 + i]; }
    if (tid < 64) { const int c = nb * 64 + tid; prm[tid] = F.in[6][c]; prm[64 + tid] = F.in[5][c]; prm[128 + tid] = F.in[5][512 + c]; prm[192 + tid] = F.in[5][1024 + c]; prm[256 + tid] = F.in[5][1536 + c];
        prm[320 + tid] = F.in[8][c]; prm[384 + tid] = F.in[10][c]; const float lam = F.in[11][c]; prm[448 + tid] = fminf(lam, 0.f) - log1pf(__expf(-fabsf(lam))); }
    float hcar = 0.f;
    for (int t0 = 0; t0 < SEQ; t0 += 64) {
        __syncthreads();
        for (int i = tid; i < 67 * 64; i += 512) { const int r = i >> 6, c = i & 63, tg = t0 - 3 + r; xat[i] = tg >= 0 ? bf2f(Z[((size_t)b * SEQ + tg) * AB_IN + nb * 64 + c]) : 0.f; }
        for (int i = tid; i < 4096; i += 512) { const int r = i >> 6, c = i & 63; ga[i] = bf2f(Z[((size_t)b * SEQ + t0 + r) * AB_IN + 512 + nb * 64 + c]); }
        __syncthreads();
        for (int i = tid; i < 4096; i += 512) { const int r = i >> 6, c = i & 63; xc[i] = prm[c] + prm[64 + c] * xat[r * 64 + c] + prm[128 + c] * xat[(r + 1) * 64 + c] + prm[192 + c] * xat[(r + 2) * 64 + c] + prm[256 + c] * xat[(r + 3) * 64 + c]; }
        __syncthreads();
        { const int tok = tid >> 3, dg = tid & 7; float aa[8], ax[8];
#pragma unroll
          for (int j = 0; j < 8; ++j) { aa[j] = 0.f; ax[j] = 0.f; }
          for (int c = 0; c < 64; ++c) { const float xv = xc[tok * 64 + c]; const LAS f32x4* pa = (const LAS f32x4*)(wa + c * 64 + dg * 8); const LAS f32x4* px = (const LAS f32x4*)(wx + c * 64 + dg * 8);
              const f32x4 a0 = pa[0], a1 = pa[1], x0 = px[0], x1 = px[1];
              aa[0] += xv * a0.x; aa[1] += xv * a0.y; aa[2] += xv * a0.z; aa[3] += xv * a0.w; aa[4] += xv * a1.x; aa[5] += xv * a1.y; aa[6] += xv * a1.z; aa[7] += xv * a1.w;
              ax[0] += xv * x0.x; ax[1] += xv * x0.y; ax[2] += xv * x0.z; ax[3] += xv * x0.w; ax[4] += xv * x1.x; ax[5] += xv * x1.y; ax[6] += xv * x1.z; ax[7] += xv * x1.w; }
#pragma unroll
          for (int j = 0; j < 8; ++j) { const int d = dg * 8 + j; const float r = sigmoidf_(aa[j] + prm[320 + d]), ig = sigmoidf_(ax[j] + prm[384 + d]);
              const float la = 8.0f * r * prm[448 + d]; av[tok * 64 + d] = __expf(la); uv[tok * 64 + d] = sqrtf(fmaxf(-expm1f(2.0f * la), 0.f)) * (ig * xc[tok * 64 + d]); } }
        __syncthreads();
        if (tid < 64) { for (int r = 0; r < 64; ++r) { hcar = av[r * 64 + tid] * hcar + uv[r * 64 + tid]; av[r * 64 + tid] = hcar; } }
        __syncthreads();
        for (int i = tid; i < 4096; i += 512) { const int r = i >> 6, c = i & 63; CAT[((size_t)b * SEQ + t0 + r) * D + nb * 64 + c] = (bf16_t)f2bf(av[i] * gelu_tanh(ga[i])); }
    }
    __syncthreads();
}
__device__ __forceinline__ void mix_attn_item(Frame& F, int b, int c, int h) {
    LAS float* Ks = (LAS float*)F.lds;   LAS float* Vs = Ks + 64 * 68;   LAS float* bs = Vs + 4096;   LAS float* Ss = bs + 520;
    const bf16_t* Z = (const bf16_t*)(F.ws + WS_Z); bf16_t* CAT = (bf16_t*)(F.ws + WS_CAT);
    const int tid = F.tid, t = tid >> 3, sub = tid & 7;
    __syncthreads();
    for (int i = tid; i < 513; i += 512) bs[i] = F.in[12][h * 513 + i];
    unsigned q2[32]; float o[64];
    { const unsigned* qp = (const unsigned*)(Z + ((size_t)b * SEQ + c * 64 + t) * AB_IN + 1024 + h * 64);
#pragma unroll
      for (int d = 0; d < 32; ++d) q2[d] = qp[d];
#pragma unroll
      for (int d = 0; d < 64; ++d) o[d] = 0.f; }
    float mrun = -3.0e38f, lrun = 0.f;
    for (int kc = (c >= 8 ? c - 8 : 0); kc <= c; ++kc) {
        __syncthreads();
        for (int i = tid; i < 4096; i += 512) { const int s = i >> 6, d = i & 63; const size_t base = ((size_t)b * SEQ + kc * 64 + s) * AB_IN + h * 64 + d;
            Ks[s * 68 + d] = bf2f(Z[base + 1536]); Vs[s * 64 + d] = bf2f(Z[base + 2048]); }
        __syncthreads();
        float tmax = -3.0e38f;
#pragma unroll 1
        for (int jj = 0; jj < 8; ++jj) { const int s = sub + 8 * jj; const LAS f32x4* kp = (const LAS f32x4*)(Ks + s * 68); float a = 0.f;
#pragma unroll
            for (int d4 = 0; d4 < 16; ++d4) { const f32x4 kv = kp[d4]; a += bf2f(q2[2 * d4] & 0xffffu) * kv.x + bf2f(q2[2 * d4] >> 16) * kv.y + bf2f(q2[2 * d4 + 1] & 0xffffu) * kv.z + bf2f(q2[2 * d4 + 1] >> 16) * kv.w; }
            a *= 0.125f;
            int rel = t - ((kc - c) * 64 + s); rel = rel < -256 ? -256 : (rel > 256 ? 256 : rel);
            a += bs[rel + 256]; Ss[t * 65 + s] = a; tmax = fmaxf(tmax, a); }
        const float mnew = fmaxf(mrun, tmax), f = __expf(mrun - mnew);
        lrun *= f;
#pragma unroll
        for (int d = 0; d < 64; ++d) o[d] *= f;
#pragma unroll 1
        for (int jj = 0; jj < 8; ++jj) { const int s = sub + 8 * jj; const float p = __expf(Ss[t * 65 + s] - mnew); lrun += p; const LAS f32x4* vp = (const LAS f32x4*)(Vs + s * 64);
#pragma unroll
            for (int d4 = 0; d4 < 16; ++d4) { const f32x4 vv = vp[d4]; o[4 * d4] += p * vv.x; o[4 * d4 + 1] += p * vv.y; o[4 * d4 + 2] += p * vv.z; o[4 * d4 + 3] += p * vv.w; } }
        mrun = mnew;
    }
    float mall = mrun;
    mall = fmaxf(mall, __shfl_xor(mall, 1)); mall = fmaxf(mall, __shfl_xor(mall, 2)); mall = fmaxf(mall, __shfl_xor(mall, 4));
    const float f = __expf(mrun - mall); lrun *= f;
    lrun += __shfl_xor(lrun, 1); lrun += __shfl_xor(lrun, 2); lrun += __shfl_xor(lrun, 4);
    const float inv = 1.0f / lrun;
    bf16_t* op = CAT + ((size_t)b * SEQ + c * 64 + t) * D + 512 + h * 64;
#pragma unroll
    for (int d = 0; d < 64; ++d) { float v = o[d] * f; v += __shfl_xor(v, 1); v += __shfl_xor(v, 2); v += __shfl_xor(v, 4); if ((d >> 3) == sub) op[d] = (bf16_t)f2bf(v * inv); }
}

typedef float f32x16 __attribute__((ext_vector_type(16)));
typedef short s16x4 __attribute__((ext_vector_type(4)));
__device__ __forceinline__ s16x4 ds_tr16(const LAS unsigned char* p) { return __builtin_bit_cast(s16x4, __builtin_amdgcn_ds_read_tr16_b64_v4i16((LAS s16x4*)p)); }
constexpr int ATT_BT_BYTES = 8 * 520 * 4;
__device__ __forceinline__ void attn_load_bias(Frame& F) {
    LAS float* bt = (LAS float*)F.lds;
    __syncthreads();
    for (int i = F.tid; i < 8 * 513; i += 512) { const int h = i / 513, j = i % 513; bt[h * 520 + j] = F.in[12][i] * 1.4426950408889634f; }
    __syncthreads();
}
__device__ __forceinline__ void attn_wave_mfma(Frame& F, int b, int c, int h) {
    const bf16_t* Z = (const bf16_t*)(F.ws + WS_Z); bf16_t* CAT = (bf16_t*)(F.ws + WS_CAT);
    const int l = F.lane, r = l & 31, hh = l >> 5;
    const LAS float* btab = (const LAS float*)F.lds + h * 520;
    LAS unsigned char* Vw = F.lds + ATT_BT_BYTES + F.wave * 8192;
    const float SC = 0.125f * 1.4426950408889634f;
    bf16x8 qf[2][4];
    { const bf16_t* Qb = Z + ((size_t)b * SEQ + c * 64) * AB_IN + 1024 + h * 64;
#pragma unroll
      for (int qb = 0; qb < 2; ++qb)
#pragma unroll
          for (int ks = 0; ks < 4; ++ks) qf[qb][ks] = *(const bf16x8*)(Qb + (size_t)(qb * 32 + r) * AB_IN + ks * 16 + hh * 8); }
    f32x16 o[2][2];
#pragma unroll
    for (int a = 0; a < 2; ++a)
#pragma unroll
        for (int d = 0; d < 2; ++d)
#pragma unroll
            for (int i = 0; i < 16; ++i) o[a][d][i] = 0.f;
    float mrun[2] = {-1.0e30f, -1.0e30f}, lsum[2] = {0.f, 0.f};
    const int q4 = (l & 15) >> 2, p4 = l & 3, cb = (l >> 4) & 1, xs = (q4 >> 1) & 1;
    const LAS unsigned char* vbase = Vw + (4 * hh + q4) * 128 + p4 * 8 + cb * 32;
    const LAS unsigned char* vb[2] = {vbase + xs * 64, vbase + (1 - xs) * 64};
    for (int kc = (c >= 8 ? c - 8 : 0); kc <= c; ++kc) {
        const bf16_t* Kb = Z + ((size_t)b * SEQ + kc * 64) * AB_IN + 1536 + h * 64; const bf16_t* Vb = Kb + 512;
#pragma unroll
        for (int hf = 0; hf < 2; ++hf) { u32x4 vr[4];
#pragma unroll
          for (int i = 0; i < 4; ++i) vr[i] = *(const u32x4*)(Vb + (size_t)((hf * 4 + i) * 8 + (l >> 3)) * AB_IN + (l & 7) * 8);
#pragma unroll
          for (int i = 0; i < 4; ++i) { const int s = (hf * 4 + i) * 8 + (l >> 3), ci = l & 7, pb = (ci >> 1) ^ (((s >> 1) & 1) << 1); *(LAS u32x4*)(Vw + s * 128 + pb * 32 + (ci & 1) * 16) = vr[i]; }
          asm volatile("" ::: "memory"); }
        asm volatile("" ::: "memory");
        bf16x8 kf[2][4];
#pragma unroll
        for (int sb = 0; sb < 2; ++sb)
#pragma unroll
            for (int ks = 0; ks < 4; ++ks) kf[sb][ks] = *(const bf16x8*)(Kb + (size_t)(sb * 32 + r) * AB_IN + ks * 16 + hh * 8);
        const int dt = (c - kc) * 64;
#pragma unroll
        for (int qb = 0; qb < 2; ++qb) {
            f32x16 st[2];
#pragma unroll
            for (int sb = 0; sb < 2; ++sb) {
#pragma unroll
                for (int i = 0; i < 16; ++i) st[sb][i] = 0.f;
#pragma unroll
                for (int ks = 0; ks < 4; ++ks) st[sb] = __builtin_amdgcn_mfma_f32_32x32x16_bf16(kf[sb][ks], qf[qb][ks], st[sb], 0, 0, 0); }
            if (dt >= 320) { const float bc = btab[512];
#pragma unroll
                for (int sb = 0; sb < 2; ++sb)
#pragma unroll
                    for (int i = 0; i < 16; ++i) st[sb][i] = st[sb][i] * SC + bc;
            } else { const int base = dt + qb * 32 + r - 4 * hh + 256;
#pragma unroll
                for (int sb = 0; sb < 2; ++sb)
#pragma unroll
                    for (int i = 0; i < 16; ++i) { int idx = base - sb * 32 - ((i & 3) + 8 * (i >> 2)); idx = idx > 512 ? 512 : idx; st[sb][i] = st[sb][i] * SC + btab[idx]; } }
            float mx = st[0][0];
#pragma unroll
            for (int sb = 0; sb < 2; ++sb)
#pragma unroll
                for (int i = 0; i < 16; ++i) mx = fmaxf(mx, st[sb][i]);
            mx = fmaxf(mx, __shfl_xor(mx, 32));
            const float mn = fmaxf(mrun[qb], mx), alpha = __builtin_amdgcn_exp2f(mrun[qb] - mn); mrun[qb] = mn;
            float rs = 0.f;
#pragma unroll
            for (int sb = 0; sb < 2; ++sb)
#pragma unroll
                for (int i = 0; i < 16; ++i) { const float pv = __builtin_amdgcn_exp2f(st[sb][i] - mn); st[sb][i] = pv; rs += pv; }
            rs += __shfl_xor(rs, 32); lsum[qb] = lsum[qb] * alpha + rs;
#pragma unroll
            for (int d = 0; d < 2; ++d)
#pragma unroll
                for (int i = 0; i < 16; ++i) o[qb][d][i] *= alpha;
            bf16x8 pf[4];
#pragma unroll
            for (int kk = 0; kk < 4; ++kk) { const int sb = kk >> 1, s2 = kk & 1; u32x4 w;
                w.x = cvt_pk_bf16(st[sb][8 * s2 + 0], st[sb][8 * s2 + 1]); w.y = cvt_pk_bf16(st[sb][8 * s2 + 2], st[sb][8 * s2 + 3]);
                w.z = cvt_pk_bf16(st[sb][8 * s2 + 4], st[sb][8 * s2 + 5]); w.w = cvt_pk_bf16(st[sb][8 * s2 + 6], st[sb][8 * s2 + 7]); pf[kk] = __builtin_bit_cast(bf16x8, w); }
#pragma unroll
            for (int d = 0; d < 2; ++d)
#pragma unroll
                for (int kk = 0; kk < 4; ++kk) { const int rowoff = ((kk >> 1) * 32 + 16 * (kk & 1)) * 128;
                    const s16x4 lo = ds_tr16(vb[d] + rowoff), hi = ds_tr16(vb[d] + rowoff + 8 * 128);
                    const bf16x8 vf = (bf16x8){lo[0], lo[1], lo[2], lo[3], hi[0], hi[1], hi[2], hi[3]};
                    o[qb][d] = __builtin_amdgcn_mfma_f32_32x32x16_bf16(vf, pf[kk], o[qb][d], 0, 0, 0); }
        }
    }
#pragma unroll
    for (int qb = 0; qb < 2; ++qb) { const float inv = 1.0f / lsum[qb]; bf16_t* op = CAT + ((size_t)b * SEQ + c * 64 + qb * 32 + r) * D + 512 + h * 64 + 4 * hh;
#pragma unroll
        for (int d = 0; d < 2; ++d)
#pragma unroll
            for (int g = 0; g < 4; ++g) { u32x2 w; w.x = cvt_pk_bf16(o[qb][d][4 * g] * inv, o[qb][d][4 * g + 1] * inv); w.y = cvt_pk_bf16(o[qb][d][4 * g + 2] * inv, o[qb][d][4 * g + 3] * inv);
                *(u32x2*)(op + d * 32 + 8 * g) = w; } }
}

constexpr int RG_XA = 0, RG_GA0 = 8704, RG_GA1 = RG_GA0 + 8192, RG_XCB = RG_GA1 + 8192, RG_WA = RG_XCB + 9216, RG_WX = RG_WA + 9216, RG_AV = RG_WX + 9216, RG_UV = RG_AV + 16384, RG_SA = RG_UV + 16384, RG_SH = RG_SA + 2048, RG_END = RG_SH + 2048;
static_assert(RG_END <= RING_BYTES, "rglru lds");
__device__ __forceinline__ float gelu_fast(float x) { const float u = 1.5957691216057308f * (x + 0.044715f * x * x * x); return x / (1.0f + __expf(-u)); }
__device__ __forceinline__ void rglru_item(Frame& F, int b, int nb) {
    const bf16_t* Z = (const bf16_t*)(F.ws + WS_Z); bf16_t* CAT = (bf16_t*)(F.ws + WS_CAT);
    LAS unsigned char* L = F.lds;
    LAS float* AV = (LAS float*)(L + RG_AV); LAS float* UV = (LAS float*)(L + RG_UV); LAS float* SA = (LAS float*)(L + RG_SA); LAS float* SH = (LAS float*)(L + RG_SH);
    const int tid = F.tid, l = F.lane, w = F.wave, i16 = l & 15, q4 = l >> 4;
    __syncthreads();
    for (int i = tid; i < 4096; i += 512) { const int c = i >> 6, d = i & 63;
        *(LAS bf16_t*)(L + RG_WA + d * 144 + c * 2) = (bf16_t)f2bf(F.in[7][nb * 4096 + i]); *(LAS bf16_t*)(L + RG_WX + d * 144 + c * 2) = (bf16_t)f2bf(F.in[9][nb * 4096 + i]); }
    const int ct = tid >> 3, ch8 = tid & 7;
    float cw[4][8], cbv[8];
#pragma unroll
    for (int j = 0; j < 8; ++j) { const int ch = nb * 64 + 8 * ch8 + j; cbv[j] = F.in[6][ch];
#pragma unroll
        for (int k = 0; k < 4; ++k) cw[k][j] = F.in[5][k * 512 + ch]; }
    const int tb = w >> 1;
    float bav[2], bxv[2], lsv[2];
#pragma unroll
    for (int cc = 0; cc < 2; ++cc) { const int d = nb * 64 + 16 * ((w & 1) * 2 + cc) + i16; bav[cc] = F.in[8][d]; bxv[cc] = F.in[10][d]; const float lam = F.in[11][d]; lsv[cc] = 8.0f * (fminf(lam, 0.f) - log1pf(__expf(-fabsf(lam)))); }
    const int sc = tid & 63, sseg = tid >> 6;
    float carry = 0.f;
    const size_t rowb = (size_t)b * SEQ;
    u32x4 px0, px1, pg;
    const u32x4 zero4 = (u32x4){0u, 0u, 0u, 0u};
#define RG_LOAD(t0_) do { { const int r = tid >> 3, tg = (t0_) - 3 + r; px0 = tg >= 0 ? *(const u32x4*)(Z + (rowb + tg) * AB_IN + nb * 64 + (tid & 7) * 8) : zero4; } \
        if (tid < 24) { const int r = 64 + (tid >> 3), tg = (t0_) - 3 + r; px1 = *(const u32x4*)(Z + (rowb + tg) * AB_IN + nb * 64 + (tid & 7) * 8); } \
        pg = *(const u32x4*)(Z + (rowb + (t0_) + (tid >> 3)) * AB_IN + 512 + nb * 64 + (tid & 7) * 8); } while (0)
    RG_LOAD(0);
#pragma unroll 1
    for (int tile = 0; tile < 32; ++tile) {
        const int t0 = tile * 64; LAS unsigned char* GA = L + ((tile & 1) ? RG_GA1 : RG_GA0);
        *(LAS u32x4*)(L + RG_XA + tid * 16) = px0; if (tid < 24) *(LAS u32x4*)(L + RG_XA + (512 + tid) * 16) = px1;
        *(LAS u32x4*)(GA + tid * 16) = pg;
        __syncthreads();
        if (tile < 31) RG_LOAD(t0 + 64);
        { float xc[8];
#pragma unroll
          for (int j = 0; j < 8; ++j) xc[j] = cbv[j];
#pragma unroll
          for (int k = 0; k < 4; ++k) { const u32x4 xv = *(const LAS u32x4*)(L + RG_XA + (ct + k) * 128 + ch8 * 16); const unsigned xa[4] = {xv.x, xv.y, xv.z, xv.w};
#pragma unroll
              for (int j = 0; j < 8; ++j) xc[j] += cw[k][j] * bf2f((j & 1) ? (xa[j >> 1] >> 16) : (xa[j >> 1] & 0xffffu)); }
          *(LAS u32x4*)(L + RG_XCB + ct * 144 + ch8 * 16) = (u32x4){cvt_pk_bf16(xc[0], xc[1]), cvt_pk_bf16(xc[2], xc[3]), cvt_pk_bf16(xc[4], xc[5]), cvt_pk_bf16(xc[6], xc[7])}; }
        __syncthreads();
#pragma unroll
        for (int cc = 0; cc < 2; ++cc) { const int db = (w & 1) * 2 + cc; f32x4 aA = (f32x4){0.f, 0.f, 0.f, 0.f}, aX = aA;
#pragma unroll
            for (int ks = 0; ks < 2; ++ks) { const bf16x8 a = *(const LAS bf16x8*)(L + RG_XCB + (16 * tb + i16) * 144 + (32 * ks + 8 * q4) * 2);
                const bf16x8 ba = *(const LAS bf16x8*)(L + RG_WA + (16 * db + i16) * 144 + (32 * ks + 8 * q4) * 2), bx = *(const LAS bf16x8*)(L + RG_WX + (16 * db + i16) * 144 + (32 * ks + 8 * q4) * 2);
                aA = MFMA16(a, ba, aA); aX = MFMA16(a, bx, aX); }
#pragma unroll
            for (int rg = 0; rg < 4; ++rg) { const int t = 16 * tb + 4 * q4 + rg, d = 16 * db + i16; const float xcv = bf2f(*(const LAS bf16_t*)(L + RG_XCB + t * 144 + d * 2));
                const float r = sigmoidf_(aA[rg] + bav[cc]), ig = sigmoidf_(aX[rg] + bxv[cc]), la = r * lsv[cc];
                AV[t * 64 + d] = __expf(la); UV[t * 64 + d] = sqrtf(fmaxf(1.0f - __expf(2.0f * la), 0.f)) * (ig * xcv); } }
        __syncthreads();
        float aj[8], uj[8];
        { float A = 1.f, H = 0.f;
#pragma unroll
          for (int j = 0; j < 8; ++j) { aj[j] = AV[(8 * sseg + j) * 64 + sc]; uj[j] = UV[(8 * sseg + j) * 64 + sc]; H = aj[j] * H + uj[j]; A *= aj[j]; }
          SA[sseg * 64 + sc] = A; SH[sseg * 64 + sc] = H; }
        __syncthreads();
        { float run = carry, hin = carry;
#pragma unroll
          for (int sg = 0; sg < 8; ++sg) { if (sg == sseg) hin = run; run = SA[sg * 64 + sc] * run + SH[sg * 64 + sc]; }
          carry = run; float hv = hin;
#pragma unroll
          for (int j = 0; j < 8; ++j) { hv = aj[j] * hv + uj[j]; const int t = 8 * sseg + j; const float g = bf2f(*(const LAS bf16_t*)(GA + t * 128 + sc * 2));
              CAT[(rowb + t0 + t) * D + nb * 64 + sc] = (bf16_t)f2bf(hv * gelu_fast(g)); } }
    }
#undef RG_LOAD
    __syncthreads();
}
__device__ __forceinline__ void p_mix0(Frame& F) {
    unsigned* ctr = (unsigned*)(F.ws + WS_CTL) + CW_Q0;
    volatile LAS int* slot = (volatile LAS int*)(F.lds + TS_OFF);
#define MIX0_PULL() do { __syncthreads(); if (F.tid == 0) *slot = (int)atomicAdd(ctr, 1u); __syncthreads(); it = __builtin_amdgcn_readfirstlane(*slot); } while (0)
    int it; MIX0_PULL();
#pragma unroll 1
    while (it < 128) { rglru_item(F, it >> 3, it & 7); MIX0_PULL(); }
    attn_load_bias(F);
#pragma unroll 1
    while (it < 640) { const int a = it - 128; const int c = a < 384 ? 8 + (a >> 4) : 7 - ((a - 384) >> 4); attn_wave_mfma(F, a & 15, c, F.wave); MIX0_PULL(); }
#undef MIX0_PULL
    __syncthreads();
}
__device__ __forceinline__ void mix_hgrn_item(Frame& F, int b, int h) {
    LAS float* L = (LAS float*)F.lds;
    LAS float* qs = L; LAS float* fs = L + 4096; LAS float* is = L + 8192; LAS float* gs = L + 12288; LAS float* op = L + 16384;
    const bf16_t* Z = (const bf16_t*)(F.ws + WS_Z); bf16_t* CAT = (bf16_t*)(F.ws + WS_CAT); const float* lb = (const float*)(F.ws + WS_LB); const float* ng = F.in[16];
    const int tid = F.tid, v = tid & 127, kq = tid >> 7;
    float S[32];
#pragma unroll
    for (int k = 0; k < 32; ++k) S[k] = 0.f;
    for (int t0 = 0; t0 < SEQ; t0 += 32) {
        __syncthreads();
        for (int i = tid; i < 4096; i += 512) { const int r = i >> 7, c = i & 127; const bf16_t* zr = Z + ((size_t)b * SEQ + t0 + r) * C_IN + h * 128 + c;
            qs[i] = bf2f(zr[0]); const float l = lb[h * 128 + c]; fs[i] = l + (1.f - l) * sigmoidf_(bf2f(zr[1024])); is[i] = bf2f(zr[2048]); gs[i] = bf2f(zr[3072]); }
        __syncthreads();
        for (int r = 0; r < 32; ++r) { const float iv = is[r * 128 + v]; float o = 0.f;
#pragma unroll
            for (int k4 = 0; k4 < 8; ++k4) { const f32x4 f4 = *(const LAS f32x4*)(fs + r * 128 + kq * 32 + 4 * k4), q4 = *(const LAS f32x4*)(qs + r * 128 + kq * 32 + 4 * k4);
                S[4 * k4] = f4.x * S[4 * k4] + (1.f - f4.x) * iv; o += q4.x * S[4 * k4];
                S[4 * k4 + 1] = f4.y * S[4 * k4 + 1] + (1.f - f4.y) * iv; o += q4.y * S[4 * k4 + 1];
                S[4 * k4 + 2] = f4.z * S[4 * k4 + 2] + (1.f - f4.z) * iv; o += q4.z * S[4 * k4 + 2];
                S[4 * k4 + 3] = f4.w * S[4 * k4 + 3] + (1.f - f4.w) * iv; o += q4.w * S[4 * k4 + 3]; }
            op[(r * 4 + kq) * 128 + v] = o; }
        __syncthreads();
#pragma unroll
        for (int rr = 0; rr < 4; ++rr) { const int r = F.wave * 4 + rr; const int l = F.lane;
            const float o1 = op[(r * 4 + 0) * 128 + l] + op[(r * 4 + 1) * 128 + l] + op[(r * 4 + 2) * 128 + l] + op[(r * 4 + 3) * 128 + l];
            const float o2 = op[(r * 4 + 0) * 128 + 64 + l] + op[(r * 4 + 1) * 128 + 64 + l] + op[(r * 4 + 2) * 128 + 64 + l] + op[(r * 4 + 3) * 128 + 64 + l];
            const float rinv = rsqrtf(wave_sum(o1 * o1 + o2 * o2) * (1.f / 128.f) + EPS);
            bf16_t* cp = CAT + ((size_t)b * SEQ + t0 + r) * D + h * 128;
            cp[l] = (bf16_t)f2bf(o1 * rinv * ng[h * 128 + l] * gs[r * 128 + l]); cp[64 + l] = (bf16_t)f2bf(o2 * rinv * ng[h * 128 + 64 + l] * gs[r * 128 + 64 + l]); }
    }
    __syncthreads();
}


constexpr size_t WS_EB = WS_LTOK;
__device__ __forceinline__ void hgrn_prep(Frame& F, int dry = 0) {
    bf16_t* Z = (bf16_t*)(F.ws + WS_Z); const float* lbp = (const float*)(F.ws + WS_LB); float* EBG = (float*)(F.ws + WS_EB);
    const int c2 = F.tid;
    const float lb0 = lbp[2 * c2], lb1 = lbp[2 * c2 + 1];
    for (int blk = F.vcu; blk < T / 32; blk += F.G) {
        unsigned* zq = (unsigned*)(Z + (size_t)blk * 32 * C_IN) + c2; unsigned* zf = zq + 512;
        float P0 = 1.f, P1 = 1.f;
#pragma unroll 8
        for (int t = 0; t < 32; ++t) { const unsigned qv = zq[(size_t)t * (C_IN / 2)], fv = zf[(size_t)t * (C_IN / 2)];
            const float f0 = lb0 + (1.f - lb0) * __builtin_amdgcn_rcpf(1.f + __expf(-bf2f(fv & 0xffffu))), f1 = lb1 + (1.f - lb1) * __builtin_amdgcn_rcpf(1.f + __expf(-bf2f(fv >> 16)));
            P0 *= f0; P1 *= f1;
            const float r0 = fminf(__builtin_amdgcn_rcpf(P0), 1.0e30f), r1 = fminf(__builtin_amdgcn_rcpf(P1), 1.0e30f);
            const unsigned nq = cvt_pk_bf16(bf2f(qv & 0xffffu) * P0, bf2f(qv >> 16) * P1), nf = cvt_pk_bf16((1.f - f0) * r0, (1.f - f1) * r1);
            zq[(size_t)t * (C_IN / 2)] = dry ? qv : nq; zf[(size_t)t * (C_IN / 2)] = dry ? fv : nf; }
        *(f32x2v*)(EBG + (size_t)blk * 1024 + 2 * c2) = (f32x2v){P0, P1};
    }
}
constexpr int HG_STR = 272, HG_TILE = 32 * HG_STR;
constexpr int HG_BUF = 4 * HG_TILE + 512;
constexpr int HG_AT = 2 * HG_BUF, HG_SSQ = HG_AT + 2560, HG_END = HG_SSQ + 1024;
static_assert(HG_END <= RING_BYTES, "hgrn lds");
__device__ __forceinline__ float xor16_add(float v) { const auto r = __builtin_amdgcn_permlane16_swap(__float_as_uint(v), __float_as_uint(v), false, false); return __uint_as_float(r[0]) + __uint_as_float(r[1]); }
__device__ __forceinline__ float xor32_add(float v) { const auto r = __builtin_amdgcn_permlane32_swap(__float_as_uint(v), __float_as_uint(v), false, false); return __uint_as_float(r[0]) + __uint_as_float(r[1]); }
__device__ __forceinline__ void hgrn_item(Frame& F, int b, int h, int nsteps = 64) {
    const bf16_t* Z = (const bf16_t*)(F.ws + WS_Z); bf16_t* CAT = (bf16_t*)(F.ws + WS_CAT); const float* EBG = (const float*)(F.ws + WS_EB); const float* ngp = F.in[16];
    LAS unsigned char* L = F.lds;
    LAS float* SSQ = (LAS float*)(L + HG_SSQ); LAS bf16_t* AT = (LAS bf16_t*)(L + HG_AT);
    const int tid = F.tid, l = F.lane, w = F.wave;
    const int lt = tid >> 4, lkc = tid & 15, i16 = l & 15, q4 = l >> 4, qq = i16 >> 2, pp = i16 & 3;
    float ngv[4];
#pragma unroll
    for (int j = 0; j < 4; ++j) ngv[j] = ngp[h * 128 + 16 * w + 4 * q4 + j];
    f32x4 S[8];
#pragma unroll
    for (int i = 0; i < 8; ++i) S[i] = (f32x4){0.f, 0.f, 0.f, 0.f};
    __syncthreads();
    for (int i = tid; i < 640; i += 512) ((LAS unsigned*)(L + HG_AT))[i] = 0u;
    const bf16_t* zrow0 = Z + ((size_t)b * SEQ + lt) * C_IN + h * 128 + 8 * lkc;
    const float* eb0 = EBG + (size_t)b * (SEQ / 32) * 1024 + h * 128 + 4 * (tid & 31);
    struct TileRegs { u32x4 q, f, v, g; f32x4 e; };
    TileRegs RA;
#define HG_LOAD(R_, st_) do { const bf16_t* zr = zrow0 + (size_t)(st_) * 32 * C_IN; R_.q = *(const u32x4*)(zr); R_.f = *(const u32x4*)(zr + 1024); R_.v = *(const u32x4*)(zr + 2048); R_.g = *(const u32x4*)(zr + 3072); \
        R_.e = *(const f32x4*)(eb0 + (size_t)(st_) * 1024); } while (0)
#define HG_PUT(R_, par_) do { LAS unsigned char* B_ = L + (par_) * HG_BUF + lt * HG_STR + lkc * 16; *(LAS u32x4*)(B_) = R_.q; *(LAS u32x4*)(B_ + HG_TILE) = R_.f; *(LAS u32x4*)(B_ + 2 * HG_TILE) = R_.v; *(LAS u32x4*)(B_ + 3 * HG_TILE) = R_.g; \
        if (tid < 32) *(LAS f32x4*)(L + (par_) * HG_BUF + 4 * HG_TILE + 16 * tid) = R_.e; } while (0)
    HG_LOAD(RA, 0); HG_PUT(RA, 0); HG_LOAD(RA, 1);
#define HG_STEP(stx, R_) do { const int st = (stx); \
        LAS unsigned char* QEb = L + (st & 1) * HG_BUF; LAS unsigned char* KNb = QEb + HG_TILE; LAS unsigned char* Vb = QEb + 2 * HG_TILE; LAS unsigned char* Gb = QEb + 3 * HG_TILE; LAS float* EB = (LAS float*)(QEb + 4 * HG_TILE); \
        __syncthreads(); \
        s16x4 vlo = ds_tr16(Vb + (8 * q4 + qq) * HG_STR + (16 * w + 4 * pp) * 2), vhi = ds_tr16(Vb + (8 * q4 + 4 + qq) * HG_STR + (16 * w + 4 * pp) * 2); \
        u32x2 qf0[4][2], qf1[4][2]; \
        _Pragma("unroll") \
        for (int m = 0; m < 4; ++m) \
        _Pragma("unroll") \
            for (int tb = 0; tb < 2; ++tb) { qf0[m][tb] = *(const LAS u32x2*)(QEb + (16 * tb + i16) * HG_STR + (32 * m + 4 * q4) * 2); qf1[m][tb] = *(const LAS u32x2*)(QEb + (16 * tb + i16) * HG_STR + (32 * m + 16 + 4 * q4) * 2); } \
        if (w < 3) { const int tb = w ? 1 : 0, sb = (w == 2) ? 1 : 0; f32x4 acc = (f32x4){0.f, 0.f, 0.f, 0.f}; \
            bf16x8 qa[4], kb4[4]; \
        _Pragma("unroll") \
            for (int ks = 0; ks < 4; ++ks) { qa[ks] = *(const LAS bf16x8*)(QEb + (16 * tb + i16) * HG_STR + (32 * ks + 8 * q4) * 2); kb4[ks] = *(const LAS bf16x8*)(KNb + (16 * sb + i16) * HG_STR + (32 * ks + 8 * q4) * 2); } \
        _Pragma("unroll") \
            for (int ks = 0; ks < 4; ++ks) acc = MFMA16(qa[ks], kb4[ks], acc); \
        _Pragma("unroll") \
            for (int rg = 0; rg < 4; ++rg) { const int t = 16 * tb + 4 * q4 + rg, sx = 16 * sb + i16; AT[t * 40 + sx] = (bf16_t)f2bf(sx <= t ? acc[rg] : 0.f); } } \
        const bf16x8 vfr = (bf16x8){vlo[0], vlo[1], vlo[2], vlo[3], vhi[0], vhi[1], vhi[2], vhi[3]}; \
        f32x4 O[2]; O[0] = (f32x4){0.f, 0.f, 0.f, 0.f}; O[1] = O[0]; \
        _Pragma("unroll") \
        for (int m = 0; m < 4; ++m) { u32x4 sp; sp.x = cvt_pk_bf16(S[2 * m][0], S[2 * m][1]); sp.y = cvt_pk_bf16(S[2 * m][2], S[2 * m][3]); sp.z = cvt_pk_bf16(S[2 * m + 1][0], S[2 * m + 1][1]); sp.w = cvt_pk_bf16(S[2 * m + 1][2], S[2 * m + 1][3]); \
            const bf16x8 spk = __builtin_bit_cast(bf16x8, sp); \
        _Pragma("unroll") \
            for (int tb = 0; tb < 2; ++tb) { const u32x4 qv = (u32x4){qf0[m][tb].x, qf0[m][tb].y, qf1[m][tb].x, qf1[m][tb].y}; O[tb] = MFMA16(spk, __builtin_bit_cast(bf16x8, qv), O[tb]); } } \
        _Pragma("unroll") \
        for (int kb = 0; kb < 8; ++kb) { const s16x4 klo = ds_tr16(KNb + (8 * q4 + qq) * HG_STR + (16 * kb + 4 * pp) * 2), khi = ds_tr16(KNb + (8 * q4 + 4 + qq) * HG_STR + (16 * kb + 4 * pp) * 2); const bf16x8 kfr = (bf16x8){klo[0], klo[1], klo[2], klo[3], khi[0], khi[1], khi[2], khi[3]}; \
            S[kb] = MFMA16(kfr, vfr, S[kb]) * *(const LAS f32x4*)(EB + 16 * kb + 4 * q4); } \
        __syncthreads(); \
        _Pragma("unroll") \
        for (int tb = 0; tb < 2; ++tb) { const bf16x8 at = *(const LAS bf16x8*)(L + HG_AT + (16 * tb + i16) * 80 + 16 * q4); O[tb] = MFMA16(vfr, at, O[tb]); } \
        _Pragma("unroll") \
        for (int tb = 0; tb < 2; ++tb) { float ss = (O[tb][0] * O[tb][0] + O[tb][1] * O[tb][1]) + (O[tb][2] * O[tb][2] + O[tb][3] * O[tb][3]); ss = xor16_add(ss); ss = xor32_add(ss); \
            if (q4 == 0) SSQ[(16 * tb + i16) * 8 + w] = ss; } \
        __syncthreads(); \
        _Pragma("unroll") \
        for (int tb = 0; tb < 2; ++tb) { const int t = 16 * tb + i16; const f32x4 a = *(const LAS f32x4*)(SSQ + t * 8), c = *(const LAS f32x4*)(SSQ + t * 8 + 4); \
            const float rinv = rsqrtf(((a.x + a.y) + (a.z + a.w) + (c.x + c.y) + (c.z + c.w)) * (1.f / 128.f) + EPS); \
            const u32x2 g2 = *(const LAS u32x2*)(Gb + t * HG_STR + (16 * w + 4 * q4) * 2); \
            const float o0 = O[tb][0] * rinv * ngv[0] * bf2f(g2.x & 0xffffu), o1 = O[tb][1] * rinv * ngv[1] * bf2f(g2.x >> 16), o2 = O[tb][2] * rinv * ngv[2] * bf2f(g2.y & 0xffffu), o3 = O[tb][3] * rinv * ngv[3] * bf2f(g2.y >> 16); \
            *(u32x2*)(CAT + ((size_t)b * SEQ + st * 32 + t) * D + h * 128 + 16 * w + 4 * q4) = (u32x2){cvt_pk_bf16(o0, o1), cvt_pk_bf16(o2, o3)}; } \
        if (st < nsteps - 1) { HG_PUT(R_, (st + 1) & 1); if (st < nsteps - 2) HG_LOAD(R_, st + 2); } \
    } while (0)
#pragma unroll 1
    for (int st1 = 0; st1 < nsteps; ++st1) { HG_STEP(st1, RA); }
#undef HG_STEP
#undef HG_LOAD
#undef HG_PUT
    __syncthreads();
}
__device__ __forceinline__ void p_gu(Frame& F, int layer) {
    unsigned char* ws = F.ws;
    moe_tables(F, layer);
    const LAS int* ts = (const LAS int*)(F.lds + TS_OFF); LAS unsigned* tab = (LAS unsigned*)(F.lds + TAB_OFF);
    pg8::MoeOrder<true> S{ts, tab, F.G, F.vcu, D};
    { const int* ltok = (const int*)(ws + WS_LTOK); pg8::Unit u;
      for (int i = 0; i < 6 && S.next(i, u); ++i) if (F.tid < 256) { const int pos = u.rl * 256 + F.tid; const int tok = pos < ts[40 + u.e] ? ltok[(size_t)u.e * CAP + pos] : 0; tab[i * 256 + F.tid] = (unsigned)tok * (unsigned)(D * 2); }
      __syncthreads(); }
    pg8::EpiGU E{(bf16_t*)(ws + WS_HB), (const float*)(ws + WS_LRSTD), ts + 40};
    pg8::gemm_phase<pg8::EpiGU, pg8::MoeOrder<true>, true>(F.lds, (const bf16_t*)(ws + WS_XB), (const bf16_t*)(ws + WS_WGU), D, S, E);
}
__device__ __forceinline__ void p_dn(Frame& F, int layer) {
    unsigned char* ws = F.ws;
    moe_tables(F, layer);
    const LAS int* ts = (const LAS int*)(F.lds + TS_OFF);
    pg8::MoeOrder<false> S{ts, nullptr, F.G, F.vcu, DEXP};
    pg8::EpiDN E{(bf16_t*)(ws + WS_Y), (const float*)(ws + WS_LW), ts + 40};
    pg8::gemm_phase<pg8::EpiDN, pg8::MoeOrder<false>, true>(F.lds, (const bf16_t*)(ws + WS_HB), (const bf16_t*)(ws + WS_WDN), DEXP, S, E);
}

__global__ void __launch_bounds__(512, 2) fwd(Args args) {
    extern __shared__ __attribute__((aligned(16))) unsigned char lds_raw[];
    Frame F;
    F.lds = (LAS unsigned char*)lds_raw; F.tid = threadIdx.x; F.lane = F.tid & 63; F.wave = __builtin_amdgcn_readfirstlane(F.tid >> 6);
    F.G = gridDim.x; { const int bx = blockIdx.x; F.vcu = (F.G % 8 == 0) ? (bx % 8) * (F.G / 8) + bx / 8 : bx; }
    F.in = args.in; F.out = args.out; F.ws = args.ws;
    unsigned char* ws = args.ws;
    bf16_t* XB = (bf16_t*)(ws + WS_XB); bf16_t* CAT = (bf16_t*)(ws + WS_CAT); bf16_t* Z = (bf16_t*)(ws + WS_Z);
    float* RSTD = (float*)(ws + WS_RSTD);
#if MK_ONE_LAUNCH == 2
    cg::grid_group grid = cg::this_grid();
#define GRID_BAR() grid.sync()
#elif MK_ONE_LAUNCH == 1
    if (F.tid < 2) ((volatile LAS unsigned*)(F.lds + MISC_OFF))[F.tid] = 0u;
    __syncthreads();
    const XcdBarrier xbar = xcd_barrier_post((unsigned*)(ws + WS_CTL) + CW_BAR, (volatile LAS unsigned*)(F.lds + MISC_OFF));
#define GRID_BAR() xcd_barrier(xbar)
#else
#define GRID_BAR() do {} while (0)
#endif
    #ifndef PH_MASK
#define PH_MASK 0x7fff
#endif
#define PHE(p) ((PH_MASK >> (p)) & 1)
    const int lo = args.ph_lo, hi = args.ph_hi;
#ifndef PROBE_MASK
#define PROBE_MASK 0
#endif
#define REPN(k) (((PROBE_MASK >> (k)) & 1) ? 2 : 1)
#define IN(k) (PHE(k) && lo <= (k) && (k) < hi)
#define SEAM(k) do { if (lo <= (k) && (k) + 1 < hi) GRID_BAR(); } while (0)
    if (IN(PH_PRO)) { { p_prologue(F); } if (REPN(PH_PRO) == 2) { GRID_BAR(); { p_prologue(F); } } } SEAM(PH_PRO);
    if (IN(PH_IN0)) { { pg8::DenseOrder S; S.init(T, AB_IN, D, F.G, (int)blockIdx.x); pg8::EpiIn E{Z, AB_IN, RSTD, 0, 1 << 30};
        pg8::gemm_phase<pg8::EpiIn, pg8::DenseOrder, true>(F.lds, XB, (const bf16_t*)(ws + WS_WIN0), D, S, E); } if (REPN(PH_IN0) == 2) { GRID_BAR(); { pg8::DenseOrder S; S.init(T, AB_IN, D, F.G, (int)blockIdx.x); pg8::EpiIn E{Z, AB_IN, RSTD, 0, 1 << 30};
        pg8::gemm_phase<pg8::EpiIn, pg8::DenseOrder, true>(F.lds, XB, (const bf16_t*)(ws + WS_WIN0), D, S, E); } } } SEAM(PH_IN0);
    if (IN(PH_MIX0)) { { p_mix0(F); } if (REPN(PH_MIX0) == 2) { GRID_BAR(); { p_mix0(F); } } } SEAM(PH_MIX0);
    if (IN(PH_OUT0)) { { pg8::DenseOrder S; S.init(T, D, D, F.G, (int)blockIdx.x); pg8::EpiOut E{XB, 0};
        pg8::gemm_phase<pg8::EpiOut, pg8::DenseOrder, true>(F.lds, CAT, (const bf16_t*)(ws + WS_WOUT0), D, S, E); } if (REPN(PH_OUT0) == 2) { GRID_BAR(); { pg8::DenseOrder S; S.init(T, D, D, F.G, (int)blockIdx.x); pg8::EpiOut E{XB, 0};
        pg8::gemm_phase<pg8::EpiOut, pg8::DenseOrder, true>(F.lds, CAT, (const bf16_t*)(ws + WS_WOUT0), D, S, E); } } } SEAM(PH_OUT0);
    if (IN(PH_R1)) { p_router(F, 0); if (PROBE_X & 1) { GRID_BAR(); p_router(F, 0, 1); } } SEAM(PH_R1);
    if (IN(PH_GU0)) { { p_gu(F, 0); } if (REPN(PH_GU0) == 2) { GRID_BAR(); { p_gu(F, 0); } } } SEAM(PH_GU0);
    if (IN(PH_DN0)) { { p_dn(F, 0); } if (REPN(PH_DN0) == 2) { GRID_BAR(); { p_dn(F, 0); } } } SEAM(PH_DN0);
    if (IN(PH_R2)) { if (PROBE_X & 2) { p_combine(F, 0, 0, 1); GRID_BAR(); } p_combine(F, 0, 0); } SEAM(PH_R2);
    if (IN(PH_IN1)) { { pg8::DenseOrder S; S.init(T, C_IN, D, F.G, (int)blockIdx.x); pg8::EpiIn E{Z, C_IN, RSTD, 1024, 3072};
        pg8::gemm_phase<pg8::EpiIn, pg8::DenseOrder, true>(F.lds, XB, (const bf16_t*)(ws + WS_WIN1), D, S, E); } if (REPN(PH_IN1) == 2) { GRID_BAR(); { pg8::DenseOrder S; S.init(T, C_IN, D, F.G, (int)blockIdx.x); pg8::EpiIn E{Z, C_IN, RSTD, 1024, 3072};
        pg8::gemm_phase<pg8::EpiIn, pg8::DenseOrder, true>(F.lds, XB, (const bf16_t*)(ws + WS_WIN1), D, S, E); } } } SEAM(PH_IN1);
    if (IN(PH_MIX1)) { if (PROBE_X & 512) moe_convert(F, 1, F.vcu, F.G); if (PROBE_X & 128) hgrn_prep(F, 1); hgrn_prep(F); GRID_BAR(); if (F.vcu < 128) {
#pragma unroll 1
        for (int rep_ = 0; rep_ < ((PROBE_X & 256) ? 2 : 1); ++rep_) hgrn_item(F, F.vcu >> 3, F.vcu & 7, (rep_ && (PROBE_X >> 12)) ? (PROBE_X >> 12) : 64); } else { __syncthreads(); if (!(PROBE_X & 512)) moe_convert(F, 1, F.vcu - 128, F.G - 128); if (PROBE_X & 4) moe_convert(F, 1, F.vcu - 128, F.G - 128); } } SEAM(PH_MIX1);
    if (IN(PH_OUT1)) { if (PROBE_X & 16) { pg8::DenseOrder S; S.init(T, D, D, F.G, (int)blockIdx.x); pg8::EpiOut E{XB, 1};
        pg8::gemm_phase<pg8::EpiOut, pg8::DenseOrder, true>(F.lds, CAT, (const bf16_t*)(ws + WS_WOUT1), D, S, E); GRID_BAR(); }
 pg8::DenseOrder S; S.init(T, D, D, F.G, (int)blockIdx.x); pg8::EpiOut E{XB, 0};
        pg8::gemm_phase<pg8::EpiOut, pg8::DenseOrder, true>(F.lds, CAT, (const bf16_t*)(ws + WS_WOUT1), D, S, E); } SEAM(PH_OUT1);
    if (IN(PH_R3)) { p_router(F, 1); } SEAM(PH_R3);
    if (IN(PH_GU1)) { { p_gu(F, 1); } if (REPN(PH_GU1) == 2) { GRID_BAR(); { p_gu(F, 1); } } } SEAM(PH_GU1);
    if (IN(PH_DN1)) { { p_dn(F, 1); } if (REPN(PH_DN1) == 2) { GRID_BAR(); { p_dn(F, 1); } } } SEAM(PH_DN1);
    if (IN(PH_R4)) { if (PROBE_X & 8) { p_combine(F, 1, 1, 1); GRID_BAR(); } p_combine(F, 1, 1); }
}

extern "C" void kernel_launch(void* const* d_in, const int* in_sizes, int n_in, void* d_out, int out_size, void* d_ws, size_t ws_size, hipStream_t stream) {
    static int grid = 0;
    if (grid == 0) {
        if (n_in != 23 || out_size != T * D || ws_size < WS_END) { fprintf(stderr, "kernel_launch: unexpected shapes: n_in %d out %d ws %zu (need %zu)\n", n_in, out_size, ws_size, (size_t)WS_END); grid = -1; return; }
        if (hipFuncSetAttribute((const void*)fwd, hipFuncAttributeMaxDynamicSharedMemorySize, LDS_BYTES) != hipSuccess) { fprintf(stderr, "kernel_launch: hipFuncSetAttribute failed\n"); grid = -1; return; }
        int dev = 0, cus = 0, per_cu = 0;
        hipGetDevice(&dev); hipDeviceGetAttribute(&cus, hipDeviceAttributeMultiprocessorCount, dev);
        hipOccupancyMaxActiveBlocksPerMultiprocessor(&per_cu, (const void*)fwd, 512, LDS_BYTES);
        (void)hipGetLastError();
        fprintf(stderr, "kernel_launch: cus %d per_cu %d ws %zu\n", cus, per_cu, ws_size);
        grid = cus > 0 ? cus : 256;
        if (per_cu < 1) fprintf(stderr, "kernel_launch: occupancy query says %d blocks per CU\n", per_cu);
    }
    if (grid < 0) return;
    hipMemsetAsync((char*)d_ws + WS_CTL, 0, CTL_BYTES, stream);
    Args a{};
    for (int i = 0; i < 23; ++i) a.in[i] = (const float*)d_in[i];
    a.out = (float*)d_out; a.ws = (unsigned char*)d_ws;
#if MK_ONE_LAUNCH
    a.ph_lo = 0; a.ph_hi = NPH;
    void* kargs[] = {&a};
    hipError_t e = hipLaunchCooperativeKernel((const void*)fwd, dim3(grid), dim3(512), kargs, LDS_BYTES, stream);
    if (e != hipSuccess) fprintf(stderr, "cooperative launch failed: %s (grid %d)\n", hipGetErrorString(e), grid);
#else
    for (int ph = 0; ph < NPH; ++ph) { a.ph_lo = ph; a.ph_hi = ph + 1; hipLaunchKernelGGL(fwd, dim3(grid), dim3(512), LDS_BYTES, stream, a); }
#endif
}
```

```cpp
#include <hip/hip_runtime.h>
#include <hip/hip_cooperative_groups.h>
#include <cstdio>
#include <cstdint>
namespace cg = cooperative_groups;

#ifndef PROBE_X
#define PROBE_X 0
#endif
#ifndef MK_ONE_LAUNCH
#define MK_ONE_LAUNCH 1
#endif

constexpr int T = 32768, D = 1024, SEQ = 2048, NB = 16;
constexpr int AB_IN = 2560, C_IN = 4096;
constexpr int NEXP = 32, DEXP = 512, CAP = 32768;
constexpr int MAXTILES = 288;
constexpr float EPS = 1e-6f;

#define LAS __attribute__((address_space(3)))
typedef unsigned short bf16_t;
typedef short bf16x8 __attribute__((ext_vector_type(8)));
typedef float f32x4 __attribute__((ext_vector_type(4)));
typedef unsigned u32x4 __attribute__((ext_vector_type(4)));
typedef unsigned u32x2 __attribute__((ext_vector_type(2)));
typedef float f32x2v __attribute__((ext_vector_type(2)));

constexpr size_t MiB = 1u << 20;
constexpr size_t WS_CTL = 0, CTL_BYTES = 1 * MiB;
constexpr size_t WS_RSTD = 1 * MiB;
constexpr size_t WS_LB = WS_RSTD + 128 * 1024;
constexpr size_t WS_RWH = WS_LB + 4096;
constexpr size_t WS_RWL = WS_RWH + 2 * 36 * 1024 * 2;
constexpr size_t WS_TOKINFO = 2 * MiB;
constexpr size_t WS_LTOK = 3 * MiB, WS_LRSTD = 7 * MiB, WS_LW = 11 * MiB;
constexpr size_t WS_WIN0 = 16 * MiB, WS_WOUT0 = 21 * MiB, WS_WIN1 = 23 * MiB, WS_WOUT1 = 31 * MiB;
constexpr size_t WS_WGU = 34 * MiB, WS_WDN = 98 * MiB;
constexpr size_t WS_XB = 130 * MiB, WS_CAT = 194 * MiB;
constexpr size_t WS_Z = 258 * MiB;
constexpr size_t WS_HB = 258 * MiB, WS_Y = 330 * MiB;
constexpr size_t WS_END = 514 * MiB;
constexpr int CW_CNT = 8192;
constexpr int CW_BAR = 4096;
constexpr int CW_Q0 = 512;

constexpr int RING_BYTES = 131072;
constexpr int TAB_OFF = RING_BYTES;
constexpr int TS_OFF = TAB_OFF + 6 * 1024;
constexpr int LDS_BYTES = 163840;
constexpr int MISC_OFF = LDS_BYTES - 64;

__device__ __forceinline__ unsigned f2bf(float f) { unsigned u = __float_as_uint(f); return (u + 0x7fffu + ((u >> 16) & 1u)) >> 16; }
__device__ __forceinline__ float bf2f(unsigned b) { return __uint_as_float(b << 16); }
__device__ __forceinline__ unsigned pk2(float lo, float hi) { return f2bf(lo) | (f2bf(hi) << 16); }
__device__ __forceinline__ unsigned cvt_pk_bf16(float lo, float hi) { unsigned r; asm volatile("v_cvt_pk_bf16_f32 %0, %1, %2" : "=v"(r) : "v"(lo), "v"(hi)); return r; }
__device__ __forceinline__ float wave_sum(float v) {
#pragma unroll
    for (int o = 1; o < 64; o <<= 1) v += __shfl_xor(v, o);
    return v;
}
__device__ __forceinline__ float sigmoidf_(float x) { return __builtin_amdgcn_rcpf(1.0f + __expf(-x)); }
__device__ __forceinline__ float siluf_(float x) { return x * __builtin_amdgcn_rcpf(1.0f + __expf(-x)); }
__device__ __forceinline__ float gelu_tanh(float x) { const float u = 0.7978845608028654f * (x + 0.044715f * x * x * x); return 0.5f * x * (1.0f + tanhf(u)); }
#define LDS_WAIT() asm volatile("s_waitcnt lgkmcnt(0)" ::: "memory")
#define MFMA16(a, b, c) __builtin_amdgcn_mfma_f32_16x16x32_bf16((a), (b), (c), 0, 0, 0)

namespace pg8 {
constexpr int BM = 256, BK = 64, HALF = 128, HTB = HALF * BK * 2, NXCD = 8, WGM = 8;
__host__ __device__ __forceinline__ int lds_byte(int r, int c) { const int st = (r >> 4) * 2 + (c >> 5), rr = r & 15, cc = c & 31, ob = rr * 64 + cc * 2; return st * 1024 + (ob ^ (((ob >> 9) & 1) << 5)); }
__host__ __device__ __forceinline__ void stage_rc(int b, int& R, int& C) { const int st = b / 1024, sb = b % 1024, swz = sb ^ (((sb >> 9) & 1) << 5); R = (st >> 1) * 16 + swz / 64; C = (st & 1) * 32 + (swz % 64) / 2; }
__host__ __device__ __forceinline__ int perm32(int rho) { const int n = rho >> 4, i = rho & 15; return 8 * (i >> 2) + 4 * n + (i & 3); }

struct Unit { unsigned boff; int arow, orow, ocol, e, rl, slot; };

struct DenseOrder {
    int nM, nN, nwg, G, c, K;
    __device__ void init(int M, int N, int K_, int G_, int c_) { nM = M / BM; nN = N / BM; nwg = nM * nN; G = G_; c = c_; K = K_; }
    __device__ __forceinline__ bool next(int i, Unit& u) const {
        const long L = (long)i * G + c; if (L >= nwg) return false;
        int wgid = (int)L; { const int q = nwg / NXCD, r = nwg % NXCD, xcd = wgid % NXCD, off = wgid / NXCD; wgid = (xcd < r ? xcd * (q + 1) : r * (q + 1) + (xcd - r) * q) + off; }
        const int nig = WGM * nN, gid = wgid / nig, fm = gid * WGM, gsz = (nM - fm) < WGM ? (nM - fm) : WGM;
        const int pm = __builtin_amdgcn_readfirstlane(fm + ((wgid % nig) % gsz)), pn = __builtin_amdgcn_readfirstlane((wgid % nig) / gsz);
        u.arow = pm * BM; u.orow = pm * BM; u.ocol = pn * BM; u.boff = (unsigned)(pn * BM) * (unsigned)K * 2u; u.e = 0; u.rl = 0; u.slot = i; return true;
    }
    static constexpr bool GATHER = false;
    __device__ __forceinline__ size_t abase(const Unit& u) const { return (size_t)u.arow * (size_t)K * 2u; }
    __device__ __forceinline__ unsigned aoff(const Unit&, int) const { return 0u; }
};
template <bool GATHER_> struct MoeOrder {
    static constexpr bool GATHER = GATHER_;
    const LAS int* ts; const LAS unsigned* tab; int G, vcu, K;
    __device__ __forceinline__ bool next(int i, Unit& u) const {
        const int L = i * G + vcu; const int NT = __builtin_amdgcn_readfirstlane(ts[32]); if (L >= NT * 4) return false;
        const int rt = L >> 2, pn = L & 3; int e = 0;
#pragma unroll
        for (int j = 1; j < 32; ++j) e += (ts[j] <= rt) ? 1 : 0;
        e = __builtin_amdgcn_readfirstlane(e);
        u.e = e; u.rl = rt - __builtin_amdgcn_readfirstlane(ts[e]); u.orow = rt * BM; u.arow = rt * BM; u.ocol = pn * BM; u.boff = (unsigned)(e * 1024 + pn * BM) * (unsigned)K * 2u; u.slot = i; return true;
    }
    __device__ __forceinline__ size_t abase(const Unit& u) const { return GATHER ? (size_t)0 : (size_t)u.arow * (size_t)K * 2u; }
    __device__ __forceinline__ unsigned aoff(const Unit& u, int r) const { return tab[u.slot * 256 + r]; }
};

typedef f32x4 Acc[2][2][4][2];

#define DPP_SCAN_MUL(v) do { \
    v *= __builtin_bit_cast(float, __builtin_amdgcn_update_dpp(0x3f800000, __builtin_bit_cast(int, v), 0x111, 0xf, 0xf, false)); \
    v *= __builtin_bit_cast(float, __builtin_amdgcn_update_dpp(0x3f800000, __builtin_bit_cast(int, v), 0x112, 0xf, 0xf, false)); \
    v *= __builtin_bit_cast(float, __builtin_amdgcn_update_dpp(0x3f800000, __builtin_bit_cast(int, v), 0x114, 0xf, 0xf, false)); \
    v *= __builtin_bit_cast(float, __builtin_amdgcn_update_dpp(0x3f800000, __builtin_bit_cast(int, v), 0x118, 0xf, 0xf, false)); } while (0)
struct EpiIn {
    static constexpr bool PERM = true;
    bf16_t* O; int ldc; const float* rstd; int silu_lo_end, silu_hi_start; int nostore; int hg_end; const float* lb; float* EBG;
    __device__ __forceinline__ void operator()(const Acc& acc, const Unit& u, int wr, int wc, int fr, int fq) const {
        if (u.ocol < hg_end) {
            const int h = u.ocol >> 8, c0 = h * 128 + wc * 32 + 8 * fq;
            float lbv[8];
#pragma unroll
            for (int j = 0; j < 8; ++j) lbv[j] = lb[c0 + j];
            const int lane = fq * 16 + fr;
#pragma unroll
            for (int ai = 0; ai < 2; ++ai)
#pragma unroll
                for (int mp = 0; mp < 2; ++mp) {
                    const int row0 = u.orow + ai * HALF + wr * 64 + mp * 32 + fr; const float rs0 = rstd[row0], rs1 = rstd[row0 + 16];
                    float qe[2][8], kn[2][8], pend[8];
#pragma unroll
                    for (int j = 0; j < 8; ++j) { const int n = j >> 2, jj = j & 3;
                        const float f0 = lbv[j] + (1.f - lbv[j]) * sigmoidf_(acc[ai][1][2 * mp][n][jj] * rs0), f1 = lbv[j] + (1.f - lbv[j]) * sigmoidf_(acc[ai][1][2 * mp + 1][n][jj] * rs1);
                        float p0 = f0, p1 = f1; DPP_SCAN_MUL(p0); DPP_SCAN_MUL(p1);
                        const float t0 = __shfl(p0, lane | 15), t1 = __shfl(p1, lane | 15);
                        p1 *= t0; pend[j] = t0 * t1;
                        qe[0][j] = siluf_(acc[ai][0][2 * mp][n][jj] * rs0) * p0; qe[1][j] = siluf_(acc[ai][0][2 * mp + 1][n][jj] * rs1) * p1;
                        kn[0][j] = (1.f - f0) * fminf(__builtin_amdgcn_rcpf(p0), 1.0e30f); kn[1][j] = (1.f - f1) * fminf(__builtin_amdgcn_rcpf(p1), 1.0e30f); }
#pragma unroll
                    for (int mm = 0; mm < 2; ++mm) { bf16_t* rowp = O + (size_t)(row0 + 16 * mm) * ldc + c0;
                        *(u32x4*)rowp = (u32x4){cvt_pk_bf16(qe[mm][0], qe[mm][1]), cvt_pk_bf16(qe[mm][2], qe[mm][3]), cvt_pk_bf16(qe[mm][4], qe[mm][5]), cvt_pk_bf16(qe[mm][6], qe[mm][7])};
                        *(u32x4*)(rowp + 1024) = (u32x4){cvt_pk_bf16(kn[mm][0], kn[mm][1]), cvt_pk_bf16(kn[mm][2], kn[mm][3]), cvt_pk_bf16(kn[mm][4], kn[mm][5]), cvt_pk_bf16(kn[mm][6], kn[mm][7])}; }
                    if (fr == 0) { float* eb = EBG + (size_t)((u.orow + ai * HALF + wr * 64 + mp * 32) >> 5) * 1024 + c0;
                        *(f32x4*)eb = (f32x4){pend[0], pend[1], pend[2], pend[3]}; *(f32x4*)(eb + 4) = (f32x4){pend[4], pend[5], pend[6], pend[7]}; }
                }
            return;
        }
        const bool act = (u.ocol < silu_lo_end) || (u.ocol >= silu_hi_start);
#pragma unroll
        for (int ai = 0; ai < 2; ++ai)
#pragma unroll
            for (int m = 0; m < 4; ++m) {
                const int row = u.orow + ai * HALF + wr * 64 + m * 16 + fr; const float rs = rstd[row];
                bf16_t* rowp = O + (size_t)row * ldc + u.ocol + wc * 32 + 8 * fq;
#pragma unroll
                for (int bj = 0; bj < 2; ++bj) { f32x4 v0 = acc[ai][bj][m][0] * rs, v1 = acc[ai][bj][m][1] * rs;
                    if (act) {
#pragma unroll
                        for (int j = 0; j < 4; ++j) { v0[j] = siluf_(v0[j]); v1[j] = siluf_(v1[j]); } }
                    u32x4 w; w.x = cvt_pk_bf16(v0[0], v0[1]); w.y = cvt_pk_bf16(v0[2], v0[3]); w.z = cvt_pk_bf16(v1[0], v1[1]); w.w = cvt_pk_bf16(v1[2], v1[3]);
                    if (!nostore) *(u32x4*)(rowp + bj * HALF) = w; else if (u.orow < 0) asm volatile("" :: "v"(w)); } }
    }
};
struct EpiNone { static constexpr bool PERM = true; __device__ __forceinline__ void operator()(const Acc& acc, const Unit& u, int, int, int, int) const { if (u.orow < 0) asm volatile("" :: "v"(acc[0][0][0][0][0]), "v"(acc[1][1][3][1][3])); } };
struct EpiOut {
    static constexpr bool PERM = true;
    bf16_t* XB; int dry;
    __device__ __forceinline__ void operator()(const Acc& acc, const Unit& u, int wr, int wc, int fr, int fq) const {
#pragma unroll
        for (int ai = 0; ai < 2; ++ai)
#pragma unroll
            for (int m = 0; m < 4; ++m) {
                const int row = u.orow + ai * HALF + wr * 64 + m * 16 + fr; const size_t off = (size_t)row * D + u.ocol + wc * 32 + 8 * fq;
#pragma unroll
                for (int bj = 0; bj < 2; ++bj) { const u32x4 r = *(const u32x4*)(XB + off + bj * HALF);
                    f32x4 v0 = (f32x4){bf2f(r.x & 0xffffu), bf2f(r.x >> 16), bf2f(r.y & 0xffffu), bf2f(r.y >> 16)}, v1 = (f32x4){bf2f(r.z & 0xffffu), bf2f(r.z >> 16), bf2f(r.w & 0xffffu), bf2f(r.w >> 16)};
                    if (!dry) { v0 += acc[ai][bj][m][0]; v1 += acc[ai][bj][m][1]; }
                    u32x4 w; w.x = cvt_pk_bf16(v0[0], v0[1]); w.y = cvt_pk_bf16(v0[2], v0[3]); w.z = cvt_pk_bf16(v1[0], v1[1]); w.w = cvt_pk_bf16(v1[2], v1[3]);
                    *(u32x4*)(XB + off + bj * HALF) = w; } }
    }
};
struct EpiGU {
    static constexpr bool PERM = true;
    bf16_t* HB; const float* lrstd; const LAS int* cnt;
    __device__ __forceinline__ void operator()(const Acc& acc, const Unit& u, int wr, int wc, int fr, int fq) const {
        const int n_e = cnt[u.e];
#pragma unroll
        for (int ai = 0; ai < 2; ++ai)
#pragma unroll
            for (int m = 0; m < 4; ++m) {
                const int r = ai * HALF + wr * 64 + m * 16 + fr, pos = u.rl * BM + r; const float rs = pos < n_e ? lrstd[(size_t)u.e * CAP + pos] : 0.f;
                float h[8];
#pragma unroll
                for (int n = 0; n < 2; ++n)
#pragma unroll
                    for (int j = 0; j < 4; ++j) { const float g = acc[ai][0][m][n][j] * rs, uu = acc[ai][1][m][n][j] * rs; h[n * 4 + j] = siluf_(g) * uu; }
                u32x4 w; w.x = cvt_pk_bf16(h[0], h[1]); w.y = cvt_pk_bf16(h[2], h[3]); w.z = cvt_pk_bf16(h[4], h[5]); w.w = cvt_pk_bf16(h[6], h[7]);
                *(u32x4*)(HB + (size_t)(u.orow + r) * DEXP + (u.ocol >> 1) + wc * 32 + 8 * fq) = w; }
    }
};
struct EpiDN {
    static constexpr bool PERM = true;
    bf16_t* Y; const float* lw; const LAS int* cnt;
    __device__ __forceinline__ void operator()(const Acc& acc, const Unit& u, int wr, int wc, int fr, int fq) const {
        const int n_e = cnt[u.e];
#pragma unroll
        for (int ai = 0; ai < 2; ++ai)
#pragma unroll
            for (int m = 0; m < 4; ++m) {
                const int r = ai * HALF + wr * 64 + m * 16 + fr, pos = u.rl * BM + r; const float ws = pos < n_e ? lw[(size_t)u.e * CAP + pos] : 0.f;
                bf16_t* rowp = Y + (size_t)(u.orow + r) * D + u.ocol + wc * 32 + 8 * fq;
#pragma unroll
                for (int bj = 0; bj < 2; ++bj) { const f32x4 v0 = acc[ai][bj][m][0] * ws, v1 = acc[ai][bj][m][1] * ws;
                    u32x4 w; w.x = cvt_pk_bf16(v0[0], v0[1]); w.y = cvt_pk_bf16(v0[2], v0[3]); w.z = cvt_pk_bf16(v1[0], v1[1]); w.w = cvt_pk_bf16(v1[2], v1[3]);
                    *(u32x4*)(rowp + bj * HALF) = w; } }
    }
};

template <class Epi, class Sched, bool ALIGN_EPI>
__device__ __forceinline__ void gemm_phase(LAS unsigned char* lds, const bf16_t* A, const bf16_t* Bt, const int K, const Sched& S, const Epi& E, const unsigned stagger_ticks = 0u) {
    if (stagger_ticks) { const unsigned long long t0_ = __builtin_amdgcn_s_memrealtime(); while (__builtin_amdgcn_s_memrealtime() - t0_ < stagger_ticks) __builtin_amdgcn_s_sleep(8); }
    const int tid = threadIdx.x, wid = __builtin_amdgcn_readfirstlane(tid >> 6), lane = tid & 63, wr = wid >> 2, wc = wid & 3, fr = lane & 15, fq = lane >> 4;
    const int nt = K / BK;
    unsigned voffB[2], vA0[2], vA1[2];
#pragma unroll
    for (int i = 0; i < 2; ++i) { int R, C; stage_rc(tid * 16 + i * 8192, R, C); const int Rb = Epi::PERM ? ((R & ~31) + perm32(R & 31)) : R;
        vA0[i] = (unsigned)(R * K + C) * 2u; vA1[i] = vA0[i]; voffB[i] = (unsigned)(Rb * K + C) * 2u; }
#define PG8_FILL(u) do { if constexpr (Sched::GATHER) { int tv_ = tid; asm volatile("" : "+v"(tv_)); _Pragma("unroll") for (int i = 0; i < 2; ++i) { int R, C; stage_rc(tv_ * 16 + i * 8192, R, C); \
        vA0[i] = S.aoff(u, R) + (unsigned)C * 2u; vA1[i] = S.aoff(u, HALF + R) + (unsigned)C * 2u; } } } while (0)
    const size_t kstep = (size_t)(BK * 2);
    const size_t hstep = (size_t)HALF * K * 2;
    const unsigned ldsw = (unsigned)wid * 1024u;
    const int aoff = lds_byte(wr * 64 + fr, fq * 8), boff = lds_byte(wc * 32 + fr, fq * 8);
#define PG8_SA(b, h) (((b) * 2 + (h)) * HTB)
#define PG8_SB(b, h) ((4 + (b) * 2 + (h)) * HTB)
#define PG8_STAGE(bufoff, gbase, voff) do { _Pragma("unroll") for (int _i = 0; _i < 2; ++_i) \
        __builtin_amdgcn_global_load_lds((const unsigned*)((const char*)(gbase) + (voff)[_i]), (LAS unsigned*)(lds + (bufoff) + ldsw + _i * 8192), 16, 0, 0); } while (0)
#define PG8_LDA(dst, b, h) do { _Pragma("unroll") for (int m = 0; m < 4; ++m) _Pragma("unroll") for (int k = 0; k < 2; ++k) dst[m][k] = *(const LAS bf16x8*)(lds + PG8_SA(b, h) + aoff + m * 2048 + k * 1024); } while (0)
#define PG8_LDB(dst, b, h) do { _Pragma("unroll") for (int n = 0; n < 2; ++n) _Pragma("unroll") for (int k = 0; k < 2; ++k) dst[n][k] = *(const LAS bf16x8*)(lds + PG8_SB(b, h) + boff + n * 2048 + k * 1024); } while (0)
#define PG8_MMA(ai, bj, At, Bt_) do { __builtin_amdgcn_s_setprio(1); _Pragma("unroll") for (int m = 0; m < 4; ++m) _Pragma("unroll") for (int n = 0; n < 2; ++n) _Pragma("unroll") for (int k = 0; k < 2; ++k) \
        acc[ai][bj][m][n] = __builtin_amdgcn_mfma_f32_16x16x32_bf16(Bt_[n][k], At[m][k], acc[ai][bj][m][n], 0, 0, 0); __builtin_amdgcn_s_setprio(0); } while (0)
#define PG8_WAIT_V(n) asm volatile("s_waitcnt vmcnt(" #n ")" ::: "memory")
#define PG8_WAIT_L(n) asm volatile("s_waitcnt lgkmcnt(" #n ")" ::: "memory")
#define PG8_BAR __builtin_amdgcn_s_barrier()
#define PG8_SCHED __builtin_amdgcn_sched_barrier(0)
    Unit cur, nxt; int ui = 0;
    if (!S.next(0, cur)) return;
    f32x4 acc[2][2][4][2];
#pragma unroll
    for (int a = 0; a < 2; ++a)
#pragma unroll
        for (int b = 0; b < 2; ++b)
#pragma unroll
            for (int m = 0; m < 4; ++m)
#pragma unroll
                for (int n = 0; n < 2; ++n) acc[a][b][m][n] = (f32x4){0.f, 0.f, 0.f, 0.f};
    bf16x8 At[4][2], B0[2][2], B1[2][2];
    PG8_FILL(cur);
    const char* cA0 = (const char*)A + S.abase(cur); const char* cA1 = cA0 + (Sched::GATHER ? (size_t)0 : hstep); const char* cB = (const char*)Bt + cur.boff;
    PG8_STAGE(PG8_SB(0, 0), cB, voffB); PG8_STAGE(PG8_SB(0, 1), cB + hstep, voffB); PG8_STAGE(PG8_SA(0, 0), cA0, vA0); PG8_STAGE(PG8_SA(0, 1), cA1, vA1);
    if (wr == 1) PG8_BAR;
    PG8_WAIT_V(2); PG8_BAR;
    PG8_STAGE(PG8_SB(1, 0), cB + kstep, voffB); PG8_STAGE(PG8_SA(1, 0), cA0 + kstep, vA0); PG8_STAGE(PG8_SB(1, 1), cB + hstep + kstep, voffB);
    PG8_WAIT_V(6); PG8_BAR;
    for (;;) {
        const bool has_next = S.next(ui + 1, nxt);
        const char* nB = has_next ? (const char*)Bt + nxt.boff : cB;
        const char* nA0 = has_next ? (const char*)A + S.abase(nxt) : cA0; const char* nA1 = nA0 + (Sched::GATHER ? (size_t)0 : hstep);
        for (int t = 0; t < nt; t += 2) {
            const bool last = (t == nt - 2);
            const char* a1 = cA1 + (size_t)(t + 1) * kstep;
            const char* a2 = last ? nA0 : cA0 + (size_t)(t + 2) * kstep; const char* a2h = last ? nA1 : cA1 + (size_t)(t + 2) * kstep; const char* b2 = last ? nB : cB + (size_t)(t + 2) * kstep;
            const char* a3 = a2 + kstep; const char* b3 = b2 + kstep;
            PG8_LDB(B0, 0, 0); PG8_LDB(B1, 0, 1); PG8_SCHED; PG8_LDA(At, 0, 0); PG8_STAGE(PG8_SA(1, 1), a1, vA1);
            if (last && has_next) PG8_FILL(nxt);
            PG8_WAIT_V(8); PG8_WAIT_L(0); PG8_BAR; PG8_MMA(0, 0, At, B0); PG8_MMA(0, 1, At, B1); PG8_BAR; PG8_SCHED;
            PG8_LDA(At, 0, 1); PG8_STAGE(PG8_SB(0, 0), b2, voffB); PG8_STAGE(PG8_SB(0, 1), b2 + hstep, voffB); PG8_STAGE(PG8_SA(0, 0), a2, vA0);
            PG8_WAIT_V(8); PG8_WAIT_L(0); PG8_BAR; PG8_MMA(1, 0, At, B0); PG8_MMA(1, 1, At, B1); PG8_BAR; PG8_SCHED;
            PG8_LDB(B0, 1, 0); PG8_LDB(B1, 1, 1); PG8_SCHED; PG8_LDA(At, 1, 0); PG8_STAGE(PG8_SA(0, 1), a2h, vA1);
            PG8_WAIT_V(8); PG8_WAIT_L(0); PG8_BAR; PG8_MMA(0, 0, At, B0); PG8_MMA(0, 1, At, B1); PG8_BAR; PG8_SCHED;
            PG8_LDA(At, 1, 1); PG8_STAGE(PG8_SB(1, 0), b3, voffB); PG8_STAGE(PG8_SB(1, 1), b3 + hstep, voffB); PG8_STAGE(PG8_SA(1, 0), a3, vA0);
            PG8_WAIT_V(8); PG8_WAIT_L(0); PG8_BAR; PG8_MMA(1, 0, At, B0); PG8_MMA(1, 1, At, B1); PG8_BAR; PG8_SCHED;
        }
        if constexpr (ALIGN_EPI) { if (wr == 0) PG8_BAR; }
        E(acc, cur, wr, wc, fr, fq);
        if (!has_next) break;
#pragma unroll
        for (int a = 0; a < 2; ++a)
#pragma unroll
            for (int b = 0; b < 2; ++b)
#pragma unroll
                for (int m = 0; m < 4; ++m)
#pragma unroll
                    for (int n = 0; n < 2; ++n) acc[a][b][m][n] = (f32x4){0.f, 0.f, 0.f, 0.f};
        cur = nxt; cB = nB; cA0 = nA0; cA1 = nA1; ++ui;
        if constexpr (ALIGN_EPI) { if (wr == 1) PG8_BAR; }
    }
    PG8_WAIT_V(0);
    if constexpr (!ALIGN_EPI) { if (wr == 0) PG8_BAR; }
    PG8_BAR;
#undef PG8_FILL
#undef PG8_SA
#undef PG8_SB
#undef PG8_STAGE
#undef PG8_LDA
#undef PG8_LDB
#undef PG8_MMA
#undef PG8_WAIT_V
#undef PG8_WAIT_L
#undef PG8_BAR
#undef PG8_SCHED
}
}


#define XB_TMO      128
#define XB_XCNT(j)  (256  + 64 * (j))
#define XB_XSUB(j)  (1280 + 64 * (j))
#define XB_XGEN(j)  (2304 + 64 * (j))
#define XB_TOP      3328
#define XB_TOPGEN   3392
#define XB_SPIN_CAP (1u << 18)
__device__ __forceinline__ unsigned xb_ld(unsigned* p)              { return __hip_atomic_load(p, __ATOMIC_RELAXED, __HIP_MEMORY_SCOPE_AGENT); }
__device__ __forceinline__ unsigned xb_add(unsigned* p, unsigned v) { return __hip_atomic_fetch_add(p, v, __ATOMIC_RELAXED, __HIP_MEMORY_SCOPE_AGENT); }
__device__ __forceinline__ unsigned xb_xcc_id() { return (unsigned)__builtin_amdgcn_s_getreg((3 << 11) | 20) & 0xFu; }
#define XB_SPIN(cond, bar) do { unsigned _sp = 0; while (cond) { __builtin_amdgcn_s_sleep(1); \
    if ((++_sp & 255u) == 0u) { if (xb_ld(&(bar)[XB_TMO])) break; if (_sp > XB_SPIN_CAP) { atomicAdd(&(bar)[XB_TMO], 1u); break; } } } } while (0)
struct XcdBarrier { unsigned* bar; unsigned x; volatile LAS unsigned* st; };
__device__ __forceinline__ XcdBarrier xcd_barrier_post(unsigned* bar, volatile LAS unsigned* st) {
    XcdBarrier b; b.bar = bar; b.x = xb_xcc_id(); b.st = st;
    if (threadIdx.x == 0) (void)xb_add(&bar[XB_XCNT(b.x)], 1u);
    return b;
}
__device__ __forceinline__ void xcd_barrier_complete(unsigned* bar, unsigned x, unsigned& nloc, unsigned& nx) {
    const unsigned G = gridDim.x * gridDim.y * gridDim.z;
    unsigned sum, cnt, mine, sp = 0u;
    for (;;) {
        sum = 0u; cnt = 0u; mine = 0u;
#pragma unroll
        for (unsigned j = 0; j < 16; ++j) { const unsigned c = xb_ld(&bar[XB_XCNT(j)]); sum += c; cnt += (c > 0u) ? 1u : 0u; mine = (j == x) ? c : mine; }
        if (sum == G) break;
        __builtin_amdgcn_s_sleep(1);
        if ((++sp & 255u) == 0u) { if (xb_ld(&bar[XB_TMO])) break; if (sp > XB_SPIN_CAP) { atomicAdd(&bar[XB_TMO], 1u); break; } }
    }
    nloc = mine > 0u ? mine : 1u; nx = cnt > 0u ? cnt : 1u;
}
__device__ __forceinline__ void xcd_barrier(const XcdBarrier& b) {
    asm volatile("s_waitcnt vmcnt(0)" ::: "memory");
    __syncthreads();
    if (threadIdx.x == 0) {
        unsigned* bar = b.bar;
        __builtin_amdgcn_s_waitcnt(0);
        unsigned nloc = b.st[0], nx = b.st[1];
        if (nloc == 0u) { xcd_barrier_complete(bar, b.x, nloc, nx); b.st[0] = nloc; b.st[1] = nx; }
        const unsigned old = xb_add(&bar[XB_XSUB(b.x)], 1u);
        const unsigned gen = old / nloc;
        if (old + 1u == (gen + 1u) * nloc) {
            __builtin_amdgcn_fence(__ATOMIC_RELEASE, "agent");
            asm volatile("s_waitcnt vmcnt(0)" ::: "memory");
            const unsigned og = xb_add(&bar[XB_TOP], 1u);
            const unsigned tg = og / nx;
            if (og + 1u == (tg + 1u) * nx) xb_add(&bar[XB_TOPGEN], 1u);
            else XB_SPIN(xb_ld(&bar[XB_TOPGEN]) == tg, bar);
            __builtin_amdgcn_fence(__ATOMIC_ACQUIRE, "agent");
            xb_add(&bar[XB_XGEN(b.x)], 1u);
            asm volatile("s_waitcnt vmcnt(0)" ::: "memory");
        } else {
            XB_SPIN(xb_ld(&bar[XB_XGEN(b.x)]) == gen, bar);
            __builtin_amdgcn_fence(__ATOMIC_ACQUIRE, "agent");
            asm volatile("s_waitcnt vmcnt(0)" ::: "memory");
        }
    }
    __syncthreads();
}

struct Args { const float* in[23]; float* out; unsigned char* ws; int ph_lo, ph_hi; };
enum { PH_PRO = 0, PH_IN0, PH_MIX0, PH_OUT0, PH_R1, PH_GU0, PH_DN0, PH_R2, PH_IN1, PH_MIX1, PH_OUT1, PH_R3, PH_GU1, PH_DN1, PH_R4, NPH };

struct Frame {
    LAS unsigned char* lds; int tid, lane, wave, vcu, G;
    const float* const* in; float* out; unsigned char* ws;
};

__device__ __forceinline__ void transpose_item(const float* W, int K, int N, const float* kscale, bf16_t* WT, int dest_row0, LAS float* scr, int kb, int nb, int lane) {
    const int k0 = 64 * kb, n0 = 32 * nb;
    float tv[32];
#pragma unroll
    for (int i = 0; i < 32; ++i) tv[i] = W[(size_t)(k0 + 2 * i + (lane >> 5)) * N + n0 + (lane & 31)];
    if (kscale) {
#pragma unroll
        for (int i = 0; i < 32; ++i) tv[i] *= kscale[k0 + 2 * i + (lane >> 5)]; }
#pragma unroll
    for (int i = 0; i < 32; ++i) scr[(2 * i + (lane >> 5)) * 33 + (lane & 31)] = tv[i];
    LDS_WAIT(); asm volatile("" ::: "memory");
    const int c = lane & 7;
#pragma unroll
    for (int j = 0; j < 4; ++j) { const int n = (lane >> 3) + 8 * j; const LAS float* s = scr + (8 * c) * 33 + n;
        u32x4 o; o.x = pk2(s[0 * 33], s[1 * 33]); o.y = pk2(s[2 * 33], s[3 * 33]); o.z = pk2(s[4 * 33], s[5 * 33]); o.w = pk2(s[6 * 33], s[7 * 33]);
        *(u32x4*)(WT + (size_t)(dest_row0 + n) * K + k0 + 8 * c) = o; }
    LDS_WAIT(); asm volatile("" ::: "memory");
}
__device__ __forceinline__ void moe_convert(Frame& F, int layer, int wg, int nwg) {
    LAS float* scr = (LAS float*)(F.lds + F.wave * 16384);
    const int gw = wg * 8 + F.wave, NGW = nwg * 8;
    const float* gffn = F.in[2] + layer * D;
    const float* Wg = F.in[20] + (size_t)layer * NEXP * D * DEXP; const float* Wu = F.in[21] + (size_t)layer * NEXP * D * DEXP; const float* Wd = F.in[22] + (size_t)layer * NEXP * DEXP * D;
    bf16_t* WGU = (bf16_t*)(F.ws + WS_WGU); bf16_t* WDN = (bf16_t*)(F.ws + WS_WDN);
    for (int it = gw; it < 3 * 8192; it += NGW) {
        const int which = it >> 13, r = it & 8191, e = r >> 8, q = r & 255;
        if (which < 2) { const int kb = q >> 4, nb = q & 15, n0 = nb * 32;
            const int dest = e * 1024 + (n0 >> 7) * 256 + (which ? 128 : 0) + (n0 & 127);
            transpose_item((which ? Wu : Wg) + (size_t)e * D * DEXP, D, DEXP, gffn, WGU, dest, scr, kb, nb, F.lane);
        } else { const int kb = q >> 5, nb = q & 31;
            transpose_item(Wd + (size_t)e * DEXP * D, DEXP, D, nullptr, WDN, e * 1024 + nb * 32, scr, kb, nb, F.lane); }
    }
}
__device__ __forceinline__ void p_prologue(Frame& F) {
    LAS float* scr = (LAS float*)(F.lds + F.wave * 16384);
    const int gw = F.vcu * 8 + F.wave, NGW = F.G * 8;
    constexpr int I0 = 16 * 80, I1 = 16 * 32, I2 = 16 * 128, I3 = 16 * 32;
    for (int it = gw; it < I0 + I1 + I2 + I3; it += NGW) {
        int r = it;
        if (r < I0) { transpose_item(F.in[4], D, AB_IN, F.in[1], (bf16_t*)(F.ws + WS_WIN0), (r % 80) * 32, scr, r / 80, r % 80, F.lane); continue; } r -= I0;
        if (r < I1) { transpose_item(F.in[13], D, D, nullptr, (bf16_t*)(F.ws + WS_WOUT0), (r % 32) * 32, scr, r / 32, r % 32, F.lane); continue; } r -= I1;
        if (r < I2) { const int nb = r % 128, n0 = nb * 32;
            const int dest = n0 < 1024 ? (n0 >> 7) * 256 + (n0 & 127) : (n0 < 2048 ? ((n0 - 1024) >> 7) * 256 + 128 + (n0 & 127) : n0);
            transpose_item(F.in[14], D, C_IN, F.in[1] + D, (bf16_t*)(F.ws + WS_WIN1), dest, scr, r / 128, nb, F.lane); continue; } r -= I2;
        transpose_item(F.in[17], D, D, nullptr, (bf16_t*)(F.ws + WS_WOUT1), (r % 32) * 32, scr, r / 32, r % 32, F.lane);
    }
    moe_convert(F, 0, F.vcu, F.G);
    { const float* x = F.in[0]; bf16_t* XB = (bf16_t*)(F.ws + WS_XB); float* rstd = (float*)(F.ws + WS_RSTD);
      for (int m = gw; m < T; m += NGW) { const f32x4* xr = (const f32x4*)(x + (size_t)m * D) + F.lane; f32x4 v[4]; float s = 0.f;
#pragma unroll
          for (int j = 0; j < 4; ++j) { v[j] = xr[64 * j]; s += (v[j].x * v[j].x + v[j].y * v[j].y) + (v[j].z * v[j].z + v[j].w * v[j].w); }
          s = wave_sum(s); if (F.lane == 0) rstd[m] = rsqrtf(s * (1.f / D) + EPS);
          u32x2* o8 = (u32x2*)(XB + (size_t)m * D) + F.lane;
#pragma unroll
          for (int j = 0; j < 4; ++j) o8[64 * j] = (u32x2){pk2(v[j].x, v[j].y), pk2(v[j].z, v[j].w)}; } }
    const int gt = F.vcu * 512 + F.tid, NGT = F.G * 512;
    { float* lb = (float*)(F.ws + WS_LB); const float* l = F.in[15];
      for (int c = gt; c < 1024; c += NGT) { const float a = l[c], b = l[1024 + c], mx = fmaxf(a, b), ea = __expf(a - mx), eb = __expf(b - mx); lb[c] = ea / (ea + eb); } }
    { bf16_t* RWH = (bf16_t*)(F.ws + WS_RWH); bf16_t* RWL = (bf16_t*)(F.ws + WS_RWL);
      for (int i = gt; i < 2 * 36 * 1024; i += NGT) { const int l = i / (36 * 1024), r = i % (36 * 1024), j = r >> 10, c = r & 1023; const float g = F.in[2][l * D + c];
          const float wv = j < 4 ? g * F.in[18][((size_t)l * D + c) * 4 + j] : g * F.in[19][((size_t)l * D + c) * 32 + (j - 4)];
          const unsigned hi = f2bf(wv); RWH[i] = (bf16_t)hi; RWL[i] = (bf16_t)f2bf(wv - bf2f(hi)); } }
}

__device__ __forceinline__ void moe_tables(Frame& F, int layer) {
    LAS int* ts = (LAS int*)(F.lds + TS_OFF); LAS int* cn = ts + 40;
    const unsigned* cnt = (const unsigned*)(F.ws + WS_CTL) + CW_CNT + layer * 32 * 64;
    __syncthreads();
    if (F.tid < 32) cn[F.tid] = (int)__hip_atomic_load(cnt + F.tid * 64, __ATOMIC_RELAXED, __HIP_MEMORY_SCOPE_AGENT);
    __syncthreads();
    if (F.tid == 0) { int s = 0; for (int e = 0; e < 32; ++e) { ts[e] = s; s += (cn[e] + 255) >> 8; } ts[32] = s; }
    __syncthreads();
}

__device__ __forceinline__ void p_router(Frame& F, int layer, int dummy = 0) {
    const bf16_t* XBp = (const bf16_t*)(F.ws + WS_XB);
    unsigned* cnt = (unsigned*)(F.ws + WS_CTL) + CW_CNT + (dummy ? 2 : layer) * 32 * 64;
    const size_t doff = dummy ? (WS_END - WS_TOKINFO) : 0;
    int* ltok = (int*)(F.ws + WS_LTOK + doff); float* lrstd = (float*)(F.ws + WS_LRSTD + doff); float* lw = (float*)(F.ws + WS_LW + doff); int* tokinfo = (int*)(F.ws + WS_TOKINFO + doff);
    LAS unsigned char* L = F.lds;
    const int tid = F.tid, l = F.lane, w = F.wave, i16 = l & 15, q4 = l >> 4;
    for (int tile = F.vcu; tile < T / 128; tile += F.G) {
        __syncthreads();
        { const u32x4* gh = (const u32x4*)(F.ws + WS_RWH + (size_t)layer * 36 * 2048); const u32x4* gl = (const u32x4*)(F.ws + WS_RWL + (size_t)layer * 36 * 2048);
          for (int i = tid; i < 36 * 128; i += 512) { const int n = i >> 7, c = i & 127, pc = c ^ (n & 15);
              *(LAS u32x4*)(L + n * 2048 + pc * 16) = gh[i]; *(LAS u32x4*)(L + 73728 + n * 2048 + pc * 16) = gl[i]; } }
        __syncthreads();
        const int row = tile * 128 + w * 16 + i16;
        const u32x4* hp = (const u32x4*)(XBp + (size_t)row * D + 8 * q4);
        f32x4 acc[3]; acc[0] = (f32x4){0.f, 0.f, 0.f, 0.f}; acc[1] = acc[0]; acc[2] = acc[0];
        int nrow[3];
#pragma unroll
        for (int nb = 0; nb < 3; ++nb) { const int n = 16 * nb + i16; nrow[nb] = n > 35 ? 35 : n; }
        float ss = 0.f;
#pragma unroll 8
        for (int ks = 0; ks < 32; ++ks) {
            const u32x4 xw = hp[4 * ks]; const unsigned xa[4] = {xw.x, xw.y, xw.z, xw.w};
#pragma unroll
            for (int p = 0; p < 4; ++p) { const float a = bf2f(xa[p] & 0xffffu), b = __uint_as_float(xa[p] & 0xffff0000u); ss += a * a + b * b; }
            const bf16x8 ah = __builtin_bit_cast(bf16x8, xw);
#pragma unroll
            for (int nb = 0; nb < 3; ++nb) { const int n = nrow[nb], pc = (4 * ks + q4) ^ (n & 15);
                const bf16x8 bh = *(const LAS bf16x8*)(L + n * 2048 + pc * 16), bl = *(const LAS bf16x8*)(L + 73728 + n * 2048 + pc * 16);
                acc[nb] = MFMA16(ah, bh, acc[nb]); acc[nb] = MFMA16(ah, bl, acc[nb]); }
        }
        ss += __shfl_xor(ss, 16); ss += __shfl_xor(ss, 32);
        __syncthreads();
        LAS float* sc = (LAS float*)(L + w * 4096);
#pragma unroll
        for (int nb = 0; nb < 3; ++nb)
#pragma unroll
            for (int rg = 0; rg < 4; ++rg) sc[(4 * q4 + rg) * 49 + 16 * nb + i16] = acc[nb][rg];
        const float rstd = rsqrtf(ss * (1.f / D) + EPS);
        LAS unsigned* lc = (LAS unsigned*)(L + 32768);
        if (tid < 32) lc[tid] = 0u;
        int e0 = 0, e1 = 0; float w0 = 0.f, w1 = 0.f;
        if (l < 16) {
            const LAS float* lr = sc + l * 49;
            float lg[4];
#pragma unroll
            for (int gi = 0; gi < 4; ++gi) lg[gi] = lr[gi] * rstd;
            int gidx = 0; float gmax = lg[0];
#pragma unroll
            for (int gi = 1; gi < 4; ++gi) if (lg[gi] > gmax) { gmax = lg[gi]; gidx = gi; }
            float gs = 0.f;
#pragma unroll
            for (int gi = 0; gi < 4; ++gi) gs += __expf(lg[gi] - gmax);
            const float ggate = 1.f / gs;
            float le[8];
#pragma unroll
            for (int e = 0; e < 8; ++e) le[e] = lr[4 + gidx * 8 + e] * rstd;
            int i0 = 0; float v0 = le[0];
#pragma unroll
            for (int e = 1; e < 8; ++e) if (le[e] > v0) { v0 = le[e]; i0 = e; }
            int i1 = -1; float v1 = -3.0e38f;
#pragma unroll
            for (int e = 0; e < 8; ++e) if (e != i0 && le[e] > v1) { v1 = le[e]; i1 = e; }
            const float ex = __expf(v1 - v0); w0 = ggate / (1.f + ex); w1 = ggate * ex / (1.f + ex);
            e0 = gidx * 8 + i0; e1 = gidx * 8 + i1;
        }
        __syncthreads();
        unsigned r0 = 0u, r1 = 0u;
        if (l < 16) { r0 = __hip_atomic_fetch_add((unsigned*)(lc + e0), 1u, __ATOMIC_RELAXED, __HIP_MEMORY_SCOPE_WORKGROUP); r1 = __hip_atomic_fetch_add((unsigned*)(lc + e1), 1u, __ATOMIC_RELAXED, __HIP_MEMORY_SCOPE_WORKGROUP); }
        __syncthreads();
        if (tid < 32) { const unsigned c = lc[tid]; lc[32 + tid] = c ? atomicAdd(cnt + tid * 64, c) : 0u; }
        __syncthreads();
        if (l < 16) {
            const int m = row; const unsigned p0 = lc[32 + e0] + r0, p1 = lc[32 + e1] + r1;
            if (!dummy) ((float*)(F.ws + WS_RSTD))[m] = rstd;
            ltok[(size_t)e0 * CAP + p0] = m; lrstd[(size_t)e0 * CAP + p0] = rstd; lw[(size_t)e0 * CAP + p0] = w0;
            ltok[(size_t)e1 * CAP + p1] = m; lrstd[(size_t)e1 * CAP + p1] = rstd; lw[(size_t)e1 * CAP + p1] = w1;
            tokinfo[2 * m] = e0 * CAP + (int)p0; tokinfo[2 * m + 1] = e1 * CAP + (int)p1;
        }
    }
    __syncthreads();
}
__device__ __forceinline__ void p_combine(Frame& F, int layer, int mode, int dry = 0) {
    moe_tables(F, layer);
    const LAS int* ts = (const LAS int*)(F.lds + TS_OFF);
    const int gw = F.vcu * 8 + F.wave, NGW = F.G * 8;
    float* OUT = F.out; const bf16_t* Y = (const bf16_t*)(F.ws + WS_Y); const int* tokinfo = (const int*)(F.ws + WS_TOKINFO);
    bf16_t* XB = (bf16_t*)(F.ws + WS_XB); float* rstd = (float*)(F.ws + WS_RSTD); const float* gfin = F.in[3];
    for (int m = gw; m < T; m += NGW) {
        const int t0 = tokinfo[2 * m], t1 = tokinfo[2 * m + 1];
        const size_t s0 = (size_t)ts[t0 >> 15] * 256 + (t0 & (CAP - 1)), s1 = (size_t)ts[t1 >> 15] * 256 + (t1 & (CAP - 1));
        u32x4* xr = (u32x4*)(XB + (size_t)m * D) + F.lane; const u32x4* y0 = (const u32x4*)(Y + s0 * D) + F.lane; const u32x4* y1 = (const u32x4*)(Y + s1 * D) + F.lane;
        float v[2][8]; float s = 0.f;
#pragma unroll
        for (int j = 0; j < 2; ++j) { const u32x4 x = xr[64 * j]; u32x4 a = y0[64 * j], b = y1[64 * j]; if (dry) { a = (u32x4){0u, 0u, 0u, 0u}; b = a; }
            const unsigned xa[4] = {x.x, x.y, x.z, x.w}, aa[4] = {a.x, a.y, a.z, a.w}, ba[4] = {b.x, b.y, b.z, b.w};
#pragma unroll
            for (int p = 0; p < 4; ++p) { const float lo = bf2f(xa[p] & 0xffffu) + bf2f(aa[p] & 0xffffu) + bf2f(ba[p] & 0xffffu), hi = bf2f(xa[p] >> 16) + bf2f(aa[p] >> 16) + bf2f(ba[p] >> 16);
                v[j][2 * p] = lo; v[j][2 * p + 1] = hi; s += lo * lo + hi * hi; } }
        const float rs = rsqrtf(wave_sum(s) * (1.f / D) + EPS);
        if (mode == 0) {
            if (F.lane == 0) rstd[m] = rs;
#pragma unroll
            for (int j = 0; j < 2; ++j) xr[64 * j] = (u32x4){cvt_pk_bf16(v[j][0], v[j][1]), cvt_pk_bf16(v[j][2], v[j][3]), cvt_pk_bf16(v[j][4], v[j][5]), cvt_pk_bf16(v[j][6], v[j][7])};
        } else {
#pragma unroll
            for (int j = 0; j < 2; ++j) { const f32x4* g4 = (const f32x4*)(gfin + 512 * j) + 2 * F.lane; f32x4* o4 = (f32x4*)(OUT + (size_t)m * D + 512 * j) + 2 * F.lane; const f32x4 g0 = g4[0], g1 = g4[1];
                if (!dry) { o4[0] = (f32x4){v[j][0] * rs * g0.x, v[j][1] * rs * g0.y, v[j][2] * rs * g0.z, v[j][3] * rs * g0.w}; o4[1] = (f32x4){v[j][4] * rs * g1.x, v[j][5] * rs * g1.y, v[j][6] * rs * g1.z, v[j][7] * rs * g1.w}; } }
        }
    }
}

__device__ __forceinline__ void mix_rglru_item(Frame& F, int b, int nb) {
    LAS float* L = (LAS float*)F.lds;
    LAS float* wa = L; LAS float* wx = L + 4096; LAS float* xat = L + 8192;   LAS float* xc = xat + 67 * 64; LAS float* ga = xc + 4096; LAS float* av = ga + 4096; LAS float* uv = av + 4096; LAS float* prm = uv + 4096;
    const bf16_t* Z = (const bf16_t*)(F.ws + WS_Z); bf16_t* CAT = (bf16_t*)(F.ws + WS_CAT);
    const int tid = F.tid;
    __syncthreads();
    for (int i = tid; i < 4096; i += 512) { wa[i] = F.in[7][nb * 4096 + i]; wx[i] = F.in[9][nb * 4096 + i]; }
    if (tid < 64) { const int c = nb * 64 + tid; prm[tid] = F.in[6][c]; prm[64 + tid] = F.in[5][c]; prm[128 + tid] = F.in[5][512 + c]; prm[192 + tid] = F.in[5][1024 + c]; prm[256 + tid] = F.in[5][1536 + c];
        prm[320 + tid] = F.in[8][c]; prm[384 + tid] = F.in[10][c]; const float lam = F.in[11][c]; prm[448 + tid] = fminf(lam, 0.f) - log1pf(__expf(-fabsf(lam))); }
    float hcar = 0.f;
    for (int t0 = 0; t0 < SEQ; t0 += 64) {
        __syncthreads();
        for (int i = tid; i < 67 * 64; i += 512) { const int r = i >> 6, c = i & 63, tg = t0 - 3 + r; xat[i] = tg >= 0 ? bf2f(Z[((size_t)b * SEQ + tg) * AB_IN + nb * 64 + c]) : 0.f; }
        for (int i = tid; i < 4096; i += 512) { const int r = i >> 6, c = i & 63; ga[i] = bf2f(Z[((size_t)b * SEQ + t0 + r) * AB_IN + 512 + nb * 64 + c]); }
        __syncthreads();
        for (int i = tid; i < 4096; i += 512) { const int r = i >> 6, c = i & 63; xc[i] = prm[c] + prm[64 + c] * xat[r * 64 + c] + prm[128 + c] * xat[(r + 1) * 64 + c] + prm[192 + c] * xat[(r + 2) * 64 + c] + prm[256 + c] * xat[(r + 3) * 64 + c]; }
        __syncthreads();
        { const int tok = tid >> 3, dg = tid & 7; float aa[8], ax[8];
#pragma unroll
          for (int j = 0; j < 8; ++j) { aa[j] = 0.f; ax[j] = 0.f; }
          for (int c = 0; c < 64; ++c) { const float xv = xc[tok * 64 + c]; const LAS f32x4* pa = (const LAS f32x4*)(wa + c * 64 + dg * 8); const LAS f32x4* px = (const LAS f32x4*)(wx + c * 64 + dg * 8);
              const f32x4 a0 = pa[0], a1 = pa[1], x0 = px[0], x1 = px[1];
              aa[0] += xv * a0.x; aa[1] += xv * a0.y; aa[2] += xv * a0.z; aa[3] += xv * a0.w; aa[4] += xv * a1.x; aa[5] += xv * a1.y; aa[6] += xv * a1.z; aa[7] += xv * a1.w;
              ax[0] += xv * x0.x; ax[1] += xv * x0.y; ax[2] += xv * x0.z; ax[3] += xv * x0.w; ax[4] += xv * x1.x; ax[5] += xv * x1.y; ax[6] += xv * x1.z; ax[7] += xv * x1.w; }
#pragma unroll
          for (int j = 0; j < 8; ++j) { const int d = dg * 8 + j; const float r = sigmoidf_(aa[j] + prm[320 + d]), ig = sigmoidf_(ax[j] + prm[384 + d]);
              const float la = 8.0f * r * prm[448 + d]; av[tok * 64 + d] = __expf(la); uv[tok * 64 + d] = sqrtf(fmaxf(-expm1f(2.0f * la), 0.f)) * (ig * xc[tok * 64 + d]); } }
        __syncthreads();
        if (tid < 64) { for (int r = 0; r < 64; ++r) { hcar = av[r * 64 + tid] * hcar + uv[r * 64 + tid]; av[r * 64 + tid] = hcar; } }
        __syncthreads();
        for (int i = tid; i < 4096; i += 512) { const int r = i >> 6, c = i & 63; CAT[((size_t)b * SEQ + t0 + r) * D + nb * 64 + c] = (bf16_t)f2bf(av[i] * gelu_tanh(ga[i])); }
    }
    __syncthreads();
}
__device__ __forceinline__ void mix_attn_item(Frame& F, int b, int c, int h) {
    LAS float* Ks = (LAS float*)F.lds;   LAS float* Vs = Ks + 64 * 68;   LAS float* bs = Vs + 4096;   LAS float* Ss = bs + 520;
    const bf16_t* Z = (const bf16_t*)(F.ws + WS_Z); bf16_t* CAT = (bf16_t*)(F.ws + WS_CAT);
    const int tid = F.tid, t = tid >> 3, sub = tid & 7;
    __syncthreads();
    for (int i = tid; i < 513; i += 512) bs[i] = F.in[12][h * 513 + i];
    unsigned q2[32]; float o[64];
    { const unsigned* qp = (const unsigned*)(Z + ((size_t)b * SEQ + c * 64 + t) * AB_IN + 1024 + h * 64);
#pragma unroll
      for (int d = 0; d < 32; ++d) q2[d] = qp[d];
#pragma unroll
      for (int d = 0; d < 64; ++d) o[d] = 0.f; }
    float mrun = -3.0e38f, lrun = 0.f;
    for (int kc = (c >= 8 ? c - 8 : 0); kc <= c; ++kc) {
        __syncthreads();
        for (int i = tid; i < 4096; i += 512) { const int s = i >> 6, d = i & 63; const size_t base = ((size_t)b * SEQ + kc * 64 + s) * AB_IN + h * 64 + d;
            Ks[s * 68 + d] = bf2f(Z[base + 1536]); Vs[s * 64 + d] = bf2f(Z[base + 2048]); }
        __syncthreads();
        float tmax = -3.0e38f;
#pragma unroll 1
        for (int jj = 0; jj < 8; ++jj) { const int s = sub + 8 * jj; const LAS f32x4* kp = (const LAS f32x4*)(Ks + s * 68); float a = 0.f;
#pragma unroll
            for (int d4 = 0; d4 < 16; ++d4) { const f32x4 kv = kp[d4]; a += bf2f(q2[2 * d4] & 0xffffu) * kv.x + bf2f(q2[2 * d4] >> 16) * kv.y + bf2f(q2[2 * d4 + 1] & 0xffffu) * kv.z + bf2f(q2[2 * d4 + 1] >> 16) * kv.w; }
            a *= 0.125f;
            int rel = t - ((kc - c) * 64 + s); rel = rel < -256 ? -256 : (rel > 256 ? 256 : rel);
            a += bs[rel + 256]; Ss[t * 65 + s] = a; tmax = fmaxf(tmax, a); }
        const float mnew = fmaxf(mrun, tmax), f = __expf(mrun - mnew);
        lrun *= f;
#pragma unroll
        for (int d = 0; d < 64; ++d) o[d] *= f;
#pragma unroll 1
        for (int jj = 0; jj < 8; ++jj) { const int s = sub + 8 * jj; const float p = __expf(Ss[t * 65 + s] - mnew); lrun += p; const LAS f32x4* vp = (const LAS f32x4*)(Vs + s * 64);
#pragma unroll
            for (int d4 = 0; d4 < 16; ++d4) { const f32x4 vv = vp[d4]; o[4 * d4] += p * vv.x; o[4 * d4 + 1] += p * vv.y; o[4 * d4 + 2] += p * vv.z; o[4 * d4 + 3] += p * vv.w; } }
        mrun = mnew;
    }
    float mall = mrun;
    mall = fmaxf(mall, __shfl_xor(mall, 1)); mall = fmaxf(mall, __shfl_xor(mall, 2)); mall = fmaxf(mall, __shfl_xor(mall, 4));
    const float f = __expf(mrun - mall); lrun *= f;
    lrun += __shfl_xor(lrun, 1); lrun += __shfl_xor(lrun, 2); lrun += __shfl_xor(lrun, 4);
    const float inv = 1.0f / lrun;
    bf16_t* op = CAT + ((size_t)b * SEQ + c * 64 + t) * D + 512 + h * 64;
#pragma unroll
    for (int d = 0; d < 64; ++d) { float v = o[d] * f; v += __shfl_xor(v, 1); v += __shfl_xor(v, 2); v += __shfl_xor(v, 4); if ((d >> 3) == sub) op[d] = (bf16_t)f2bf(v * inv); }
}

typedef float f32x16 __attribute__((ext_vector_type(16)));
typedef short s16x4 __attribute__((ext_vector_type(4)));
__device__ __forceinline__ s16x4 ds_tr16(const LAS unsigned char* p) { return __builtin_bit_cast(s16x4, __builtin_amdgcn_ds_read_tr16_b64_v4i16((LAS s16x4*)p)); }
constexpr int ATT_BT_BYTES = 8 * 520 * 4;
__device__ __forceinline__ void attn_load_bias(Frame& F) {
    LAS float* bt = (LAS float*)F.lds;
    __syncthreads();
    for (int i = F.tid; i < 8 * 513; i += 512) { const int h = i / 513, j = i % 513; bt[h * 520 + j] = F.in[12][i] * 1.4426950408889634f; }
    __syncthreads();
}
__device__ __forceinline__ void attn_wave_mfma(Frame& F, int b, int c, int h) {
    const bf16_t* Z = (const bf16_t*)(F.ws + WS_Z); bf16_t* CAT = (bf16_t*)(F.ws + WS_CAT);
    const int l = F.lane, r = l & 31, hh = l >> 5;
    const LAS float* btab = (const LAS float*)F.lds + h * 520;
    LAS unsigned char* Vw = F.lds + ATT_BT_BYTES + F.wave * 8192;
    const float SC = 0.125f * 1.4426950408889634f;
    bf16x8 qf[2][4];
    { const bf16_t* Qb = Z + ((size_t)b * SEQ + c * 64) * AB_IN + 1024 + h * 64;
#pragma unroll
      for (int qb = 0; qb < 2; ++qb)
#pragma unroll
          for (int ks = 0; ks < 4; ++ks) qf[qb][ks] = *(const bf16x8*)(Qb + (size_t)(qb * 32 + r) * AB_IN + ks * 16 + hh * 8); }
    f32x16 o[2][2];
#pragma unroll
    for (int a = 0; a < 2; ++a)
#pragma unroll
        for (int d = 0; d < 2; ++d)
#pragma unroll
            for (int i = 0; i < 16; ++i) o[a][d][i] = 0.f;
    float mrun[2] = {-1.0e30f, -1.0e30f}, lsum[2] = {0.f, 0.f};
    const int q4 = (l & 15) >> 2, p4 = l & 3, cb = (l >> 4) & 1, xs = (q4 >> 1) & 1;
    const LAS unsigned char* vbase = Vw + (4 * hh + q4) * 128 + p4 * 8 + cb * 32;
    const LAS unsigned char* vb[2] = {vbase + xs * 64, vbase + (1 - xs) * 64};
    for (int kc = (c >= 8 ? c - 8 : 0); kc <= c; ++kc) {
        const bf16_t* Kb = Z + ((size_t)b * SEQ + kc * 64) * AB_IN + 1536 + h * 64; const bf16_t* Vb = Kb + 512;
#pragma unroll
        for (int hf = 0; hf < 2; ++hf) { u32x4 vr[4];
#pragma unroll
          for (int i = 0; i < 4; ++i) vr[i] = *(const u32x4*)(Vb + (size_t)((hf * 4 + i) * 8 + (l >> 3)) * AB_IN + (l & 7) * 8);
#pragma unroll
          for (int i = 0; i < 4; ++i) { const int s = (hf * 4 + i) * 8 + (l >> 3), ci = l & 7, pb = (ci >> 1) ^ (((s >> 1) & 1) << 1); *(LAS u32x4*)(Vw + s * 128 + pb * 32 + (ci & 1) * 16) = vr[i]; }
          asm volatile("" ::: "memory"); }
        asm volatile("" ::: "memory");
        bf16x8 kf[2][4];
#pragma unroll
        for (int sb = 0; sb < 2; ++sb)
#pragma unroll
            for (int ks = 0; ks < 4; ++ks) kf[sb][ks] = *(const bf16x8*)(Kb + (size_t)(sb * 32 + r) * AB_IN + ks * 16 + hh * 8);
        const int dt = (c - kc) * 64;
#pragma unroll
        for (int qb = 0; qb < 2; ++qb) {
            f32x16 st[2];
#pragma unroll
            for (int sb = 0; sb < 2; ++sb) {
#pragma unroll
                for (int i = 0; i < 16; ++i) st[sb][i] = 0.f;
#pragma unroll
                for (int ks = 0; ks < 4; ++ks) st[sb] = __builtin_amdgcn_mfma_f32_32x32x16_bf16(kf[sb][ks], qf[qb][ks], st[sb], 0, 0, 0); }
            if (dt >= 320) { const float bc = btab[512];
#pragma unroll
                for (int sb = 0; sb < 2; ++sb)
#pragma unroll
                    for (int i = 0; i < 16; ++i) st[sb][i] = st[sb][i] * SC + bc;
            } else { const int base = dt + qb * 32 + r - 4 * hh + 256;
#pragma unroll
                for (int sb = 0; sb < 2; ++sb)
#pragma unroll
                    for (int i = 0; i < 16; ++i) { int idx = base - sb * 32 - ((i & 3) + 8 * (i >> 2)); idx = idx > 512 ? 512 : idx; st[sb][i] = st[sb][i] * SC + btab[idx]; } }
            float mx = st[0][0];
#pragma unroll
            for (int sb = 0; sb < 2; ++sb)
#pragma unroll
                for (int i = 0; i < 16; ++i) mx = fmaxf(mx, st[sb][i]);
            mx = fmaxf(mx, __shfl_xor(mx, 32));
            const float mn = fmaxf(mrun[qb], mx), alpha = __builtin_amdgcn_exp2f(mrun[qb] - mn); mrun[qb] = mn;
            float rs = 0.f;
#pragma unroll
            for (int sb = 0; sb < 2; ++sb)
#pragma unroll
                for (int i = 0; i < 16; ++i) { const float pv = __builtin_amdgcn_exp2f(st[sb][i] - mn); st[sb][i] = pv; rs += pv; }
            rs += __shfl_xor(rs, 32); lsum[qb] = lsum[qb] * alpha + rs;
#pragma unroll
            for (int d = 0; d < 2; ++d)
#pragma unroll
                for (int i = 0; i < 16; ++i) o[qb][d][i] *= alpha;
            bf16x8 pf[4];
#pragma unroll
            for (int kk = 0; kk < 4; ++kk) { const int sb = kk >> 1, s2 = kk & 1; u32x4 w;
                w.x = cvt_pk_bf16(st[sb][8 * s2 + 0], st[sb][8 * s2 + 1]); w.y = cvt_pk_bf16(st[sb][8 * s2 + 2], st[sb][8 * s2 + 3]);
                w.z = cvt_pk_bf16(st[sb][8 * s2 + 4], st[sb][8 * s2 + 5]); w.w = cvt_pk_bf16(st[sb][8 * s2 + 6], st[sb][8 * s2 + 7]); pf[kk] = __builtin_bit_cast(bf16x8, w); }
#pragma unroll
            for (int d = 0; d < 2; ++d)
#pragma unroll
                for (int kk = 0; kk < 4; ++kk) { const int rowoff = ((kk >> 1) * 32 + 16 * (kk & 1)) * 128;
                    const s16x4 lo = ds_tr16(vb[d] + rowoff), hi = ds_tr16(vb[d] + rowoff + 8 * 128);
                    const bf16x8 vf = (bf16x8){lo[0], lo[1], lo[2], lo[3], hi[0], hi[1], hi[2], hi[3]};
                    o[qb][d] = __builtin_amdgcn_mfma_f32_32x32x16_bf16(vf, pf[kk], o[qb][d], 0, 0, 0); }
        }
    }
#pragma unroll
    for (int qb = 0; qb < 2; ++qb) { const float inv = 1.0f / lsum[qb]; bf16_t* op = CAT + ((size_t)b * SEQ + c * 64 + qb * 32 + r) * D + 512 + h * 64 + 4 * hh;
#pragma unroll
        for (int d = 0; d < 2; ++d)
#pragma unroll
            for (int g = 0; g < 4; ++g) { u32x2 w; w.x = cvt_pk_bf16(o[qb][d][4 * g] * inv, o[qb][d][4 * g + 1] * inv); w.y = cvt_pk_bf16(o[qb][d][4 * g + 2] * inv, o[qb][d][4 * g + 3] * inv);
                *(u32x2*)(op + d * 32 + 8 * g) = w; } }
}

constexpr int RG_XA = 0, RG_GA0 = 8704, RG_GA1 = RG_GA0 + 8192, RG_XCB = RG_GA1 + 8192, RG_WA = RG_XCB + 9216, RG_WX = RG_WA + 9216, RG_AV = RG_WX + 9216, RG_UV = RG_AV + 16384, RG_SA = RG_UV + 16384, RG_SH = RG_SA + 2048, RG_END = RG_SH + 2048;
static_assert(RG_END <= RING_BYTES, "rglru lds");
__device__ __forceinline__ float gelu_fast(float x) { const float u = 1.5957691216057308f * (x + 0.044715f * x * x * x); return x * __builtin_amdgcn_rcpf(1.0f + __expf(-u)); }
__device__ __forceinline__ void rglru_item(Frame& F, int b, int nb) {
    const bf16_t* Z = (const bf16_t*)(F.ws + WS_Z); bf16_t* CAT = (bf16_t*)(F.ws + WS_CAT);
    LAS unsigned char* L = F.lds;
    LAS float* AV = (LAS float*)(L + RG_AV); LAS float* UV = (LAS float*)(L + RG_UV); LAS float* SA = (LAS float*)(L + RG_SA); LAS float* SH = (LAS float*)(L + RG_SH);
    const int tid = F.tid, l = F.lane, w = F.wave, i16 = l & 15, q4 = l >> 4;
    __syncthreads();
    for (int i = tid; i < 4096; i += 512) { const int c = i >> 6, d = i & 63;
        *(LAS bf16_t*)(L + RG_WA + d * 144 + c * 2) = (bf16_t)f2bf(F.in[7][nb * 4096 + i]); *(LAS bf16_t*)(L + RG_WX + d * 144 + c * 2) = (bf16_t)f2bf(F.in[9][nb * 4096 + i]); }
    const int ct = tid >> 3, ch8 = tid & 7;
    float cw[4][8], cbv[8];
#pragma unroll
    for (int j = 0; j < 8; ++j) { const int ch = nb * 64 + 8 * ch8 + j; cbv[j] = F.in[6][ch];
#pragma unroll
        for (int k = 0; k < 4; ++k) cw[k][j] = F.in[5][k * 512 + ch]; }
    const int tb = w >> 1;
    float bav[2], bxv[2], lsv[2];
#pragma unroll
    for (int cc = 0; cc < 2; ++cc) { const int d = nb * 64 + 16 * ((w & 1) * 2 + cc) + i16; bav[cc] = F.in[8][d]; bxv[cc] = F.in[10][d]; const float lam = F.in[11][d]; lsv[cc] = 8.0f * (fminf(lam, 0.f) - log1pf(__expf(-fabsf(lam)))); }
    const int sc = tid & 63, sseg = tid >> 6;
    float carry = 0.f;
    const size_t rowb = (size_t)b * SEQ;
    u32x4 px0, px1, pg;
    const u32x4 zero4 = (u32x4){0u, 0u, 0u, 0u};
#define RG_LOAD(t0_) do { { const int r = tid >> 3, tg = (t0_) - 3 + r; px0 = tg >= 0 ? *(const u32x4*)(Z + (rowb + tg) * AB_IN + nb * 64 + (tid & 7) * 8) : zero4; } \
        if (tid < 24) { const int r = 64 + (tid >> 3), tg = (t0_) - 3 + r; px1 = *(const u32x4*)(Z + (rowb + tg) * AB_IN + nb * 64 + (tid & 7) * 8); } \
        pg = *(const u32x4*)(Z + (rowb + (t0_) + (tid >> 3)) * AB_IN + 512 + nb * 64 + (tid & 7) * 8); } while (0)
    RG_LOAD(0);
#pragma unroll 1
    for (int tile = 0; tile < 32; ++tile) {
        const int t0 = tile * 64; LAS unsigned char* GA = L + ((tile & 1) ? RG_GA1 : RG_GA0);
        *(LAS u32x4*)(L + RG_XA + tid * 16) = px0; if (tid < 24) *(LAS u32x4*)(L + RG_XA + (512 + tid) * 16) = px1;
        *(LAS u32x4*)(GA + tid * 16) = pg;
        __syncthreads();
        if (tile < 31) RG_LOAD(t0 + 64);
        { float xc[8];
#pragma unroll
          for (int j = 0; j < 8; ++j) xc[j] = cbv[j];
#pragma unroll
          for (int k = 0; k < 4; ++k) { const u32x4 xv = *(const LAS u32x4*)(L + RG_XA + (ct + k) * 128 + ch8 * 16); const unsigned xa[4] = {xv.x, xv.y, xv.z, xv.w};
#pragma unroll
              for (int j = 0; j < 8; ++j) xc[j] += cw[k][j] * bf2f((j & 1) ? (xa[j >> 1] >> 16) : (xa[j >> 1] & 0xffffu)); }
          *(LAS u32x4*)(L + RG_XCB + ct * 144 + ch8 * 16) = (u32x4){cvt_pk_bf16(xc[0], xc[1]), cvt_pk_bf16(xc[2], xc[3]), cvt_pk_bf16(xc[4], xc[5]), cvt_pk_bf16(xc[6], xc[7])}; }
        __syncthreads();
#pragma unroll
        for (int cc = 0; cc < 2; ++cc) { const int db = (w & 1) * 2 + cc; f32x4 aA = (f32x4){0.f, 0.f, 0.f, 0.f}, aX = aA;
#pragma unroll
            for (int ks = 0; ks < 2; ++ks) { const bf16x8 a = *(const LAS bf16x8*)(L + RG_XCB + (16 * tb + i16) * 144 + (32 * ks + 8 * q4) * 2);
                const bf16x8 ba = *(const LAS bf16x8*)(L + RG_WA + (16 * db + i16) * 144 + (32 * ks + 8 * q4) * 2), bx = *(const LAS bf16x8*)(L + RG_WX + (16 * db + i16) * 144 + (32 * ks + 8 * q4) * 2);
                aA = MFMA16(a, ba, aA); aX = MFMA16(a, bx, aX); }
#pragma unroll
            for (int rg = 0; rg < 4; ++rg) { const int t = 16 * tb + 4 * q4 + rg, d = 16 * db + i16; const float xcv = bf2f(*(const LAS bf16_t*)(L + RG_XCB + t * 144 + d * 2));
                const float r = sigmoidf_(aA[rg] + bav[cc]), ig = sigmoidf_(aX[rg] + bxv[cc]), la = r * lsv[cc];
                AV[t * 64 + d] = __expf(la); UV[t * 64 + d] = sqrtf(fmaxf(1.0f - __expf(2.0f * la), 0.f)) * (ig * xcv); } }
        __syncthreads();
        float aj[8], uj[8];
        { float A = 1.f, H = 0.f;
#pragma unroll
          for (int j = 0; j < 8; ++j) { aj[j] = AV[(8 * sseg + j) * 64 + sc]; uj[j] = UV[(8 * sseg + j) * 64 + sc]; H = aj[j] * H + uj[j]; A *= aj[j]; }
          SA[sseg * 64 + sc] = A; SH[sseg * 64 + sc] = H; }
        __syncthreads();
        { float run = carry, hin = carry;
#pragma unroll
          for (int sg = 0; sg < 8; ++sg) { if (sg == sseg) hin = run; run = SA[sg * 64 + sc] * run + SH[sg * 64 + sc]; }
          carry = run; float hv = hin;
#pragma unroll
          for (int j = 0; j < 8; ++j) { hv = aj[j] * hv + uj[j]; const int t = 8 * sseg + j; const float g = bf2f(*(const LAS bf16_t*)(GA + t * 128 + sc * 2));
              CAT[(rowb + t0 + t) * D + nb * 64 + sc] = (bf16_t)f2bf(hv * gelu_fast(g)); } }
    }
#undef RG_LOAD
    __syncthreads();
}
__device__ __forceinline__ void p_mix0(Frame& F) {
    unsigned* ctr = (unsigned*)(F.ws + WS_CTL) + CW_Q0;
    volatile LAS int* slot = (volatile LAS int*)(F.lds + TS_OFF);
#define MIX0_PULL() do { __syncthreads(); if (F.tid == 0) *slot = (int)atomicAdd(ctr, 1u); __syncthreads(); it = __builtin_amdgcn_readfirstlane(*slot); } while (0)
    int it; MIX0_PULL();
#pragma unroll 1
    while (it < 128) { rglru_item(F, it >> 3, it & 7); MIX0_PULL(); }
    attn_load_bias(F);
#pragma unroll 1
    while (it < 640) { const int a = it - 128; const int c = a < 384 ? 8 + (a >> 4) : 7 - ((a - 384) >> 4); attn_wave_mfma(F, a & 15, c, F.wave); MIX0_PULL(); }
#undef MIX0_PULL
    __syncthreads();
}
__device__ __forceinline__ void mix_hgrn_item(Frame& F, int b, int h) {
    LAS float* L = (LAS float*)F.lds;
    LAS float* qs = L; LAS float* fs = L + 4096; LAS float* is = L + 8192; LAS float* gs = L + 12288; LAS float* op = L + 16384;
    const bf16_t* Z = (const bf16_t*)(F.ws + WS_Z); bf16_t* CAT = (bf16_t*)(F.ws + WS_CAT); const float* lb = (const float*)(F.ws + WS_LB); const float* ng = F.in[16];
    const int tid = F.tid, v = tid & 127, kq = tid >> 7;
    float S[32];
#pragma unroll
    for (int k = 0; k < 32; ++k) S[k] = 0.f;
    for (int t0 = 0; t0 < SEQ; t0 += 32) {
        __syncthreads();
        for (int i = tid; i < 4096; i += 512) { const int r = i >> 7, c = i & 127; const bf16_t* zr = Z + ((size_t)b * SEQ + t0 + r) * C_IN + h * 128 + c;
            qs[i] = bf2f(zr[0]); const float l = lb[h * 128 + c]; fs[i] = l + (1.f - l) * sigmoidf_(bf2f(zr[1024])); is[i] = bf2f(zr[2048]); gs[i] = bf2f(zr[3072]); }
        __syncthreads();
        for (int r = 0; r < 32; ++r) { const float iv = is[r * 128 + v]; float o = 0.f;
#pragma unroll
            for (int k4 = 0; k4 < 8; ++k4) { const f32x4 f4 = *(const LAS f32x4*)(fs + r * 128 + kq * 32 + 4 * k4), q4 = *(const LAS f32x4*)(qs + r * 128 + kq * 32 + 4 * k4);
                S[4 * k4] = f4.x * S[4 * k4] + (1.f - f4.x) * iv; o += q4.x * S[4 * k4];
                S[4 * k4 + 1] = f4.y * S[4 * k4 + 1] + (1.f - f4.y) * iv; o += q4.y * S[4 * k4 + 1];
                S[4 * k4 + 2] = f4.z * S[4 * k4 + 2] + (1.f - f4.z) * iv; o += q4.z * S[4 * k4 + 2];
                S[4 * k4 + 3] = f4.w * S[4 * k4 + 3] + (1.f - f4.w) * iv; o += q4.w * S[4 * k4 + 3]; }
            op[(r * 4 + kq) * 128 + v] = o; }
        __syncthreads();
#pragma unroll
        for (int rr = 0; rr < 4; ++rr) { const int r = F.wave * 4 + rr; const int l = F.lane;
            const float o1 = op[(r * 4 + 0) * 128 + l] + op[(r * 4 + 1) * 128 + l] + op[(r * 4 + 2) * 128 + l] + op[(r * 4 + 3) * 128 + l];
            const float o2 = op[(r * 4 + 0) * 128 + 64 + l] + op[(r * 4 + 1) * 128 + 64 + l] + op[(r * 4 + 2) * 128 + 64 + l] + op[(r * 4 + 3) * 128 + 64 + l];
            const float rinv = rsqrtf(wave_sum(o1 * o1 + o2 * o2) * (1.f / 128.f) + EPS);
            bf16_t* cp = CAT + ((size_t)b * SEQ + t0 + r) * D + h * 128;
            cp[l] = (bf16_t)f2bf(o1 * rinv * ng[h * 128 + l] * gs[r * 128 + l]); cp[64 + l] = (bf16_t)f2bf(o2 * rinv * ng[h * 128 + 64 + l] * gs[r * 128 + 64 + l]); }
    }
    __syncthreads();
}


constexpr size_t WS_EB = WS_LTOK;
__device__ __forceinline__ void hgrn_prep(Frame& F, int dry = 0) {
    bf16_t* Z = (bf16_t*)(F.ws + WS_Z); const float* lbp = (const float*)(F.ws + WS_LB); float* EBG = (float*)(F.ws + WS_EB);
    const int c2 = F.tid;
    const float lb0 = lbp[2 * c2], lb1 = lbp[2 * c2 + 1];
    for (int blk = F.vcu; blk < T / 32; blk += F.G) {
        unsigned* zq = (unsigned*)(Z + (size_t)blk * 32 * C_IN) + c2; unsigned* zf = zq + 512;
        float P0 = 1.f, P1 = 1.f;
#pragma unroll 8
        for (int t = 0; t < 32; ++t) { const unsigned qv = zq[(size_t)t * (C_IN / 2)], fv = zf[(size_t)t * (C_IN / 2)];
            const float f0 = lb0 + (1.f - lb0) * __builtin_amdgcn_rcpf(1.f + __expf(-bf2f(fv & 0xffffu))), f1 = lb1 + (1.f - lb1) * __builtin_amdgcn_rcpf(1.f + __expf(-bf2f(fv >> 16)));
            P0 *= f0; P1 *= f1;
            const float r0 = fminf(__builtin_amdgcn_rcpf(P0), 1.0e30f), r1 = fminf(__builtin_amdgcn_rcpf(P1), 1.0e30f);
            const unsigned nq = cvt_pk_bf16(bf2f(qv & 0xffffu) * P0, bf2f(qv >> 16) * P1), nf = cvt_pk_bf16((1.f - f0) * r0, (1.f - f1) * r1);
            zq[(size_t)t * (C_IN / 2)] = dry ? qv : nq; zf[(size_t)t * (C_IN / 2)] = dry ? fv : nf; }
        *(f32x2v*)(EBG + (size_t)blk * 1024 + 2 * c2) = (f32x2v){P0, P1};
    }
}
constexpr int HG_STR = 272, HG_TILE = 32 * HG_STR;
constexpr int HG_BUF = 4 * HG_TILE + 512;
constexpr int HG_AT = 2 * HG_BUF, HG_SSQ = HG_AT + 2560, HG_END = HG_SSQ + 1024;
static_assert(HG_END <= RING_BYTES, "hgrn lds");
__device__ __forceinline__ float xor16_add(float v) { const auto r = __builtin_amdgcn_permlane16_swap(__float_as_uint(v), __float_as_uint(v), false, false); return __uint_as_float(r[0]) + __uint_as_float(r[1]); }
__device__ __forceinline__ float xor32_add(float v) { const auto r = __builtin_amdgcn_permlane32_swap(__float_as_uint(v), __float_as_uint(v), false, false); return __uint_as_float(r[0]) + __uint_as_float(r[1]); }
__device__ __forceinline__ void hgrn_item(Frame& F, int b, int h, int nsteps = 64) {
    const bf16_t* Z = (const bf16_t*)(F.ws + WS_Z); bf16_t* CAT = (bf16_t*)(F.ws + WS_CAT); const float* EBG = (const float*)(F.ws + WS_EB); const float* ngp = F.in[16];
    LAS unsigned char* L = F.lds;
    LAS float* SSQ = (LAS float*)(L + HG_SSQ); LAS bf16_t* AT = (LAS bf16_t*)(L + HG_AT);
    const int tid = F.tid, l = F.lane, w = F.wave;
    const int lt = tid >> 4, lkc = tid & 15, i16 = l & 15, q4 = l >> 4, qq = i16 >> 2, pp = i16 & 3;
    float ngv[4];
#pragma unroll
    for (int j = 0; j < 4; ++j) ngv[j] = ngp[h * 128 + 16 * w + 4 * q4 + j];
    f32x4 S[8];
#pragma unroll
    for (int i = 0; i < 8; ++i) S[i] = (f32x4){0.f, 0.f, 0.f, 0.f};
    __syncthreads();
    for (int i = tid; i < 640; i += 512) ((LAS unsigned*)(L + HG_AT))[i] = 0u;
    const bf16_t* zrow0 = Z + ((size_t)b * SEQ + lt) * C_IN + h * 128 + 8 * lkc;
    const float* eb0 = EBG + (size_t)b * (SEQ / 32) * 1024 + h * 128 + 4 * (tid & 31);
    struct TileRegs { u32x4 q, f, v, g; f32x4 e; };
    TileRegs RA;
#define HG_LOAD(R_, st_) do { const bf16_t* zr = zrow0 + (size_t)(st_) * 32 * C_IN; R_.q = *(const u32x4*)(zr); R_.f = *(const u32x4*)(zr + 1024); R_.v = *(const u32x4*)(zr + 2048); R_.g = *(const u32x4*)(zr + 3072); \
        R_.e = *(const f32x4*)(eb0 + (size_t)(st_) * 1024); } while (0)
#define HG_PUT(R_, par_) do { LAS unsigned char* B_ = L + (par_) * HG_BUF + lt * HG_STR + lkc * 16; *(LAS u32x4*)(B_) = R_.q; *(LAS u32x4*)(B_ + HG_TILE) = R_.f; *(LAS u32x4*)(B_ + 2 * HG_TILE) = R_.v; *(LAS u32x4*)(B_ + 3 * HG_TILE) = R_.g; \
        if (tid < 32) *(LAS f32x4*)(L + (par_) * HG_BUF + 4 * HG_TILE + 16 * tid) = R_.e; } while (0)
    HG_LOAD(RA, 0); HG_PUT(RA, 0); HG_LOAD(RA, 1);
#define HG_STEP(stx, R_) do { const int st = (stx); \
        LAS unsigned char* QEb = L + (st & 1) * HG_BUF; LAS unsigned char* KNb = QEb + HG_TILE; LAS unsigned char* Vb = QEb + 2 * HG_TILE; LAS unsigned char* Gb = QEb + 3 * HG_TILE; LAS float* EB = (LAS float*)(QEb + 4 * HG_TILE); \
        __syncthreads(); \
        s16x4 vlo = ds_tr16(Vb + (8 * q4 + qq) * HG_STR + (16 * w + 4 * pp) * 2), vhi = ds_tr16(Vb + (8 * q4 + 4 + qq) * HG_STR + (16 * w + 4 * pp) * 2); \
        u32x2 qf0[4][2], qf1[4][2]; \
        _Pragma("unroll") \
        for (int m = 0; m < 4; ++m) \
        _Pragma("unroll") \
            for (int tb = 0; tb < 2; ++tb) { qf0[m][tb] = *(const LAS u32x2*)(QEb + (16 * tb + i16) * HG_STR + (32 * m + 4 * q4) * 2); qf1[m][tb] = *(const LAS u32x2*)(QEb + (16 * tb + i16) * HG_STR + (32 * m + 16 + 4 * q4) * 2); } \
        if (w < 3) { const int tb = w ? 1 : 0, sb = (w == 2) ? 1 : 0; f32x4 acc = (f32x4){0.f, 0.f, 0.f, 0.f}; \
            bf16x8 qa[4], kb4[4]; \
        _Pragma("unroll") \
            for (int ks = 0; ks < 4; ++ks) { qa[ks] = *(const LAS bf16x8*)(QEb + (16 * tb + i16) * HG_STR + (32 * ks + 8 * q4) * 2); kb4[ks] = *(const LAS bf16x8*)(KNb + (16 * sb + i16) * HG_STR + (32 * ks + 8 * q4) * 2); } \
        _Pragma("unroll") \
            for (int ks = 0; ks < 4; ++ks) acc = MFMA16(qa[ks], kb4[ks], acc); \
        _Pragma("unroll") \
            for (int rg = 0; rg < 4; ++rg) { const int t = 16 * tb + 4 * q4 + rg, sx = 16 * sb + i16; AT[t * 40 + sx] = (bf16_t)f2bf(sx <= t ? acc[rg] : 0.f); } } \
        const bf16x8 vfr = (bf16x8){vlo[0], vlo[1], vlo[2], vlo[3], vhi[0], vhi[1], vhi[2], vhi[3]}; \
        f32x4 O[2]; O[0] = (f32x4){0.f, 0.f, 0.f, 0.f}; O[1] = O[0]; \
        _Pragma("unroll") \
        for (int m = 0; m < 4; ++m) { u32x4 sp; sp.x = cvt_pk_bf16(S[2 * m][0], S[2 * m][1]); sp.y = cvt_pk_bf16(S[2 * m][2], S[2 * m][3]); sp.z = cvt_pk_bf16(S[2 * m + 1][0], S[2 * m + 1][1]); sp.w = cvt_pk_bf16(S[2 * m + 1][2], S[2 * m + 1][3]); \
            const bf16x8 spk = __builtin_bit_cast(bf16x8, sp); \
        _Pragma("unroll") \
            for (int tb = 0; tb < 2; ++tb) { const u32x4 qv = (u32x4){qf0[m][tb].x, qf0[m][tb].y, qf1[m][tb].x, qf1[m][tb].y}; O[tb] = MFMA16(spk, __builtin_bit_cast(bf16x8, qv), O[tb]); } } \
        _Pragma("unroll") \
        for (int kb = 0; kb < 8; ++kb) { const s16x4 klo = ds_tr16(KNb + (8 * q4 + qq) * HG_STR + (16 * kb + 4 * pp) * 2), khi = ds_tr16(KNb + (8 * q4 + 4 + qq) * HG_STR + (16 * kb + 4 * pp) * 2); const bf16x8 kfr = (bf16x8){klo[0], klo[1], klo[2], klo[3], khi[0], khi[1], khi[2], khi[3]}; \
            S[kb] = MFMA16(kfr, vfr, S[kb]) * *(const LAS f32x4*)(EB + 16 * kb + 4 * q4); } \
        __syncthreads(); \
        _Pragma("unroll") \
        for (int tb = 0; tb < 2; ++tb) { const bf16x8 at = *(const LAS bf16x8*)(L + HG_AT + (16 * tb + i16) * 80 + 16 * q4); O[tb] = MFMA16(vfr, at, O[tb]); } \
        _Pragma("unroll") \
        for (int tb = 0; tb < 2; ++tb) { float ss = (O[tb][0] * O[tb][0] + O[tb][1] * O[tb][1]) + (O[tb][2] * O[tb][2] + O[tb][3] * O[tb][3]); ss = xor16_add(ss); ss = xor32_add(ss); \
            if (q4 == 0) SSQ[(16 * tb + i16) * 8 + w] = ss; } \
        __syncthreads(); \
        _Pragma("unroll") \
        for (int tb = 0; tb < 2; ++tb) { const int t = 16 * tb + i16; const f32x4 a = *(const LAS f32x4*)(SSQ + t * 8), c = *(const LAS f32x4*)(SSQ + t * 8 + 4); \
            const float rinv = rsqrtf(((a.x + a.y) + (a.z + a.w) + (c.x + c.y) + (c.z + c.w)) * (1.f / 128.f) + EPS); \
            const u32x2 g2 = *(const LAS u32x2*)(Gb + t * HG_STR + (16 * w + 4 * q4) * 2); \
            const float o0 = O[tb][0] * rinv * ngv[0] * bf2f(g2.x & 0xffffu), o1 = O[tb][1] * rinv * ngv[1] * bf2f(g2.x >> 16), o2 = O[tb][2] * rinv * ngv[2] * bf2f(g2.y & 0xffffu), o3 = O[tb][3] * rinv * ngv[3] * bf2f(g2.y >> 16); \
            *(u32x2*)(CAT + ((size_t)b * SEQ + st * 32 + t) * D + h * 128 + 16 * w + 4 * q4) = (u32x2){cvt_pk_bf16(o0, o1), cvt_pk_bf16(o2, o3)}; } \
        if (st < nsteps - 1) { HG_PUT(R_, (st + 1) & 1); if (st < nsteps - 2) HG_LOAD(R_, st + 2); } \
    } while (0)
#pragma unroll 1
    for (int st1 = 0; st1 < nsteps; ++st1) { HG_STEP(st1, RA); }
#undef HG_STEP
#undef HG_LOAD
#undef HG_PUT
    __syncthreads();
}
__device__ __forceinline__ void p_gu(Frame& F, int layer) {
    unsigned char* ws = F.ws;
    moe_tables(F, layer);
    const LAS int* ts = (const LAS int*)(F.lds + TS_OFF); LAS unsigned* tab = (LAS unsigned*)(F.lds + TAB_OFF);
    pg8::MoeOrder<true> S{ts, tab, F.G, F.vcu, D};
    { const int* ltok = (const int*)(ws + WS_LTOK); pg8::Unit u;
      for (int i = 0; i < 6 && S.next(i, u); ++i) if (F.tid < 256) { const int pos = u.rl * 256 + F.tid; const int tok = pos < ts[40 + u.e] ? ltok[(size_t)u.e * CAP + pos] : 0; tab[i * 256 + F.tid] = (unsigned)tok * (unsigned)(D * 2); }
      __syncthreads(); }
    pg8::EpiGU E{(bf16_t*)(ws + WS_HB), (const float*)(ws + WS_LRSTD), ts + 40};
    pg8::gemm_phase<pg8::EpiGU, pg8::MoeOrder<true>, true>(F.lds, (const bf16_t*)(ws + WS_XB), (const bf16_t*)(ws + WS_WGU), D, S, E);
}
__device__ __forceinline__ void p_dn(Frame& F, int layer) {
    unsigned char* ws = F.ws;
    moe_tables(F, layer);
    const LAS int* ts = (const LAS int*)(F.lds + TS_OFF);
    pg8::MoeOrder<false> S{ts, nullptr, F.G, F.vcu, DEXP};
    pg8::EpiDN E{(bf16_t*)(ws + WS_Y), (const float*)(ws + WS_LW), ts + 40};
    pg8::gemm_phase<pg8::EpiDN, pg8::MoeOrder<false>, true>(F.lds, (const bf16_t*)(ws + WS_HB), (const bf16_t*)(ws + WS_WDN), DEXP, S, E);
}

__global__ void __launch_bounds__(512, 2) fwd(Args args) {
    extern __shared__ __attribute__((aligned(16))) unsigned char lds_raw[];
    Frame F;
    F.lds = (LAS unsigned char*)lds_raw; F.tid = threadIdx.x; F.lane = F.tid & 63; F.wave = __builtin_amdgcn_readfirstlane(F.tid >> 6);
    F.G = gridDim.x; { const int bx = blockIdx.x; F.vcu = (F.G % 8 == 0) ? (bx % 8) * (F.G / 8) + bx / 8 : bx; }
    F.in = args.in; F.out = args.out; F.ws = args.ws;
    unsigned char* ws = args.ws;
    bf16_t* XB = (bf16_t*)(ws + WS_XB); bf16_t* CAT = (bf16_t*)(ws + WS_CAT); bf16_t* Z = (bf16_t*)(ws + WS_Z);
    float* RSTD = (float*)(ws + WS_RSTD);
#if MK_ONE_LAUNCH == 2
    cg::grid_group grid = cg::this_grid();
#define GRID_BAR() grid.sync()
#elif MK_ONE_LAUNCH == 1
    if (F.tid < 2) ((volatile LAS unsigned*)(F.lds + MISC_OFF))[F.tid] = 0u;
    __syncthreads();
    const XcdBarrier xbar = xcd_barrier_post((unsigned*)(ws + WS_CTL) + CW_BAR, (volatile LAS unsigned*)(F.lds + MISC_OFF));
#define GRID_BAR() xcd_barrier(xbar)
#else
#define GRID_BAR() do {} while (0)
#endif
    #ifndef PH_MASK
#define PH_MASK 0x7fff
#endif
#define PHE(p) ((PH_MASK >> (p)) & 1)
    const int lo = args.ph_lo, hi = args.ph_hi;
#ifndef PROBE_MASK
#define PROBE_MASK 0
#endif
#ifndef STAG_T
#define STAG_T 0
#endif
#define STAG(F) ((unsigned)(((F).vcu >> 0) & 3) * STAG_T)
#define REPN(k) (((PROBE_MASK >> (k)) & 1) ? 2 : 1)
#define IN(k) (PHE(k) && lo <= (k) && (k) < hi)
#define SEAM(k) do { if (lo <= (k) && (k) + 1 < hi) GRID_BAR(); } while (0)
    if (IN(PH_PRO)) { { p_prologue(F); } if (REPN(PH_PRO) == 2) { GRID_BAR(); { p_prologue(F); } } } SEAM(PH_PRO);
    if (IN(PH_IN0)) { { pg8::DenseOrder S; S.init(T, AB_IN, D, F.G, (int)blockIdx.x); pg8::EpiIn E{Z, AB_IN, RSTD, 0, 1 << 30, 0, 0, nullptr, nullptr};
        pg8::gemm_phase<pg8::EpiIn, pg8::DenseOrder, true>(F.lds, XB, (const bf16_t*)(ws + WS_WIN0), D, S, E, STAG(F)); } if (REPN(PH_IN0) == 2) { GRID_BAR(); { pg8::DenseOrder S; S.init(T, AB_IN, D, F.G, (int)blockIdx.x); pg8::EpiIn E{Z, AB_IN, RSTD, 0, 1 << 30, 0, 0, nullptr, nullptr};
        pg8::gemm_phase<pg8::EpiIn, pg8::DenseOrder, true>(F.lds, XB, (const bf16_t*)(ws + WS_WIN0), D, S, E, STAG(F)); } } } SEAM(PH_IN0);
    if (IN(PH_MIX0)) { { p_mix0(F); } if (REPN(PH_MIX0) == 2) { GRID_BAR(); { p_mix0(F); } } } SEAM(PH_MIX0);
    if (IN(PH_OUT0)) { { pg8::DenseOrder S; S.init(T, D, D, F.G, (int)blockIdx.x); pg8::EpiOut E{XB, 0};
        pg8::gemm_phase<pg8::EpiOut, pg8::DenseOrder, true>(F.lds, CAT, (const bf16_t*)(ws + WS_WOUT0), D, S, E); } if (REPN(PH_OUT0) == 2) { GRID_BAR(); { pg8::DenseOrder S; S.init(T, D, D, F.G, (int)blockIdx.x); pg8::EpiOut E{XB, 0};
        pg8::gemm_phase<pg8::EpiOut, pg8::DenseOrder, true>(F.lds, CAT, (const bf16_t*)(ws + WS_WOUT0), D, S, E); } } } SEAM(PH_OUT0);
    if (IN(PH_R1)) { p_router(F, 0); if (PROBE_X & 1) { GRID_BAR(); p_router(F, 0, 1); } } SEAM(PH_R1);
    if (IN(PH_GU0)) { { p_gu(F, 0); } if (REPN(PH_GU0) == 2) { GRID_BAR(); { p_gu(F, 0); } } } SEAM(PH_GU0);
    if (IN(PH_DN0)) { { p_dn(F, 0); } if (REPN(PH_DN0) == 2) { GRID_BAR(); { p_dn(F, 0); } } } SEAM(PH_DN0);
    if (IN(PH_R2)) { if (PROBE_X & 2) { p_combine(F, 0, 0, 1); GRID_BAR(); } p_combine(F, 0, 0); } SEAM(PH_R2);
    if (IN(PH_IN1)) { if (PROBE_X & 2048) { pg8::DenseOrder S; S.init(T, C_IN, D, F.G, (int)blockIdx.x); pg8::EpiNone E; pg8::gemm_phase<pg8::EpiNone, pg8::DenseOrder, true>(F.lds, XB, (const bf16_t*)(ws + WS_WIN1), D, S, E); GRID_BAR(); }
        if (PROBE_X & 4096) { pg8::DenseOrder S; S.init(T, C_IN, D, F.G, (int)blockIdx.x); pg8::EpiIn E{Z, C_IN, RSTD, 0, 3072, 1, 2048, (const float*)(ws + WS_LB), (float*)(ws + WS_EB)}; pg8::gemm_phase<pg8::EpiIn, pg8::DenseOrder, true>(F.lds, XB, (const bf16_t*)(ws + WS_WIN1), D, S, E); GRID_BAR(); } { pg8::DenseOrder S; S.init(T, C_IN, D, F.G, (int)blockIdx.x); pg8::EpiIn E{Z, C_IN, RSTD, 0, 3072, 0, 2048, (const float*)(ws + WS_LB), (float*)(ws + WS_EB)};
        pg8::gemm_phase<pg8::EpiIn, pg8::DenseOrder, true>(F.lds, XB, (const bf16_t*)(ws + WS_WIN1), D, S, E, STAG(F)); } if (REPN(PH_IN1) == 2) { GRID_BAR(); { pg8::DenseOrder S; S.init(T, C_IN, D, F.G, (int)blockIdx.x); pg8::EpiIn E{Z, C_IN, RSTD, 0, 3072, 0, 2048, (const float*)(ws + WS_LB), (float*)(ws + WS_EB)};
        pg8::gemm_phase<pg8::EpiIn, pg8::DenseOrder, true>(F.lds, XB, (const bf16_t*)(ws + WS_WIN1), D, S, E, STAG(F)); } } } SEAM(PH_IN1);
    if (IN(PH_MIX1)) { if (PROBE_X & 512) moe_convert(F, 1, F.vcu, F.G); if (F.vcu < 128) {
#pragma unroll 1
        for (int rep_ = 0; rep_ < ((PROBE_X & 256) ? 2 : 1); ++rep_) hgrn_item(F, F.vcu >> 3, F.vcu & 7, (rep_ && (PROBE_X >> 12)) ? (PROBE_X >> 12) : 64); } else { __syncthreads(); if (!(PROBE_X & 512)) moe_convert(F, 1, F.vcu - 128, F.G - 128); if (PROBE_X & 4) moe_convert(F, 1, F.vcu - 128, F.G - 128); } } SEAM(PH_MIX1);
    if (IN(PH_OUT1)) { if (PROBE_X & 16) { pg8::DenseOrder S; S.init(T, D, D, F.G, (int)blockIdx.x); pg8::EpiOut E{XB, 1};
        pg8::gemm_phase<pg8::EpiOut, pg8::DenseOrder, true>(F.lds, CAT, (const bf16_t*)(ws + WS_WOUT1), D, S, E); GRID_BAR(); }
 pg8::DenseOrder S; S.init(T, D, D, F.G, (int)blockIdx.x); pg8::EpiOut E{XB, 0};
        pg8::gemm_phase<pg8::EpiOut, pg8::DenseOrder, true>(F.lds, CAT, (const bf16_t*)(ws + WS_WOUT1), D, S, E); } SEAM(PH_OUT1);
    if (IN(PH_R3)) { p_router(F, 1); } SEAM(PH_R3);
    if (IN(PH_GU1)) { { p_gu(F, 1); } if (REPN(PH_GU1) == 2) { GRID_BAR(); { p_gu(F, 1); } } } SEAM(PH_GU1);
    if (IN(PH_DN1)) { { p_dn(F, 1); } if (REPN(PH_DN1) == 2) { GRID_BAR(); { p_dn(F, 1); } } } SEAM(PH_DN1);
    if (IN(PH_R4)) { if (PROBE_X & 8) { p_combine(F, 1, 1, 1); GRID_BAR(); } p_combine(F, 1, 1); }
}

extern "C" void kernel_launch(void* const* d_in, const int* in_sizes, int n_in, void* d_out, int out_size, void* d_ws, size_t ws_size, hipStream_t stream) {
    static int grid = 0;
    if (grid == 0) {
        if (n_in != 23 || out_size != T * D || ws_size < WS_END) { fprintf(stderr, "kernel_launch: unexpected shapes: n_in %d out %d ws %zu (need %zu)\n", n_in, out_size, ws_size, (size_t)WS_END); grid = -1; return; }
        if (hipFuncSetAttribute((const void*)fwd, hipFuncAttributeMaxDynamicSharedMemorySize, LDS_BYTES) != hipSuccess) { fprintf(stderr, "kernel_launch: hipFuncSetAttribute failed\n"); grid = -1; return; }
        int dev = 0, cus = 0, per_cu = 0;
        hipGetDevice(&dev); hipDeviceGetAttribute(&cus, hipDeviceAttributeMultiprocessorCount, dev);
        hipOccupancyMaxActiveBlocksPerMultiprocessor(&per_cu, (const void*)fwd, 512, LDS_BYTES);
        (void)hipGetLastError();
        fprintf(stderr, "kernel_launch: cus %d per_cu %d ws %zu\n", cus, per_cu, ws_size);
        grid = cus > 0 ? cus : 256;
        if (per_cu < 1) fprintf(stderr, "kernel_launch: occupancy query says %d blocks per CU\n", per_cu);
    }
    if (grid < 0) return;
    hipMemsetAsync((char*)d_ws + WS_CTL, 0, CTL_BYTES, stream);
    Args a{};
    for (int i = 0; i < 23; ++i) a.in[i] = (const float*)d_in[i];
    a.out = (float*)d_out; a.ws = (unsigned char*)d_ws;
#if MK_ONE_LAUNCH
    a.ph_lo = 0; a.ph_hi = NPH;
    void* kargs[] = {&a};
    hipError_t e = hipLaunchCooperativeKernel((const void*)fwd, dim3(grid), dim3(512), kargs, LDS_BYTES, stream);
    if (e != hipSuccess) fprintf(stderr, "cooperative launch failed: %s (grid %d)\n", hipGetErrorString(e), grid);
#else
    for (int ph = 0; ph < NPH; ++ph) { a.ph_lo = ph; a.ph_hi = ph + 1; hipLaunchKernelGGL(fwd, dim3(grid), dim3(512), LDS_BYTES, stream, a); }
#endif
}
```
